# Optimizing an MI355X kernel written in HIP

```python
import math
import jax, jax.numpy as jnp
from jax import lax
import numpy as np

D_MODEL = 1024
BATCH = 16
SEQ = 2048
DEPTH = 2

HEAD_DIM = 64
SSM_WIDTH = D_MODEL // 4
SSM_GROUP_CH = 16
SSM_GROUPS = SSM_WIDTH // SSM_GROUP_CH
SSM_STATE = 64
DT_MIN = 1e-3
DT_MAX = 1e-1
SWA_HEADS = (3 * D_MODEL // 8) // HEAD_DIM
SWA_KV_HEADS = 2
SWA_WINDOW = 128
MOBA_HEADS = (3 * D_MODEL // 8) // HEAD_DIM
MOBA_KV_HEADS = 2
MOBA_BLOCK = 256
MOBA_TOPK = 3
MOBA_Q_CHUNK = 32
D_MIX = SSM_WIDTH + (SWA_HEADS + MOBA_HEADS) * HEAD_DIM
PROJ_SIZES = (
    SSM_WIDTH, SSM_WIDTH,
    SWA_HEADS * HEAD_DIM, SWA_KV_HEADS * HEAD_DIM, SWA_KV_HEADS * HEAD_DIM, SWA_HEADS * HEAD_DIM,
    MOBA_HEADS * HEAD_DIM, MOBA_KV_HEADS * HEAD_DIM, MOBA_KV_HEADS * HEAD_DIM, MOBA_HEADS * HEAD_DIM,
)
D_PROJ = sum(PROJ_SIZES)
RMS_EPS = 1e-6

kernel_name = 'hybrid_s5_swa_moba_block'


def rms_norm(x, g):
    xf = x.astype(jnp.float32)
    y = xf * lax.rsqrt(jnp.mean(xf * xf, axis=-1, keepdims=True) + RMS_EPS)
    return (y * g.astype(jnp.float32)).astype(x.dtype)


def s5_mixer(u, lam_re, lam_im, log_dt, b_re, b_im, c_re, c_im, d, glu_w, glu_b):
    bsz, seqlen, width = u.shape
    f32 = jnp.float32
    uf = u.astype(f32).reshape(bsz, seqlen, SSM_GROUPS, SSM_GROUP_CH)
    dt = jnp.exp(log_dt.astype(f32))[:, None]
    lr = lam_re.astype(f32)
    li = lam_im.astype(f32)
    mag = jnp.exp(lr * dt)
    abar_re = mag * jnp.cos(li * dt)
    abar_im = mag * jnp.sin(li * dt)
    den = lr * lr + li * li
    nr = abar_re - 1.0
    ni = abar_im
    cr = (nr * lr + ni * li) / den
    ci = (ni * lr - nr * li) / den
    br = b_re.astype(f32)
    bi = b_im.astype(f32)
    bbar_re = cr[..., None] * br - ci[..., None] * bi
    bbar_im = cr[..., None] * bi + ci[..., None] * br
    bu_re = jnp.einsum('blgh,gph->blgp', uf, bbar_re)
    bu_im = jnp.einsum('blgh,gph->blgp', uf, bbar_im)
    a_re = jnp.broadcast_to(abar_re, bu_re.shape)
    a_im = jnp.broadcast_to(abar_im, bu_im.shape)

    def combine(e1, e2):
        a1r, a1i, b1r, b1i = e1
        a2r, a2i, b2r, b2i = e2
        return (a2r * a1r - a2i * a1i,
                a2r * a1i + a2i * a1r,
                a2r * b1r - a2i * b1i + b2r,
                a2r * b1i + a2i * b1r + b2i)

    _, _, xs_re, xs_im = lax.associative_scan(combine, (a_re, a_im, bu_re, bu_im), axis=1)
    y = (jnp.einsum('blgp,ghp->blgh', xs_re, c_re.astype(f32))
         - jnp.einsum('blgp,ghp->blgh', xs_im, c_im.astype(f32)))
    y = y.reshape(bsz, seqlen, width) + d.astype(f32) * u.astype(f32)
    y = jax.nn.gelu(y)
    y = y * jax.nn.sigmoid(jnp.einsum('ble,ef->blf', y, glu_w.astype(f32)) + glu_b.astype(f32))
    return y.astype(u.dtype)


def swa_attention(q, k, v, sink):
    bsz, seqlen, n_q, hd = q.shape
    n_kv = k.shape[2]
    grp = n_q // n_kv
    w = SWA_WINDOW
    nblk = seqlen // w
    qb = q.reshape(bsz, nblk, w, n_kv, grp, hd)

    def band(a):
        prev = jnp.pad(a, ((0, 0), (w, 0), (0, 0), (0, 0)))[:, :seqlen]
        return jnp.concatenate([prev.reshape(bsz, nblk, w, n_kv, hd),
                                a.reshape(bsz, nblk, w, n_kv, hd)], axis=2)

    kb = band(k)
    vb = band(v)
    s = jnp.einsum('bnqhgd,bnshd->bnhgqs', qb, kb).astype(jnp.float32) * (hd ** -0.5)
    qi = jnp.arange(w)[:, None]
    si = jnp.arange(2 * w)[None, :]
    rel = qi + w - si
    in_win = (rel >= 0) & (rel < w)
    blk = jnp.arange(nblk)[:, None, None]
    mask = in_win[None] & ((blk > 0) | (si[None] >= w))
    s = jnp.where(mask[None, :, None, None], s, -jnp.inf)
    sink_l = jnp.broadcast_to(sink.astype(jnp.float32).reshape(1, 1, n_kv, grp, 1, 1),
                              s.shape[:-1] + (1,))
    p = jax.nn.softmax(jnp.concatenate([s, sink_l], axis=-1), axis=-1)[..., :-1]
    o = jnp.einsum('bnhgqs,bnshd->bnqhgd', p.astype(vb.dtype), vb)
    return o.reshape(bsz, seqlen, n_q * hd)


def moba_attention(q, k, v):
    bsz, seqlen, n_q, hd = q.shape
    n_kv = k.shape[2]
    grp = n_q // n_kv
    f32 = jnp.float32
    nb = -(-seqlen // MOBA_BLOCK)
    padded = nb * MOBA_BLOCK
    pad = ((0, 0), (0, padded - seqlen), (0, 0), (0, 0))
    kp = jnp.pad(k, pad).reshape(bsz, nb, MOBA_BLOCK, n_kv, hd)
    vp = jnp.pad(v, pad).reshape(bsz, nb, MOBA_BLOCK, n_kv, hd)
    k_mean = jnp.mean(kp.astype(f32), axis=2)
    kb = kp.transpose(0, 3, 1, 2, 4)
    vb = vp.transpose(0, 3, 1, 2, 4)
    qg = q.reshape(bsz, seqlen, n_kv, grp, hd)
    pos = jnp.arange(seqlen, dtype=jnp.int32)
    q_blk = pos // MOBA_BLOCK
    gate = jnp.einsum('blhgd,bnhd->blhn', qg.astype(f32), k_mean)
    fully_past = jnp.arange(nb, dtype=jnp.int32)[None, :] < q_blk[:, None]
    gate = jnp.where(fully_past[None, :, None, :], gate, -jnp.inf)
    n_sel = min(MOBA_TOPK, nb)
    _, sel = lax.top_k(gate, n_sel)
    sel = sel.astype(jnp.int32)
    sel_ok = sel < q_blk[None, :, None, None]
    own = jnp.broadcast_to(q_blk[None, :, None, None], (bsz, seqlen, n_kv, 1))
    idx = jnp.concatenate([sel, own], axis=-1)
    slot_ok = jnp.concatenate([sel_ok, jnp.ones(own.shape, dtype=bool)], axis=-1)
    n_chunks = seqlen // MOBA_Q_CHUNK

    def to_chunks(a):
        return jnp.moveaxis(a.reshape((bsz, n_chunks, MOBA_Q_CHUNK) + a.shape[2:]), 1, 0)

    b_ix = jnp.arange(bsz)[:, None, None, None]
    h_ix = jnp.arange(n_kv)[None, None, :, None]
    blk_off = jnp.arange(MOBA_BLOCK, dtype=jnp.int32)
    scale = hd ** -0.5

    def attend_chunk(args):
        qc, ic, oc, pc = args
        kg = kb[b_ix, h_ix, ic]
        vg = vb[b_ix, h_ix, ic]
        s = jnp.einsum('bchgd,bchnkd->bchgnk', qc, kg).astype(f32) * scale
        key_pos = ic[..., None] * MOBA_BLOCK + blk_off
        ok = oc[..., None] & (key_pos <= pc[None, :, None, None, None])
        s = jnp.where(ok[:, :, :, None], s, -jnp.inf)
        shp = s.shape
        p = jax.nn.softmax(s.reshape(shp[:4] + (-1,)), axis=-1).reshape(shp)
        return jnp.einsum('bchgnk,bchnkd->bchgd', p.astype(vg.dtype), vg)

    out = lax.map(attend_chunk, (to_chunks(qg), to_chunks(idx), to_chunks(slot_ok),
                                 pos.reshape(n_chunks, MOBA_Q_CHUNK)))
    return jnp.moveaxis(out, 0, 1).reshape(bsz, seqlen, n_q * hd)


def hybrid_layer(x, norm_g, w_in, lam_re, lam_im, log_dt, b_re, b_im, c_re, c_im, d,
                 glu_w, glu_b, swa_q_norm, swa_k_norm, swa_sink, moba_q_norm, moba_k_norm, w_out):
    bsz, seqlen, _ = x.shape
    h = rms_norm(x, norm_g)
    proj = jnp.einsum('bld,de->ble', h, w_in)
    parts = []
    off = 0
    for n in PROJ_SIZES:
        parts.append(proj[..., off:off + n])
        off += n
    s_u, s_g, a_q, a_k, a_v, a_g, m_q, m_k, m_v, m_g = parts

    def heads(t, n):
        return t.reshape(bsz, seqlen, n, HEAD_DIM)

    y_ssm = s5_mixer(s_u, lam_re, lam_im, log_dt, b_re, b_im, c_re, c_im, d, glu_w, glu_b) * jax.nn.silu(s_g)
    aq = rms_norm(heads(a_q, SWA_HEADS), swa_q_norm)
    ak = rms_norm(heads(a_k, SWA_KV_HEADS), swa_k_norm)
    y_swa = swa_attention(aq, ak, heads(a_v, SWA_KV_HEADS), swa_sink) * jax.nn.silu(a_g)
    mq = rms_norm(heads(m_q, MOBA_HEADS), moba_q_norm)
    mk = rms_norm(heads(m_k, MOBA_KV_HEADS), moba_k_norm)
    y_moba = moba_attention(mq, mk, heads(m_v, MOBA_KV_HEADS)) * jax.nn.silu(m_g)
    y = jnp.concatenate([y_ssm, y_swa.astype(y_ssm.dtype), y_moba.astype(y_ssm.dtype)], axis=-1)
    return x + jnp.einsum('ble,ed->bld', y, w_out).astype(x.dtype)


def setup_inputs(seed: int = 0) -> dict:
    key = jax.random.key(seed)
    ks = jax.random.split(key, 19)
    f32 = jnp.float32
    nrm = jax.random.normal
    G, P, H = SSM_GROUPS, SSM_STATE, SSM_GROUP_CH
    n_idx = jnp.arange(P, dtype=f32)
    return {
        'x': nrm(ks[0], (BATCH, SEQ, D_MODEL), f32),
        'norm_g': 1.0 + 0.02 * nrm(ks[1], (DEPTH, D_MODEL), f32),
        'w_in': nrm(ks[2], (DEPTH, D_MODEL, D_PROJ), f32) * D_MODEL ** -0.5,
        'ssm_lam_re': -0.5 + 0.01 * nrm(ks[3], (DEPTH, G, P), f32),
        'ssm_lam_im': math.pi * n_idx + 0.01 * nrm(ks[4], (DEPTH, G, P), f32),
        'ssm_log_dt': jax.random.uniform(ks[5], (DEPTH, G), f32, math.log(DT_MIN), math.log(DT_MAX)),
        'ssm_b_re': nrm(ks[6], (DEPTH, G, P, H), f32) * (2 * H) ** -0.5,
        'ssm_b_im': nrm(ks[7], (DEPTH, G, P, H), f32) * (2 * H) ** -0.5,
        'ssm_c_re': nrm(ks[8], (DEPTH, G, H, P), f32) * P ** -0.5,
        'ssm_c_im': nrm(ks[9], (DEPTH, G, H, P), f32) * P ** -0.5,
        'ssm_d': nrm(ks[10], (DEPTH, SSM_WIDTH), f32),
        'ssm_glu_w': nrm(ks[11], (DEPTH, SSM_WIDTH, SSM_WIDTH), f32) * SSM_WIDTH ** -0.5,
        'ssm_glu_b': 0.02 * nrm(ks[12], (DEPTH, SSM_WIDTH), f32),
        'swa_q_norm': 1.0 + 0.02 * nrm(ks[13], (DEPTH, HEAD_DIM), f32),
        'swa_k_norm': 1.0 + 0.02 * nrm(ks[14], (DEPTH, HEAD_DIM), f32),
        'swa_sink': 0.5 * nrm(ks[15], (DEPTH, SWA_HEADS), f32),
        'moba_q_norm': 1.0 + 0.02 * nrm(ks[16], (DEPTH, HEAD_DIM), f32),
        'moba_k_norm': 1.0 + 0.02 * nrm(ks[17], (DEPTH, HEAD_DIM), f32),
        'w_out': nrm(ks[18], (DEPTH, D_MIX, D_MODEL), f32) * D_MIX ** -0.5,
    }


def reference(x, norm_g, w_in, ssm_lam_re, ssm_lam_im, ssm_log_dt, ssm_b_re, ssm_b_im,
              ssm_c_re, ssm_c_im, ssm_d, ssm_glu_w, ssm_glu_b, swa_q_norm, swa_k_norm,
              swa_sink, moba_q_norm, moba_k_norm, w_out):
    for l in range(DEPTH):
        x = hybrid_layer(x, norm_g[l], w_in[l], ssm_lam_re[l], ssm_lam_im[l], ssm_log_dt[l],
                         ssm_b_re[l], ssm_b_im[l], ssm_c_re[l], ssm_c_im[l], ssm_d[l],
                         ssm_glu_w[l], ssm_glu_b[l], swa_q_norm[l], swa_k_norm[l], swa_sink[l],
                         moba_q_norm[l], moba_k_norm[l], w_out[l])
    return x
```

```cpp
#include <hip/hip_runtime.h>
#include <hip/hip_cooperative_groups.h>
#include <cstdio>
#include <cstdint>
namespace cg = cooperative_groups;
namespace pg8 {
#define PG8_LAS __attribute__((address_space(3)))
typedef unsigned short bf16_t;
typedef short bf16x8 __attribute__((ext_vector_type(8)));
typedef float f32x4 __attribute__((ext_vector_type(4)));
typedef unsigned u32x4 __attribute__((ext_vector_type(4)));
constexpr int BM = 256, BK = 64, HALF = 128, HTB = HALF * BK * 2  , STAGE_BYTES = 8 * HTB, NXCD = 8, WGM = 8;

__host__ __device__ __forceinline__ int lds_byte(int r, int c) { const int st = (r >> 4) * 2 + (c >> 5), rr = r & 15, cc = c & 31, ob = rr * 64 + cc * 2; return st * 1024 + (ob ^ (((ob >> 9) & 1) << 5)); }
__host__ __device__ __forceinline__ void stage_rc(int b, int& R, int& C) { const int st = b / 1024, sb = b % 1024, swz = sb ^ (((sb >> 9) & 1) << 5); R = (st >> 1) * 16 + swz / 64; C = (st & 1) * 32 + (swz % 64) / 2; }
__host__ __device__ __forceinline__ int perm32(int rho) { const int n = rho >> 4, i = rho & 15; return 8 * (i >> 2) + 4 * n + (i & 3); }

struct Unit { int pm, pn; };
struct Gemm { const bf16_t* A; const bf16_t* Bt; int M, N, K; };

__device__ __forceinline__ unsigned cvt_pk_bf16(float lo, float hi) { unsigned r; asm volatile("v_cvt_pk_bf16_f32 %0, %1, %2" : "=v"(r) : "v"(lo), "v"(hi)); return r; }
typedef float f32x2 __attribute__((ext_vector_type(2)));
template <class Epi, class Sched, bool ALIGN_EPI = false, bool SP2 = false>
__device__ __forceinline__ void gemm_phase(PG8_LAS unsigned char* lds, const Gemm g, const Sched& S, const Epi& E) {
    int tid_ = threadIdx.x; asm volatile("" : "+v"(tid_));
    const int tid = tid_, wid = __builtin_amdgcn_readfirstlane(tid >> 6), lane = tid & 63, wr = wid >> 2, wc = wid & 3, fr = lane & 15, fq = lane >> 4;
    const int K = g.K, nt = K / BK;
    unsigned voffA[2], voffB[2];
#pragma unroll
    for (int i = 0; i < 2; ++i) { int R, C; stage_rc(tid * 16 + i * 8192, R, C); const int Rb = Epi::PERM ? ((R & ~31) + perm32(R & 31)) : R;
        voffA[i] = (unsigned)(R * K + C) * 2u; voffB[i] = (unsigned)(Rb * K + C) * 2u; }
    const size_t kstep = (size_t)(BK * 2);
    const size_t hstep = (size_t)HALF * K * 2;
    const size_t tstep = 2 * hstep;
    const unsigned ldsw = (unsigned)wid * 1024u;
    const int aoff = lds_byte(wr * 64 + fr, fq * 8), boff = lds_byte(wc * 32 + fr, fq * 8);
#define PG8_SA(b, h) (((b) * 2 + (h)) * HTB)
#define PG8_SB(b, h) ((4 + (b) * 2 + (h)) * HTB)
#define PG8_STAGE(bufoff, gbase, voff) do { _Pragma("unroll") for (int _i = 0; _i < 2; ++_i) \
        __builtin_amdgcn_global_load_lds((const unsigned*)((const char*)(gbase) + (voff)[_i]), (PG8_LAS unsigned*)(lds + (bufoff) + ldsw + _i * 8192), 16, 0, 0); } while (0)
#define PG8_LDA(dst, b, h) do { _Pragma("unroll") for (int m = 0; m < 4; ++m) _Pragma("unroll") for (int k = 0; k < 2; ++k) dst[m][k] = *(const PG8_LAS bf16x8*)(lds + PG8_SA(b, h) + aoff + m * 2048 + k * 1024); } while (0)
#define PG8_LDB(dst, b, h) do { _Pragma("unroll") for (int n = 0; n < 2; ++n) _Pragma("unroll") for (int k = 0; k < 2; ++k) dst[n][k] = *(const PG8_LAS bf16x8*)(lds + PG8_SB(b, h) + boff + n * 2048 + k * 1024); } while (0)
#define PG8_MMA(ai, bj, At, Bt) do { __builtin_amdgcn_s_setprio(1); _Pragma("unroll") for (int m = 0; m < 4; ++m) _Pragma("unroll") for (int n = 0; n < 2; ++n) _Pragma("unroll") for (int k = 0; k < 2; ++k) \
        acc[ai][bj][m][n] = __builtin_amdgcn_mfma_f32_16x16x32_bf16(Bt[n][k], At[m][k], acc[ai][bj][m][n], 0, 0, 0); __builtin_amdgcn_s_setprio(0); } while (0)
#define PG8_WAIT_V(n) asm volatile("s_waitcnt vmcnt(" #n ")" ::: "memory")
#define PG8_WAIT_L(n) asm volatile("s_waitcnt lgkmcnt(" #n ")" ::: "memory")
#define PG8_BAR __builtin_amdgcn_s_barrier()
#define PG8_SCHED __builtin_amdgcn_sched_barrier(0)
    Unit cur, nxt; int ui = 0;
    if (!S.next(0, cur)) return;
    f32x4 acc[2][2][4][2];
#pragma unroll
    for (int a = 0; a < 2; ++a)
#pragma unroll
        for (int b = 0; b < 2; ++b)
#pragma unroll
            for (int m = 0; m < 4; ++m)
#pragma unroll
                for (int n = 0; n < 2; ++n) acc[a][b][m][n] = (f32x4){0.f, 0.f, 0.f, 0.f};
    bf16x8 At[4][2], B0[2][2], B1[2][2];
    const char* cA = (const char*)g.A + (size_t)cur.pm * tstep; const char* cB = (const char*)g.Bt + (size_t)cur.pn * tstep;
    S.a_ready(cur);
    if constexpr (SP2) {
        PG8_STAGE(PG8_SB(0, 0), cB, voffB); PG8_STAGE(PG8_SB(0, 1), cB + hstep, voffB); PG8_STAGE(PG8_SA(0, 0), cA, voffA); PG8_STAGE(PG8_SA(0, 1), cA + hstep, voffA);
        if (wr == 1) PG8_BAR;
        PG8_WAIT_V(2); PG8_BAR;
        PG8_STAGE(PG8_SB(1, 0), cB + kstep, voffB); PG8_STAGE(PG8_SA(1, 0), cA + kstep, voffA); PG8_STAGE(PG8_SB(1, 1), cB + hstep + kstep, voffB);
        PG8_WAIT_V(6); PG8_BAR;
    } else {
        PG8_STAGE(PG8_SB(0, 0), cB, voffB); PG8_STAGE(PG8_SA(0, 0), cA, voffA); PG8_STAGE(PG8_SB(0, 1), cB + hstep, voffB); PG8_STAGE(PG8_SA(0, 1), cA + hstep, voffA);
        if (wr == 1) PG8_BAR;
        PG8_WAIT_V(4); PG8_BAR;
        PG8_STAGE(PG8_SB(1, 0), cB + kstep, voffB); PG8_STAGE(PG8_SA(1, 0), cA + kstep, voffA); PG8_STAGE(PG8_SB(1, 1), cB + hstep + kstep, voffB);
        PG8_WAIT_V(6); PG8_BAR;
    }
    for (;;) {
        const bool has_next = S.next(ui + 1, nxt);
        const char* nA = has_next ? (const char*)g.A + (size_t)nxt.pm * tstep : cA; const char* nB = has_next ? (const char*)g.Bt + (size_t)nxt.pn * tstep : cB;
        for (int t = 0; t < nt; t += 2) {
            const bool last = (t == nt - 2);
            const char* a1 = cA + (size_t)(t + 1) * kstep;
            const char* a2 = last ? nA : cA + (size_t)(t + 2) * kstep; const char* b2 = last ? nB : cB + (size_t)(t + 2) * kstep;
            const char* a3 = a2 + kstep; const char* b3 = b2 + kstep;
            if (last && has_next) S.a_ready(nxt);
            if constexpr (SP2) {
            PG8_LDB(B0, 0, 0); PG8_LDB(B1, 0, 1); PG8_SCHED; PG8_LDA(At, 0, 0); PG8_STAGE(PG8_SA(1, 1), a1 + hstep, voffA);
            PG8_WAIT_V(8); PG8_WAIT_L(0); PG8_BAR; PG8_MMA(0, 0, At, B0); PG8_MMA(0, 1, At, B1); PG8_BAR; PG8_SCHED;
            PG8_LDA(At, 0, 1); PG8_STAGE(PG8_SB(0, 0), b2, voffB); PG8_STAGE(PG8_SB(0, 1), b2 + hstep, voffB); PG8_STAGE(PG8_SA(0, 0), a2, voffA);
            PG8_WAIT_V(8); PG8_WAIT_L(0); PG8_BAR; PG8_MMA(1, 0, At, B0); PG8_MMA(1, 1, At, B1); PG8_BAR; PG8_SCHED;
            PG8_LDB(B0, 1, 0); PG8_LDB(B1, 1, 1); PG8_SCHED; PG8_LDA(At, 1, 0); PG8_STAGE(PG8_SA(0, 1), a2 + hstep, voffA);
            PG8_WAIT_V(8); PG8_WAIT_L(0); PG8_BAR; PG8_MMA(0, 0, At, B0); PG8_MMA(0, 1, At, B1); PG8_BAR; PG8_SCHED;
            PG8_LDA(At, 1, 1); PG8_STAGE(PG8_SB(1, 0), b3, voffB); PG8_STAGE(PG8_SB(1, 1), b3 + hstep, voffB); PG8_STAGE(PG8_SA(1, 0), a3, voffA);
            PG8_WAIT_V(8); PG8_WAIT_L(0); PG8_BAR; PG8_MMA(1, 0, At, B0); PG8_MMA(1, 1, At, B1); PG8_BAR; PG8_SCHED;
            } else {
            PG8_LDB(B0, 0, 0); PG8_SCHED; PG8_LDA(At, 0, 0); PG8_STAGE(PG8_SA(1, 1), a1 + hstep, voffA);
            PG8_WAIT_L(8); PG8_BAR; PG8_WAIT_L(0); PG8_MMA(0, 0, At, B0); PG8_BAR; PG8_SCHED;
            PG8_LDB(B1, 0, 1); PG8_STAGE(PG8_SB(0, 0), b2, voffB);
            PG8_BAR; PG8_WAIT_L(0); PG8_MMA(0, 1, At, B1); PG8_BAR;
            PG8_LDA(At, 0, 1); PG8_STAGE(PG8_SA(0, 0), a2, voffA);
            PG8_BAR; PG8_WAIT_L(0); PG8_MMA(1, 0, At, B0); PG8_BAR; PG8_SCHED;
            PG8_STAGE(PG8_SB(0, 1), b2 + hstep, voffB);
            PG8_WAIT_V(6); PG8_BAR; PG8_MMA(1, 1, At, B1); PG8_BAR;
            PG8_LDB(B0, 1, 0); PG8_SCHED; PG8_LDA(At, 1, 0); PG8_STAGE(PG8_SA(0, 1), a2 + hstep, voffA);
            PG8_WAIT_L(8); PG8_BAR; PG8_WAIT_L(0); PG8_MMA(0, 0, At, B0); PG8_BAR; PG8_SCHED;
            PG8_LDB(B1, 1, 1); PG8_STAGE(PG8_SB(1, 0), b3, voffB);
            PG8_BAR; PG8_WAIT_L(0); PG8_MMA(0, 1, At, B1); PG8_BAR;
            PG8_LDA(At, 1, 1); PG8_STAGE(PG8_SA(1, 0), a3, voffA);
            PG8_BAR; PG8_WAIT_L(0); PG8_MMA(1, 0, At, B0); PG8_BAR; PG8_SCHED;
            PG8_STAGE(PG8_SB(1, 1), b3 + hstep, voffB);
            PG8_WAIT_V(6); PG8_BAR; PG8_MMA(1, 1, At, B1); PG8_BAR;
            }
        }
        if constexpr (ALIGN_EPI) { if (wr == 0) PG8_BAR; }
        if constexpr (!Epi::AFTER_DRAIN) { E(acc, cur, wr, wc, fr, fq); S.done(cur); }
        if (!has_next) break;
#pragma unroll
        for (int a = 0; a < 2; ++a)
#pragma unroll
            for (int b = 0; b < 2; ++b)
#pragma unroll
                for (int m = 0; m < 4; ++m)
#pragma unroll
                    for (int n = 0; n < 2; ++n) acc[a][b][m][n] = (f32x4){0.f, 0.f, 0.f, 0.f};
        cur = nxt; cA = nA; cB = nB; ++ui;
        if constexpr (ALIGN_EPI) { if (wr == 1) PG8_BAR; }
    }
    PG8_WAIT_V(0);
    if constexpr (!ALIGN_EPI) { if (wr == 0) PG8_BAR; }
    PG8_BAR;
    if constexpr (Epi::AFTER_DRAIN) { E.fused(acc, cur, wr, wc, fr, fq, lds, wid, lane); S.done(cur); }
#undef PG8_SA
#undef PG8_SB
#undef PG8_STAGE
#undef PG8_LDA
#undef PG8_LDB
#undef PG8_MMA
#undef PG8_WAIT_V
#undef PG8_WAIT_L
#undef PG8_BAR
#undef PG8_SCHED
}
}

#define GAS __attribute__((address_space(1)))
#define LAS __attribute__((address_space(3)))
typedef unsigned short bf16;
typedef short bf16x8 __attribute__((ext_vector_type(8)));
typedef float f32x4 __attribute__((ext_vector_type(4)));
typedef float f32x16 __attribute__((ext_vector_type(16)));
typedef unsigned u32x4 __attribute__((ext_vector_type(4)));
typedef unsigned u32x2 __attribute__((ext_vector_type(2)));
typedef float f32x2_t __attribute__((ext_vector_type(2)));
typedef __bf16 bf16x2_t __attribute__((ext_vector_type(2)));
using pg8::Unit;

constexpr int NB = 16, SEQ = 2048, MTOK = NB * SEQ, DM = 1024, NPROJ = 2560, DEPTH = 2;
constexpr int NTT = MTOK / 256;
constexpr int ZROWS = MTOK + DEPTH * NPROJ;
constexpr float RMS_EPS = 1e-6f;
constexpr float LOG2E = 1.4426950408889634f;
constexpr float QSCALE = 0.125f * LOG2E;
constexpr int LDS_BYTES = 147456;
constexpr int LDS_MISC = 131072;

constexpr size_t MiB = 1u << 20;
constexpr size_t WS_CTL = 0, CTL_BYTES = 1 * MiB;
constexpr size_t WS_Z = 2 * MiB, WS_WOUT = 78 * MiB, WS_GLU = 82 * MiB, WS_TE = 83 * MiB, WS_G = 89 * MiB, WS_AT = 91 * MiB;
constexpr size_t WS_U = 92 * MiB, WS_SG = 108 * MiB, WS_AQ = 124 * MiB, WS_AK = 148 * MiB, WS_AG = 156 * MiB, WS_MQ = 180 * MiB, WS_MK = 204 * MiB, WS_MG = 212 * MiB;
constexpr size_t WS_VT = 236 * MiB, WS_KPART = 252 * MiB, WS_ROWSS = 253 * MiB, WS_YPRE = 254 * MiB, WS_Y = 270 * MiB, WS_END = 334 * MiB;
static_assert(WS_Z + (size_t)ZROWS * DM * 2 <= WS_WOUT, "Z fits");
constexpr size_t WS_NW = 1 * MiB;
constexpr int TE_ELEMS = 256 * 384, G_ELEMS = 128 * 256;
constexpr int CW_QUEUE = 1024;

__device__ __forceinline__ unsigned pk2(float lo, float hi) { f32x2_t v = {lo, hi}; bf16x2_t b = __builtin_convertvector(v, bf16x2_t); return __builtin_bit_cast(unsigned, b); }
__device__ __forceinline__ float bf2f(unsigned short x) { return __uint_as_float((unsigned)x << 16); }
__device__ __forceinline__ float bflo(unsigned w) { return __uint_as_float(w << 16); }
__device__ __forceinline__ float bfhi(unsigned w) { return __uint_as_float(w & 0xffff0000u); }
__device__ __forceinline__ float wave_sum(float v) {
#pragma unroll
    for (int o = 1; o < 64; o <<= 1) v += __shfl_xor(v, o);
    return v;
}
__device__ __forceinline__ float fast_rcp(float x) { return __builtin_amdgcn_rcpf(x); }
__device__ __forceinline__ float silu_f(float x) { return x * fast_rcp(1.f + __builtin_amdgcn_exp2f(-x * LOG2E)); }
__device__ __forceinline__ float sigmoid_f(float x) { return fast_rcp(1.f + __builtin_amdgcn_exp2f(-x * LOG2E)); }
__device__ __forceinline__ float gelu_tanh_f(float x) { const float z = 0.7978845608028654f * (x + 0.044715f * x * x * x); return x * fast_rcp(1.f + __builtin_amdgcn_exp2f(-2.f * LOG2E * z)); }
__device__ __forceinline__ float swap32_max(float m) { auto rr = __builtin_amdgcn_permlane32_swap(__float_as_uint(m), __float_as_uint(m), false, false); return fmaxf(__uint_as_float(rr[0]), __uint_as_float(rr[1])); }
__device__ __forceinline__ float swap32_sum(float m) { auto rr = __builtin_amdgcn_permlane32_swap(__float_as_uint(m), __float_as_uint(m), false, false); return __uint_as_float(rr[0]) + __uint_as_float(rr[1]); }
__device__ __forceinline__ void glds16(const void* gsrc, LAS unsigned char* ldst) {
    __builtin_amdgcn_global_load_lds((const unsigned*)gsrc, (LAS unsigned*)ldst, 16, 0, 0);
}

struct Params {
    const float* in[19]; float* out; unsigned char* ws;
};
typedef const float* const __attribute__((address_space(4))) * kargs_t;
__device__ __forceinline__ const float* kin(int i) { kargs_t ka = (kargs_t)__builtin_amdgcn_kernarg_segment_ptr(); asm volatile("" : "+s"(ka)); return ka[i]; }
struct Frame {
    LAS unsigned char* lds; int tid, lane, wave, G, bid; float* out; unsigned char* ws; unsigned* ctl;
};

__device__ __forceinline__ int proj_dest_row(int n0) {
    int slot, off;
    if (n0 < 512)       { slot = n0 >> 6; off = n0 & 63; }
    else if (n0 < 1024) { slot = 8 + ((n0 - 512) >> 6); off = n0 & 63; }
    else if (n0 < 1152) { return 2304 + (n0 - 1024); }
    else if (n0 < 1536) { slot = 16 + ((n0 - 1152) >> 6); off = (n0 - 1152) & 63; }
    else if (n0 < 1920) { slot = 22 + ((n0 - 1536) >> 6); off = (n0 - 1536) & 63; }
    else if (n0 < 2048) { slot = 28 + ((n0 - 1920) >> 6); off = (n0 - 1920) & 63; }
    else if (n0 < 2176) { return 2304 + 128 + (n0 - 2048); }
    else                { slot = 30 + ((n0 - 2176) >> 6); off = (n0 - 2176) & 63; }
    const int t = slot >> 2, wc = slot & 3;
    return 256 * t + 128 * (off >> 5) + 32 * wc;
}
__device__ __forceinline__ void p0_transpose_item(const float* W, int K, int N, const float* gk, bf16* WT, int ldk, int drow0, LAS float* scr, int k0, int n0, int lane) {
#pragma unroll 8
    for (int i = 0; i < 32; ++i) { const int kk = 2 * i + (lane >> 5); float v = W[(size_t)(k0 + kk) * N + n0 + (lane & 31)]; if (gk) v *= gk[k0 + kk]; scr[kk * 33 + (lane & 31)] = v; }
    asm volatile("s_waitcnt lgkmcnt(0)" ::: "memory");
    const int c = lane & 7;
#pragma unroll
    for (int j = 0; j < 4; ++j) { const int n = (lane >> 3) + 8 * j; const LAS float* s = scr + (8 * c) * 33 + n;
        u32x4 o; o.x = pk2(s[0 * 33], s[1 * 33]); o.y = pk2(s[2 * 33], s[3 * 33]); o.z = pk2(s[4 * 33], s[5 * 33]); o.w = pk2(s[6 * 33], s[7 * 33]);
        *(u32x4*)(WT + (size_t)(drow0 + n) * ldk + k0 + 8 * c) = o; }
    asm volatile("s_waitcnt lgkmcnt(0)" ::: "memory");
}
__device__ __forceinline__ void p0_ssm_consts(const Params& P, Frame& F, int pair) {
    const int l = pair >> 4, g = pair & 15, tid = F.tid;
    LAS float* pwr = (LAS float*)(F.lds);
    LAS float* pwi = pwr + 17 * 64;
    LAS float* bbr = pwi + 17 * 64;
    LAS float* bbi = bbr + 1024;
    LAS float* ccr = bbi + 1024;
    LAS float* cci = ccr + 1024;
    LAS float* Kt = cci + 1024;
    const float dt = expf(kin(5)[l * 16 + g]);
    const float* lre = kin(3) + (l * 16 + g) * 64; const float* lim = kin(4) + (l * 16 + g) * 64;
    for (int t = tid; t < 17 * 64; t += 512) { const int p = t & 63, lag = t >> 6; const float lr = lre[p], li = lim[p];
        const float mag = expf(lr * dt * (float)lag); float sn, cs; sincosf(li * dt * (float)lag, &sn, &cs); pwr[t] = mag * cs; pwi[t] = mag * sn; }
    for (int t = tid; t < 1024; t += 512) { const int p = t >> 4, h = t & 15; const float lr = lre[p], li = lim[p];
        const float mag = expf(lr * dt); float sn, cs; sincosf(li * dt, &sn, &cs); const float ar = mag * cs, ai = mag * sn;
        const float den = lr * lr + li * li, nr = ar - 1.f, ni = ai; const float cr = (nr * lr + ni * li) / den, ci = (ni * lr - nr * li) / den;
        const float br = kin(6)[((size_t)(l * 16 + g) * 64 + p) * 16 + h], bi = kin(7)[((size_t)(l * 16 + g) * 64 + p) * 16 + h];
        bbr[t] = cr * br - ci * bi; bbi[t] = cr * bi + ci * br; }
    for (int t = tid; t < 1024; t += 512) { ccr[t] = kin(8)[(size_t)(l * 16 + g) * 1024 + t]; cci[t] = kin(9)[(size_t)(l * 16 + g) * 1024 + t]; }
    __syncthreads();
    for (int t = tid; t < 4096; t += 512) { const int lag = t >> 8, hp = (t >> 4) & 15, h = t & 15; float s = 0.f;
        for (int p = 0; p < 64; ++p) { const float cr = ccr[hp * 64 + p], ci = cci[hp * 64 + p], pr = pwr[lag * 64 + p], pi = pwi[lag * 64 + p];
            const float xr = cr * pr - ci * pi, xi = cr * pi + ci * pr; s += xr * bbr[p * 16 + h] - xi * bbi[p * 16 + h]; }
        if (lag == 0 && hp == h) s += kin(10)[l * 256 + g * 16 + h];
        Kt[t] = s; }
    __syncthreads();
    bf16* TE = ((bf16*)(F.ws + WS_TE)) + (size_t)pair * TE_ELEMS; bf16* GM = ((bf16*)(F.ws + WS_G)) + (size_t)pair * G_ELEMS;
    for (int t = tid; t < 256 * 192; t += 512) { const int n = t / 192, kp = t % 192, k = 2 * kp; const int i = n >> 4, hp = n & 15; float v0, v1;
        if (k < 256) { const int j = k >> 4, h = k & 15; if (j <= i) { v0 = Kt[((i - j) * 16 + hp) * 16 + h]; v1 = Kt[((i - j) * 16 + hp) * 16 + h + 1]; } else { v0 = 0.f; v1 = 0.f; } }
        else { const int p = (k - 256) >> 1; const float cr = ccr[hp * 64 + p], ci = cci[hp * 64 + p], pr = pwr[(i + 1) * 64 + p], pi = pwi[(i + 1) * 64 + p];
            v0 = cr * pr - ci * pi; v1 = -(cr * pi + ci * pr); }
        *(unsigned*)(TE + (size_t)n * 384 + k) = pk2(v0, v1); }
    for (int t = tid; t < 128 * 128; t += 512) { const int n = t >> 7, kp = t & 127, k = 2 * kp; const int p = n >> 1, ri = n & 1, j = k >> 4, h = k & 15;
        const float pr = pwr[(15 - j) * 64 + p], pi = pwi[(15 - j) * 64 + p];
        float v0, v1;
        { const float br = bbr[p * 16 + h], bi = bbi[p * 16 + h]; v0 = ri ? (pr * bi + pi * br) : (pr * br - pi * bi); }
        { const float br = bbr[p * 16 + h + 1], bi = bbi[p * 16 + h + 1]; v1 = ri ? (pr * bi + pi * br) : (pr * br - pi * bi); }
        *(unsigned*)(GM + (size_t)n * 256 + k) = pk2(v0, v1); }
    if (tid < 64) { ((float*)(F.ws + WS_AT))[(size_t)pair * 128 + 2 * tid] = pwr[16 * 64 + tid]; ((float*)(F.ws + WS_AT))[(size_t)pair * 128 + 2 * tid + 1] = pwi[16 * 64 + tid]; }
    __syncthreads();
}
__device__ __forceinline__ void p0_prologue(const Params& P, Frame& F) {
    const bool split = F.G > 64;
    if (!split || F.bid < 32) { for (int pair = F.bid; pair < 32; pair += (split ? 32 : F.G)) p0_ssm_consts(P, F, pair); if (split) return; }
    const int vb = split ? F.bid - 32 : F.bid, nvb = split ? F.G - 32 : F.G;
    if (vb == 0) { float* nwp = (float*)(F.ws + WS_NW);
        for (int t = F.tid; t < DEPTH * 256; t += 512) { const int l = t >> 8, k = (t >> 6) & 3, d = t & 63;
            nwp[t] = (k == 0) ? kin(13)[l * 64 + d] * QSCALE : (k == 1) ? kin(14)[l * 64 + d] : (k == 2) ? kin(16)[l * 64 + d] * QSCALE : kin(17)[l * 64 + d]; } }
    const int gw = vb * 8 + F.wave, NGW = nvb * 8;
    LAS float* scr = (LAS float*)(F.lds + F.wave * 16384);
    constexpr int I_IN = 16 * 80, I_OUT = 16 * 32, I_GLU = 4 * 8, I_L = I_IN + I_OUT + I_GLU;
    for (int it = gw; it < DEPTH * I_L; it += NGW) {
        const int l = it / I_L; int r = it % I_L;
        if (r < I_IN) { const int kb = r / 80, nb = r % 80; p0_transpose_item(kin(2) + (size_t)l * DM * NPROJ, DM, NPROJ, kin(1) + l * DM, ((bf16*)(F.ws + WS_Z)) + (size_t)(MTOK + l * NPROJ) * DM, DM, proj_dest_row(32 * nb), scr, 64 * kb, 32 * nb, F.lane); continue; }
        r -= I_IN;
        if (r < I_OUT) { const int kb = r / 32, nb = r % 32; p0_transpose_item(kin(18) + (size_t)l * DM * DM, DM, DM, nullptr, ((bf16*)(F.ws + WS_WOUT)) + (size_t)l * DM * DM, DM, 32 * nb, scr, 64 * kb, 32 * nb, F.lane); continue; }
        r -= I_OUT;
        { const int kb = r / 8, nb = r % 8; p0_transpose_item(kin(11) + (size_t)l * 65536, 256, 256, nullptr, ((bf16*)(F.ws + WS_GLU)) + (size_t)l * 65536, 256, 32 * nb, scr, 64 * kb, 32 * nb, F.lane); }
    }
    for (int m = gw; m < MTOK; m += NGW) {
        const f32x4* xr = (const f32x4*)(kin(0) + (size_t)m * DM) + F.lane; f32x4 v[4]; float s = 0.f;
#pragma unroll
        for (int j = 0; j < 4; ++j) { v[j] = xr[64 * j]; s += (v[j].x * v[j].x + v[j].y * v[j].y) + (v[j].z * v[j].z + v[j].w * v[j].w); }
        s = wave_sum(s);
        u32x2* o8 = (u32x2*)(((bf16*)(F.ws + WS_Z)) + (size_t)m * DM) + F.lane;
#pragma unroll
        for (int j = 0; j < 4; ++j) { u32x2 w; w.x = pk2(v[j].x, v[j].y); w.y = pk2(v[j].z, v[j].w); o8[64 * j] = w; }
        if (F.lane < 4) ((float*)(F.ws + WS_ROWSS))[(size_t)m * 4 + F.lane] = (F.lane == 0) ? s : 0.f;
    }
}

__device__ __forceinline__ Frame phase_frame(const Frame& F0) {
    Frame F = F0; asm volatile("" : "+v"(F.tid)); F.lane = F.tid & 63; F.wave = __builtin_amdgcn_readfirstlane(F.tid >> 6);
    asm volatile("" : "+s"(F.ws)); F.ctl = (unsigned*)(F.ws + WS_CTL); return F;
}
struct SchedP1 { int G, c, wbase;
    __device__ __forceinline__ bool next(int i, Unit& u) const {
        int tok, j;
        if (G == 256) { if (i >= 5) return false; const int x = c & 7, l = c >> 3, n = i * 32 + l, tq = n / 40, rem = n % 40; j = rem >> 2; tok = 16 * x + 4 * tq + (rem & 3); }
        else { const long L = (long)i * G + c; if (L >= NTT * 10) return false; tok = (int)(L / 10); j = (int)(L % 10); }
        if (j < 9) { u.pm = tok; u.pn = wbase + j; } else { u.pm = wbase + 9; u.pn = tok; }
        return true; }
    __device__ __forceinline__ void a_ready(const Unit&) const {}
    __device__ __forceinline__ void done(const Unit&) const {}
};
struct SchedP3 { int G, c;
    __device__ __forceinline__ bool next(int i, Unit& u) const {
        if (G == 256) { if (i >= 2) return false; const int x = c & 7, l = c >> 3, n = i * 32 + l, tq = n >> 4, rem = n & 15; u.pn = rem >> 2; u.pm = 16 * x + 4 * tq + (rem & 3); }
        else { const long L = (long)i * G + c; if (L >= NTT * 4) return false; u.pm = (int)(L / 4); u.pn = (int)(L % 4); }
        return true; }
    __device__ __forceinline__ void a_ready(const Unit&) const {}
    __device__ __forceinline__ void done(const Unit&) const {}
};
struct SchedGlu { int G, c;
    __device__ __forceinline__ bool next(int i, Unit& u) const {
        if (G == 256) { if (i >= 1 || (c >> 3) >= 16) return false; u.pm = 16 * (c & 7) + (c >> 3); u.pn = 0; }
        else { const long L = (long)i * G + c; if (L >= NTT) return false; u.pm = (int)L; u.pn = 0; }
        return true; }
    __device__ __forceinline__ void a_ready(const Unit&) const {}
    __device__ __forceinline__ void done(const Unit&) const {}
};

struct EpiProj {
    static constexpr bool PERM = true, AFTER_DRAIN = false;
    int wbase, layer; unsigned char* ws;
    __device__ __forceinline__ void operator()(const f32x4 (&acc)[2][2][4][2], const Unit& u, int wr, int wc, int fr, int fq) const {
        const float* rowss = (const float*)(ws + WS_ROWSS);
        if (u.pm >= NTT) {
            bf16* VT = (bf16*)(ws + WS_VT);
            const int tc = u.pn * 256 + wc * 32 + 8 * fq;
            float rs[2][8];
#pragma unroll
            for (int bj = 0; bj < 2; ++bj)
#pragma unroll
                for (int e = 0; e < 8; ++e) { const f32x4 p = *(const f32x4*)(rowss + (size_t)(tc + bj * 128 + e) * 4); rs[bj][e] = rsqrtf(((p.x + p.y) + (p.z + p.w)) * (1.f / DM) + RMS_EPS); }
#pragma unroll
            for (int ai = 0; ai < 2; ++ai)
#pragma unroll
                for (int m = 0; m < 4; ++m) { const int f = ai * 128 + wr * 64 + m * 16 + fr;
#pragma unroll
                    for (int bj = 0; bj < 2; ++bj) { const f32x4 a = acc[ai][bj][m][0], b = acc[ai][bj][m][1]; u32x4 w;
                        w.x = pk2(a[0] * rs[bj][0], a[1] * rs[bj][1]); w.y = pk2(a[2] * rs[bj][2], a[3] * rs[bj][3]); w.z = pk2(b[0] * rs[bj][4], b[1] * rs[bj][5]); w.w = pk2(b[2] * rs[bj][6], b[3] * rs[bj][7]);
                        *(u32x4*)(VT + (size_t)f * MTOK + tc + bj * 128) = w; } }
            return;
        }
        const int t = u.pn - wbase;
        int kind, pitch, col, nwi = 0; size_t dsto;
        switch (t) {
            case 0: kind = 0; dsto = WS_U; pitch = 256; col = 64 * wc; break;
            case 1: kind = 1; dsto = WS_SG; pitch = 256; col = 64 * wc; break;
            case 2: kind = 2; dsto = WS_AQ; pitch = 384; col = 64 * wc; nwi = 0; break;
            case 3: if (wc < 2) { kind = 2; dsto = WS_AQ; pitch = 384; col = 64 * (4 + wc); nwi = 0; } else { kind = 2; dsto = WS_AK; pitch = 128; col = 64 * (wc - 2); nwi = 1; } break;
            case 4: kind = 1; dsto = WS_AG; pitch = 384; col = 64 * wc; break;
            case 5: if (wc < 2) { kind = 1; dsto = WS_AG; pitch = 384; col = 64 * (4 + wc); } else { kind = 2; dsto = WS_MQ; pitch = 384; col = 64 * (wc - 2); nwi = 2; } break;
            case 6: kind = 2; dsto = WS_MQ; pitch = 384; col = 64 * (2 + wc); nwi = 2; break;
            case 7: if (wc < 2) { kind = 5; dsto = WS_MK; pitch = 128; col = 64 * wc; nwi = 3; } else { kind = 1; dsto = WS_MG; pitch = 384; col = 64 * (wc - 2); } break;
            default: kind = 1; dsto = WS_MG; pitch = 384; col = 64 * (2 + wc); break;
        }
        bf16* dst = (bf16*)(ws + dsto) + col + 8 * fq; const float* nw = (const float*)(ws + WS_NW) + (layer * 4 + nwi) * 64 + 8 * fq;
        const int row0 = u.pm * 256 + wr * 64 + fr;
        if (kind == 0) rows<0>(acc, row0, dst, pitch, nw, rowss, nullptr);
        else if (kind == 1) rows<1>(acc, row0, dst, pitch, nw, rowss, nullptr);
        else if (kind == 2) rows<2>(acc, row0, dst, pitch, nw, rowss, nullptr);
        else rows<5>(acc, row0, dst, pitch, nw, rowss, (fr == 0) ? (float*)(ws + WS_KPART) + ((size_t)(u.pm * 2 + wr) * 2 + wc) * 64 + 8 * fq : nullptr);
    }
    template <int KIND>
    __device__ __forceinline__ void rows(const f32x4 (&acc)[2][2][4][2], int row0, bf16* dst, int pitch, const float* nw, const float* rowss, float* kp) const {
        f32x4 wv[2][2], ks[2][2];
        if (KIND >= 2) {
#pragma unroll
            for (int bj = 0; bj < 2; ++bj)
#pragma unroll
                for (int n = 0; n < 2; ++n) { wv[bj][n] = *(const f32x4*)(nw + 32 * bj + 4 * n); ks[bj][n] = (f32x4){0.f, 0.f, 0.f, 0.f}; }
        }
#pragma unroll
        for (int ai = 0; ai < 2; ++ai)
#pragma unroll
            for (int m = 0; m < 4; ++m) {
                const int row = row0 + ai * 128 + m * 16;
                const f32x4 p = *(const f32x4*)(rowss + (size_t)row * 4);
                const float rs = rsqrtf(((p.x + p.y) + (p.z + p.w)) * (1.f / DM) + RMS_EPS);
                f32x4 v[2][2];
#pragma unroll
                for (int bj = 0; bj < 2; ++bj)
#pragma unroll
                    for (int n = 0; n < 2; ++n) v[bj][n] = acc[ai][bj][m][n] * rs;
                if (KIND >= 2) {
                    float ss = 0.f;
#pragma unroll
                    for (int bj = 0; bj < 2; ++bj)
#pragma unroll
                        for (int n = 0; n < 2; ++n) { const f32x4 q = v[bj][n]; ss += (q[0] * q[0] + q[1] * q[1]) + (q[2] * q[2] + q[3] * q[3]); }
                    ss += __shfl_xor(ss, 16); ss += __shfl_xor(ss, 32);
                    const float hn = rsqrtf(ss * (1.f / 64.f) + RMS_EPS);
#pragma unroll
                    for (int bj = 0; bj < 2; ++bj)
#pragma unroll
                        for (int n = 0; n < 2; ++n) { v[bj][n] = v[bj][n] * wv[bj][n] * hn; if (KIND == 5) ks[bj][n] += v[bj][n]; }
                } else if (KIND == 1) {
#pragma unroll
                    for (int bj = 0; bj < 2; ++bj)
#pragma unroll
                        for (int n = 0; n < 2; ++n)
#pragma unroll
                            for (int e = 0; e < 4; ++e) v[bj][n][e] = silu_f(v[bj][n][e]);
                }
                bf16* rp = dst + (size_t)row * pitch;
#pragma unroll
                for (int bj = 0; bj < 2; ++bj) { u32x4 w; w.x = pk2(v[bj][0][0], v[bj][0][1]); w.y = pk2(v[bj][0][2], v[bj][0][3]); w.z = pk2(v[bj][1][0], v[bj][1][1]); w.w = pk2(v[bj][1][2], v[bj][1][3]);
                    *(u32x4*)(rp + 32 * bj) = w; }
                if (m & 1) asm volatile("" ::: "memory");
            }
        if (KIND == 5) {
#pragma unroll
            for (int bj = 0; bj < 2; ++bj)
#pragma unroll
                for (int n = 0; n < 2; ++n)
#pragma unroll
                    for (int e = 0; e < 4; ++e) { float s = ks[bj][n][e]; s += __shfl_xor(s, 1); s += __shfl_xor(s, 2); s += __shfl_xor(s, 4); s += __shfl_xor(s, 8); ks[bj][n][e] = s; }
            if (kp) {
#pragma unroll
                for (int bj = 0; bj < 2; ++bj)
#pragma unroll
                    for (int n = 0; n < 2; ++n) *(f32x4*)(kp + 32 * bj + 4 * n) = ks[bj][n];
            }
        }
    }
};
struct EpiGlu {
    static constexpr bool PERM = true, AFTER_DRAIN = false;
    const bf16* YPRE; const bf16* SG; const float* gb; bf16* Y;
    __device__ __forceinline__ void operator()(const f32x4 (&acc)[2][2][4][2], const Unit& u, int wr, int wc, int fr, int fq) const {
#pragma unroll
        for (int bj = 0; bj < 2; ++bj) { const int c = wc * 32 + 8 * fq + 128 * bj;
            const f32x4 b0 = *(const f32x4*)(gb + c), b1 = *(const f32x4*)(gb + c + 4);
#pragma unroll
            for (int ai = 0; ai < 2; ++ai)
#pragma unroll
                for (int m = 0; m < 4; ++m) { const int row = u.pm * 256 + ai * 128 + wr * 64 + m * 16 + fr;
                    const u32x4 yp = *(const u32x4*)(YPRE + (size_t)row * 256 + c), sg = *(const u32x4*)(SG + (size_t)row * 256 + c);
                    const f32x4 z0 = acc[ai][bj][m][0] + b0, z1 = acc[ai][bj][m][1] + b1;
                    u32x4 w;
                    w.x = pk2(bflo(yp.x) * sigmoid_f(z0[0]) * bflo(sg.x), bfhi(yp.x) * sigmoid_f(z0[1]) * bfhi(sg.x));
                    w.y = pk2(bflo(yp.y) * sigmoid_f(z0[2]) * bflo(sg.y), bfhi(yp.y) * sigmoid_f(z0[3]) * bfhi(sg.y));
                    w.z = pk2(bflo(yp.z) * sigmoid_f(z1[0]) * bflo(sg.z), bfhi(yp.z) * sigmoid_f(z1[1]) * bfhi(sg.z));
                    w.w = pk2(bflo(yp.w) * sigmoid_f(z1[2]) * bflo(sg.w), bfhi(yp.w) * sigmoid_f(z1[3]) * bfhi(sg.w));
                    *(u32x4*)(Y + (size_t)row * DM + c) = w;
                    if (m & 1) asm volatile("" ::: "memory"); } }
    }
};
struct EpiOut {
    static constexpr bool PERM = false, AFTER_DRAIN = false;
    const float* resid; float* out; bf16* xb; float* rowss; int write_next; LAS float* xch;
    __device__ __forceinline__ void operator()(const f32x4 (&acc)[2][2][4][2], const Unit& u, int wr, int wc, int fr, int fq) const {
        const int c0 = u.pn * 256 + wc * 32 + 4 * fq;
#pragma unroll
        for (int ai = 0; ai < 2; ++ai)
#pragma unroll
            for (int m = 0; m < 4; ++m) { const int rt = ai * 128 + wr * 64 + m * 16 + fr; const size_t off = (size_t)(u.pm * 256 + rt) * DM + c0; float ss = 0.f;
#pragma unroll
                for (int bj = 0; bj < 2; ++bj)
#pragma unroll
                    for (int n = 0; n < 2; ++n) { const size_t o2 = off + bj * 128 + n * 16; const f32x4 o = *(const f32x4*)(resid + o2) + acc[ai][bj][m][n];
                        *(f32x4*)(out + o2) = o;
                        if (write_next) { u32x2 w; w.x = pk2(o[0], o[1]); w.y = pk2(o[2], o[3]); *(u32x2*)(xb + o2) = w; ss += (o[0] * o[0] + o[1] * o[1]) + (o[2] * o[2] + o[3] * o[3]); } }
                if (write_next) { ss += __shfl_xor(ss, 16); ss += __shfl_xor(ss, 32); if (fq == 0) xch[rt * 4 + wc] = ss; }
            }
        asm volatile("s_waitcnt lgkmcnt(0)" ::: "memory"); __builtin_amdgcn_s_barrier(); asm volatile("" ::: "memory");
        if (write_next && threadIdx.x < 256) { const f32x4 p = *(const LAS f32x4*)(xch + threadIdx.x * 4); rowss[(size_t)(u.pm * 256 + threadIdx.x) * 4 + u.pn] = (p.x + p.y) + (p.z + p.w); }
    }
};

__device__ __forceinline__ int pi32(int r) { return (r & ~12) | ((r & 8) >> 1) | ((r & 4) << 1); }
template <int MODE>
__device__ __forceinline__ void attn_tile(const bf16x8 (&kf)[4], const bf16x8 (&vf)[2][2], const bf16x8 (&qf)[4], float cinit, float& m, float& l, f32x16 (&O)[2], int a, int h) {
    f32x16 S;
#pragma unroll
    for (int i = 0; i < 16; ++i) S[i] = cinit;
#pragma unroll
    for (int ks = 0; ks < 4; ++ks) S = __builtin_amdgcn_mfma_f32_32x32x16_bf16(kf[ks], qf[ks], S, 0, 0, 0);
    if (MODE != 0) {
#pragma unroll
        for (int i = 0; i < 16; ++i) { const int c = pi32((i & 3) + 8 * (i >> 2) + 4 * h); const bool dead = (MODE == 1) ? (c > a) : (c <= a); if (dead) S[i] = -1e30f; }
    }
    float mx = fmaxf(fmaxf(S[0], S[1]), fmaxf(S[2], S[3]));
#pragma unroll
    for (int i = 4; i < 16; i += 4) mx = fmaxf(mx, fmaxf(fmaxf(S[i], S[i + 1]), fmaxf(S[i + 2], S[i + 3])));
    mx = swap32_max(mx);
    if (__any(mx > m + 8.f)) {
        const float mn = fmaxf(m, mx), al = __builtin_amdgcn_exp2f(m - mn);
        l *= al;
#pragma unroll
        for (int i = 0; i < 16; ++i) { O[0][i] *= al; O[1][i] *= al; }
        m = mn;
    }
    float sum = 0.f;
#pragma unroll
    for (int i = 0; i < 16; ++i) { S[i] = __builtin_amdgcn_exp2f(S[i] - m); sum += S[i]; }
    l += sum;
    bf16x8 pb[2];
#pragma unroll
    for (int s = 0; s < 2; ++s) { u32x4 w; w.x = pk2(S[8 * s], S[8 * s + 1]); w.y = pk2(S[8 * s + 2], S[8 * s + 3]); w.z = pk2(S[8 * s + 4], S[8 * s + 5]); w.w = pk2(S[8 * s + 6], S[8 * s + 7]); pb[s] = __builtin_bit_cast(bf16x8, w); }
#pragma unroll
    for (int dt = 0; dt < 2; ++dt)
#pragma unroll
        for (int s = 0; s < 2; ++s) O[dt] = __builtin_amdgcn_mfma_f32_32x32x16_bf16(vf[dt][s], pb[s], O[dt], 0, 0, 0);
}
template <int NK>
__device__ __forceinline__ void stage_kv(LAS unsigned char* Kimg, LAS unsigned char* Vimg, const bf16* Ksrc  , const bf16* Vsrc  ,
                                         long key_lo  , long key_min  , int wave, int lane) {
    constexpr int KP = NK * 128 / 1024, VCH = NK / 8, VP = 64 * VCH * 16 / 1024;
    for (int p = wave; p < KP; p += 8) { const int L = p * 64 + lane, r = L >> 3, s = L & 7, c = s ^ ((r >> 1) & 7); long kr = key_lo + r; if (kr < key_min) kr = key_min;
        glds16(Ksrc + (kr - key_lo) * 128 + c * 8, Kimg + p * 1024); }
    for (int p = wave; p < VP; p += 8) { const int L = p * 64 + lane, d = L / VCH, s = L % VCH, c = s ^ (d & 15); long kc = key_lo + 8 * c; if (kc < key_min) kc = key_min;
        glds16(Vsrc + (size_t)d * MTOK + (kc - key_lo), Vimg + p * 1024); }
}
template <int NK>
__device__ __forceinline__ void load_kv_frags(bf16x8 (&kf)[4], bf16x8 (&vf)[2][2], const LAS unsigned char* Kimg, const LAS unsigned char* Vimg, int row0  , int lane) {
    const int r = row0 + pi32(lane & 31), h = lane >> 5;
#pragma unroll
    for (int ks = 0; ks < 4; ++ks) kf[ks] = *(const LAS bf16x8*)(Kimg + r * 128 + (((2 * ks + h) ^ ((r >> 1) & 7)) << 4));
#pragma unroll
    for (int dt = 0; dt < 2; ++dt) { const int d = 32 * dt + (lane & 31);
#pragma unroll
        for (int s = 0; s < 2; ++s) { const int c = (row0 >> 3) + 2 * s + h; vf[dt][s] = *(const LAS bf16x8*)(Vimg + d * (NK * 2) + ((c ^ (d & 15)) << 4)); } }
}
__device__ __forceinline__ void attn_store(const f32x16 (&O)[2], float l, const bf16* gate  , bf16* y  , int h) {
    const float inv = 1.f / swap32_sum(l);
#pragma unroll
    for (int dt = 0; dt < 2; ++dt)
#pragma unroll
        for (int q = 0; q < 4; ++q) { const int d = 32 * dt + 8 * q + 4 * h; const u32x2 gv = *(const u32x2*)(gate + d);
            u32x2 w; w.x = pk2(O[dt][4 * q] * inv * bflo(gv.x), O[dt][4 * q + 1] * inv * bfhi(gv.x)); w.y = pk2(O[dt][4 * q + 2] * inv * bflo(gv.y), O[dt][4 * q + 3] * inv * bfhi(gv.y));
            *(u32x2*)(y + d) = w; }
}

__device__ __forceinline__ void moba_unit(Frame& F, int b, int kvh, int qb) {
    constexpr int IMG = 32768;
    LAS unsigned char* buf0 = F.lds; LAS unsigned char* buf1 = F.lds + 2 * IMG;
    LAS float* km = (LAS float*)(F.lds + LDS_MISC + 1024);
    const int lane = F.lane, wave = F.wave, a = lane & 31, h = lane >> 5;
    const long tok0 = (long)b * SEQ + 256 * qb;
    const bf16* Kb = ((bf16*)(F.ws + WS_MK)) + (size_t)b * SEQ * 128 + kvh * 64;
    const bf16* Vb = ((bf16*)(F.ws + WS_VT)) + (size_t)(128 + kvh * 64) * MTOK + (size_t)b * SEQ;
    const int nsteps = qb + 1, T = 3 * nsteps;
    stage_kv<256>(buf0, buf0 + IMG, Kb + (size_t)(256 * qb) * 128, Vb + 256 * qb, 0, 0, wave, lane);
    { const int n = F.tid >> 6, d = F.tid & 63; float s = 0.f;
      if (n < qb) { const int tile = b * 8 + n; s = ((float*)(F.ws + WS_KPART))[((size_t)(tile * 2 + 0) * 2 + kvh) * 64 + d] + ((float*)(F.ws + WS_KPART))[((size_t)(tile * 2 + 1) * 2 + kvh) * 64 + d]; }
      km[n * 64 + d] = s; }
    const bf16* qp = ((bf16*)(F.ws + WS_MQ)) + (size_t)(tok0 + 32 * wave + a) * 384 + kvh * 192 + 8 * h;
    __syncthreads();
    unsigned selmask = 0;
    if (qb > 0) {
        float sc[8];
#pragma unroll
        for (int n = 0; n < 8; ++n) sc[n] = 0.f;
#pragma unroll
        for (int ks = 0; ks < 4; ++ks) { const bf16x8 q0 = *(const bf16x8*)(qp + 16 * ks), q1 = *(const bf16x8*)(qp + 64 + 16 * ks), q2 = *(const bf16x8*)(qp + 128 + 16 * ks);
#pragma unroll
            for (int j = 0; j < 8; ++j) { const float qs = bf2f((unsigned short)q0[j]) + bf2f((unsigned short)q1[j]) + bf2f((unsigned short)q2[j]); const int d = 16 * ks + 8 * h + j;
#pragma unroll
                for (int n = 0; n < 7; ++n) sc[n] += qs * km[n * 64 + d]; } }
#pragma unroll
        for (int n = 0; n < 7; ++n) { sc[n] = swap32_sum(sc[n]); if (n >= qb) sc[n] = -INFINITY; }
#pragma unroll
        for (int t = 0; t < 3; ++t) { float best = -INFINITY; int bi = -1;
#pragma unroll
            for (int n = 0; n < 7; ++n) if (sc[n] > best) { best = sc[n]; bi = n; }
            if (bi >= 0) { selmask |= 1u << bi;
#pragma unroll
                for (int n = 0; n < 7; ++n) if (n == bi) sc[n] = -INFINITY; } }
    }
    float m = -1e30f, l = 0.f; f32x16 O[2]; bf16x8 qf[4];
    int g = 0, s = 0;
#pragma unroll 1
    for (int tau = 0; tau < T; ++tau) {
        LAS unsigned char* cur = (tau & 1) ? buf1 : buf0; LAS unsigned char* nxt = (tau & 1) ? buf0 : buf1;
        if (tau + 1 < T) { const int s1 = (s == qb) ? 0 : s + 1; const int blk = (s1 == 0) ? qb : s1 - 1;
            stage_kv<256>(nxt, nxt + IMG, Kb + (size_t)(256 * blk) * 128, Vb + 256 * blk, 0, 0, wave, lane); }
        if (s == 0) {
            m = -1e30f; l = 0.f;
#pragma unroll
            for (int i = 0; i < 16; ++i) { O[0][i] = 0.f; O[1][i] = 0.f; }
#pragma unroll
            for (int ks = 0; ks < 4; ++ks) qf[ks] = *(const bf16x8*)(qp + g * 64 + 16 * ks);
#pragma unroll 1
            for (int kt = 0; kt <= wave; ++kt) { bf16x8 kf[4], vf[2][2]; load_kv_frags<256>(kf, vf, cur, cur + IMG, 32 * kt, lane);
                if (kt == wave) attn_tile<1>(kf, vf, qf, 0.f, m, l, O, a, h); else attn_tile<0>(kf, vf, qf, 0.f, m, l, O, a, h); }
        } else {
            const float cinit = ((selmask >> (s - 1)) & 1u) ? 0.f : -1e30f;
            if (__any(cinit == 0.f)) {
#pragma unroll 1
                for (int kt = 0; kt < 8; ++kt) { bf16x8 kf[4], vf[2][2]; load_kv_frags<256>(kf, vf, cur, cur + IMG, 32 * kt, lane); attn_tile<0>(kf, vf, qf, cinit, m, l, O, a, h); }
            }
        }
        if (s == qb) { const size_t row = (size_t)(tok0 + 32 * wave + a); attn_store(O, l, ((bf16*)(F.ws + WS_MG)) + row * 384 + (kvh * 3 + g) * 64, ((bf16*)(F.ws + WS_Y)) + row * DM + 640 + (kvh * 3 + g) * 64, h); s = 0; ++g; }
        else ++s;
        __syncthreads();
    }
}

__device__ __forceinline__ void swa_unit(const Params& P, Frame& F, int layer, int b, int kvh, int qblk) {
    constexpr int NK = 384;
    LAS unsigned char* Kimg = F.lds; LAS unsigned char* Vimg = F.lds + NK * 128;
    const int lane = F.lane, wave = F.wave, a = lane & 31, h = lane >> 5;
    const int q0 = 256 * qblk; const long tok0 = (long)b * SEQ + q0;
    const bf16* Kb = ((bf16*)(F.ws + WS_AK)) + ((long)b * SEQ + q0 - 128) * 128 + kvh * 64;
    const bf16* Vb = ((bf16*)(F.ws + WS_VT)) + (size_t)(kvh * 64) * MTOK + ((long)b * SEQ + q0 - 128);
    stage_kv<NK>(Kimg, Vimg, Kb, Vb, (long)q0 - 128, 0, wave, lane);
    const size_t row = (size_t)(tok0 + 32 * wave + a);
    const bf16* qp = ((bf16*)(F.ws + WS_AQ)) + row * 384 + kvh * 192 + 8 * h;
    __syncthreads();
#pragma unroll 1
    for (int g = 0; g < 3; ++g) {
        bf16x8 qf[4];
#pragma unroll
        for (int ks = 0; ks < 4; ++ks) qf[ks] = *(const bf16x8*)(qp + g * 64 + 16 * ks);
        float m = kin(15)[layer * 6 + kvh * 3 + g] * LOG2E, l = 0.5f;
        f32x16 O[2];
#pragma unroll
        for (int i = 0; i < 16; ++i) { O[0][i] = 0.f; O[1][i] = 0.f; }
#pragma unroll 1
        for (int kt = 0; kt < 5; ++kt) {
            const int row0 = 32 * wave + 32 * kt;
            if (q0 - 128 + row0 < 0) continue;
            bf16x8 kf[4], vf[2][2]; load_kv_frags<NK>(kf, vf, Kimg, Vimg, row0, lane);
            if (kt == 0) attn_tile<2>(kf, vf, qf, 0.f, m, l, O, a, h);
            else if (kt == 4) attn_tile<1>(kf, vf, qf, 0.f, m, l, O, a, h);
            else attn_tile<0>(kf, vf, qf, 0.f, m, l, O, a, h);
        }
        attn_store(O, l, ((bf16*)(F.ws + WS_AG)) + row * 384 + (kvh * 3 + g) * 64, ((bf16*)(F.ws + WS_Y)) + row * DM + 256 + (kvh * 3 + g) * 64, h);
    }
    __syncthreads();
}

__device__ __forceinline__ void ssm_unit(Frame& F, int layer, int b, int g) {
    constexpr int APITCH = 528;
    LAS unsigned char* AU = F.lds;
    LAS unsigned char* SC = F.lds + 128 * APITCH;
    LAS float* seg = (LAS float*)(F.lds + 2 * 128 * APITCH);
    const int lane = F.lane, wave = F.wave, tid = F.tid, fr = lane & 15, fq = lane >> 4;
    const int pair = layer * 16 + g;
    const bf16* TE = ((bf16*)(F.ws + WS_TE)) + (size_t)pair * TE_ELEMS; const bf16* GM = ((bf16*)(F.ws + WS_G)) + (size_t)pair * G_ELEMS;
    { const bf16* up = ((bf16*)(F.ws + WS_U)) + (size_t)b * SEQ * 256 + g * 16;
#pragma unroll
      for (int i = 0; i < 8; ++i) { const int idx = tid + 512 * i, t = idx >> 1, hf = idx & 1; const u32x4 v = *(const u32x4*)(up + (size_t)t * 256 + 8 * hf);
          *(LAS u32x4*)(AU + (t >> 4) * APITCH + ((t & 15) * 16 + 8 * hf) * 2) = v; } }
    __syncthreads();
    {
        bf16x8 gf[8];
#pragma unroll
        for (int ks = 0; ks < 8; ++ks) gf[ks] = *(const bf16x8*)(GM + (size_t)(16 * wave + fr) * 256 + 32 * ks + 8 * fq);
#pragma unroll
        for (int rt = 0; rt < 8; ++rt) { f32x4 acc = {0.f, 0.f, 0.f, 0.f};
#pragma unroll
            for (int ks = 0; ks < 8; ++ks) { const bf16x8 af = *(const LAS bf16x8*)(AU + (16 * rt + fr) * APITCH + (32 * ks + 8 * fq) * 2); acc = __builtin_amdgcn_mfma_f32_16x16x32_bf16(gf[ks], af, acc, 0, 0, 0); }
            *(LAS f32x4*)(SC + (16 * rt + fr) * APITCH + (16 * wave + 4 * fq) * 4) = acc; }
    }
    __syncthreads();
    {
        const float ar = ((float*)(F.ws + WS_AT))[(size_t)pair * 128 + 2 * lane], ai = ((float*)(F.ws + WS_AT))[(size_t)pair * 128 + 2 * lane + 1];
        float lr = 0.f, li = 0.f, locr[16], loci[16];
#pragma unroll
        for (int k = 0; k < 16; ++k) { locr[k] = lr; loci[k] = li; const f32x2_t s = *(const LAS f32x2_t*)(SC + (16 * wave + k) * APITCH + lane * 8);
            const float nr = ar * lr - ai * li + s.x, ni = ar * li + ai * lr + s.y; lr = nr; li = ni; }
        seg[(wave * 64 + lane) * 2] = lr; seg[(wave * 64 + lane) * 2 + 1] = li;
        __syncthreads();
        float a16r = ar, a16i = ai;
#pragma unroll
        for (int q = 0; q < 4; ++q) { const float tr = a16r * a16r - a16i * a16i, ti = 2.f * a16r * a16i; a16r = tr; a16i = ti; }
        float ir = 0.f, ii = 0.f;
        for (int w2 = 0; w2 < wave; ++w2) { const float sr = seg[(w2 * 64 + lane) * 2], si = seg[(w2 * 64 + lane) * 2 + 1]; const float nr = a16r * ir - a16i * ii + sr, ni = a16r * ii + a16i * ir + si; ir = nr; ii = ni; }
        float pr = 1.f, pi = 0.f;
#pragma unroll
        for (int k = 0; k < 16; ++k) { const float cr = locr[k] + pr * ir - pi * ii, ci = loci[k] + pr * ii + pi * ir;
            *(LAS unsigned*)(SC + (16 * wave + k) * APITCH + lane * 4) = pk2(cr, ci);
            const float tr = pr * ar - pi * ai, ti = pr * ai + pi * ar; pr = tr; pi = ti; }
    }
    __syncthreads();
#pragma unroll 1
    for (int half = 0; half < 2; ++half) {
        const int i = half ? 15 - wave : wave;
        f32x4 acc[8];
#pragma unroll
        for (int rt = 0; rt < 8; ++rt) acc[rt] = (f32x4){0.f, 0.f, 0.f, 0.f};
        const bf16* tp = TE + (size_t)(16 * i + fr) * 384 + 8 * fq;
        for (int ks = 0; ks <= (i >> 1); ++ks) { const bf16x8 tf = *(const bf16x8*)(tp + 32 * ks);
#pragma unroll
            for (int rt = 0; rt < 8; ++rt) { const bf16x8 af = *(const LAS bf16x8*)(AU + (16 * rt + fr) * APITCH + (32 * ks + 8 * fq) * 2); acc[rt] = __builtin_amdgcn_mfma_f32_16x16x32_bf16(tf, af, acc[rt], 0, 0, 0); } }
#pragma unroll
        for (int ks = 0; ks < 4; ++ks) { const bf16x8 tf = *(const bf16x8*)(tp + 256 + 32 * ks);
#pragma unroll
            for (int rt = 0; rt < 8; ++rt) { const bf16x8 af = *(const LAS bf16x8*)(SC + (16 * rt + fr) * APITCH + (32 * ks + 8 * fq) * 2); acc[rt] = __builtin_amdgcn_mfma_f32_16x16x32_bf16(tf, af, acc[rt], 0, 0, 0); } }
#pragma unroll
        for (int rt = 0; rt < 8; ++rt) { const int chunk = 16 * rt + fr; u32x2 w; w.x = pk2(gelu_tanh_f(acc[rt][0]), gelu_tanh_f(acc[rt][1])); w.y = pk2(gelu_tanh_f(acc[rt][2]), gelu_tanh_f(acc[rt][3]));
            *(u32x2*)(((bf16*)(F.ws + WS_YPRE)) + ((size_t)b * SEQ + 16 * chunk + i) * 256 + g * 16 + 4 * fq) = w; }
    }
    __syncthreads();
}

__device__ __forceinline__ void mixer_phase(const Params& P, Frame& F, int layer) {
    volatile LAS int* qw = (volatile LAS int*)(F.lds + LDS_MISC);
    unsigned* head = F.ctl + CW_QUEUE + 64 * layer;
    for (;;) {
        if (F.tid == 0) qw[0] = (int)atomicAdd(head, 1u);
        __syncthreads();
        const int it = qw[0];
        __syncthreads();
        if (it >= 768) break;
#ifndef NO_MOBA
        if (it < 256) { const int qb = 7 - (it >> 5), r = it & 31; moba_unit(F, r >> 1, r & 1, qb); }
#endif
#ifndef NO_SSM
        if (it >= 256 && it < 512) { const int r = it - 256; ssm_unit(F, layer, r >> 4, r & 15); }
#endif
#ifndef NO_SWA
        if (it >= 512) { const int r = it - 512; swa_unit(P, F, layer, r >> 4, (r >> 3) & 1, r & 7); }
#endif
    }
}

__global__ void __launch_bounds__(512, 2) mk_fwd(Params P) {
    extern __shared__ __attribute__((aligned(16))) unsigned char lds_raw[];
    cg::grid_group grid = cg::this_grid();
    Frame F;
    F.lds = (LAS unsigned char*)lds_raw; F.tid = threadIdx.x; F.lane = F.tid & 63; F.wave = __builtin_amdgcn_readfirstlane(F.tid >> 6); F.G = gridDim.x; F.bid = blockIdx.x;
    F.out = (float*)kin(19); F.ws = (unsigned char*)kin(20); F.ctl = (unsigned*)(F.ws + WS_CTL);

#ifndef NO_P0
    { Frame Fp = phase_frame(F); p0_prologue(P, Fp); }
#endif
    grid.sync();
#pragma unroll 1
    for (int layer = 0; layer < DEPTH; ++layer) {
#ifndef NO_P1
        {
            Frame Fp = phase_frame(F);
            pg8::Gemm g{((bf16*)(Fp.ws + WS_Z)), ((bf16*)(Fp.ws + WS_Z)), ZROWS, ZROWS, DM}; SchedP1 S{F.G, F.bid, NTT + 10 * layer};
            EpiProj E{NTT + 10 * layer, layer, Fp.ws};
            pg8::gemm_phase<EpiProj, SchedP1, true, true>(F.lds, g, S, E);
        }
#endif
        grid.sync();
#ifndef NO_MIX
        { Frame Fp = phase_frame(F); mixer_phase(P, Fp, layer); }
#endif
        grid.sync();
#ifndef NO_GLU
        {
            int kglu = 256; asm volatile("" : "+s"(kglu));
            Frame Fp = phase_frame(F);
            pg8::Gemm g{((bf16*)(Fp.ws + WS_YPRE)), ((bf16*)(Fp.ws + WS_GLU)) + (size_t)layer * 65536, MTOK, 256, kglu}; SchedGlu S{F.G, F.bid};
            EpiGlu E{((bf16*)(Fp.ws + WS_YPRE)), ((bf16*)(Fp.ws + WS_SG)), kin(12) + layer * 256, ((bf16*)(Fp.ws + WS_Y))};
            pg8::gemm_phase<EpiGlu, SchedGlu, true, true>(F.lds, g, S, E);
        }
#endif
        grid.sync();
#ifndef NO_P3
        {
            Frame Fp = phase_frame(F);
            pg8::Gemm g{((bf16*)(Fp.ws + WS_Y)), ((bf16*)(Fp.ws + WS_WOUT)) + (size_t)layer * DM * DM, MTOK, DM, DM}; SchedP3 S{F.G, F.bid};
            EpiOut E{layer == 0 ? kin(0) : F.out, F.out, ((bf16*)(Fp.ws + WS_Z)), ((float*)(Fp.ws + WS_ROWSS)), layer + 1 < DEPTH ? 1 : 0, (LAS float*)(F.lds + LDS_MISC + 4096)};
            pg8::gemm_phase<EpiOut, SchedP3, true, true>(F.lds, g, S, E);
        }
#endif
        if (layer + 1 < DEPTH) grid.sync();
    }
}

extern "C" void kernel_launch(void* const* d_in, const int* in_sizes, int n_in, void* d_out, int out_size, void* d_ws, size_t ws_size, hipStream_t stream) {
    static int grid = 0;
    if (grid == 0) {
        if (n_in != 19 || out_size != MTOK * DM || ws_size < WS_END) { fprintf(stderr, "kernel_launch: unexpected problem (n_in %d out %d ws %zu)\n", n_in, out_size, ws_size); grid = -1; return; }
        int dev = 0, cus = 0, per_cu = 0;
        (void)hipGetDevice(&dev);
        (void)hipDeviceGetAttribute(&cus, hipDeviceAttributeMultiprocessorCount, dev);
        (void)hipFuncSetAttribute((const void*)mk_fwd, hipFuncAttributeMaxDynamicSharedMemorySize, LDS_BYTES);
        (void)hipOccupancyMaxActiveBlocksPerMultiprocessor(&per_cu, (const void*)mk_fwd, 512, LDS_BYTES);
        if (per_cu < 1) { fprintf(stderr, "kernel_launch: occupancy query says %d blocks per CU\n", per_cu); per_cu = 1; }
        grid = cus;
    }
    if (grid < 0) return;
    (void)hipMemsetAsync((char*)d_ws + WS_CTL, 0, CTL_BYTES, stream);
    Params p{};
    for (int i = 0; i < 19; ++i) p.in[i] = (const float*)d_in[i];
    p.out = (float*)d_out; p.ws = (unsigned char*)d_ws;
    void* args[] = {&p};
    hipError_t e = hipLaunchCooperativeKernel((const void*)mk_fwd, dim3(grid), dim3(512), args, LDS_BYTES, stream);
    if (e != hipSuccess) fprintf(stderr, "cooperative launch failed: %s (grid %d)\n", hipGetErrorString(e), grid);
}
```

```cpp
#include <hip/hip_runtime.h>
#include <hip/hip_cooperative_groups.h>
#include <cstdio>
#include <cstdint>
namespace cg = cooperative_groups;
namespace pg8 {
#define PG8_LAS __attribute__((address_space(3)))
typedef unsigned short bf16_t;
typedef short bf16x8 __attribute__((ext_vector_type(8)));
typedef float f32x4 __attribute__((ext_vector_type(4)));
typedef unsigned u32x4 __attribute__((ext_vector_type(4)));
constexpr int BM = 256, BK = 64, HALF = 128, HTB = HALF * BK * 2  , STAGE_BYTES = 8 * HTB, NXCD = 8, WGM = 8;

__host__ __device__ __forceinline__ int lds_byte(int r, int c) { const int st = (r >> 4) * 2 + (c >> 5), rr = r & 15, cc = c & 31, ob = rr * 64 + cc * 2; return st * 1024 + (ob ^ (((ob >> 9) & 1) << 5)); }
__host__ __device__ __forceinline__ void stage_rc(int b, int& R, int& C) { const int st = b / 1024, sb = b % 1024, swz = sb ^ (((sb >> 9) & 1) << 5); R = (st >> 1) * 16 + swz / 64; C = (st & 1) * 32 + (swz % 64) / 2; }
__host__ __device__ __forceinline__ int perm32(int rho) { const int n = rho >> 4, i = rho & 15; return 8 * (i >> 2) + 4 * n + (i & 3); }

struct Unit { int pm, pn; };
struct Gemm { const bf16_t* A; const bf16_t* Bt; int M, N, K; };

__device__ __forceinline__ unsigned cvt_pk_bf16(float lo, float hi) { unsigned r; asm volatile("v_cvt_pk_bf16_f32 %0, %1, %2" : "=v"(r) : "v"(lo), "v"(hi)); return r; }
typedef float f32x2 __attribute__((ext_vector_type(2)));
template <class Epi, class Sched, bool ALIGN_EPI = false, bool SP2 = false>
__device__ __forceinline__ void gemm_phase(PG8_LAS unsigned char* lds, const Gemm g, const Sched& S, const Epi& E) {
    int tid_ = threadIdx.x; asm volatile("" : "+v"(tid_));
    const int tid = tid_, wid = __builtin_amdgcn_readfirstlane(tid >> 6), lane = tid & 63, wr = wid >> 2, wc = wid & 3, fr = lane & 15, fq = lane >> 4;
    const int K = g.K, nt = K / BK;
    unsigned voffA[2], voffB[2];
#pragma unroll
    for (int i = 0; i < 2; ++i) { int R, C; stage_rc(tid * 16 + i * 8192, R, C); const int Rb = Epi::PERM ? ((R & ~31) + perm32(R & 31)) : R;
        voffA[i] = (unsigned)(R * K + C) * 2u; voffB[i] = (unsigned)(Rb * K + C) * 2u; }
    const size_t kstep = (size_t)(BK * 2);
    const size_t hstep = (size_t)HALF * K * 2;
    const size_t tstep = 2 * hstep;
    const unsigned ldsw = (unsigned)wid * 1024u;
    const int aoff = lds_byte(wr * 64 + fr, fq * 8), boff = lds_byte(wc * 32 + fr, fq * 8);
#define PG8_SA(b, h) (((b) * 2 + (h)) * HTB)
#define PG8_SB(b, h) ((4 + (b) * 2 + (h)) * HTB)
#define PG8_STAGE(bufoff, gbase, voff) do { _Pragma("unroll") for (int _i = 0; _i < 2; ++_i) \
        __builtin_amdgcn_global_load_lds((const unsigned*)((const char*)(gbase) + (voff)[_i]), (PG8_LAS unsigned*)(lds + (bufoff) + ldsw + _i * 8192), 16, 0, 0); } while (0)
#define PG8_LDA(dst, b, h) do { _Pragma("unroll") for (int m = 0; m < 4; ++m) _Pragma("unroll") for (int k = 0; k < 2; ++k) dst[m][k] = *(const PG8_LAS bf16x8*)(lds + PG8_SA(b, h) + aoff + m * 2048 + k * 1024); } while (0)
#define PG8_LDB(dst, b, h) do { _Pragma("unroll") for (int n = 0; n < 2; ++n) _Pragma("unroll") for (int k = 0; k < 2; ++k) dst[n][k] = *(const PG8_LAS bf16x8*)(lds + PG8_SB(b, h) + boff + n * 2048 + k * 1024); } while (0)
#define PG8_MMA(ai, bj, At, Bt) do { __builtin_amdgcn_s_setprio(1); _Pragma("unroll") for (int m = 0; m < 4; ++m) _Pragma("unroll") for (int n = 0; n < 2; ++n) _Pragma("unroll") for (int k = 0; k < 2; ++k) \
        acc[ai][bj][m][n] = __builtin_amdgcn_mfma_f32_16x16x32_bf16(Bt[n][k], At[m][k], acc[ai][bj][m][n], 0, 0, 0); __builtin_amdgcn_s_setprio(0); } while (0)
#define PG8_WAIT_V(n) asm volatile("s_waitcnt vmcnt(" #n ")" ::: "memory")
#define PG8_WAIT_L(n) asm volatile("s_waitcnt lgkmcnt(" #n ")" ::: "memory")
#define PG8_BAR __builtin_amdgcn_s_barrier()
#define PG8_SCHED __builtin_amdgcn_sched_barrier(0)
    Unit cur, nxt; int ui = 0;
    if (!S.next(0, cur)) return;
    f32x4 acc[2][2][4][2];
#pragma unroll
    for (int a = 0; a < 2; ++a)
#pragma unroll
        for (int b = 0; b < 2; ++b)
#pragma unroll
            for (int m = 0; m < 4; ++m)
#pragma unroll
                for (int n = 0; n < 2; ++n) acc[a][b][m][n] = (f32x4){0.f, 0.f, 0.f, 0.f};
    bf16x8 At[4][2], B0[2][2], B1[2][2];
    const char* cA = (const char*)g.A + (size_t)cur.pm * tstep; const char* cB = (const char*)g.Bt + (size_t)cur.pn * tstep;
    S.a_ready(cur);
    if constexpr (SP2) {
        PG8_STAGE(PG8_SB(0, 0), cB, voffB); PG8_STAGE(PG8_SB(0, 1), cB + hstep, voffB); PG8_STAGE(PG8_SA(0, 0), cA, voffA); PG8_STAGE(PG8_SA(0, 1), cA + hstep, voffA);
        if (wr == 1) PG8_BAR;
        PG8_WAIT_V(2); PG8_BAR;
        PG8_STAGE(PG8_SB(1, 0), cB + kstep, voffB); PG8_STAGE(PG8_SA(1, 0), cA + kstep, voffA); PG8_STAGE(PG8_SB(1, 1), cB + hstep + kstep, voffB);
        PG8_WAIT_V(6); PG8_BAR;
    } else {
        PG8_STAGE(PG8_SB(0, 0), cB, voffB); PG8_STAGE(PG8_SA(0, 0), cA, voffA); PG8_STAGE(PG8_SB(0, 1), cB + hstep, voffB); PG8_STAGE(PG8_SA(0, 1), cA + hstep, voffA);
        if (wr == 1) PG8_BAR;
        PG8_WAIT_V(4); PG8_BAR;
        PG8_STAGE(PG8_SB(1, 0), cB + kstep, voffB); PG8_STAGE(PG8_SA(1, 0), cA + kstep, voffA); PG8_STAGE(PG8_SB(1, 1), cB + hstep + kstep, voffB);
        PG8_WAIT_V(6); PG8_BAR;
    }
    for (;;) {
        const bool has_next = S.next(ui + 1, nxt);
        const char* nA = has_next ? (const char*)g.A + (size_t)nxt.pm * tstep : cA; const char* nB = has_next ? (const char*)g.Bt + (size_t)nxt.pn * tstep : cB;
        for (int t = 0; t < nt; t += 2) {
            const bool last = (t == nt - 2);
            const char* a1 = cA + (size_t)(t + 1) * kstep;
            const char* a2 = last ? nA : cA + (size_t)(t + 2) * kstep; const char* b2 = last ? nB : cB + (size_t)(t + 2) * kstep;
            const char* a3 = a2 + kstep; const char* b3 = b2 + kstep;
            if (last && has_next) S.a_ready(nxt);
            if constexpr (SP2) {
            PG8_LDB(B0, 0, 0); PG8_LDB(B1, 0, 1); PG8_SCHED; PG8_LDA(At, 0, 0); PG8_STAGE(PG8_SA(1, 1), a1 + hstep, voffA);
            PG8_WAIT_V(8); PG8_WAIT_L(0); PG8_BAR; PG8_MMA(0, 0, At, B0); PG8_MMA(0, 1, At, B1); PG8_BAR; PG8_SCHED;
            PG8_LDA(At, 0, 1); PG8_STAGE(PG8_SB(0, 0), b2, voffB); PG8_STAGE(PG8_SB(0, 1), b2 + hstep, voffB); PG8_STAGE(PG8_SA(0, 0), a2, voffA);
            PG8_WAIT_V(8); PG8_WAIT_L(0); PG8_BAR; PG8_MMA(1, 0, At, B0); PG8_MMA(1, 1, At, B1); PG8_BAR; PG8_SCHED;
            PG8_LDB(B0, 1, 0); PG8_LDB(B1, 1, 1); PG8_SCHED; PG8_LDA(At, 1, 0); PG8_STAGE(PG8_SA(0, 1), a2 + hstep, voffA);
            PG8_WAIT_V(8); PG8_WAIT_L(0); PG8_BAR; PG8_MMA(0, 0, At, B0); PG8_MMA(0, 1, At, B1); PG8_BAR; PG8_SCHED;
            PG8_LDA(At, 1, 1); PG8_STAGE(PG8_SB(1, 0), b3, voffB); PG8_STAGE(PG8_SB(1, 1), b3 + hstep, voffB); PG8_STAGE(PG8_SA(1, 0), a3, voffA);
            PG8_WAIT_V(8); PG8_WAIT_L(0); PG8_BAR; PG8_MMA(1, 0, At, B0); PG8_MMA(1, 1, At, B1); PG8_BAR; PG8_SCHED;
            } else {
            PG8_LDB(B0, 0, 0); PG8_SCHED; PG8_LDA(At, 0, 0); PG8_STAGE(PG8_SA(1, 1), a1 + hstep, voffA);
            PG8_WAIT_L(8); PG8_BAR; PG8_WAIT_L(0); PG8_MMA(0, 0, At, B0); PG8_BAR; PG8_SCHED;
            PG8_LDB(B1, 0, 1); PG8_STAGE(PG8_SB(0, 0), b2, voffB);
            PG8_BAR; PG8_WAIT_L(0); PG8_MMA(0, 1, At, B1); PG8_BAR;
            PG8_LDA(At, 0, 1); PG8_STAGE(PG8_SA(0, 0), a2, voffA);
            PG8_BAR; PG8_WAIT_L(0); PG8_MMA(1, 0, At, B0); PG8_BAR; PG8_SCHED;
            PG8_STAGE(PG8_SB(0, 1), b2 + hstep, voffB);
            PG8_WAIT_V(6); PG8_BAR; PG8_MMA(1, 1, At, B1); PG8_BAR;
            PG8_LDB(B0, 1, 0); PG8_SCHED; PG8_LDA(At, 1, 0); PG8_STAGE(PG8_SA(0, 1), a2 + hstep, voffA);
            PG8_WAIT_L(8); PG8_BAR; PG8_WAIT_L(0); PG8_MMA(0, 0, At, B0); PG8_BAR; PG8_SCHED;
            PG8_LDB(B1, 1, 1); PG8_STAGE(PG8_SB(1, 0), b3, voffB);
            PG8_BAR; PG8_WAIT_L(0); PG8_MMA(0, 1, At, B1); PG8_BAR;
            PG8_LDA(At, 1, 1); PG8_STAGE(PG8_SA(1, 0), a3, voffA);
            PG8_BAR; PG8_WAIT_L(0); PG8_MMA(1, 0, At, B0); PG8_BAR; PG8_SCHED;
            PG8_STAGE(PG8_SB(1, 1), b3 + hstep, voffB);
            PG8_WAIT_V(6); PG8_BAR; PG8_MMA(1, 1, At, B1); PG8_BAR;
            }
        }
        if constexpr (ALIGN_EPI) { if (wr == 0) PG8_BAR; }
        if constexpr (!Epi::AFTER_DRAIN) { E(acc, cur, wr, wc, fr, fq); S.done(cur); }
        if (!has_next) break;
#pragma unroll
        for (int a = 0; a < 2; ++a)
#pragma unroll
            for (int b = 0; b < 2; ++b)
#pragma unroll
                for (int m = 0; m < 4; ++m)
#pragma unroll
                    for (int n = 0; n < 2; ++n) acc[a][b][m][n] = (f32x4){0.f, 0.f, 0.f, 0.f};
        cur = nxt; cA = nA; cB = nB; ++ui;
        if constexpr (ALIGN_EPI) { if (wr == 1) PG8_BAR; }
    }
    PG8_WAIT_V(0);
    if constexpr (!ALIGN_EPI) { if (wr == 0) PG8_BAR; }
    PG8_BAR;
    if constexpr (Epi::AFTER_DRAIN) { E.fused(acc, cur, wr, wc, fr, fq, lds, wid, lane); S.done(cur); }
#undef PG8_SA
#undef PG8_SB
#undef PG8_STAGE
#undef PG8_LDA
#undef PG8_LDB
#undef PG8_MMA
#undef PG8_WAIT_V
#undef PG8_WAIT_L
#undef PG8_BAR
#undef PG8_SCHED
}
}

#define GAS __attribute__((address_space(1)))
#define LAS __attribute__((address_space(3)))
typedef unsigned short bf16;
typedef short bf16x8 __attribute__((ext_vector_type(8)));
typedef float f32x4 __attribute__((ext_vector_type(4)));
typedef float f32x16 __attribute__((ext_vector_type(16)));
typedef unsigned u32x4 __attribute__((ext_vector_type(4)));
typedef unsigned u32x2 __attribute__((ext_vector_type(2)));
typedef float f32x2_t __attribute__((ext_vector_type(2)));
typedef __bf16 bf16x2_t __attribute__((ext_vector_type(2)));
using pg8::Unit;

constexpr int NB = 16, SEQ = 2048, MTOK = NB * SEQ, DM = 1024, NPROJ = 2560, DEPTH = 2;
constexpr int NTT = MTOK / 256;
constexpr int ZROWS = MTOK + DEPTH * NPROJ;
constexpr float RMS_EPS = 1e-6f;
constexpr float LOG2E = 1.4426950408889634f;
constexpr float QSCALE = 0.125f * LOG2E;
constexpr int LDS_BYTES = 147456;
constexpr int LDS_MISC = 131072;
constexpr int LDS_CTL = LDS_BYTES - 512;

constexpr size_t MiB = 1u << 20;
constexpr size_t WS_CTL = 0, CTL_BYTES = 1 * MiB;
constexpr size_t WS_Z = 2 * MiB, WS_WOUT = 78 * MiB, WS_GLU = 82 * MiB, WS_TE = 83 * MiB, WS_G = 89 * MiB, WS_AT = 91 * MiB;
constexpr size_t WS_U = 92 * MiB, WS_SG = 108 * MiB, WS_AQ = 124 * MiB, WS_AK = 148 * MiB, WS_AG = 156 * MiB, WS_MQ = 180 * MiB, WS_MK = 204 * MiB, WS_MG = 212 * MiB;
constexpr size_t WS_VT = 236 * MiB, WS_KPART = 252 * MiB, WS_ROWSS = 253 * MiB, WS_YPRE = 254 * MiB, WS_Y = 270 * MiB, WS_END = 334 * MiB;
static_assert(WS_Z + (size_t)ZROWS * DM * 2 <= WS_WOUT, "Z fits");
constexpr size_t WS_NW = 1 * MiB;
constexpr int TE_ELEMS = 256 * 384, G_ELEMS = 128 * 256;
constexpr int CW_QUEUE = 1024;

__device__ __forceinline__ unsigned pk2(float lo, float hi) { f32x2_t v = {lo, hi}; bf16x2_t b = __builtin_convertvector(v, bf16x2_t); return __builtin_bit_cast(unsigned, b); }
__device__ __forceinline__ float bf2f(unsigned short x) { return __uint_as_float((unsigned)x << 16); }
__device__ __forceinline__ float bflo(unsigned w) { return __uint_as_float(w << 16); }
__device__ __forceinline__ float bfhi(unsigned w) { return __uint_as_float(w & 0xffff0000u); }
__device__ __forceinline__ float wave_sum(float v) {
#pragma unroll
    for (int o = 1; o < 64; o <<= 1) v += __shfl_xor(v, o);
    return v;
}
__device__ __forceinline__ float fast_rcp(float x) { return __builtin_amdgcn_rcpf(x); }
__device__ __forceinline__ float silu_f(float x) { return x * fast_rcp(1.f + __builtin_amdgcn_exp2f(-x * LOG2E)); }
__device__ __forceinline__ float sigmoid_f(float x) { return fast_rcp(1.f + __builtin_amdgcn_exp2f(-x * LOG2E)); }
__device__ __forceinline__ float gelu_tanh_f(float x) { const float z = 0.7978845608028654f * (x + 0.044715f * x * x * x); return x * fast_rcp(1.f + __builtin_amdgcn_exp2f(-2.f * LOG2E * z)); }
__device__ __forceinline__ float swap32_max(float m) { auto rr = __builtin_amdgcn_permlane32_swap(__float_as_uint(m), __float_as_uint(m), false, false); return fmaxf(__uint_as_float(rr[0]), __uint_as_float(rr[1])); }
__device__ __forceinline__ float swap32_sum(float m) { auto rr = __builtin_amdgcn_permlane32_swap(__float_as_uint(m), __float_as_uint(m), false, false); return __uint_as_float(rr[0]) + __uint_as_float(rr[1]); }
__device__ __forceinline__ void glds16(const void* gsrc, LAS unsigned char* ldst) {
    __builtin_amdgcn_global_load_lds((const unsigned*)gsrc, (LAS unsigned*)ldst, 16, 0, 0);
}

struct Params {
    const float* in[19]; float* out; unsigned char* ws;
};
typedef const float* const __attribute__((address_space(4))) * kargs_t;
__device__ __forceinline__ const float* kin(int i) { kargs_t ka = (kargs_t)__builtin_amdgcn_kernarg_segment_ptr(); asm volatile("" : "+s"(ka)); return ka[i]; }
struct Frame {
    LAS unsigned char* lds; int tid, lane, wave, G, bid; float* out; unsigned char* ws; unsigned* ctl;
};

__device__ __forceinline__ int proj_dest_row(int n0) {
    int slot, off;
    if (n0 < 512)       { slot = n0 >> 6; off = n0 & 63; }
    else if (n0 < 1024) { slot = 8 + ((n0 - 512) >> 6); off = n0 & 63; }
    else if (n0 < 1152) { return 2304 + (n0 - 1024); }
    else if (n0 < 1536) { slot = 16 + ((n0 - 1152) >> 6); off = (n0 - 1152) & 63; }
    else if (n0 < 1920) { slot = 22 + ((n0 - 1536) >> 6); off = (n0 - 1536) & 63; }
    else if (n0 < 2048) { slot = 28 + ((n0 - 1920) >> 6); off = (n0 - 1920) & 63; }
    else if (n0 < 2176) { return 2304 + 128 + (n0 - 2048); }
    else                { slot = 30 + ((n0 - 2176) >> 6); off = (n0 - 2176) & 63; }
    const int t = slot >> 2, wc = slot & 3;
    return 256 * t + 128 * (off >> 5) + 32 * wc;
}
__device__ __forceinline__ void p0_transpose_item(const float* W, int K, int N, const float* gk, bf16* WT, int ldk, int drow0, LAS float* scr, int k0, int n0, int lane) {
#pragma unroll 8
    for (int i = 0; i < 32; ++i) { const int kk = 2 * i + (lane >> 5); float v = W[(size_t)(k0 + kk) * N + n0 + (lane & 31)]; if (gk) v *= gk[k0 + kk]; scr[kk * 33 + (lane & 31)] = v; }
    asm volatile("s_waitcnt lgkmcnt(0)" ::: "memory");
    const int c = lane & 7;
#pragma unroll
    for (int j = 0; j < 4; ++j) { const int n = (lane >> 3) + 8 * j; const LAS float* s = scr + (8 * c) * 33 + n;
        u32x4 o; o.x = pk2(s[0 * 33], s[1 * 33]); o.y = pk2(s[2 * 33], s[3 * 33]); o.z = pk2(s[4 * 33], s[5 * 33]); o.w = pk2(s[6 * 33], s[7 * 33]);
        *(u32x4*)(WT + (size_t)(drow0 + n) * ldk + k0 + 8 * c) = o; }
    asm volatile("s_waitcnt lgkmcnt(0)" ::: "memory");
}
__device__ __forceinline__ void p0_ssm_consts(const Params& P, Frame& F, int pair) {
    const int l = pair >> 4, g = pair & 15, tid = F.tid;
    LAS float* pwr = (LAS float*)(F.lds);
    LAS float* pwi = pwr + 17 * 64;
    LAS float* bbr = pwi + 17 * 64;
    LAS float* bbi = bbr + 1024;
    LAS float* ccr = bbi + 1024;
    LAS float* cci = ccr + 1024;
    LAS float* Kt = cci + 1024;
    const float dt = expf(kin(5)[l * 16 + g]);
    const float* lre = kin(3) + (l * 16 + g) * 64; const float* lim = kin(4) + (l * 16 + g) * 64;
    for (int t = tid; t < 17 * 64; t += 512) { const int p = t & 63, lag = t >> 6; const float lr = lre[p], li = lim[p];
        const float mag = expf(lr * dt * (float)lag); float sn, cs; sincosf(li * dt * (float)lag, &sn, &cs); pwr[t] = mag * cs; pwi[t] = mag * sn; }
    for (int t = tid; t < 1024; t += 512) { const int p = t >> 4, h = t & 15; const float lr = lre[p], li = lim[p];
        const float mag = expf(lr * dt); float sn, cs; sincosf(li * dt, &sn, &cs); const float ar = mag * cs, ai = mag * sn;
        const float den = lr * lr + li * li, nr = ar - 1.f, ni = ai; const float cr = (nr * lr + ni * li) / den, ci = (ni * lr - nr * li) / den;
        const float br = kin(6)[((size_t)(l * 16 + g) * 64 + p) * 16 + h], bi = kin(7)[((size_t)(l * 16 + g) * 64 + p) * 16 + h];
        bbr[t] = cr * br - ci * bi; bbi[t] = cr * bi + ci * br; }
    for (int t = tid; t < 1024; t += 512) { ccr[t] = kin(8)[(size_t)(l * 16 + g) * 1024 + t]; cci[t] = kin(9)[(size_t)(l * 16 + g) * 1024 + t]; }
    __syncthreads();
    for (int t = tid; t < 4096; t += 512) { const int lag = t >> 8, hp = (t >> 4) & 15, h = t & 15; float s = 0.f;
        for (int p = 0; p < 64; ++p) { const float cr = ccr[hp * 64 + p], ci = cci[hp * 64 + p], pr = pwr[lag * 64 + p], pi = pwi[lag * 64 + p];
            const float xr = cr * pr - ci * pi, xi = cr * pi + ci * pr; s += xr * bbr[p * 16 + h] - xi * bbi[p * 16 + h]; }
        if (lag == 0 && hp == h) s += kin(10)[l * 256 + g * 16 + h];
        Kt[t] = s; }
    __syncthreads();
    bf16* TE = ((bf16*)(F.ws + WS_TE)) + (size_t)pair * TE_ELEMS; bf16* GM = ((bf16*)(F.ws + WS_G)) + (size_t)pair * G_ELEMS;
    for (int t = tid; t < 256 * 192; t += 512) { const int n = t / 192, kp = t % 192, k = 2 * kp; const int i = n >> 4, hp = n & 15; float v0, v1;
        if (k < 256) { const int j = k >> 4, h = k & 15; if (j <= i) { v0 = Kt[((i - j) * 16 + hp) * 16 + h]; v1 = Kt[((i - j) * 16 + hp) * 16 + h + 1]; } else { v0 = 0.f; v1 = 0.f; } }
        else { const int p = (k - 256) >> 1; const float cr = ccr[hp * 64 + p], ci = cci[hp * 64 + p], pr = pwr[(i + 1) * 64 + p], pi = pwi[(i + 1) * 64 + p];
            v0 = cr * pr - ci * pi; v1 = -(cr * pi + ci * pr); }
        *(unsigned*)(TE + (size_t)n * 384 + k) = pk2(v0, v1); }
    for (int t = tid; t < 128 * 128; t += 512) { const int n = t >> 7, kp = t & 127, k = 2 * kp; const int p = n >> 1, ri = n & 1, j = k >> 4, h = k & 15;
        const float pr = pwr[(15 - j) * 64 + p], pi = pwi[(15 - j) * 64 + p];
        float v0, v1;
        { const float br = bbr[p * 16 + h], bi = bbi[p * 16 + h]; v0 = ri ? (pr * bi + pi * br) : (pr * br - pi * bi); }
        { const float br = bbr[p * 16 + h + 1], bi = bbi[p * 16 + h + 1]; v1 = ri ? (pr * bi + pi * br) : (pr * br - pi * bi); }
        *(unsigned*)(GM + (size_t)n * 256 + k) = pk2(v0, v1); }
    if (tid < 64) { ((float*)(F.ws + WS_AT))[(size_t)pair * 128 + 2 * tid] = pwr[16 * 64 + tid]; ((float*)(F.ws + WS_AT))[(size_t)pair * 128 + 2 * tid + 1] = pwi[16 * 64 + tid]; }
    __syncthreads();
}
__device__ __forceinline__ void p0_prologue(const Params& P, Frame& F) {
    const bool split = F.G > 64;
    if (!split || F.bid < 32) { for (int pair = F.bid; pair < 32; pair += (split ? 32 : F.G)) p0_ssm_consts(P, F, pair); if (split) return; }
    const int vb = split ? F.bid - 32 : F.bid, nvb = split ? F.G - 32 : F.G;
    if (vb == 0) { float* nwp = (float*)(F.ws + WS_NW);
        for (int t = F.tid; t < DEPTH * 256; t += 512) { const int l = t >> 8, k = (t >> 6) & 3, d = t & 63;
            nwp[t] = (k == 0) ? kin(13)[l * 64 + d] * QSCALE : (k == 1) ? kin(14)[l * 64 + d] : (k == 2) ? kin(16)[l * 64 + d] * QSCALE : kin(17)[l * 64 + d]; } }
    const int gw = vb * 8 + F.wave, NGW = nvb * 8;
    LAS float* scr = (LAS float*)(F.lds + F.wave * 16384);
    constexpr int I_IN = 16 * 80, I_OUT = 16 * 32, I_GLU = 4 * 8, I_L = I_IN + I_OUT + I_GLU;
    for (int it = gw; it < DEPTH * I_L; it += NGW) {
        const int l = it / I_L; int r = it % I_L;
        if (r < I_IN) { const int kb = r / 80, nb = r % 80; p0_transpose_item(kin(2) + (size_t)l * DM * NPROJ, DM, NPROJ, kin(1) + l * DM, ((bf16*)(F.ws + WS_Z)) + (size_t)(MTOK + l * NPROJ) * DM, DM, proj_dest_row(32 * nb), scr, 64 * kb, 32 * nb, F.lane); continue; }
        r -= I_IN;
        if (r < I_OUT) { const int kb = r / 32, nb = r % 32; p0_transpose_item(kin(18) + (size_t)l * DM * DM, DM, DM, nullptr, ((bf16*)(F.ws + WS_WOUT)) + (size_t)l * DM * DM, DM, 32 * nb, scr, 64 * kb, 32 * nb, F.lane); continue; }
        r -= I_OUT;
        { const int kb = r / 8, nb = r % 8; p0_transpose_item(kin(11) + (size_t)l * 65536, 256, 256, nullptr, ((bf16*)(F.ws + WS_GLU)) + (size_t)l * 65536, 256, 32 * nb, scr, 64 * kb, 32 * nb, F.lane); }
    }
    for (int m = gw; m < MTOK; m += NGW) {
        const f32x4* xr = (const f32x4*)(kin(0) + (size_t)m * DM) + F.lane; f32x4 v[4]; float s = 0.f;
#pragma unroll
        for (int j = 0; j < 4; ++j) { v[j] = xr[64 * j]; s += (v[j].x * v[j].x + v[j].y * v[j].y) + (v[j].z * v[j].z + v[j].w * v[j].w); }
        s = wave_sum(s);
        u32x2* o8 = (u32x2*)(((bf16*)(F.ws + WS_Z)) + (size_t)m * DM) + F.lane;
#pragma unroll
        for (int j = 0; j < 4; ++j) { u32x2 w; w.x = pk2(v[j].x, v[j].y); w.y = pk2(v[j].z, v[j].w); o8[64 * j] = w; }
        if (F.lane < 4) ((float*)(F.ws + WS_ROWSS))[(size_t)m * 4 + F.lane] = (F.lane == 0) ? s : 0.f;
    }
}

__device__ __forceinline__ Frame phase_frame(const Frame& F0) {
    Frame F = F0; asm volatile("" : "+v"(F.tid)); F.lane = F.tid & 63; F.wave = __builtin_amdgcn_readfirstlane(F.tid >> 6);
    asm volatile("" : "+s"(F.ws)); F.ctl = (unsigned*)(F.ws + WS_CTL); return F;
}
struct SchedTab { const volatile LAS int* tab; int n;
    __device__ __forceinline__ bool next(int i, Unit& u) const { if (i >= n) return false; u.pm = __builtin_amdgcn_readfirstlane(tab[2 * i]); u.pn = __builtin_amdgcn_readfirstlane(tab[2 * i + 1]); return true; }
    __device__ __forceinline__ void a_ready(const Unit&) const {}
    __device__ __forceinline__ void done(const Unit&) const {}
};
__device__ __forceinline__ bool unit_p1(int G, int c, int wbase, int i, int& pm, int& pn) {
    int tok, j;
    if (G == 256) { if (i >= 5) return false; const int x = c & 7, l = c >> 3, n = i * 32 + l, tq = n / 40, rem = n % 40; j = rem >> 2; tok = 16 * x + 4 * tq + (rem & 3); }
    else { const long L = (long)i * G + c; if (L >= NTT * 10) return false; tok = (int)(L / 10); j = (int)(L % 10); }
    if (j < 9) { pm = tok; pn = wbase + j; } else { pm = wbase + 9; pn = tok; }
    return true;
}
__device__ __forceinline__ bool unit_p3(int G, int c, int i, int& pm, int& pn) {
    if (G == 256) { if (i >= 2) return false; const int x = c & 7, l = c >> 3, n = i * 32 + l, tq = n >> 4, rem = n & 15; pn = rem >> 2; pm = 16 * x + 4 * tq + (rem & 3); }
    else { const long L = (long)i * G + c; if (L >= NTT * 4) return false; pm = (int)(L / 4); pn = (int)(L % 4); }
    return true;
}
__device__ __forceinline__ bool unit_glu(int G, int c, int i, int& pm, int& pn) {
    if (G == 256) { if (i >= 1 || (c >> 3) >= 16) return false; pm = 16 * (c & 7) + (c >> 3); pn = 0; }
    else { const long L = (long)i * G + c; if (L >= NTT) return false; pm = (int)L; pn = 0; }
    return true;
}
template <int KIND>
__device__ __forceinline__ SchedTab make_sched(const Frame& F, int wbase) {
    volatile LAS int* tab = (volatile LAS int*)(F.lds + LDS_CTL + 64);
    volatile LAS int* cnt = (volatile LAS int*)(F.lds + LDS_CTL + 32);
    if (F.tid == 0) { int n = 0;
#pragma unroll 1
        for (int i = 0; i < 24; ++i) { int pm, pn; const bool ok = (KIND == 0) ? unit_p1(F.G, F.bid, wbase, i, pm, pn) : (KIND == 1) ? unit_p3(F.G, F.bid, i, pm, pn) : unit_glu(F.G, F.bid, i, pm, pn);
            if (!ok) break; tab[2 * i] = pm; tab[2 * i + 1] = pn; n = i + 1; }
        cnt[0] = n; }
    __syncthreads();
    SchedTab S; S.tab = tab; S.n = __builtin_amdgcn_readfirstlane(cnt[0]); return S;
}

struct EpiProj {
    static constexpr bool PERM = true, AFTER_DRAIN = false;
    int wbase, layer; unsigned char* ws;
    __device__ __forceinline__ void operator()(const f32x4 (&acc)[2][2][4][2], const Unit& u, int wr, int wc, int fr, int fq) const {
        const float* rowss = (const float*)(ws + WS_ROWSS);
        if (u.pm >= NTT) {
            bf16* VT = (bf16*)(ws + WS_VT);
            const int tc = u.pn * 256 + wc * 32 + 8 * fq;
            float rs[2][8];
#pragma unroll
            for (int bj = 0; bj < 2; ++bj)
#pragma unroll
                for (int e = 0; e < 8; ++e) { const f32x4 p = *(const f32x4*)(rowss + (size_t)(tc + bj * 128 + e) * 4); rs[bj][e] = rsqrtf(((p.x + p.y) + (p.z + p.w)) * (1.f / DM) + RMS_EPS); }
#pragma unroll
            for (int ai = 0; ai < 2; ++ai)
#pragma unroll
                for (int m = 0; m < 4; ++m) { const int f = ai * 128 + wr * 64 + m * 16 + fr;
#pragma unroll
                    for (int bj = 0; bj < 2; ++bj) { const f32x4 a = acc[ai][bj][m][0], b = acc[ai][bj][m][1]; u32x4 w;
                        w.x = pk2(a[0] * rs[bj][0], a[1] * rs[bj][1]); w.y = pk2(a[2] * rs[bj][2], a[3] * rs[bj][3]); w.z = pk2(b[0] * rs[bj][4], b[1] * rs[bj][5]); w.w = pk2(b[2] * rs[bj][6], b[3] * rs[bj][7]);
                        *(u32x4*)(VT + (size_t)f * MTOK + tc + bj * 128) = w; } }
            return;
        }
        const int t = u.pn - wbase;
        int kind, pitch, col, nwi = 0; size_t dsto;
        switch (t) {
            case 0: kind = 0; dsto = WS_U; pitch = 256; col = 64 * wc; break;
            case 1: kind = 1; dsto = WS_SG; pitch = 256; col = 64 * wc; break;
            case 2: kind = 2; dsto = WS_AQ; pitch = 384; col = 64 * wc; nwi = 0; break;
            case 3: if (wc < 2) { kind = 2; dsto = WS_AQ; pitch = 384; col = 64 * (4 + wc); nwi = 0; } else { kind = 2; dsto = WS_AK; pitch = 128; col = 64 * (wc - 2); nwi = 1; } break;
            case 4: kind = 1; dsto = WS_AG; pitch = 384; col = 64 * wc; break;
            case 5: if (wc < 2) { kind = 1; dsto = WS_AG; pitch = 384; col = 64 * (4 + wc); } else { kind = 2; dsto = WS_MQ; pitch = 384; col = 64 * (wc - 2); nwi = 2; } break;
            case 6: kind = 2; dsto = WS_MQ; pitch = 384; col = 64 * (2 + wc); nwi = 2; break;
            case 7: if (wc < 2) { kind = 5; dsto = WS_MK; pitch = 128; col = 64 * wc; nwi = 3; } else { kind = 1; dsto = WS_MG; pitch = 384; col = 64 * (wc - 2); } break;
            default: kind = 1; dsto = WS_MG; pitch = 384; col = 64 * (2 + wc); break;
        }
        bf16* dst = (bf16*)(ws + dsto) + col + 8 * fq; const float* nw = (const float*)(ws + WS_NW) + (layer * 4 + nwi) * 64 + 8 * fq;
        const int row0 = u.pm * 256 + wr * 64 + fr;
        if (kind == 0) rows<0>(acc, row0, dst, pitch, nw, rowss, nullptr);
        else if (kind == 1) rows<1>(acc, row0, dst, pitch, nw, rowss, nullptr);
        else if (kind == 2) rows<2>(acc, row0, dst, pitch, nw, rowss, nullptr);
        else rows<5>(acc, row0, dst, pitch, nw, rowss, (fr == 0) ? (float*)(ws + WS_KPART) + ((size_t)(u.pm * 2 + wr) * 2 + wc) * 64 + 8 * fq : nullptr);
    }
    template <int KIND>
    __device__ __forceinline__ void rows(const f32x4 (&acc)[2][2][4][2], int row0, bf16* dst, int pitch, const float* nw, const float* rowss, float* kp) const {
        f32x4 wv[2][2], ks[2][2];
        if (KIND >= 2) {
#pragma unroll
            for (int bj = 0; bj < 2; ++bj)
#pragma unroll
                for (int n = 0; n < 2; ++n) { wv[bj][n] = *(const f32x4*)(nw + 32 * bj + 4 * n); ks[bj][n] = (f32x4){0.f, 0.f, 0.f, 0.f}; }
        }
#pragma unroll
        for (int ai = 0; ai < 2; ++ai)
#pragma unroll
            for (int m = 0; m < 4; ++m) {
                const int row = row0 + ai * 128 + m * 16;
                const f32x4 p = *(const f32x4*)(rowss + (size_t)row * 4);
                const float rs = rsqrtf(((p.x + p.y) + (p.z + p.w)) * (1.f / DM) + RMS_EPS);
                f32x4 v[2][2];
#pragma unroll
                for (int bj = 0; bj < 2; ++bj)
#pragma unroll
                    for (int n = 0; n < 2; ++n) v[bj][n] = acc[ai][bj][m][n] * rs;
                if (KIND >= 2) {
                    float ss = 0.f;
#pragma unroll
                    for (int bj = 0; bj < 2; ++bj)
#pragma unroll
                        for (int n = 0; n < 2; ++n) { const f32x4 q = v[bj][n]; ss += (q[0] * q[0] + q[1] * q[1]) + (q[2] * q[2] + q[3] * q[3]); }
                    ss += __shfl_xor(ss, 16); ss += __shfl_xor(ss, 32);
                    const float hn = rsqrtf(ss * (1.f / 64.f) + RMS_EPS);
#pragma unroll
                    for (int bj = 0; bj < 2; ++bj)
#pragma unroll
                        for (int n = 0; n < 2; ++n) { v[bj][n] = v[bj][n] * wv[bj][n] * hn; if (KIND == 5) ks[bj][n] += v[bj][n]; }
                } else if (KIND == 1) {
#pragma unroll
                    for (int bj = 0; bj < 2; ++bj)
#pragma unroll
                        for (int n = 0; n < 2; ++n)
#pragma unroll
                            for (int e = 0; e < 4; ++e) v[bj][n][e] = silu_f(v[bj][n][e]);
                }
                bf16* rp = dst + (size_t)row * pitch;
#pragma unroll
                for (int bj = 0; bj < 2; ++bj) { u32x4 w; w.x = pk2(v[bj][0][0], v[bj][0][1]); w.y = pk2(v[bj][0][2], v[bj][0][3]); w.z = pk2(v[bj][1][0], v[bj][1][1]); w.w = pk2(v[bj][1][2], v[bj][1][3]);
                    *(u32x4*)(rp + 32 * bj) = w; }
                if (m & 1) asm volatile("" ::: "memory");
            }
        if (KIND == 5) {
#pragma unroll
            for (int bj = 0; bj < 2; ++bj)
#pragma unroll
                for (int n = 0; n < 2; ++n)
#pragma unroll
                    for (int e = 0; e < 4; ++e) { float s = ks[bj][n][e]; s += __shfl_xor(s, 1); s += __shfl_xor(s, 2); s += __shfl_xor(s, 4); s += __shfl_xor(s, 8); ks[bj][n][e] = s; }
            if (kp) {
#pragma unroll
                for (int bj = 0; bj < 2; ++bj)
#pragma unroll
                    for (int n = 0; n < 2; ++n) *(f32x4*)(kp + 32 * bj + 4 * n) = ks[bj][n];
            }
        }
    }
};
struct EpiGlu {
    static constexpr bool PERM = true, AFTER_DRAIN = false;
    const bf16* YPRE; const bf16* SG; const float* gb; bf16* Y;
    __device__ __forceinline__ void operator()(const f32x4 (&acc)[2][2][4][2], const Unit& u, int wr, int wc, int fr, int fq) const {
#pragma unroll
        for (int bj = 0; bj < 2; ++bj) { const int c = wc * 32 + 8 * fq + 128 * bj;
            const f32x4 b0 = *(const f32x4*)(gb + c), b1 = *(const f32x4*)(gb + c + 4);
#pragma unroll
            for (int ai = 0; ai < 2; ++ai)
#pragma unroll
                for (int m = 0; m < 4; ++m) { const int row = u.pm * 256 + ai * 128 + wr * 64 + m * 16 + fr;
                    const u32x4 yp = *(const u32x4*)(YPRE + (size_t)row * 256 + c), sg = *(const u32x4*)(SG + (size_t)row * 256 + c);
                    const f32x4 z0 = acc[ai][bj][m][0] + b0, z1 = acc[ai][bj][m][1] + b1;
                    u32x4 w;
                    w.x = pk2(bflo(yp.x) * sigmoid_f(z0[0]) * bflo(sg.x), bfhi(yp.x) * sigmoid_f(z0[1]) * bfhi(sg.x));
                    w.y = pk2(bflo(yp.y) * sigmoid_f(z0[2]) * bflo(sg.y), bfhi(yp.y) * sigmoid_f(z0[3]) * bfhi(sg.y));
                    w.z = pk2(bflo(yp.z) * sigmoid_f(z1[0]) * bflo(sg.z), bfhi(yp.z) * sigmoid_f(z1[1]) * bfhi(sg.z));
                    w.w = pk2(bflo(yp.w) * sigmoid_f(z1[2]) * bflo(sg.w), bfhi(yp.w) * sigmoid_f(z1[3]) * bfhi(sg.w));
                    *(u32x4*)(Y + (size_t)row * DM + c) = w;
                    if (m & 1) asm volatile("" ::: "memory"); } }
    }
};
struct EpiOut {
    static constexpr bool PERM = false, AFTER_DRAIN = false;
    const float* resid; float* out; bf16* xb; float* rowss; int write_next; LAS float* xch;
    __device__ __forceinline__ void operator()(const f32x4 (&acc)[2][2][4][2], const Unit& u, int wr, int wc, int fr, int fq) const {
        const int c0 = u.pn * 256 + wc * 32 + 4 * fq;
#pragma unroll
        for (int ai = 0; ai < 2; ++ai)
#pragma unroll
            for (int m = 0; m < 4; ++m) { const int rt = ai * 128 + wr * 64 + m * 16 + fr; const size_t off = (size_t)(u.pm * 256 + rt) * DM + c0; float ss = 0.f;
#pragma unroll
                for (int bj = 0; bj < 2; ++bj)
#pragma unroll
                    for (int n = 0; n < 2; ++n) { const size_t o2 = off + bj * 128 + n * 16; const f32x4 o = *(const f32x4*)(resid + o2) + acc[ai][bj][m][n];
                        *(f32x4*)(out + o2) = o;
                        if (write_next) { u32x2 w; w.x = pk2(o[0], o[1]); w.y = pk2(o[2], o[3]); *(u32x2*)(xb + o2) = w; ss += (o[0] * o[0] + o[1] * o[1]) + (o[2] * o[2] + o[3] * o[3]); } }
                if (write_next) { ss += __shfl_xor(ss, 16); ss += __shfl_xor(ss, 32); if (fq == 0) xch[rt * 4 + wc] = ss; }
            }
        asm volatile("s_waitcnt lgkmcnt(0)" ::: "memory"); __builtin_amdgcn_s_barrier(); asm volatile("" ::: "memory");
        if (write_next && threadIdx.x < 256) { const f32x4 p = *(const LAS f32x4*)(xch + threadIdx.x * 4); rowss[(size_t)(u.pm * 256 + threadIdx.x) * 4 + u.pn] = (p.x + p.y) + (p.z + p.w); }
    }
};

__device__ __forceinline__ int pi32(int r) { return (r & ~12) | ((r & 8) >> 1) | ((r & 4) << 1); }
template <int MODE>
__device__ __forceinline__ void attn_tile(const bf16x8 (&kf)[4], const bf16x8 (&vf)[2][2], const bf16x8 (&qf)[4], float cinit, float& m, float& l, f32x16 (&O)[2], int a, int h) {
    f32x16 S;
#pragma unroll
    for (int i = 0; i < 16; ++i) S[i] = cinit;
#pragma unroll
    for (int ks = 0; ks < 4; ++ks) S = __builtin_amdgcn_mfma_f32_32x32x16_bf16(kf[ks], qf[ks], S, 0, 0, 0);
    if (MODE != 0) {
#pragma unroll
        for (int i = 0; i < 16; ++i) { const int c = pi32((i & 3) + 8 * (i >> 2) + 4 * h); const bool dead = (MODE == 1) ? (c > a) : (c <= a); if (dead) S[i] = -1e30f; }
    }
    float mx = fmaxf(fmaxf(S[0], S[1]), fmaxf(S[2], S[3]));
#pragma unroll
    for (int i = 4; i < 16; i += 4) mx = fmaxf(mx, fmaxf(fmaxf(S[i], S[i + 1]), fmaxf(S[i + 2], S[i + 3])));
    mx = swap32_max(mx);
    if (__any(mx > m + 8.f)) {
        const float mn = fmaxf(m, mx), al = __builtin_amdgcn_exp2f(m - mn);
        l *= al;
#pragma unroll
        for (int i = 0; i < 16; ++i) { O[0][i] *= al; O[1][i] *= al; }
        m = mn;
    }
    float sum = 0.f;
#pragma unroll
    for (int i = 0; i < 16; ++i) { S[i] = __builtin_amdgcn_exp2f(S[i] - m); sum += S[i]; }
    l += sum;
    bf16x8 pb[2];
#pragma unroll
    for (int s = 0; s < 2; ++s) { u32x4 w; w.x = pk2(S[8 * s], S[8 * s + 1]); w.y = pk2(S[8 * s + 2], S[8 * s + 3]); w.z = pk2(S[8 * s + 4], S[8 * s + 5]); w.w = pk2(S[8 * s + 6], S[8 * s + 7]); pb[s] = __builtin_bit_cast(bf16x8, w); }
#pragma unroll
    for (int dt = 0; dt < 2; ++dt)
#pragma unroll
        for (int s = 0; s < 2; ++s) O[dt] = __builtin_amdgcn_mfma_f32_32x32x16_bf16(vf[dt][s], pb[s], O[dt], 0, 0, 0);
}
template <int NK>
__device__ __forceinline__ void stage_kv(LAS unsigned char* Kimg, LAS unsigned char* Vimg, const bf16* Ksrc  , const bf16* Vsrc  ,
                                         long key_lo  , long key_min  , int wave, int lane) {
    constexpr int KP = NK * 128 / 1024, VCH = NK / 8, VP = 64 * VCH * 16 / 1024;
    for (int p = wave; p < KP; p += 8) { const int L = p * 64 + lane, r = L >> 3, s = L & 7, c = s ^ ((r >> 1) & 7); long kr = key_lo + r; if (kr < key_min) kr = key_min;
        glds16(Ksrc + (kr - key_lo) * 128 + c * 8, Kimg + p * 1024); }
    for (int p = wave; p < VP; p += 8) { const int L = p * 64 + lane, d = L / VCH, s = L % VCH, c = s ^ (d & 15); long kc = key_lo + 8 * c; if (kc < key_min) kc = key_min;
        glds16(Vsrc + (size_t)d * MTOK + (kc - key_lo), Vimg + p * 1024); }
}
template <int NK>
__device__ __forceinline__ void load_kv_frags(bf16x8 (&kf)[4], bf16x8 (&vf)[2][2], const LAS unsigned char* Kimg, const LAS unsigned char* Vimg, int row0  , int lane) {
    const int r = row0 + pi32(lane & 31), h = lane >> 5;
#pragma unroll
    for (int ks = 0; ks < 4; ++ks) kf[ks] = *(const LAS bf16x8*)(Kimg + r * 128 + (((2 * ks + h) ^ ((r >> 1) & 7)) << 4));
#pragma unroll
    for (int dt = 0; dt < 2; ++dt) { const int d = 32 * dt + (lane & 31);
#pragma unroll
        for (int s = 0; s < 2; ++s) { const int c = (row0 >> 3) + 2 * s + h; vf[dt][s] = *(const LAS bf16x8*)(Vimg + d * (NK * 2) + ((c ^ (d & 15)) << 4)); } }
}
__device__ __forceinline__ void attn_store(const f32x16 (&O)[2], float l, const bf16* gate  , bf16* y  , int h) {
    const float inv = 1.f / swap32_sum(l);
#pragma unroll
    for (int dt = 0; dt < 2; ++dt)
#pragma unroll
        for (int q = 0; q < 4; ++q) { const int d = 32 * dt + 8 * q + 4 * h; const u32x2 gv = *(const u32x2*)(gate + d);
            u32x2 w; w.x = pk2(O[dt][4 * q] * inv * bflo(gv.x), O[dt][4 * q + 1] * inv * bfhi(gv.x)); w.y = pk2(O[dt][4 * q + 2] * inv * bflo(gv.y), O[dt][4 * q + 3] * inv * bfhi(gv.y));
            *(u32x2*)(y + d) = w; }
}

__device__ __forceinline__ void moba_unit(Frame& F, int b, int kvh, int qb) {
    constexpr int IMG = 32768;
    LAS unsigned char* buf0 = F.lds; LAS unsigned char* buf1 = F.lds + 2 * IMG;
    LAS float* km = (LAS float*)(F.lds + LDS_MISC + 1024);
    const int lane = F.lane, wave = F.wave, a = lane & 31, h = lane >> 5;
    const long tok0 = (long)b * SEQ + 256 * qb;
    const bf16* Kb = ((bf16*)(F.ws + WS_MK)) + (size_t)b * SEQ * 128 + kvh * 64;
    const bf16* Vb = ((bf16*)(F.ws + WS_VT)) + (size_t)(128 + kvh * 64) * MTOK + (size_t)b * SEQ;
    const int nsteps = qb + 1, T = 3 * nsteps;
    stage_kv<256>(buf0, buf0 + IMG, Kb + (size_t)(256 * qb) * 128, Vb + 256 * qb, 0, 0, wave, lane);
    { const int n = F.tid >> 6, d = F.tid & 63; float s = 0.f;
      if (n < qb) { const int tile = b * 8 + n; s = ((float*)(F.ws + WS_KPART))[((size_t)(tile * 2 + 0) * 2 + kvh) * 64 + d] + ((float*)(F.ws + WS_KPART))[((size_t)(tile * 2 + 1) * 2 + kvh) * 64 + d]; }
      km[n * 64 + d] = s; }
    const bf16* qp = ((bf16*)(F.ws + WS_MQ)) + (size_t)(tok0 + 32 * wave + a) * 384 + kvh * 192 + 8 * h;
    __syncthreads();
    unsigned selmask = 0;
    if (qb > 0) {
        float sc[8];
#pragma unroll
        for (int n = 0; n < 8; ++n) sc[n] = 0.f;
#pragma unroll
        for (int ks = 0; ks < 4; ++ks) { const bf16x8 q0 = *(const bf16x8*)(qp + 16 * ks), q1 = *(const bf16x8*)(qp + 64 + 16 * ks), q2 = *(const bf16x8*)(qp + 128 + 16 * ks);
#pragma unroll
            for (int j = 0; j < 8; ++j) { const float qs = bf2f((unsigned short)q0[j]) + bf2f((unsigned short)q1[j]) + bf2f((unsigned short)q2[j]); const int d = 16 * ks + 8 * h + j;
#pragma unroll
                for (int n = 0; n < 7; ++n) sc[n] += qs * km[n * 64 + d]; } }
#pragma unroll
        for (int n = 0; n < 7; ++n) { sc[n] = swap32_sum(sc[n]); if (n >= qb) sc[n] = -INFINITY; }
#pragma unroll
        for (int t = 0; t < 3; ++t) { float best = -INFINITY; int bi = -1;
#pragma unroll
            for (int n = 0; n < 7; ++n) if (sc[n] > best) { best = sc[n]; bi = n; }
            if (bi >= 0) { selmask |= 1u << bi;
#pragma unroll
                for (int n = 0; n < 7; ++n) if (n == bi) sc[n] = -INFINITY; } }
    }
    float m = -1e30f, l = 0.f; f32x16 O[2]; bf16x8 qf[4];
    int g = 0, s = 0;
#pragma unroll 1
    for (int tau = 0; tau < T; ++tau) {
        LAS unsigned char* cur = (tau & 1) ? buf1 : buf0; LAS unsigned char* nxt = (tau & 1) ? buf0 : buf1;
        if (tau + 1 < T) { const int s1 = (s == qb) ? 0 : s + 1; const int blk = (s1 == 0) ? qb : s1 - 1;
            stage_kv<256>(nxt, nxt + IMG, Kb + (size_t)(256 * blk) * 128, Vb + 256 * blk, 0, 0, wave, lane); }
        if (s == 0) {
            m = -1e30f; l = 0.f;
#pragma unroll
            for (int i = 0; i < 16; ++i) { O[0][i] = 0.f; O[1][i] = 0.f; }
#pragma unroll
            for (int ks = 0; ks < 4; ++ks) qf[ks] = *(const bf16x8*)(qp + g * 64 + 16 * ks);
#pragma unroll 1
            for (int kt = 0; kt <= wave; ++kt) { bf16x8 kf[4], vf[2][2]; load_kv_frags<256>(kf, vf, cur, cur + IMG, 32 * kt, lane);
                if (kt == wave) attn_tile<1>(kf, vf, qf, 0.f, m, l, O, a, h); else attn_tile<0>(kf, vf, qf, 0.f, m, l, O, a, h); }
        } else {
            const float cinit = ((selmask >> (s - 1)) & 1u) ? 0.f : -1e30f;
            if (__any(cinit == 0.f)) {
#pragma unroll 1
                for (int kt = 0; kt < 8; ++kt) { bf16x8 kf[4], vf[2][2]; load_kv_frags<256>(kf, vf, cur, cur + IMG, 32 * kt, lane); attn_tile<0>(kf, vf, qf, cinit, m, l, O, a, h); }
            }
        }
        if (s == qb) { const size_t row = (size_t)(tok0 + 32 * wave + a); attn_store(O, l, ((bf16*)(F.ws + WS_MG)) + row * 384 + (kvh * 3 + g) * 64, ((bf16*)(F.ws + WS_Y)) + row * DM + 640 + (kvh * 3 + g) * 64, h); s = 0; ++g; }
        else ++s;
        __syncthreads();
    }
}

__device__ __forceinline__ void swa_unit(const Params& P, Frame& F, int layer, int b, int kvh, int qblk) {
    constexpr int NK = 384;
    LAS unsigned char* Kimg = F.lds; LAS unsigned char* Vimg = F.lds + NK * 128;
    const int lane = F.lane, wave = F.wave, a = lane & 31, h = lane >> 5;
    const int q0 = 256 * qblk; const long tok0 = (long)b * SEQ + q0;
    const bf16* Kb = ((bf16*)(F.ws + WS_AK)) + ((long)b * SEQ + q0 - 128) * 128 + kvh * 64;
    const bf16* Vb = ((bf16*)(F.ws + WS_VT)) + (size_t)(kvh * 64) * MTOK + ((long)b * SEQ + q0 - 128);
    stage_kv<NK>(Kimg, Vimg, Kb, Vb, (long)q0 - 128, 0, wave, lane);
    const size_t row = (size_t)(tok0 + 32 * wave + a);
    const bf16* qp = ((bf16*)(F.ws + WS_AQ)) + row * 384 + kvh * 192 + 8 * h;
    __syncthreads();
#pragma unroll 1
    for (int g = 0; g < 3; ++g) {
        bf16x8 qf[4];
#pragma unroll
        for (int ks = 0; ks < 4; ++ks) qf[ks] = *(const bf16x8*)(qp + g * 64 + 16 * ks);
        float m = kin(15)[layer * 6 + kvh * 3 + g] * LOG2E, l = 0.5f;
        f32x16 O[2];
#pragma unroll
        for (int i = 0; i < 16; ++i) { O[0][i] = 0.f; O[1][i] = 0.f; }
#pragma unroll 1
        for (int kt = 0; kt < 5; ++kt) {
            const int row0 = 32 * wave + 32 * kt;
            if (q0 - 128 + row0 < 0) continue;
            bf16x8 kf[4], vf[2][2]; load_kv_frags<NK>(kf, vf, Kimg, Vimg, row0, lane);
            if (kt == 0) attn_tile<2>(kf, vf, qf, 0.f, m, l, O, a, h);
            else if (kt == 4) attn_tile<1>(kf, vf, qf, 0.f, m, l, O, a, h);
            else attn_tile<0>(kf, vf, qf, 0.f, m, l, O, a, h);
        }
        attn_store(O, l, ((bf16*)(F.ws + WS_AG)) + row * 384 + (kvh * 3 + g) * 64, ((bf16*)(F.ws + WS_Y)) + row * DM + 256 + (kvh * 3 + g) * 64, h);
    }
    __syncthreads();
}

__device__ __forceinline__ void ssm_unit(Frame& F, int layer, int b, int g) {
    constexpr int APITCH = 528;
    LAS unsigned char* AU = F.lds;
    LAS unsigned char* SC = F.lds + 128 * APITCH;
    LAS float* seg = (LAS float*)(F.lds + 2 * 128 * APITCH);
    const int lane = F.lane, wave = F.wave, tid = F.tid, fr = lane & 15, fq = lane >> 4;
    const int pair = layer * 16 + g;
    const bf16* TE = ((bf16*)(F.ws + WS_TE)) + (size_t)pair * TE_ELEMS; const bf16* GM = ((bf16*)(F.ws + WS_G)) + (size_t)pair * G_ELEMS;
    { const bf16* up = ((bf16*)(F.ws + WS_U)) + (size_t)b * SEQ * 256 + g * 16;
#pragma unroll
      for (int i = 0; i < 8; ++i) { const int idx = tid + 512 * i, t = idx >> 1, hf = idx & 1; const u32x4 v = *(const u32x4*)(up + (size_t)t * 256 + 8 * hf);
          *(LAS u32x4*)(AU + (t >> 4) * APITCH + ((t & 15) * 16 + 8 * hf) * 2) = v; } }
    __syncthreads();
    {
        bf16x8 gf[8];
#pragma unroll
        for (int ks = 0; ks < 8; ++ks) gf[ks] = *(const bf16x8*)(GM + (size_t)(16 * wave + fr) * 256 + 32 * ks + 8 * fq);
#pragma unroll
        for (int rt = 0; rt < 8; ++rt) { f32x4 acc = {0.f, 0.f, 0.f, 0.f};
#pragma unroll
            for (int ks = 0; ks < 8; ++ks) { const bf16x8 af = *(const LAS bf16x8*)(AU + (16 * rt + fr) * APITCH + (32 * ks + 8 * fq) * 2); acc = __builtin_amdgcn_mfma_f32_16x16x32_bf16(gf[ks], af, acc, 0, 0, 0); }
            *(LAS f32x4*)(SC + (16 * rt + fr) * APITCH + (16 * wave + 4 * fq) * 4) = acc; }
    }
    __syncthreads();
    {
        const float ar = ((float*)(F.ws + WS_AT))[(size_t)pair * 128 + 2 * lane], ai = ((float*)(F.ws + WS_AT))[(size_t)pair * 128 + 2 * lane + 1];
        float lr = 0.f, li = 0.f, locr[16], loci[16];
#pragma unroll
        for (int k = 0; k < 16; ++k) { locr[k] = lr; loci[k] = li; const f32x2_t s = *(const LAS f32x2_t*)(SC + (16 * wave + k) * APITCH + lane * 8);
            const float nr = ar * lr - ai * li + s.x, ni = ar * li + ai * lr + s.y; lr = nr; li = ni; }
        seg[(wave * 64 + lane) * 2] = lr; seg[(wave * 64 + lane) * 2 + 1] = li;
        __syncthreads();
        float a16r = ar, a16i = ai;
#pragma unroll
        for (int q = 0; q < 4; ++q) { const float tr = a16r * a16r - a16i * a16i, ti = 2.f * a16r * a16i; a16r = tr; a16i = ti; }
        float ir = 0.f, ii = 0.f;
        for (int w2 = 0; w2 < wave; ++w2) { const float sr = seg[(w2 * 64 + lane) * 2], si = seg[(w2 * 64 + lane) * 2 + 1]; const float nr = a16r * ir - a16i * ii + sr, ni = a16r * ii + a16i * ir + si; ir = nr; ii = ni; }
        float pr = 1.f, pi = 0.f;
#pragma unroll
        for (int k = 0; k < 16; ++k) { const float cr = locr[k] + pr * ir - pi * ii, ci = loci[k] + pr * ii + pi * ir;
            *(LAS unsigned*)(SC + (16 * wave + k) * APITCH + lane * 4) = pk2(cr, ci);
            const float tr = pr * ar - pi * ai, ti = pr * ai + pi * ar; pr = tr; pi = ti; }
    }
    __syncthreads();
#pragma unroll 1
    for (int half = 0; half < 2; ++half) {
        const int i = half ? 15 - wave : wave;
        f32x4 acc[8];
#pragma unroll
        for (int rt = 0; rt < 8; ++rt) acc[rt] = (f32x4){0.f, 0.f, 0.f, 0.f};
        const bf16* tp = TE + (size_t)(16 * i + fr) * 384 + 8 * fq;
        for (int ks = 0; ks <= (i >> 1); ++ks) { const bf16x8 tf = *(const bf16x8*)(tp + 32 * ks);
#pragma unroll
            for (int rt = 0; rt < 8; ++rt) { const bf16x8 af = *(const LAS bf16x8*)(AU + (16 * rt + fr) * APITCH + (32 * ks + 8 * fq) * 2); acc[rt] = __builtin_amdgcn_mfma_f32_16x16x32_bf16(tf, af, acc[rt], 0, 0, 0); } }
#pragma unroll
        for (int ks = 0; ks < 4; ++ks) { const bf16x8 tf = *(const bf16x8*)(tp + 256 + 32 * ks);
#pragma unroll
            for (int rt = 0; rt < 8; ++rt) { const bf16x8 af = *(const LAS bf16x8*)(SC + (16 * rt + fr) * APITCH + (32 * ks + 8 * fq) * 2); acc[rt] = __builtin_amdgcn_mfma_f32_16x16x32_bf16(tf, af, acc[rt], 0, 0, 0); } }
#pragma unroll
        for (int rt = 0; rt < 8; ++rt) { const int chunk = 16 * rt + fr; u32x2 w; w.x = pk2(gelu_tanh_f(acc[rt][0]), gelu_tanh_f(acc[rt][1])); w.y = pk2(gelu_tanh_f(acc[rt][2]), gelu_tanh_f(acc[rt][3]));
            *(u32x2*)(((bf16*)(F.ws + WS_YPRE)) + ((size_t)b * SEQ + 16 * chunk + i) * 256 + g * 16 + 4 * fq) = w; }
    }
    __syncthreads();
}

__device__ __forceinline__ void mixer_phase(const Params& P, Frame& F, int qslot, int layer, int mask) {
    volatile LAS int* qw = (volatile LAS int*)(F.lds + LDS_CTL);
    unsigned* head = F.ctl + CW_QUEUE + 64 * qslot;
    for (;;) {
        if (F.tid == 0) qw[0] = (int)atomicAdd(head, 1u);
        __syncthreads();
        const int it = qw[0];
        __syncthreads();
        if (it >= 768) break;
#ifndef NO_MOBA
        if (it < 256 && (mask & 1)) { const int qb = 7 - (it >> 5), r = it & 31; moba_unit(F, r >> 1, r & 1, qb); }
#endif
#ifndef NO_SSM
        if (it >= 256 && it < 512 && (mask & 2)) { const int r = it - 256; ssm_unit(F, layer, r >> 4, r & 15); }
#endif
#ifndef NO_SWA
        if (it >= 512 && (mask & 4)) { const int r = it - 512; swa_unit(P, F, layer, r >> 4, (r >> 3) & 1, r & 7); }
#endif
    }
}

#define XB_TMO      128
#define XB_XCNT(j)  (256  + 64 * (j))
#define XB_XSUB(j)  (1280 + 64 * (j))
#define XB_XGEN(j)  (2304 + 64 * (j))
#define XB_TOP      3328
#define XB_TOPGEN   3392
#define XCD_BAR_WORDS 3456
#define XB_SPIN_CAP (1u << 18)

__device__ __forceinline__ unsigned xb_ld(unsigned* p)              { return __hip_atomic_load(p, __ATOMIC_RELAXED, __HIP_MEMORY_SCOPE_AGENT); }
__device__ __forceinline__ unsigned xb_add(unsigned* p, unsigned v) { return __hip_atomic_fetch_add(p, v, __ATOMIC_RELAXED, __HIP_MEMORY_SCOPE_AGENT); }
__device__ __forceinline__ unsigned xb_xcc_id() { return (unsigned)__builtin_amdgcn_s_getreg((3 << 11) | 20) & 0xFu; }
#define XB_SPIN(cond, bar) do { unsigned _sp = 0; while (cond) { __builtin_amdgcn_s_sleep(1); \
    if ((++_sp & 255u) == 0u) { if (xb_ld(&(bar)[XB_TMO])) break; if (_sp > XB_SPIN_CAP) { atomicAdd(&(bar)[XB_TMO], 1u); break; } } } } while (0)

struct XcdBarrier {
    unsigned* bar; unsigned x;
    volatile LAS unsigned* st;
};

__device__ __forceinline__ XcdBarrier xcd_barrier_post(unsigned* bar, volatile LAS unsigned* st) {
    XcdBarrier b; b.bar = bar; b.x = xb_xcc_id(); b.st = st;
    if (threadIdx.x == 0) (void)xb_add(&bar[XB_XCNT(b.x)], 1u);
    return b;
}
__device__ __forceinline__ void xcd_barrier_complete(unsigned* bar, unsigned x, unsigned& nloc, unsigned& nx) {
    const unsigned G = gridDim.x * gridDim.y * gridDim.z;
    unsigned sum, cnt, mine, sp = 0u;
    for (;;) {
        sum = 0u; cnt = 0u; mine = 0u;
#pragma unroll 1
        for (unsigned j = 0; j < 16; ++j) { const unsigned c = xb_ld(&bar[XB_XCNT(j)]); sum += c; cnt += (c > 0u) ? 1u : 0u; mine = (j == x) ? c : mine; }
        if (sum == G) break;
        __builtin_amdgcn_s_sleep(1);
        if ((++sp & 255u) == 0u) { if (xb_ld(&bar[XB_TMO])) break; if (sp > XB_SPIN_CAP) { atomicAdd(&bar[XB_TMO], 1u); break; } }
    }
    nloc = mine > 0u ? mine : 1u; nx = cnt > 0u ? cnt : 1u;
}

__device__ __forceinline__ void xcd_barrier(const XcdBarrier& b) {
    asm volatile("s_waitcnt vmcnt(0)" ::: "memory");
    __syncthreads();
    if (threadIdx.x == 0) {
        unsigned* bar = b.bar;
        __builtin_amdgcn_s_waitcnt(0);
        unsigned nloc = b.st[0], nx = b.st[1];
        if (nloc == 0u) { xcd_barrier_complete(bar, b.x, nloc, nx); b.st[0] = nloc; b.st[1] = nx; }
        const unsigned old = xb_add(&bar[XB_XSUB(b.x)], 1u);
        const unsigned gen = old / nloc;
        if (old + 1u == (gen + 1u) * nloc) {
            __builtin_amdgcn_fence(__ATOMIC_RELEASE, "agent");
            asm volatile("s_waitcnt vmcnt(0)" ::: "memory");
            const unsigned og = xb_add(&bar[XB_TOP], 1u);
            const unsigned tg = og / nx;
            if (og + 1u == (tg + 1u) * nx) xb_add(&bar[XB_TOPGEN], 1u);
            else XB_SPIN(xb_ld(&bar[XB_TOPGEN]) == tg, bar);
            __builtin_amdgcn_fence(__ATOMIC_ACQUIRE, "agent");
            xb_add(&bar[XB_XGEN(b.x)], 1u);
            asm volatile("s_waitcnt vmcnt(0)" ::: "memory");
        } else {
            XB_SPIN(xb_ld(&bar[XB_XGEN(b.x)]) == gen, bar);
            __builtin_amdgcn_fence(__ATOMIC_ACQUIRE, "agent");
            asm volatile("s_waitcnt vmcnt(0)" ::: "memory");
        }
    }
    __syncthreads();
}

constexpr int CW_BAR = 4096;
#ifndef USE_COOP_LAUNCH
#define USE_COOP_LAUNCH 0
#endif
#ifndef REP_P0
#define REP_P0 1
#endif
#ifndef REP_P1
#define REP_P1 1
#endif
#ifndef REP_MIX
#define REP_MIX 1
#endif
#ifndef REP_GLU
#define REP_GLU 1
#endif
#ifndef REP_P3L0
#define REP_P3L0 1
#endif
#ifndef REP_SYNC
#define REP_SYNC 1
#endif
#ifndef MIX_EXTRA_MASK
#define MIX_EXTRA_MASK 7
#endif
#ifndef USE_CG_SYNC
#define USE_CG_SYNC 0
#endif
#define GRID_SYNC() do { for (int r_ = 0; r_ < REP_SYNC; ++r_) { if (USE_CG_SYNC) cg::this_grid().sync(); else xcd_barrier(xbar); } } while (0)
__global__ void __launch_bounds__(512, 2) mk_fwd(Params P) {
    extern __shared__ __attribute__((aligned(16))) unsigned char lds_raw[];
    Frame F;
    F.lds = (LAS unsigned char*)lds_raw; F.tid = threadIdx.x; F.lane = F.tid & 63; F.wave = __builtin_amdgcn_readfirstlane(F.tid >> 6); F.G = gridDim.x; F.bid = blockIdx.x;
    F.out = (float*)kin(19); F.ws = (unsigned char*)kin(20); F.ctl = (unsigned*)(F.ws + WS_CTL);
    if (F.tid < 128) ((LAS unsigned*)(F.lds + LDS_CTL))[F.tid] = 0u;
    __syncthreads();
    const XcdBarrier xbar = xcd_barrier_post(F.ctl + CW_BAR, (volatile LAS unsigned*)(F.lds + LDS_CTL + 16));

#ifndef NO_P0
    for (int rep = 0; rep < REP_P0; ++rep) { Frame Fp = phase_frame(F); p0_prologue(P, Fp); }
#endif
    GRID_SYNC();
#pragma unroll 1
    for (int layer = 0; layer < DEPTH; ++layer) {
#ifndef NO_P1
        for (int rep = 0; rep < REP_P1; ++rep) {
            Frame Fp = phase_frame(F);
            pg8::Gemm g{((bf16*)(Fp.ws + WS_Z)), ((bf16*)(Fp.ws + WS_Z)), ZROWS, ZROWS, DM}; const SchedTab S = make_sched<0>(Fp, NTT + 10 * layer);
            EpiProj E{NTT + 10 * layer, layer, Fp.ws};
            pg8::gemm_phase<EpiProj, SchedTab, true, true>(F.lds, g, S, E);
        }
#endif
        GRID_SYNC();
#ifndef NO_MIX
        for (int rep = 0; rep < REP_MIX; ++rep) { Frame Fp = phase_frame(F); mixer_phase(P, Fp, layer + 2 * rep, layer, rep ? MIX_EXTRA_MASK : 7); }
#endif
        GRID_SYNC();
#ifndef NO_GLU
        for (int rep = 0; rep < REP_GLU; ++rep) {
            int kglu = 256; asm volatile("" : "+s"(kglu));
            Frame Fp = phase_frame(F);
            pg8::Gemm g{((bf16*)(Fp.ws + WS_YPRE)), ((bf16*)(Fp.ws + WS_GLU)) + (size_t)layer * 65536, MTOK, 256, kglu}; const SchedTab S = make_sched<2>(Fp, 0);
            EpiGlu E{((bf16*)(Fp.ws + WS_YPRE)), ((bf16*)(Fp.ws + WS_SG)), kin(12) + layer * 256, ((bf16*)(Fp.ws + WS_Y))};
            pg8::gemm_phase<EpiGlu, SchedTab, true, true>(F.lds, g, S, E);
        }
#endif
        GRID_SYNC();
#ifndef NO_P3
        for (int rep = 0; rep < (layer == 0 ? REP_P3L0 : 1); ++rep) {
            Frame Fp = phase_frame(F);
            pg8::Gemm g{((bf16*)(Fp.ws + WS_Y)), ((bf16*)(Fp.ws + WS_WOUT)) + (size_t)layer * DM * DM, MTOK, DM, DM}; const SchedTab S = make_sched<1>(Fp, 0);
            EpiOut E{layer == 0 ? kin(0) : F.out, F.out, ((bf16*)(Fp.ws + WS_Z)), ((float*)(Fp.ws + WS_ROWSS)), layer + 1 < DEPTH ? 1 : 0, (LAS float*)(F.lds + LDS_MISC + 4096)};
            pg8::gemm_phase<EpiOut, SchedTab, true, true>(F.lds, g, S, E);
        }
#endif
        if (layer + 1 < DEPTH) GRID_SYNC();
    }
}

extern "C" void kernel_launch(void* const* d_in, const int* in_sizes, int n_in, void* d_out, int out_size, void* d_ws, size_t ws_size, hipStream_t stream) {
    static int grid = 0;
    if (grid == 0) {
        if (n_in != 19 || out_size != MTOK * DM || ws_size < WS_END) { fprintf(stderr, "kernel_launch: unexpected problem (n_in %d out %d ws %zu)\n", n_in, out_size, ws_size); grid = -1; return; }
        int dev = 0, cus = 0, per_cu = 0;
        (void)hipGetDevice(&dev);
        (void)hipDeviceGetAttribute(&cus, hipDeviceAttributeMultiprocessorCount, dev);
        (void)hipFuncSetAttribute((const void*)mk_fwd, hipFuncAttributeMaxDynamicSharedMemorySize, LDS_BYTES);
        (void)hipOccupancyMaxActiveBlocksPerMultiprocessor(&per_cu, (const void*)mk_fwd, 512, LDS_BYTES);
        if (per_cu < 1) { fprintf(stderr, "kernel_launch: occupancy query says %d blocks per CU\n", per_cu); per_cu = 1; }
        grid = cus;
    }
    if (grid < 0) return;
    (void)hipMemsetAsync((char*)d_ws + WS_CTL, 0, CTL_BYTES, stream);
    Params p{};
    for (int i = 0; i < 19; ++i) p.in[i] = (const float*)d_in[i];
    p.out = (float*)d_out; p.ws = (unsigned char*)d_ws;
#if USE_COOP_LAUNCH
    void* args[] = {&p};
    hipError_t e = hipLaunchCooperativeKernel((const void*)mk_fwd, dim3(grid), dim3(512), args, LDS_BYTES, stream);
    if (e != hipSuccess) fprintf(stderr, "cooperative launch failed: %s (grid %d)\n", hipGetErrorString(e), grid);
#else
    hipLaunchKernelGGL(mk_fwd, dim3(grid), dim3(512), LDS_BYTES, stream, p);
    const hipError_t e = hipPeekAtLastError();
    if (e != hipSuccess) fprintf(stderr, "launch failed: %s (grid %d)\n", hipGetErrorString(e), grid);
#endif
}
```

```cpp
#include <hip/hip_runtime.h>
#include <hip/hip_cooperative_groups.h>
#include <cstdio>
#include <cstdint>
namespace cg = cooperative_groups;
namespace pg8 {
#define PG8_LAS __attribute__((address_space(3)))
typedef unsigned short bf16_t;
typedef short bf16x8 __attribute__((ext_vector_type(8)));
typedef float f32x4 __attribute__((ext_vector_type(4)));
typedef unsigned u32x4 __attribute__((ext_vector_type(4)));
constexpr int BM = 256, BK = 64, HALF = 128, HTB = HALF * BK * 2  , STAGE_BYTES = 8 * HTB, NXCD = 8, WGM = 8;

__host__ __device__ __forceinline__ int lds_byte(int r, int c) { const int st = (r >> 4) * 2 + (c >> 5), rr = r & 15, cc = c & 31, ob = rr * 64 + cc * 2; return st * 1024 + (ob ^ (((ob >> 9) & 1) << 5)); }
__host__ __device__ __forceinline__ void stage_rc(int b, int& R, int& C) { const int st = b / 1024, sb = b % 1024, swz = sb ^ (((sb >> 9) & 1) << 5); R = (st >> 1) * 16 + swz / 64; C = (st & 1) * 32 + (swz % 64) / 2; }
__host__ __device__ __forceinline__ int perm32(int rho) { const int n = rho >> 4, i = rho & 15; return 8 * (i >> 2) + 4 * n + (i & 3); }

struct Unit { int pm, pn; };
struct Gemm { const bf16_t* A; const bf16_t* Bt; int M, N, K; };

__device__ __forceinline__ unsigned cvt_pk_bf16(float lo, float hi) { unsigned r; asm volatile("v_cvt_pk_bf16_f32 %0, %1, %2" : "=v"(r) : "v"(lo), "v"(hi)); return r; }
typedef float f32x2 __attribute__((ext_vector_type(2)));
template <class Epi, class Sched, bool ALIGN_EPI = false, bool SP2 = false>
__device__ __forceinline__ void gemm_phase(PG8_LAS unsigned char* lds, const Gemm g, const Sched& S, const Epi& E) {
    int tid_ = threadIdx.x; asm volatile("" : "+v"(tid_));
    const int tid = tid_, wid = __builtin_amdgcn_readfirstlane(tid >> 6), lane = tid & 63, wr = wid >> 2, wc = wid & 3, fr = lane & 15, fq = lane >> 4;
    const int K = g.K, nt = K / BK;
    unsigned voffA[2], voffB[2];
#pragma unroll
    for (int i = 0; i < 2; ++i) { int R, C; stage_rc(tid * 16 + i * 8192, R, C); const int Rb = Epi::PERM ? ((R & ~31) + perm32(R & 31)) : R;
        voffA[i] = (unsigned)(R * K + C) * 2u; voffB[i] = (unsigned)(Rb * K + C) * 2u; }
    const size_t kstep = (size_t)(BK * 2);
    const size_t hstep = (size_t)HALF * K * 2;
    const size_t tstep = 2 * hstep;
    const unsigned ldsw = (unsigned)wid * 1024u;
    const int aoff = lds_byte(wr * 64 + fr, fq * 8), boff = lds_byte(wc * 32 + fr, fq * 8);
#define PG8_SA(b, h) (((b) * 2 + (h)) * HTB)
#define PG8_SB(b, h) ((4 + (b) * 2 + (h)) * HTB)
#define PG8_STAGE(bufoff, gbase, voff) do { _Pragma("unroll") for (int _i = 0; _i < 2; ++_i) \
        __builtin_amdgcn_global_load_lds((const unsigned*)((const char*)(gbase) + (voff)[_i]), (PG8_LAS unsigned*)(lds + (bufoff) + ldsw + _i * 8192), 16, 0, 0); } while (0)
#define PG8_LDA(dst, b, h) do { _Pragma("unroll") for (int m = 0; m < 4; ++m) _Pragma("unroll") for (int k = 0; k < 2; ++k) dst[m][k] = *(const PG8_LAS bf16x8*)(lds + PG8_SA(b, h) + aoff + m * 2048 + k * 1024); } while (0)
#define PG8_LDB(dst, b, h) do { _Pragma("unroll") for (int n = 0; n < 2; ++n) _Pragma("unroll") for (int k = 0; k < 2; ++k) dst[n][k] = *(const PG8_LAS bf16x8*)(lds + PG8_SB(b, h) + boff + n * 2048 + k * 1024); } while (0)
#define PG8_MMA(ai, bj, At, Bt) do { __builtin_amdgcn_s_setprio(1); _Pragma("unroll") for (int m = 0; m < 4; ++m) _Pragma("unroll") for (int n = 0; n < 2; ++n) _Pragma("unroll") for (int k = 0; k < 2; ++k) \
        acc[ai][bj][m][n] = __builtin_amdgcn_mfma_f32_16x16x32_bf16(Bt[n][k], At[m][k], acc[ai][bj][m][n], 0, 0, 0); __builtin_amdgcn_s_setprio(0); } while (0)
#define PG8_WAIT_V(n) asm volatile("s_waitcnt vmcnt(" #n ")" ::: "memory")
#define PG8_WAIT_L(n) asm volatile("s_waitcnt lgkmcnt(" #n ")" ::: "memory")
#define PG8_BAR __builtin_amdgcn_s_barrier()
#define PG8_SCHED __builtin_amdgcn_sched_barrier(0)
    Unit cur, nxt; int ui = 0;
    if (!S.next(0, cur)) return;
    f32x4 acc[2][2][4][2];
#pragma unroll
    for (int a = 0; a < 2; ++a)
#pragma unroll
        for (int b = 0; b < 2; ++b)
#pragma unroll
            for (int m = 0; m < 4; ++m)
#pragma unroll
                for (int n = 0; n < 2; ++n) acc[a][b][m][n] = (f32x4){0.f, 0.f, 0.f, 0.f};
    bf16x8 At[4][2], B0[2][2], B1[2][2];
    const char* cA = (const char*)g.A + (size_t)cur.pm * tstep; const char* cB = (const char*)g.Bt + (size_t)cur.pn * tstep;
    S.a_ready(cur);
    if constexpr (SP2) {
        PG8_STAGE(PG8_SB(0, 0), cB, voffB); PG8_STAGE(PG8_SB(0, 1), cB + hstep, voffB); PG8_STAGE(PG8_SA(0, 0), cA, voffA); PG8_STAGE(PG8_SA(0, 1), cA + hstep, voffA);
        if (wr == 1) PG8_BAR;
        PG8_WAIT_V(2); PG8_BAR;
        PG8_STAGE(PG8_SB(1, 0), cB + kstep, voffB); PG8_STAGE(PG8_SA(1, 0), cA + kstep, voffA); PG8_STAGE(PG8_SB(1, 1), cB + hstep + kstep, voffB);
        PG8_WAIT_V(6); PG8_BAR;
    } else {
        PG8_STAGE(PG8_SB(0, 0), cB, voffB); PG8_STAGE(PG8_SA(0, 0), cA, voffA); PG8_STAGE(PG8_SB(0, 1), cB + hstep, voffB); PG8_STAGE(PG8_SA(0, 1), cA + hstep, voffA);
        if (wr == 1) PG8_BAR;
        PG8_WAIT_V(4); PG8_BAR;
        PG8_STAGE(PG8_SB(1, 0), cB + kstep, voffB); PG8_STAGE(PG8_SA(1, 0), cA + kstep, voffA); PG8_STAGE(PG8_SB(1, 1), cB + hstep + kstep, voffB);
        PG8_WAIT_V(6); PG8_BAR;
    }
    for (;;) {
        const bool has_next = S.next(ui + 1, nxt);
        const char* nA = has_next ? (const char*)g.A + (size_t)nxt.pm * tstep : cA; const char* nB = has_next ? (const char*)g.Bt + (size_t)nxt.pn * tstep : cB;
        for (int t = 0; t < nt; t += 2) {
            const bool last = (t == nt - 2);
            const char* a1 = cA + (size_t)(t + 1) * kstep;
            const char* a2 = last ? nA : cA + (size_t)(t + 2) * kstep; const char* b2 = last ? nB : cB + (size_t)(t + 2) * kstep;
            const char* a3 = a2 + kstep; const char* b3 = b2 + kstep;
            if (last && has_next) S.a_ready(nxt);
            if constexpr (SP2) {
            PG8_LDB(B0, 0, 0); PG8_LDB(B1, 0, 1); PG8_SCHED; PG8_LDA(At, 0, 0); PG8_STAGE(PG8_SA(1, 1), a1 + hstep, voffA);
            PG8_WAIT_V(8); PG8_WAIT_L(0); PG8_BAR; PG8_MMA(0, 0, At, B0); PG8_MMA(0, 1, At, B1); PG8_BAR; PG8_SCHED;
            PG8_LDA(At, 0, 1); PG8_STAGE(PG8_SB(0, 0), b2, voffB); PG8_STAGE(PG8_SB(0, 1), b2 + hstep, voffB); PG8_STAGE(PG8_SA(0, 0), a2, voffA);
            PG8_WAIT_V(8); PG8_WAIT_L(0); PG8_BAR; PG8_MMA(1, 0, At, B0); PG8_MMA(1, 1, At, B1); PG8_BAR; PG8_SCHED;
            PG8_LDB(B0, 1, 0); PG8_LDB(B1, 1, 1); PG8_SCHED; PG8_LDA(At, 1, 0); PG8_STAGE(PG8_SA(0, 1), a2 + hstep, voffA);
            PG8_WAIT_V(8); PG8_WAIT_L(0); PG8_BAR; PG8_MMA(0, 0, At, B0); PG8_MMA(0, 1, At, B1); PG8_BAR; PG8_SCHED;
            PG8_LDA(At, 1, 1); PG8_STAGE(PG8_SB(1, 0), b3, voffB); PG8_STAGE(PG8_SB(1, 1), b3 + hstep, voffB); PG8_STAGE(PG8_SA(1, 0), a3, voffA);
            PG8_WAIT_V(8); PG8_WAIT_L(0); PG8_BAR; PG8_MMA(1, 0, At, B0); PG8_MMA(1, 1, At, B1); PG8_BAR; PG8_SCHED;
            } else {
            PG8_LDB(B0, 0, 0); PG8_SCHED; PG8_LDA(At, 0, 0); PG8_STAGE(PG8_SA(1, 1), a1 + hstep, voffA);
            PG8_WAIT_L(8); PG8_BAR; PG8_WAIT_L(0); PG8_MMA(0, 0, At, B0); PG8_BAR; PG8_SCHED;
            PG8_LDB(B1, 0, 1); PG8_STAGE(PG8_SB(0, 0), b2, voffB);
            PG8_BAR; PG8_WAIT_L(0); PG8_MMA(0, 1, At, B1); PG8_BAR;
            PG8_LDA(At, 0, 1); PG8_STAGE(PG8_SA(0, 0), a2, voffA);
            PG8_BAR; PG8_WAIT_L(0); PG8_MMA(1, 0, At, B0); PG8_BAR; PG8_SCHED;
            PG8_STAGE(PG8_SB(0, 1), b2 + hstep, voffB);
            PG8_WAIT_V(6); PG8_BAR; PG8_MMA(1, 1, At, B1); PG8_BAR;
            PG8_LDB(B0, 1, 0); PG8_SCHED; PG8_LDA(At, 1, 0); PG8_STAGE(PG8_SA(0, 1), a2 + hstep, voffA);
            PG8_WAIT_L(8); PG8_BAR; PG8_WAIT_L(0); PG8_MMA(0, 0, At, B0); PG8_BAR; PG8_SCHED;
            PG8_LDB(B1, 1, 1); PG8_STAGE(PG8_SB(1, 0), b3, voffB);
            PG8_BAR; PG8_WAIT_L(0); PG8_MMA(0, 1, At, B1); PG8_BAR;
            PG8_LDA(At, 1, 1); PG8_STAGE(PG8_SA(1, 0), a3, voffA);
            PG8_BAR; PG8_WAIT_L(0); PG8_MMA(1, 0, At, B0); PG8_BAR; PG8_SCHED;
            PG8_STAGE(PG8_SB(1, 1), b3 + hstep, voffB);
            PG8_WAIT_V(6); PG8_BAR; PG8_MMA(1, 1, At, B1); PG8_BAR;
            }
        }
        if constexpr (ALIGN_EPI) { if (wr == 0) PG8_BAR; }
        if constexpr (!Epi::AFTER_DRAIN) { E(acc, cur, wr, wc, fr, fq); S.done(cur); }
        if (!has_next) break;
#pragma unroll
        for (int a = 0; a < 2; ++a)
#pragma unroll
            for (int b = 0; b < 2; ++b)
#pragma unroll
                for (int m = 0; m < 4; ++m)
#pragma unroll
                    for (int n = 0; n < 2; ++n) acc[a][b][m][n] = (f32x4){0.f, 0.f, 0.f, 0.f};
        cur = nxt; cA = nA; cB = nB; ++ui;
        if constexpr (ALIGN_EPI) { if (wr == 1) PG8_BAR; }
    }
    PG8_WAIT_V(0);
    if constexpr (!ALIGN_EPI) { if (wr == 0) PG8_BAR; }
    PG8_BAR;
    if constexpr (Epi::AFTER_DRAIN) { E.fused(acc, cur, wr, wc, fr, fq, lds, wid, lane); S.done(cur); }
#undef PG8_SA
#undef PG8_SB
#undef PG8_STAGE
#undef PG8_LDA
#undef PG8_LDB
#undef PG8_MMA
#undef PG8_WAIT_V
#undef PG8_WAIT_L
#undef PG8_BAR
#undef PG8_SCHED
}
}

#define GAS __attribute__((address_space(1)))
#define LAS __attribute__((address_space(3)))
typedef unsigned short bf16;
typedef short bf16x8 __attribute__((ext_vector_type(8)));
typedef float f32x4 __attribute__((ext_vector_type(4)));
typedef float f32x16 __attribute__((ext_vector_type(16)));
typedef unsigned u32x4 __attribute__((ext_vector_type(4)));
typedef unsigned u32x2 __attribute__((ext_vector_type(2)));
typedef float f32x2_t __attribute__((ext_vector_type(2)));
typedef __bf16 bf16x2_t __attribute__((ext_vector_type(2)));
using pg8::Unit;

constexpr int NB = 16, SEQ = 2048, MTOK = NB * SEQ, DM = 1024, NPROJ = 2560, DEPTH = 2;
constexpr int NTT = MTOK / 256;
constexpr int ZROWS = MTOK + DEPTH * NPROJ;
constexpr float RMS_EPS = 1e-6f;
constexpr float LOG2E = 1.4426950408889634f;
constexpr float QSCALE = 0.125f * LOG2E;
constexpr int LDS_BYTES = 147456;
constexpr int LDS_MISC = 131072;
constexpr int LDS_CTL = LDS_BYTES - 512;

constexpr size_t MiB = 1u << 20;
constexpr size_t WS_CTL = 0, CTL_BYTES = 1 * MiB;
constexpr size_t WS_Z = 2 * MiB, WS_WOUT = 78 * MiB, WS_GLU = 82 * MiB, WS_TE = 83 * MiB, WS_G = 89 * MiB, WS_AT = 91 * MiB;
constexpr size_t WS_U = 92 * MiB, WS_SG = 108 * MiB, WS_AQ = 124 * MiB, WS_AK = 148 * MiB, WS_AG = 156 * MiB, WS_MQ = 180 * MiB, WS_MK = 204 * MiB, WS_MG = 212 * MiB;
constexpr size_t WS_VT = 236 * MiB, WS_KPART = 252 * MiB, WS_ROWSS = 253 * MiB, WS_YPRE = 254 * MiB, WS_Y = 270 * MiB, WS_END = 334 * MiB;
static_assert(WS_Z + (size_t)ZROWS * DM * 2 <= WS_WOUT, "Z fits");
constexpr size_t WS_NW = 1 * MiB;
constexpr int TE_ELEMS = 256 * 384, G_ELEMS = 128 * 256;
constexpr int CW_QUEUE = 1024;

__device__ __forceinline__ unsigned pk2(float lo, float hi) { f32x2_t v = {lo, hi}; bf16x2_t b = __builtin_convertvector(v, bf16x2_t); return __builtin_bit_cast(unsigned, b); }
__device__ __forceinline__ float bf2f(unsigned short x) { return __uint_as_float((unsigned)x << 16); }
__device__ __forceinline__ float bflo(unsigned w) { return __uint_as_float(w << 16); }
__device__ __forceinline__ float bfhi(unsigned w) { return __uint_as_float(w & 0xffff0000u); }
__device__ __forceinline__ float wave_sum(float v) {
#pragma unroll
    for (int o = 1; o < 64; o <<= 1) v += __shfl_xor(v, o);
    return v;
}
__device__ __forceinline__ float fast_rcp(float x) { return __builtin_amdgcn_rcpf(x); }
__device__ __forceinline__ float silu_f(float x) { return x * fast_rcp(1.f + __builtin_amdgcn_exp2f(-x * LOG2E)); }
__device__ __forceinline__ float sigmoid_f(float x) { return fast_rcp(1.f + __builtin_amdgcn_exp2f(-x * LOG2E)); }
__device__ __forceinline__ float gelu_tanh_f(float x) { const float z = 0.7978845608028654f * (x + 0.044715f * x * x * x); return x * fast_rcp(1.f + __builtin_amdgcn_exp2f(-2.f * LOG2E * z)); }
__device__ __forceinline__ float swap32_max(float m) { auto rr = __builtin_amdgcn_permlane32_swap(__float_as_uint(m), __float_as_uint(m), false, false); return fmaxf(__uint_as_float(rr[0]), __uint_as_float(rr[1])); }
__device__ __forceinline__ float swap32_sum(float m) { auto rr = __builtin_amdgcn_permlane32_swap(__float_as_uint(m), __float_as_uint(m), false, false); return __uint_as_float(rr[0]) + __uint_as_float(rr[1]); }
__device__ __forceinline__ void glds16(const void* gsrc, LAS unsigned char* ldst) {
    __builtin_amdgcn_global_load_lds((const unsigned*)gsrc, (LAS unsigned*)ldst, 16, 0, 0);
}

struct Params {
    const float* in[19]; float* out; unsigned char* ws;
};
typedef const float* const __attribute__((address_space(4))) * kargs_t;
__device__ __forceinline__ const float* kin(int i) { kargs_t ka = (kargs_t)__builtin_amdgcn_kernarg_segment_ptr(); asm volatile("" : "+s"(ka)); return ka[i]; }
struct Frame {
    LAS unsigned char* lds; int tid, lane, wave, G, bid; float* out; unsigned char* ws; unsigned* ctl;
};

__device__ __forceinline__ int proj_dest_row(int n0) {
    int slot, off;
    if (n0 < 512)       { slot = n0 >> 6; off = n0 & 63; }
    else if (n0 < 1024) { slot = 8 + ((n0 - 512) >> 6); off = n0 & 63; }
    else if (n0 < 1152) { return 2304 + (n0 - 1024); }
    else if (n0 < 1536) { slot = 16 + ((n0 - 1152) >> 6); off = (n0 - 1152) & 63; }
    else if (n0 < 1920) { slot = 22 + ((n0 - 1536) >> 6); off = (n0 - 1536) & 63; }
    else if (n0 < 2048) { slot = 28 + ((n0 - 1920) >> 6); off = (n0 - 1920) & 63; }
    else if (n0 < 2176) { return 2304 + 128 + (n0 - 2048); }
    else                { slot = 30 + ((n0 - 2176) >> 6); off = (n0 - 2176) & 63; }
    const int t = slot >> 2, wc = slot & 3;
    return 256 * t + 128 * (off >> 5) + 32 * wc;
}
__device__ __forceinline__ void p0_transpose_item(const float* W, int K, int N, const float* gk, bf16* WT, int ldk, int drow0, LAS float* scr, int k0, int n0, int lane) {
#pragma unroll 8
    for (int i = 0; i < 32; ++i) { const int kk = 2 * i + (lane >> 5); float v = W[(size_t)(k0 + kk) * N + n0 + (lane & 31)]; if (gk) v *= gk[k0 + kk]; scr[kk * 33 + (lane & 31)] = v; }
    asm volatile("s_waitcnt lgkmcnt(0)" ::: "memory");
    const int c = lane & 7;
#pragma unroll
    for (int j = 0; j < 4; ++j) { const int n = (lane >> 3) + 8 * j; const LAS float* s = scr + (8 * c) * 33 + n;
        u32x4 o; o.x = pk2(s[0 * 33], s[1 * 33]); o.y = pk2(s[2 * 33], s[3 * 33]); o.z = pk2(s[4 * 33], s[5 * 33]); o.w = pk2(s[6 * 33], s[7 * 33]);
        *(u32x4*)(WT + (size_t)(drow0 + n) * ldk + k0 + 8 * c) = o; }
    asm volatile("s_waitcnt lgkmcnt(0)" ::: "memory");
}
__device__ __forceinline__ void p0_ssm_consts(const Params& P, Frame& F, int pair) {
    const int l = pair >> 4, g = pair & 15, tid = F.tid;
    LAS float* pwr = (LAS float*)(F.lds);
    LAS float* pwi = pwr + 17 * 64;
    LAS float* bbr = pwi + 17 * 64;
    LAS float* bbi = bbr + 1024;
    LAS float* ccr = bbi + 1024;
    LAS float* cci = ccr + 1024;
    LAS float* Kt = cci + 1024;
    const float dt = expf(kin(5)[l * 16 + g]);
    const float* lre = kin(3) + (l * 16 + g) * 64; const float* lim = kin(4) + (l * 16 + g) * 64;
    for (int t = tid; t < 17 * 64; t += 512) { const int p = t & 63, lag = t >> 6; const float lr = lre[p], li = lim[p];
        const float mag = expf(lr * dt * (float)lag); float sn, cs; sincosf(li * dt * (float)lag, &sn, &cs); pwr[t] = mag * cs; pwi[t] = mag * sn; }
    for (int t = tid; t < 1024; t += 512) { const int p = t >> 4, h = t & 15; const float lr = lre[p], li = lim[p];
        const float mag = expf(lr * dt); float sn, cs; sincosf(li * dt, &sn, &cs); const float ar = mag * cs, ai = mag * sn;
        const float den = lr * lr + li * li, nr = ar - 1.f, ni = ai; const float cr = (nr * lr + ni * li) / den, ci = (ni * lr - nr * li) / den;
        const float br = kin(6)[((size_t)(l * 16 + g) * 64 + p) * 16 + h], bi = kin(7)[((size_t)(l * 16 + g) * 64 + p) * 16 + h];
        bbr[t] = cr * br - ci * bi; bbi[t] = cr * bi + ci * br; }
    for (int t = tid; t < 1024; t += 512) { ccr[t] = kin(8)[(size_t)(l * 16 + g) * 1024 + t]; cci[t] = kin(9)[(size_t)(l * 16 + g) * 1024 + t]; }
    __syncthreads();
    for (int t = tid; t < 4096; t += 512) { const int lag = t >> 8, hp = (t >> 4) & 15, h = t & 15; float s = 0.f;
        for (int p = 0; p < 64; ++p) { const float cr = ccr[hp * 64 + p], ci = cci[hp * 64 + p], pr = pwr[lag * 64 + p], pi = pwi[lag * 64 + p];
            const float xr = cr * pr - ci * pi, xi = cr * pi + ci * pr; s += xr * bbr[p * 16 + h] - xi * bbi[p * 16 + h]; }
        if (lag == 0 && hp == h) s += kin(10)[l * 256 + g * 16 + h];
        Kt[t] = s; }
    __syncthreads();
    bf16* TE = ((bf16*)(F.ws + WS_TE)) + (size_t)pair * TE_ELEMS; bf16* GM = ((bf16*)(F.ws + WS_G)) + (size_t)pair * G_ELEMS;
    for (int t = tid; t < 256 * 192; t += 512) { const int n = t / 192, kp = t % 192, k = 2 * kp; const int i = n >> 4, hp = n & 15; float v0, v1;
        if (k < 256) { const int j = k >> 4, h = k & 15; if (j <= i) { v0 = Kt[((i - j) * 16 + hp) * 16 + h]; v1 = Kt[((i - j) * 16 + hp) * 16 + h + 1]; } else { v0 = 0.f; v1 = 0.f; } }
        else { const int p = (k - 256) >> 1; const float cr = ccr[hp * 64 + p], ci = cci[hp * 64 + p], pr = pwr[(i + 1) * 64 + p], pi = pwi[(i + 1) * 64 + p];
            v0 = cr * pr - ci * pi; v1 = -(cr * pi + ci * pr); }
        *(unsigned*)(TE + (size_t)n * 384 + k) = pk2(v0, v1); }
    for (int t = tid; t < 128 * 128; t += 512) { const int n = t >> 7, kp = t & 127, k = 2 * kp; const int p = n >> 1, ri = n & 1, j = k >> 4, h = k & 15;
        const float pr = pwr[(15 - j) * 64 + p], pi = pwi[(15 - j) * 64 + p];
        float v0, v1;
        { const float br = bbr[p * 16 + h], bi = bbi[p * 16 + h]; v0 = ri ? (pr * bi + pi * br) : (pr * br - pi * bi); }
        { const float br = bbr[p * 16 + h + 1], bi = bbi[p * 16 + h + 1]; v1 = ri ? (pr * bi + pi * br) : (pr * br - pi * bi); }
        *(unsigned*)(GM + (size_t)n * 256 + k) = pk2(v0, v1); }
    if (tid < 64) { ((float*)(F.ws + WS_AT))[(size_t)pair * 128 + 2 * tid] = pwr[16 * 64 + tid]; ((float*)(F.ws + WS_AT))[(size_t)pair * 128 + 2 * tid + 1] = pwi[16 * 64 + tid]; }
    __syncthreads();
}
__device__ __forceinline__ void p0_prologue(const Params& P, Frame& F) {
    const bool split = F.G > 64;
    if (!split || F.bid < 32) { for (int pair = F.bid; pair < 32; pair += (split ? 32 : F.G)) p0_ssm_consts(P, F, pair); if (split) return; }
    const int vb = split ? F.bid - 32 : F.bid, nvb = split ? F.G - 32 : F.G;
    if (vb == 0) { float* nwp = (float*)(F.ws + WS_NW);
        for (int t = F.tid; t < DEPTH * 256; t += 512) { const int l = t >> 8, k = (t >> 6) & 3, d = t & 63;
            nwp[t] = (k == 0) ? kin(13)[l * 64 + d] * QSCALE : (k == 1) ? kin(14)[l * 64 + d] : (k == 2) ? kin(16)[l * 64 + d] * QSCALE : kin(17)[l * 64 + d]; } }
    const int gw = vb * 8 + F.wave, NGW = nvb * 8;
    LAS float* scr = (LAS float*)(F.lds + F.wave * 16384);
    constexpr int I_IN = 16 * 80, I_OUT = 16 * 32, I_GLU = 4 * 8, I_L = I_IN + I_OUT + I_GLU;
    for (int it = gw; it < DEPTH * I_L; it += NGW) {
        const int l = it / I_L; int r = it % I_L;
        if (r < I_IN) { const int kb = r / 80, nb = r % 80; p0_transpose_item(kin(2) + (size_t)l * DM * NPROJ, DM, NPROJ, kin(1) + l * DM, ((bf16*)(F.ws + WS_Z)) + (size_t)(MTOK + l * NPROJ) * DM, DM, proj_dest_row(32 * nb), scr, 64 * kb, 32 * nb, F.lane); continue; }
        r -= I_IN;
        if (r < I_OUT) { const int kb = r / 32, nb = r % 32; p0_transpose_item(kin(18) + (size_t)l * DM * DM, DM, DM, nullptr, ((bf16*)(F.ws + WS_WOUT)) + (size_t)l * DM * DM, DM, 32 * nb, scr, 64 * kb, 32 * nb, F.lane); continue; }
        r -= I_OUT;
        { const int kb = r / 8, nb = r % 8; p0_transpose_item(kin(11) + (size_t)l * 65536, 256, 256, nullptr, ((bf16*)(F.ws + WS_GLU)) + (size_t)l * 65536, 256, 32 * nb, scr, 64 * kb, 32 * nb, F.lane); }
    }
    for (int m = gw; m < MTOK; m += NGW) {
        const f32x4* xr = (const f32x4*)(kin(0) + (size_t)m * DM) + F.lane; f32x4 v[4]; float s = 0.f;
#pragma unroll
        for (int j = 0; j < 4; ++j) { v[j] = xr[64 * j]; s += (v[j].x * v[j].x + v[j].y * v[j].y) + (v[j].z * v[j].z + v[j].w * v[j].w); }
        s = wave_sum(s);
        u32x2* o8 = (u32x2*)(((bf16*)(F.ws + WS_Z)) + (size_t)m * DM) + F.lane;
#pragma unroll
        for (int j = 0; j < 4; ++j) { u32x2 w; w.x = pk2(v[j].x, v[j].y); w.y = pk2(v[j].z, v[j].w); o8[64 * j] = w; }
        if (F.lane < 4) ((float*)(F.ws + WS_ROWSS))[(size_t)m * 4 + F.lane] = (F.lane == 0) ? s : 0.f;
    }
}

__device__ __forceinline__ Frame phase_frame(const Frame& F0) {
    Frame F = F0; asm volatile("" : "+v"(F.tid)); F.lane = F.tid & 63; F.wave = __builtin_amdgcn_readfirstlane(F.tid >> 6);
    asm volatile("" : "+s"(F.ws)); F.ctl = (unsigned*)(F.ws + WS_CTL); return F;
}
struct SchedTab { const volatile LAS int* tab; int n;
    __device__ __forceinline__ bool next(int i, Unit& u) const { if (i >= n) return false; u.pm = __builtin_amdgcn_readfirstlane(tab[2 * i]); u.pn = __builtin_amdgcn_readfirstlane(tab[2 * i + 1]); return true; }
    __device__ __forceinline__ void a_ready(const Unit&) const {}
    __device__ __forceinline__ void done(const Unit&) const {}
};
__device__ __forceinline__ bool unit_p1(int G, int c, int wbase, int i, int& pm, int& pn) {
    int tok, j;
    if (G == 256) { if (i >= 5) return false; const int x = c & 7, l = c >> 3, n = i * 32 + l, tq = n / 40, rem = n % 40; j = rem >> 2; tok = 16 * x + 4 * tq + (rem & 3); }
    else { const long L = (long)i * G + c; if (L >= NTT * 10) return false; tok = (int)(L / 10); j = (int)(L % 10); }
    if (j < 9) { pm = tok; pn = wbase + j; } else { pm = wbase + 9; pn = tok; }
    return true;
}
__device__ __forceinline__ bool unit_p3(int G, int c, int i, int& pm, int& pn) {
    if (G == 256) { if (i >= 2) return false; const int x = c & 7, l = c >> 3, n = i * 32 + l, tq = n >> 4, rem = n & 15; pn = rem >> 2; pm = 16 * x + 4 * tq + (rem & 3); }
    else { const long L = (long)i * G + c; if (L >= NTT * 4) return false; pm = (int)(L / 4); pn = (int)(L % 4); }
    return true;
}
__device__ __forceinline__ bool unit_glu(int G, int c, int i, int& pm, int& pn) {
    if (G == 256) { if (i >= 1 || (c >> 3) >= 16) return false; pm = 16 * (c & 7) + (c >> 3); pn = 0; }
    else { const long L = (long)i * G + c; if (L >= NTT) return false; pm = (int)L; pn = 0; }
    return true;
}
template <int KIND>
__device__ __forceinline__ SchedTab make_sched(const Frame& F, int wbase) {
    volatile LAS int* tab = (volatile LAS int*)(F.lds + LDS_CTL + 64);
    volatile LAS int* cnt = (volatile LAS int*)(F.lds + LDS_CTL + 32);
    if (F.tid == 0) { int n = 0;
#pragma unroll 1
        for (int i = 0; i < 24; ++i) { int pm, pn; const bool ok = (KIND == 0) ? unit_p1(F.G, F.bid, wbase, i, pm, pn) : (KIND == 1) ? unit_p3(F.G, F.bid, i, pm, pn) : unit_glu(F.G, F.bid, i, pm, pn);
            if (!ok) break; tab[2 * i] = pm; tab[2 * i + 1] = pn; n = i + 1; }
        cnt[0] = n; }
    __syncthreads();
    SchedTab S; S.tab = tab; S.n = __builtin_amdgcn_readfirstlane(cnt[0]); return S;
}

struct EpiProj {
    static constexpr bool PERM = true, AFTER_DRAIN = false;
    int wbase, layer; unsigned char* ws;
    __device__ __forceinline__ void operator()(const f32x4 (&acc)[2][2][4][2], const Unit& u, int wr, int wc, int fr, int fq) const {
        const float* rowss = (const float*)(ws + WS_ROWSS);
        if (u.pm >= NTT) {
            bf16* VT = (bf16*)(ws + WS_VT);
            const int tc = u.pn * 256 + wc * 32 + 8 * fq;
            float rs[2][8];
#pragma unroll
            for (int bj = 0; bj < 2; ++bj)
#pragma unroll
                for (int e = 0; e < 8; ++e) { const f32x4 p = *(const f32x4*)(rowss + (size_t)(tc + bj * 128 + e) * 4); rs[bj][e] = rsqrtf(((p.x + p.y) + (p.z + p.w)) * (1.f / DM) + RMS_EPS); }
#pragma unroll
            for (int ai = 0; ai < 2; ++ai)
#pragma unroll
                for (int m = 0; m < 4; ++m) { const int f = ai * 128 + wr * 64 + m * 16 + fr;
#pragma unroll
                    for (int bj = 0; bj < 2; ++bj) { const f32x4 a = acc[ai][bj][m][0], b = acc[ai][bj][m][1]; u32x4 w;
                        w.x = pk2(a[0] * rs[bj][0], a[1] * rs[bj][1]); w.y = pk2(a[2] * rs[bj][2], a[3] * rs[bj][3]); w.z = pk2(b[0] * rs[bj][4], b[1] * rs[bj][5]); w.w = pk2(b[2] * rs[bj][6], b[3] * rs[bj][7]);
                        *(u32x4*)(VT + (size_t)f * MTOK + tc + bj * 128) = w; } }
            return;
        }
        const int t = u.pn - wbase;
        int kind, pitch, col, nwi = 0; size_t dsto;
        switch (t) {
            case 0: kind = 0; dsto = WS_U; pitch = 256; col = 64 * wc; break;
            case 1: kind = 1; dsto = WS_SG; pitch = 256; col = 64 * wc; break;
            case 2: kind = 2; dsto = WS_AQ; pitch = 384; col = 64 * wc; nwi = 0; break;
            case 3: if (wc < 2) { kind = 2; dsto = WS_AQ; pitch = 384; col = 64 * (4 + wc); nwi = 0; } else { kind = 2; dsto = WS_AK; pitch = 128; col = 64 * (wc - 2); nwi = 1; } break;
            case 4: kind = 1; dsto = WS_AG; pitch = 384; col = 64 * wc; break;
            case 5: if (wc < 2) { kind = 1; dsto = WS_AG; pitch = 384; col = 64 * (4 + wc); } else { kind = 2; dsto = WS_MQ; pitch = 384; col = 64 * (wc - 2); nwi = 2; } break;
            case 6: kind = 2; dsto = WS_MQ; pitch = 384; col = 64 * (2 + wc); nwi = 2; break;
            case 7: if (wc < 2) { kind = 5; dsto = WS_MK; pitch = 128; col = 64 * wc; nwi = 3; } else { kind = 1; dsto = WS_MG; pitch = 384; col = 64 * (wc - 2); } break;
            default: kind = 1; dsto = WS_MG; pitch = 384; col = 64 * (2 + wc); break;
        }
        bf16* dst = (bf16*)(ws + dsto) + col + 8 * fq; const float* nw = (const float*)(ws + WS_NW) + (layer * 4 + nwi) * 64 + 8 * fq;
        const int row0 = u.pm * 256 + wr * 64 + fr;
        if (kind == 0) rows<0>(acc, row0, dst, pitch, nw, rowss, nullptr);
        else if (kind == 1) rows<1>(acc, row0, dst, pitch, nw, rowss, nullptr);
        else if (kind == 2) rows<2>(acc, row0, dst, pitch, nw, rowss, nullptr);
        else rows<5>(acc, row0, dst, pitch, nw, rowss, (fr == 0) ? (float*)(ws + WS_KPART) + ((size_t)(u.pm * 2 + wr) * 2 + wc) * 64 + 8 * fq : nullptr);
    }
    template <int KIND>
    __device__ __forceinline__ void rows(const f32x4 (&acc)[2][2][4][2], int row0, bf16* dst, int pitch, const float* nw, const float* rowss, float* kp) const {
        f32x4 wv[2][2], ks[2][2];
        if (KIND >= 2) {
#pragma unroll
            for (int bj = 0; bj < 2; ++bj)
#pragma unroll
                for (int n = 0; n < 2; ++n) { wv[bj][n] = *(const f32x4*)(nw + 32 * bj + 4 * n); ks[bj][n] = (f32x4){0.f, 0.f, 0.f, 0.f}; }
        }
#pragma unroll
        for (int ai = 0; ai < 2; ++ai)
#pragma unroll
            for (int m = 0; m < 4; ++m) {
                const int row = row0 + ai * 128 + m * 16;
                const f32x4 p = *(const f32x4*)(rowss + (size_t)row * 4);
                const float rs = rsqrtf(((p.x + p.y) + (p.z + p.w)) * (1.f / DM) + RMS_EPS);
                f32x4 v[2][2];
#pragma unroll
                for (int bj = 0; bj < 2; ++bj)
#pragma unroll
                    for (int n = 0; n < 2; ++n) v[bj][n] = acc[ai][bj][m][n] * rs;
                if (KIND >= 2) {
                    float ss = 0.f;
#pragma unroll
                    for (int bj = 0; bj < 2; ++bj)
#pragma unroll
                        for (int n = 0; n < 2; ++n) { const f32x4 q = v[bj][n]; ss += (q[0] * q[0] + q[1] * q[1]) + (q[2] * q[2] + q[3] * q[3]); }
                    ss += __shfl_xor(ss, 16); ss += __shfl_xor(ss, 32);
                    const float hn = rsqrtf(ss * (1.f / 64.f) + RMS_EPS);
#pragma unroll
                    for (int bj = 0; bj < 2; ++bj)
#pragma unroll
                        for (int n = 0; n < 2; ++n) { v[bj][n] = v[bj][n] * wv[bj][n] * hn; if (KIND == 5) ks[bj][n] += v[bj][n]; }
                } else if (KIND == 1) {
#pragma unroll
                    for (int bj = 0; bj < 2; ++bj)
#pragma unroll
                        for (int n = 0; n < 2; ++n)
#pragma unroll
                            for (int e = 0; e < 4; ++e) v[bj][n][e] = silu_f(v[bj][n][e]);
                }
                bf16* rp = dst + (size_t)row * pitch;
#pragma unroll
                for (int bj = 0; bj < 2; ++bj) { u32x4 w; w.x = pk2(v[bj][0][0], v[bj][0][1]); w.y = pk2(v[bj][0][2], v[bj][0][3]); w.z = pk2(v[bj][1][0], v[bj][1][1]); w.w = pk2(v[bj][1][2], v[bj][1][3]);
                    *(u32x4*)(rp + 32 * bj) = w; }
                if (m & 1) asm volatile("" ::: "memory");
            }
        if (KIND == 5) {
#pragma unroll
            for (int bj = 0; bj < 2; ++bj)
#pragma unroll
                for (int n = 0; n < 2; ++n)
#pragma unroll
                    for (int e = 0; e < 4; ++e) { float s = ks[bj][n][e]; s += __shfl_xor(s, 1); s += __shfl_xor(s, 2); s += __shfl_xor(s, 4); s += __shfl_xor(s, 8); ks[bj][n][e] = s; }
            if (kp) {
#pragma unroll
                for (int bj = 0; bj < 2; ++bj)
#pragma unroll
                    for (int n = 0; n < 2; ++n) *(f32x4*)(kp + 32 * bj + 4 * n) = ks[bj][n];
            }
        }
    }
};
struct EpiGlu {
    static constexpr bool PERM = true, AFTER_DRAIN = false;
    const bf16* YPRE; const bf16* SG; const float* gb; bf16* Y;
    __device__ __forceinline__ void operator()(const f32x4 (&acc)[2][2][4][2], const Unit& u, int wr, int wc, int fr, int fq) const {
#pragma unroll
        for (int bj = 0; bj < 2; ++bj) { const int c = wc * 32 + 8 * fq + 128 * bj;
            const f32x4 b0 = *(const f32x4*)(gb + c), b1 = *(const f32x4*)(gb + c + 4);
#pragma unroll
            for (int ai = 0; ai < 2; ++ai)
#pragma unroll
                for (int m = 0; m < 4; ++m) { const int row = u.pm * 256 + ai * 128 + wr * 64 + m * 16 + fr;
                    const u32x4 yp = *(const u32x4*)(YPRE + (size_t)row * 256 + c), sg = *(const u32x4*)(SG + (size_t)row * 256 + c);
                    const f32x4 z0 = acc[ai][bj][m][0] + b0, z1 = acc[ai][bj][m][1] + b1;
                    u32x4 w;
                    w.x = pk2(bflo(yp.x) * sigmoid_f(z0[0]) * bflo(sg.x), bfhi(yp.x) * sigmoid_f(z0[1]) * bfhi(sg.x));
                    w.y = pk2(bflo(yp.y) * sigmoid_f(z0[2]) * bflo(sg.y), bfhi(yp.y) * sigmoid_f(z0[3]) * bfhi(sg.y));
                    w.z = pk2(bflo(yp.z) * sigmoid_f(z1[0]) * bflo(sg.z), bfhi(yp.z) * sigmoid_f(z1[1]) * bfhi(sg.z));
                    w.w = pk2(bflo(yp.w) * sigmoid_f(z1[2]) * bflo(sg.w), bfhi(yp.w) * sigmoid_f(z1[3]) * bfhi(sg.w));
                    *(u32x4*)(Y + (size_t)row * DM + c) = w;
                    if (m & 1) asm volatile("" ::: "memory"); } }
    }
};
struct EpiOut {
    static constexpr bool PERM = false, AFTER_DRAIN = false;
    const float* resid_f; float* out; bf16* xb; float* rowss; int write_next; LAS float* xch;
    __device__ __forceinline__ void operator()(const f32x4 (&acc)[2][2][4][2], const Unit& u, int wr, int wc, int fr, int fq) const {
        const int c0 = u.pn * 256 + wc * 32 + 4 * fq;
#pragma unroll
        for (int ai = 0; ai < 2; ++ai)
#pragma unroll
            for (int m = 0; m < 4; ++m) { const int rt = ai * 128 + wr * 64 + m * 16 + fr; const size_t off = (size_t)(u.pm * 256 + rt) * DM + c0; float ss = 0.f;
#pragma unroll
                for (int bj = 0; bj < 2; ++bj)
#pragma unroll
                    for (int n = 0; n < 2; ++n) { const size_t o2 = off + bj * 128 + n * 16; const f32x4 a4 = acc[ai][bj][m][n]; f32x4 o;
                        if (write_next) o = *(const f32x4*)(resid_f + o2) + a4;
                        else { const u32x2 rb = *(const u32x2*)(xb + o2); o[0] = bflo(rb.x) + a4[0]; o[1] = bfhi(rb.x) + a4[1]; o[2] = bflo(rb.y) + a4[2]; o[3] = bfhi(rb.y) + a4[3]; }
                        if (write_next) { u32x2 w; w.x = pk2(o[0], o[1]); w.y = pk2(o[2], o[3]); *(u32x2*)(xb + o2) = w; ss += (o[0] * o[0] + o[1] * o[1]) + (o[2] * o[2] + o[3] * o[3]); }
                        else __builtin_nontemporal_store(o, (f32x4*)(out + o2)); }
                if (write_next) { ss += __shfl_xor(ss, 16); ss += __shfl_xor(ss, 32); if (fq == 0) xch[rt * 4 + wc] = ss; }
            }
        asm volatile("s_waitcnt lgkmcnt(0)" ::: "memory"); __builtin_amdgcn_s_barrier(); asm volatile("" ::: "memory");
        if (write_next && threadIdx.x < 256) { const f32x4 p = *(const LAS f32x4*)(xch + threadIdx.x * 4); rowss[(size_t)(u.pm * 256 + threadIdx.x) * 4 + u.pn] = (p.x + p.y) + (p.z + p.w); }
    }
};

__device__ __forceinline__ int pi32(int r) { return (r & ~12) | ((r & 8) >> 1) | ((r & 4) << 1); }
template <int MODE>
__device__ __forceinline__ void attn_tile(const bf16x8 (&kf)[4], const bf16x8 (&vf)[2][2], const bf16x8 (&qf)[4], const f32x16& cv, float& l, f32x16 (&O)[2], int a, int h) {
    f32x16 S = __builtin_amdgcn_mfma_f32_32x32x16_bf16(kf[0], qf[0], cv, 0, 0, 0);
#pragma unroll
    for (int ks = 1; ks < 4; ++ks) S = __builtin_amdgcn_mfma_f32_32x32x16_bf16(kf[ks], qf[ks], S, 0, 0, 0);
    if (MODE != 0) {
#pragma unroll
        for (int i = 0; i < 16; ++i) { const int c = pi32((i & 3) + 8 * (i >> 2) + 4 * h); const bool dead = (MODE == 1) ? (c > a) : (c <= a); if (dead) S[i] = -1e30f; }
    }
    float s0 = 0.f, s1 = 0.f;
#pragma unroll
    for (int i = 0; i < 16; i += 2) { S[i] = __builtin_amdgcn_exp2f(S[i]); S[i + 1] = __builtin_amdgcn_exp2f(S[i + 1]); s0 += S[i]; s1 += S[i + 1]; }
    l += s0 + s1;
    bf16x8 pb[2];
#pragma unroll
    for (int s = 0; s < 2; ++s) { u32x4 w; w.x = pk2(S[8 * s], S[8 * s + 1]); w.y = pk2(S[8 * s + 2], S[8 * s + 3]); w.z = pk2(S[8 * s + 4], S[8 * s + 5]); w.w = pk2(S[8 * s + 6], S[8 * s + 7]); pb[s] = __builtin_bit_cast(bf16x8, w); }
#pragma unroll
    for (int dt = 0; dt < 2; ++dt)
#pragma unroll
        for (int s = 0; s < 2; ++s) O[dt] = __builtin_amdgcn_mfma_f32_32x32x16_bf16(vf[dt][s], pb[s], O[dt], 0, 0, 0);
}
template <int NK>
__device__ __forceinline__ void stage_kv(LAS unsigned char* Kimg, LAS unsigned char* Vimg, const bf16* Ksrc  , const bf16* Vsrc  ,
                                         long key_lo  , long key_min  , int wave, int lane) {
    constexpr int KP = NK * 128 / 1024, VCH = NK / 8, VP = 64 * VCH * 16 / 1024;
    for (int p = wave; p < KP; p += 8) { const int L = p * 64 + lane, r = L >> 3, s = L & 7, c = s ^ ((r >> 1) & 7); long kr = key_lo + r; if (kr < key_min) kr = key_min;
        glds16(Ksrc + (kr - key_lo) * 128 + c * 8, Kimg + p * 1024); }
    for (int p = wave; p < VP; p += 8) { const int L = p * 64 + lane, d = L / VCH, s = L % VCH, c = s ^ (d & 15); long kc = key_lo + 8 * c; if (kc < key_min) kc = key_min;
        glds16(Vsrc + (size_t)d * MTOK + (kc - key_lo), Vimg + p * 1024); }
}
template <int NK>
__device__ __forceinline__ void load_kv_frags(bf16x8 (&kf)[4], bf16x8 (&vf)[2][2], const LAS unsigned char* Kimg, const LAS unsigned char* Vimg, int row0  , int lane) {
    const int r = row0 + pi32(lane & 31), h = lane >> 5;
#pragma unroll
    for (int ks = 0; ks < 4; ++ks) kf[ks] = *(const LAS bf16x8*)(Kimg + r * 128 + (((2 * ks + h) ^ ((r >> 1) & 7)) << 4));
#pragma unroll
    for (int dt = 0; dt < 2; ++dt) { const int d = 32 * dt + (lane & 31);
#pragma unroll
        for (int s = 0; s < 2; ++s) { const int c = (row0 >> 3) + 2 * s + h; vf[dt][s] = *(const LAS bf16x8*)(Vimg + d * (NK * 2) + ((c ^ (d & 15)) << 4)); } }
}
__device__ __forceinline__ void attn_store(const f32x16 (&O)[2], float l, const bf16* gate  , bf16* y  , int h) {
    const float inv = 1.f / swap32_sum(l);
#pragma unroll
    for (int dt = 0; dt < 2; ++dt)
#pragma unroll
        for (int q = 0; q < 4; ++q) { const int d = 32 * dt + 8 * q + 4 * h; const u32x2 gv = *(const u32x2*)(gate + d);
            u32x2 w; w.x = pk2(O[dt][4 * q] * inv * bflo(gv.x), O[dt][4 * q + 1] * inv * bfhi(gv.x)); w.y = pk2(O[dt][4 * q + 2] * inv * bflo(gv.y), O[dt][4 * q + 3] * inv * bfhi(gv.y));
            *(u32x2*)(y + d) = w; }
}

template <int VAR>
__device__ __forceinline__ void moba_unit(Frame& F, int b, int kvh, int qb, int g) {
    constexpr int IMG = 32768;
    LAS unsigned char* buf0 = F.lds; LAS unsigned char* buf1 = F.lds + 2 * IMG;
    LAS float* km = (LAS float*)(F.lds + LDS_MISC + 1024);
    const int lane = F.lane, wave = F.wave, a = lane & 31, h = lane >> 5;
    const long tok0 = (long)b * SEQ + 256 * qb;
    const bf16* Kb = ((bf16*)(F.ws + WS_MK)) + (size_t)b * SEQ * 128 + kvh * 64;
    const bf16* Vb = ((bf16*)(F.ws + WS_VT)) + (size_t)(128 + kvh * 64) * MTOK + (size_t)b * SEQ;
    if (VAR != 1) stage_kv<256>(buf0, buf0 + IMG, Kb + (size_t)(256 * qb) * 128, Vb + 256 * qb, 0, 0, wave, lane);
    { const int n = F.tid >> 6, d = F.tid & 63; float s = 0.f;
      if (n < qb) { const int tile = b * 8 + n; s = ((float*)(F.ws + WS_KPART))[((size_t)(tile * 2 + 0) * 2 + kvh) * 64 + d] + ((float*)(F.ws + WS_KPART))[((size_t)(tile * 2 + 1) * 2 + kvh) * 64 + d]; }
      km[n * 64 + d] = s; }
    const size_t row = (size_t)(tok0 + 32 * wave + a);
    const bf16* qp = ((bf16*)(F.ws + WS_MQ)) + row * 384 + kvh * 192 + 8 * h;
    __syncthreads();
    unsigned selmask = 0;
    if (qb > 0) {
        float sc[8];
#pragma unroll
        for (int n = 0; n < 8; ++n) sc[n] = 0.f;
#pragma unroll
        for (int ks = 0; ks < 4; ++ks) { const bf16x8 q0 = *(const bf16x8*)(qp + 16 * ks), q1 = *(const bf16x8*)(qp + 64 + 16 * ks), q2 = *(const bf16x8*)(qp + 128 + 16 * ks);
#pragma unroll
            for (int j = 0; j < 8; ++j) { const float qs = bf2f((unsigned short)q0[j]) + bf2f((unsigned short)q1[j]) + bf2f((unsigned short)q2[j]); const int d = 16 * ks + 8 * h + j;
#pragma unroll
                for (int n = 0; n < 7; ++n) sc[n] += qs * km[n * 64 + d]; } }
#pragma unroll
        for (int n = 0; n < 7; ++n) { sc[n] = swap32_sum(sc[n]); if (n >= qb) sc[n] = -INFINITY; }
#pragma unroll
        for (int t = 0; t < 3; ++t) { float best = -INFINITY; int bi = -1;
#pragma unroll
            for (int n = 0; n < 7; ++n) if (sc[n] > best) { best = sc[n]; bi = n; }
            if (bi >= 0) { selmask |= 1u << bi;
#pragma unroll
                for (int n = 0; n < 7; ++n) if (n == bi) sc[n] = -INFINITY; } }
    }
    float l = 0.f; f32x16 O[2]; bf16x8 qf[4];
#pragma unroll
    for (int i = 0; i < 16; ++i) { O[0][i] = 0.f; O[1][i] = 0.f; }
#pragma unroll
    for (int ks = 0; ks < 4; ++ks) qf[ks] = *(const bf16x8*)(qp + g * 64 + 16 * ks);
#pragma unroll 1
    for (int s = 0; s <= qb; ++s) {
        LAS unsigned char* cur = (s & 1) ? buf1 : buf0; LAS unsigned char* nxt = (s & 1) ? buf0 : buf1;
        if (s < qb && VAR != 1) stage_kv<256>(nxt, nxt + IMG, Kb + (size_t)(256 * s) * 128, Vb + 256 * s, 0, 0, wave, lane);
        if (VAR == 2) {} else if (s == 0) {
            f32x16 cv;
#pragma unroll
            for (int i = 0; i < 16; ++i) cv[i] = 0.f;
            int kt = 0;
#pragma unroll 1
            for (; kt + 1 < wave; kt += 2) { bf16x8 kfa[4], vfa[2][2], kfb[4], vfb[2][2]; load_kv_frags<256>(kfa, vfa, cur, cur + IMG, 32 * kt, lane); load_kv_frags<256>(kfb, vfb, cur, cur + IMG, 32 * kt + 32, lane);
                attn_tile<0>(kfa, vfa, qf, cv, l, O, a, h); attn_tile<0>(kfb, vfb, qf, cv, l, O, a, h); }
            if (kt < wave) { bf16x8 kfa[4], vfa[2][2], kfb[4], vfb[2][2]; load_kv_frags<256>(kfa, vfa, cur, cur + IMG, 32 * kt, lane); load_kv_frags<256>(kfb, vfb, cur, cur + IMG, 32 * kt + 32, lane);
                attn_tile<0>(kfa, vfa, qf, cv, l, O, a, h); attn_tile<1>(kfb, vfb, qf, cv, l, O, a, h); }
            else { bf16x8 kfa[4], vfa[2][2]; load_kv_frags<256>(kfa, vfa, cur, cur + IMG, 32 * kt, lane); attn_tile<1>(kfa, vfa, qf, cv, l, O, a, h); }
        } else {
            const float cinit = ((selmask >> (s - 1)) & 1u) ? 0.f : -1e30f;
            if (__any(cinit == 0.f)) {
                f32x16 cv;
#pragma unroll
                for (int i = 0; i < 16; ++i) cv[i] = cinit;
#pragma unroll 1
                for (int kt = 0; kt < 8; kt += 2) { bf16x8 kfa[4], vfa[2][2], kfb[4], vfb[2][2]; load_kv_frags<256>(kfa, vfa, cur, cur + IMG, 32 * kt, lane); load_kv_frags<256>(kfb, vfb, cur, cur + IMG, 32 * kt + 32, lane);
                    attn_tile<0>(kfa, vfa, qf, cv, l, O, a, h); attn_tile<0>(kfb, vfb, qf, cv, l, O, a, h); }
            }
        }
        __syncthreads();
    }
    attn_store(O, l, ((bf16*)(F.ws + WS_MG)) + row * 384 + (kvh * 3 + g) * 64, ((bf16*)(F.ws + (VAR ? WS_END : WS_Y))) + row * DM + 640 + (kvh * 3 + g) * 64, h);
}

__device__ __forceinline__ void swa_unit(const Params& P, Frame& F, int layer, int b, int kvh, int qblk) {
    constexpr int NK = 384;
    LAS unsigned char* Kimg = F.lds; LAS unsigned char* Vimg = F.lds + NK * 128;
    const int lane = F.lane, wave = F.wave, a = lane & 31, h = lane >> 5;
    const int q0 = 256 * qblk; const long tok0 = (long)b * SEQ + q0;
    const bf16* Kb = ((bf16*)(F.ws + WS_AK)) + ((long)b * SEQ + q0 - 128) * 128 + kvh * 64;
    const bf16* Vb = ((bf16*)(F.ws + WS_VT)) + (size_t)(kvh * 64) * MTOK + ((long)b * SEQ + q0 - 128);
    stage_kv<NK>(Kimg, Vimg, Kb, Vb, (long)q0 - 128, 0, wave, lane);
    const size_t row = (size_t)(tok0 + 32 * wave + a);
    const bf16* qp = ((bf16*)(F.ws + WS_AQ)) + row * 384 + kvh * 192 + 8 * h;
    f32x16 cv;
#pragma unroll
    for (int i = 0; i < 16; ++i) cv[i] = 0.f;
    const bool head = (q0 - 128 + 32 * wave) >= 0;
    __syncthreads();
#pragma unroll 1
    for (int g = 0; g < 3; ++g) {
        bf16x8 qf[4];
#pragma unroll
        for (int ks = 0; ks < 4; ++ks) qf[ks] = *(const bf16x8*)(qp + g * 64 + 16 * ks);
        float l = 0.5f * __builtin_amdgcn_exp2f(kin(15)[layer * 6 + kvh * 3 + g] * LOG2E);
        f32x16 O[2];
#pragma unroll
        for (int i = 0; i < 16; ++i) { O[0][i] = 0.f; O[1][i] = 0.f; }
        const int r0 = 32 * wave;
        if (head) {
            { bf16x8 kfa[4], vfa[2][2], kfb[4], vfb[2][2]; load_kv_frags<NK>(kfa, vfa, Kimg, Vimg, r0, lane); load_kv_frags<NK>(kfb, vfb, Kimg, Vimg, r0 + 32, lane);
              attn_tile<2>(kfa, vfa, qf, cv, l, O, a, h); attn_tile<0>(kfb, vfb, qf, cv, l, O, a, h); }
            { bf16x8 kfa[4], vfa[2][2], kfb[4], vfb[2][2]; load_kv_frags<NK>(kfa, vfa, Kimg, Vimg, r0 + 64, lane); load_kv_frags<NK>(kfb, vfb, Kimg, Vimg, r0 + 96, lane);
              attn_tile<0>(kfa, vfa, qf, cv, l, O, a, h); attn_tile<0>(kfb, vfb, qf, cv, l, O, a, h); }
        } else {
#pragma unroll 1
            for (int kt = 4 - wave; kt < 4; ++kt) { bf16x8 kfa[4], vfa[2][2]; load_kv_frags<NK>(kfa, vfa, Kimg, Vimg, r0 + 32 * kt, lane); attn_tile<0>(kfa, vfa, qf, cv, l, O, a, h); }
        }
        { bf16x8 kfa[4], vfa[2][2]; load_kv_frags<NK>(kfa, vfa, Kimg, Vimg, r0 + 128, lane); attn_tile<1>(kfa, vfa, qf, cv, l, O, a, h); }
        attn_store(O, l, ((bf16*)(F.ws + WS_AG)) + row * 384 + (kvh * 3 + g) * 64, ((bf16*)(F.ws + WS_Y)) + row * DM + 256 + (kvh * 3 + g) * 64, h);
    }
    __syncthreads();
}

__device__ __forceinline__ void ssm_unit(Frame& F, int layer, int b, int g) {
    constexpr int APITCH = 528;
    LAS unsigned char* AU = F.lds;
    LAS unsigned char* SC = F.lds + 128 * APITCH;
    LAS float* seg = (LAS float*)(F.lds + 2 * 128 * APITCH);
    const int lane = F.lane, wave = F.wave, tid = F.tid, fr = lane & 15, fq = lane >> 4;
    const int pair = layer * 16 + g;
    const bf16* TE = ((bf16*)(F.ws + WS_TE)) + (size_t)pair * TE_ELEMS; const bf16* GM = ((bf16*)(F.ws + WS_G)) + (size_t)pair * G_ELEMS;
    { const bf16* up = ((bf16*)(F.ws + WS_U)) + (size_t)b * SEQ * 256 + g * 16;
#pragma unroll
      for (int i = 0; i < 8; ++i) { const int idx = tid + 512 * i, t = idx >> 1, hf = idx & 1; const u32x4 v = *(const u32x4*)(up + (size_t)t * 256 + 8 * hf);
          *(LAS u32x4*)(AU + (t >> 4) * APITCH + ((t & 15) * 16 + 8 * hf) * 2) = v; } }
    __syncthreads();
    {
        bf16x8 gf[8];
#pragma unroll
        for (int ks = 0; ks < 8; ++ks) gf[ks] = *(const bf16x8*)(GM + (size_t)(16 * wave + fr) * 256 + 32 * ks + 8 * fq);
#pragma unroll
        for (int rt = 0; rt < 8; ++rt) { f32x4 acc = {0.f, 0.f, 0.f, 0.f};
#pragma unroll
            for (int ks = 0; ks < 8; ++ks) { const bf16x8 af = *(const LAS bf16x8*)(AU + (16 * rt + fr) * APITCH + (32 * ks + 8 * fq) * 2); acc = __builtin_amdgcn_mfma_f32_16x16x32_bf16(gf[ks], af, acc, 0, 0, 0); }
            *(LAS f32x4*)(SC + (16 * rt + fr) * APITCH + (16 * wave + 4 * fq) * 4) = acc; }
    }
    __syncthreads();
    {
        const float ar = ((float*)(F.ws + WS_AT))[(size_t)pair * 128 + 2 * lane], ai = ((float*)(F.ws + WS_AT))[(size_t)pair * 128 + 2 * lane + 1];
        float lr = 0.f, li = 0.f, locr[16], loci[16];
#pragma unroll
        for (int k = 0; k < 16; ++k) { locr[k] = lr; loci[k] = li; const f32x2_t s = *(const LAS f32x2_t*)(SC + (16 * wave + k) * APITCH + lane * 8);
            const float nr = ar * lr - ai * li + s.x, ni = ar * li + ai * lr + s.y; lr = nr; li = ni; }
        seg[(wave * 64 + lane) * 2] = lr; seg[(wave * 64 + lane) * 2 + 1] = li;
        __syncthreads();
        float a16r = ar, a16i = ai;
#pragma unroll
        for (int q = 0; q < 4; ++q) { const float tr = a16r * a16r - a16i * a16i, ti = 2.f * a16r * a16i; a16r = tr; a16i = ti; }
        float ir = 0.f, ii = 0.f;
        for (int w2 = 0; w2 < wave; ++w2) { const float sr = seg[(w2 * 64 + lane) * 2], si = seg[(w2 * 64 + lane) * 2 + 1]; const float nr = a16r * ir - a16i * ii + sr, ni = a16r * ii + a16i * ir + si; ir = nr; ii = ni; }
        float pr = 1.f, pi = 0.f;
#pragma unroll
        for (int k = 0; k < 16; ++k) { const float cr = locr[k] + pr * ir - pi * ii, ci = loci[k] + pr * ii + pi * ir;
            *(LAS unsigned*)(SC + (16 * wave + k) * APITCH + lane * 4) = pk2(cr, ci);
            const float tr = pr * ar - pi * ai, ti = pr * ai + pi * ar; pr = tr; pi = ti; }
    }
    __syncthreads();
#pragma unroll 1
    for (int half = 0; half < 2; ++half) {
        const int i = half ? 15 - wave : wave;
        f32x4 acc[8];
#pragma unroll
        for (int rt = 0; rt < 8; ++rt) acc[rt] = (f32x4){0.f, 0.f, 0.f, 0.f};
        const bf16* tp = TE + (size_t)(16 * i + fr) * 384 + 8 * fq;
        const int nks = (i >> 1) + 1;
        bf16x8 tfu[8], tfc[4];
#pragma unroll
        for (int ks = 0; ks < 8; ++ks) tfu[ks] = *(const bf16x8*)(tp + 32 * (ks < nks ? ks : 0));
#pragma unroll
        for (int ks = 0; ks < 4; ++ks) tfc[ks] = *(const bf16x8*)(tp + 256 + 32 * ks);
#pragma unroll
        for (int ks = 0; ks < 8; ++ks) { if (ks < nks) {
#pragma unroll
            for (int rt = 0; rt < 8; ++rt) { const bf16x8 af = *(const LAS bf16x8*)(AU + (16 * rt + fr) * APITCH + (32 * ks + 8 * fq) * 2); acc[rt] = __builtin_amdgcn_mfma_f32_16x16x32_bf16(tfu[ks], af, acc[rt], 0, 0, 0); } } }
#pragma unroll
        for (int ks = 0; ks < 4; ++ks) {
#pragma unroll
            for (int rt = 0; rt < 8; ++rt) { const bf16x8 af = *(const LAS bf16x8*)(SC + (16 * rt + fr) * APITCH + (32 * ks + 8 * fq) * 2); acc[rt] = __builtin_amdgcn_mfma_f32_16x16x32_bf16(tfc[ks], af, acc[rt], 0, 0, 0); } }
#pragma unroll
        for (int rt = 0; rt < 8; ++rt) { const int chunk = 16 * rt + fr; u32x2 w; w.x = pk2(gelu_tanh_f(acc[rt][0]), gelu_tanh_f(acc[rt][1])); w.y = pk2(gelu_tanh_f(acc[rt][2]), gelu_tanh_f(acc[rt][3]));
            *(u32x2*)(((bf16*)(F.ws + WS_YPRE)) + ((size_t)b * SEQ + 16 * chunk + i) * 256 + g * 16 + 4 * fq) = w; }
    }
    __syncthreads();
}

__device__ __forceinline__ void mixer_phase(const Params& P, Frame& F, int qslot, int layer, int mask) {
    volatile LAS int* qw = (volatile LAS int*)(F.lds + LDS_CTL);
    unsigned* head = F.ctl + CW_QUEUE + 64 * qslot;
    for (;;) {
        if (F.tid == 0) qw[0] = (int)atomicAdd(head, 1u);
        __syncthreads();
        const int it = qw[0];
        __syncthreads();
        if (it >= 1280) break;
        Frame Fu = phase_frame(F);
#ifndef NO_MOBA
        if (it < 768 && (mask & 1)) { const int qb = 7 - it / 96, r = it % 96, b = r / 6, kvh = (r % 6) / 3, g = r % 3;
            if (mask & 8) moba_unit<1>(Fu, b, kvh, qb, g); else if (mask & 16) moba_unit<2>(Fu, b, kvh, qb, g); else moba_unit<0>(Fu, b, kvh, qb, g); }
#endif
#ifndef NO_SSM
        if (it >= 768 && it < 1024 && (mask & 2)) { const int r = it - 768; ssm_unit(Fu, layer, r >> 4, r & 15); }
#endif
#ifndef NO_SWA
        if (it >= 1024 && (mask & 4)) { const int r = it - 1024; swa_unit(P, Fu, layer, r >> 4, (r >> 3) & 1, r & 7); }
#endif
    }
}

#define XB_TMO      128
#define XB_XCNT(j)  (256  + 64 * (j))
#define XB_XSUB(j)  (1280 + 64 * (j))
#define XB_XGEN(j)  (2304 + 64 * (j))
#define XB_TOP      3328
#define XB_TOPGEN   3392
#define XCD_BAR_WORDS 3456
#define XB_SPIN_CAP (1u << 18)

__device__ __forceinline__ unsigned xb_ld(unsigned* p)              { return __hip_atomic_load(p, __ATOMIC_RELAXED, __HIP_MEMORY_SCOPE_AGENT); }
__device__ __forceinline__ unsigned xb_add(unsigned* p, unsigned v) { return __hip_atomic_fetch_add(p, v, __ATOMIC_RELAXED, __HIP_MEMORY_SCOPE_AGENT); }
__device__ __forceinline__ unsigned xb_xcc_id() { return (unsigned)__builtin_amdgcn_s_getreg((3 << 11) | 20) & 0xFu; }
#define XB_SPIN(cond, bar) do { unsigned _sp = 0; while (cond) { __builtin_amdgcn_s_sleep(1); \
    if ((++_sp & 255u) == 0u) { if (xb_ld(&(bar)[XB_TMO])) break; if (_sp > XB_SPIN_CAP) { atomicAdd(&(bar)[XB_TMO], 1u); break; } } } } while (0)

struct XcdBarrier {
    unsigned* bar; unsigned x;
    volatile LAS unsigned* st;
};

__device__ __forceinline__ XcdBarrier xcd_barrier_post(unsigned* bar, volatile LAS unsigned* st) {
    XcdBarrier b; b.bar = bar; b.x = xb_xcc_id(); b.st = st;
    if (threadIdx.x == 0) (void)xb_add(&bar[XB_XCNT(b.x)], 1u);
    return b;
}
__device__ __forceinline__ void xcd_barrier_complete(unsigned* bar, unsigned x, unsigned& nloc, unsigned& nx) {
    const unsigned G = gridDim.x * gridDim.y * gridDim.z;
    unsigned sum, cnt, mine, sp = 0u;
    for (;;) {
        sum = 0u; cnt = 0u; mine = 0u;
#pragma unroll 1
        for (unsigned j = 0; j < 16; ++j) { const unsigned c = xb_ld(&bar[XB_XCNT(j)]); sum += c; cnt += (c > 0u) ? 1u : 0u; mine = (j == x) ? c : mine; }
        if (sum == G) break;
        __builtin_amdgcn_s_sleep(1);
        if ((++sp & 255u) == 0u) { if (xb_ld(&bar[XB_TMO])) break; if (sp > XB_SPIN_CAP) { atomicAdd(&bar[XB_TMO], 1u); break; } }
    }
    nloc = mine > 0u ? mine : 1u; nx = cnt > 0u ? cnt : 1u;
}

__device__ __forceinline__ void xcd_barrier(const XcdBarrier& b) {
    asm volatile("s_waitcnt vmcnt(0)" ::: "memory");
    __syncthreads();
    if (threadIdx.x == 0) {
        unsigned* bar = b.bar;
        __builtin_amdgcn_s_waitcnt(0);
        unsigned nloc = b.st[0], nx = b.st[1];
        if (nloc == 0u) { xcd_barrier_complete(bar, b.x, nloc, nx); b.st[0] = nloc; b.st[1] = nx; }
        const unsigned old = xb_add(&bar[XB_XSUB(b.x)], 1u);
        const unsigned gen = old / nloc;
        if (old + 1u == (gen + 1u) * nloc) {
            __builtin_amdgcn_fence(__ATOMIC_RELEASE, "agent");
            asm volatile("s_waitcnt vmcnt(0)" ::: "memory");
            const unsigned og = xb_add(&bar[XB_TOP], 1u);
            const unsigned tg = og / nx;
            if (og + 1u == (tg + 1u) * nx) xb_add(&bar[XB_TOPGEN], 1u);
            else XB_SPIN(xb_ld(&bar[XB_TOPGEN]) == tg, bar);
            __builtin_amdgcn_fence(__ATOMIC_ACQUIRE, "agent");
            xb_add(&bar[XB_XGEN(b.x)], 1u);
            asm volatile("s_waitcnt vmcnt(0)" ::: "memory");
        } else {
            XB_SPIN(xb_ld(&bar[XB_XGEN(b.x)]) == gen, bar);
            __builtin_amdgcn_fence(__ATOMIC_ACQUIRE, "agent");
            asm volatile("s_waitcnt vmcnt(0)" ::: "memory");
        }
    }
    __syncthreads();
}

constexpr int CW_BAR = 4096;
#ifndef USE_COOP_LAUNCH
#define USE_COOP_LAUNCH 0
#endif
#ifndef REP_P0
#define REP_P0 1
#endif
#ifndef REP_P1
#define REP_P1 1
#endif
#ifndef REP_MIX
#define REP_MIX 1
#endif
#ifndef REP_GLU
#define REP_GLU 1
#endif
#ifndef REP_P3L0
#define REP_P3L0 1
#endif
#ifndef REP_SYNC
#define REP_SYNC 1
#endif
#ifndef MIX_EXTRA_MASK
#define MIX_EXTRA_MASK 7
#endif
#ifndef USE_CG_SYNC
#define USE_CG_SYNC 0
#endif
#define GRID_SYNC() do { for (int r_ = 0; r_ < REP_SYNC; ++r_) { if (USE_CG_SYNC) cg::this_grid().sync(); else xcd_barrier(xbar); } } while (0)
__global__ void __launch_bounds__(512, 2) mk_fwd(Params P) {
    extern __shared__ __attribute__((aligned(16))) unsigned char lds_raw[];
    Frame F;
    F.lds = (LAS unsigned char*)lds_raw; F.tid = threadIdx.x; F.lane = F.tid & 63; F.wave = __builtin_amdgcn_readfirstlane(F.tid >> 6); F.G = gridDim.x; F.bid = blockIdx.x;
    F.out = (float*)kin(19); F.ws = (unsigned char*)kin(20); F.ctl = (unsigned*)(F.ws + WS_CTL);
    if (F.tid < 128) ((LAS unsigned*)(F.lds + LDS_CTL))[F.tid] = 0u;
    __syncthreads();
    const XcdBarrier xbar = xcd_barrier_post(F.ctl + CW_BAR, (volatile LAS unsigned*)(F.lds + LDS_CTL + 16));

#ifndef NO_P0
    for (int rep = 0; rep < REP_P0; ++rep) { Frame Fp = phase_frame(F); p0_prologue(P, Fp); }
#endif
    GRID_SYNC();
#pragma unroll 1
    for (int layer = 0; layer < DEPTH; ++layer) {
#ifndef NO_P1
        for (int rep = 0; rep < REP_P1; ++rep) {
            Frame Fp = phase_frame(F);
            pg8::Gemm g{((bf16*)(Fp.ws + WS_Z)), ((bf16*)(Fp.ws + WS_Z)), ZROWS, ZROWS, DM}; const SchedTab S = make_sched<0>(Fp, NTT + 10 * layer);
            EpiProj E{NTT + 10 * layer, layer, Fp.ws};
            pg8::gemm_phase<EpiProj, SchedTab, true, true>(F.lds, g, S, E);
        }
#endif
        GRID_SYNC();
#ifndef NO_MIX
        for (int rep = 0; rep < REP_MIX; ++rep) { Frame Fp = phase_frame(F); mixer_phase(P, Fp, layer + 2 * rep, layer, rep ? MIX_EXTRA_MASK : 7); }
#endif
        GRID_SYNC();
#ifndef NO_GLU
        for (int rep = 0; rep < REP_GLU; ++rep) {
            int kglu = 256; asm volatile("" : "+s"(kglu));
            Frame Fp = phase_frame(F);
            pg8::Gemm g{((bf16*)(Fp.ws + WS_YPRE)), ((bf16*)(Fp.ws + WS_GLU)) + (size_t)layer * 65536, MTOK, 256, kglu}; const SchedTab S = make_sched<2>(Fp, 0);
            EpiGlu E{((bf16*)(Fp.ws + WS_YPRE)), ((bf16*)(Fp.ws + WS_SG)), kin(12) + layer * 256, ((bf16*)(Fp.ws + WS_Y))};
            pg8::gemm_phase<EpiGlu, SchedTab, true, true>(F.lds, g, S, E);
        }
#endif
        GRID_SYNC();
#ifndef NO_P3
        {
            Frame Fp = phase_frame(F);
            pg8::Gemm g{((bf16*)(Fp.ws + WS_Y)), ((bf16*)(Fp.ws + WS_WOUT)) + (size_t)layer * DM * DM, MTOK, DM, DM}; const SchedTab S = make_sched<1>(Fp, 0);
            EpiOut E{kin(0), F.out, ((bf16*)(Fp.ws + WS_Z)), ((float*)(Fp.ws + WS_ROWSS)), layer + 1 < DEPTH ? 1 : 0, (LAS float*)(F.lds + LDS_MISC + 4096)};
            pg8::gemm_phase<EpiOut, SchedTab, true, true>(F.lds, g, S, E);
        }
#endif
        if (layer + 1 < DEPTH) GRID_SYNC();
    }
}

extern "C" void kernel_launch(void* const* d_in, const int* in_sizes, int n_in, void* d_out, int out_size, void* d_ws, size_t ws_size, hipStream_t stream) {
    static int grid = 0;
    if (grid == 0) {
        if (n_in != 19 || out_size != MTOK * DM || ws_size < WS_END) { fprintf(stderr, "kernel_launch: unexpected problem (n_in %d out %d ws %zu)\n", n_in, out_size, ws_size); grid = -1; return; }
        int dev = 0, cus = 0, per_cu = 0;
        (void)hipGetDevice(&dev);
        (void)hipDeviceGetAttribute(&cus, hipDeviceAttributeMultiprocessorCount, dev);
        (void)hipFuncSetAttribute((const void*)mk_fwd, hipFuncAttributeMaxDynamicSharedMemorySize, LDS_BYTES);
        (void)hipOccupancyMaxActiveBlocksPerMultiprocessor(&per_cu, (const void*)mk_fwd, 512, LDS_BYTES);
        if (per_cu < 1) { fprintf(stderr, "kernel_launch: occupancy query says %d blocks per CU\n", per_cu); per_cu = 1; }
        grid = cus;
    }
    if (grid < 0) return;
    (void)hipMemsetAsync((char*)d_ws + WS_CTL, 0, CTL_BYTES, stream);
    Params p{};
    for (int i = 0; i < 19; ++i) p.in[i] = (const float*)d_in[i];
    p.out = (float*)d_out; p.ws = (unsigned char*)d_ws;
#if USE_COOP_LAUNCH
    void* args[] = {&p};
    hipError_t e = hipLaunchCooperativeKernel((const void*)mk_fwd, dim3(grid), dim3(512), args, LDS_BYTES, stream);
    if (e != hipSuccess) fprintf(stderr, "cooperative launch failed: %s (grid %d)\n", hipGetErrorString(e), grid);
#else
    hipLaunchKernelGGL(mk_fwd, dim3(grid), dim3(512), LDS_BYTES, stream, p);
    const hipError_t e = hipPeekAtLastError();
    if (e != hipSuccess) fprintf(stderr, "launch failed: %s (grid %d)\n", hipGetErrorString(e), grid);
#endif
}
```

```cpp
#include <hip/hip_runtime.h>
#include <hip/hip_cooperative_groups.h>
#include <cstdio>
#include <cstdint>
namespace cg = cooperative_groups;
namespace pg8 {
#define PG8_LAS __attribute__((address_space(3)))
typedef unsigned short bf16_t;
typedef short bf16x8 __attribute__((ext_vector_type(8)));
typedef float f32x4 __attribute__((ext_vector_type(4)));
typedef unsigned u32x4 __attribute__((ext_vector_type(4)));
constexpr int BM = 256, BK = 64, HALF = 128, HTB = HALF * BK * 2  , STAGE_BYTES = 8 * HTB, NXCD = 8, WGM = 8;

__host__ __device__ __forceinline__ int lds_byte(int r, int c) { const int st = (r >> 4) * 2 + (c >> 5), rr = r & 15, cc = c & 31, ob = rr * 64 + cc * 2; return st * 1024 + (ob ^ (((ob >> 9) & 1) << 5)); }
__host__ __device__ __forceinline__ void stage_rc(int b, int& R, int& C) { const int st = b / 1024, sb = b % 1024, swz = sb ^ (((sb >> 9) & 1) << 5); R = (st >> 1) * 16 + swz / 64; C = (st & 1) * 32 + (swz % 64) / 2; }
__host__ __device__ __forceinline__ int perm32(int rho) { const int n = rho >> 4, i = rho & 15; return 8 * (i >> 2) + 4 * n + (i & 3); }

struct Unit { int pm, pn; };
struct Gemm { const bf16_t* A; const bf16_t* Bt; int M, N, K; };

__device__ __forceinline__ unsigned cvt_pk_bf16(float lo, float hi) { unsigned r; asm volatile("v_cvt_pk_bf16_f32 %0, %1, %2" : "=v"(r) : "v"(lo), "v"(hi)); return r; }
typedef float f32x2 __attribute__((ext_vector_type(2)));
template <class Epi, class Sched, bool ALIGN_EPI = false, bool SP2 = false>
__device__ __forceinline__ void gemm_phase(PG8_LAS unsigned char* lds, const Gemm g, const Sched& S, const Epi& E) {
    int tid_ = threadIdx.x; asm volatile("" : "+v"(tid_));
    const int tid = tid_, wid = __builtin_amdgcn_readfirstlane(tid >> 6), lane = tid & 63, wr = wid >> 2, wc = wid & 3, fr = lane & 15, fq = lane >> 4;
    const int K = g.K, nt = K / BK;
    unsigned voffA[2], voffB[2];
#pragma unroll
    for (int i = 0; i < 2; ++i) { int R, C; stage_rc(tid * 16 + i * 8192, R, C); const int Rb = Epi::PERM ? ((R & ~31) + perm32(R & 31)) : R;
        voffA[i] = (unsigned)(R * K + C) * 2u; voffB[i] = (unsigned)(Rb * K + C) * 2u; }
    const size_t kstep = (size_t)(BK * 2);
    const size_t hstep = (size_t)HALF * K * 2;
    const size_t tstep = 2 * hstep;
    const unsigned ldsw = (unsigned)wid * 1024u;
    const int aoff = lds_byte(wr * 64 + fr, fq * 8), boff = lds_byte(wc * 32 + fr, fq * 8);
#define PG8_SA(b, h) (((b) * 2 + (h)) * HTB)
#define PG8_SB(b, h) ((4 + (b) * 2 + (h)) * HTB)
#define PG8_STAGE(bufoff, gbase, voff) do { _Pragma("unroll") for (int _i = 0; _i < 2; ++_i) \
        __builtin_amdgcn_global_load_lds((const unsigned*)((const char*)(gbase) + (voff)[_i]), (PG8_LAS unsigned*)(lds + (bufoff) + ldsw + _i * 8192), 16, 0, 0); } while (0)
#define PG8_LDA(dst, b, h) do { _Pragma("unroll") for (int m = 0; m < 4; ++m) _Pragma("unroll") for (int k = 0; k < 2; ++k) dst[m][k] = *(const PG8_LAS bf16x8*)(lds + PG8_SA(b, h) + aoff + m * 2048 + k * 1024); } while (0)
#define PG8_LDB(dst, b, h) do { _Pragma("unroll") for (int n = 0; n < 2; ++n) _Pragma("unroll") for (int k = 0; k < 2; ++k) dst[n][k] = *(const PG8_LAS bf16x8*)(lds + PG8_SB(b, h) + boff + n * 2048 + k * 1024); } while (0)
#define PG8_MMA(ai, bj, At, Bt) do { __builtin_amdgcn_s_setprio(1); _Pragma("unroll") for (int m = 0; m < 4; ++m) _Pragma("unroll") for (int n = 0; n < 2; ++n) _Pragma("unroll") for (int k = 0; k < 2; ++k) \
        acc[ai][bj][m][n] = __builtin_amdgcn_mfma_f32_16x16x32_bf16(Bt[n][k], At[m][k], acc[ai][bj][m][n], 0, 0, 0); __builtin_amdgcn_s_setprio(0); } while (0)
#define PG8_WAIT_V(n) asm volatile("s_waitcnt vmcnt(" #n ")" ::: "memory")
#define PG8_WAIT_L(n) asm volatile("s_waitcnt lgkmcnt(" #n ")" ::: "memory")
#define PG8_BAR __builtin_amdgcn_s_barrier()
#define PG8_SCHED __builtin_amdgcn_sched_barrier(0)
    Unit cur, nxt; int ui = 0;
    if (!S.next(0, cur)) return;
    f32x4 acc[2][2][4][2];
#pragma unroll
    for (int a = 0; a < 2; ++a)
#pragma unroll
        for (int b = 0; b < 2; ++b)
#pragma unroll
            for (int m = 0; m < 4; ++m)
#pragma unroll
                for (int n = 0; n < 2; ++n) acc[a][b][m][n] = (f32x4){0.f, 0.f, 0.f, 0.f};
    bf16x8 At[4][2], B0[2][2], B1[2][2];
    const char* cA = (const char*)g.A + (size_t)cur.pm * tstep; const char* cB = (const char*)g.Bt + (size_t)cur.pn * tstep;
    S.a_ready(cur);
    if constexpr (SP2) {
        PG8_STAGE(PG8_SB(0, 0), cB, voffB); PG8_STAGE(PG8_SB(0, 1), cB + hstep, voffB); PG8_STAGE(PG8_SA(0, 0), cA, voffA); PG8_STAGE(PG8_SA(0, 1), cA + hstep, voffA);
        if (wr == 1) PG8_BAR;
        PG8_WAIT_V(2); PG8_BAR;
        PG8_STAGE(PG8_SB(1, 0), cB + kstep, voffB); PG8_STAGE(PG8_SA(1, 0), cA + kstep, voffA); PG8_STAGE(PG8_SB(1, 1), cB + hstep + kstep, voffB);
        PG8_WAIT_V(6); PG8_BAR;
    } else {
        PG8_STAGE(PG8_SB(0, 0), cB, voffB); PG8_STAGE(PG8_SA(0, 0), cA, voffA); PG8_STAGE(PG8_SB(0, 1), cB + hstep, voffB); PG8_STAGE(PG8_SA(0, 1), cA + hstep, voffA);
        if (wr == 1) PG8_BAR;
        PG8_WAIT_V(4); PG8_BAR;
        PG8_STAGE(PG8_SB(1, 0), cB + kstep, voffB); PG8_STAGE(PG8_SA(1, 0), cA + kstep, voffA); PG8_STAGE(PG8_SB(1, 1), cB + hstep + kstep, voffB);
        PG8_WAIT_V(6); PG8_BAR;
    }
    for (;;) {
        const bool has_next = S.next(ui + 1, nxt);
        const char* nA = has_next ? (const char*)g.A + (size_t)nxt.pm * tstep : cA; const char* nB = has_next ? (const char*)g.Bt + (size_t)nxt.pn * tstep : cB;
        for (int t = 0; t < nt; t += 2) {
            const bool last = (t == nt - 2);
            const char* a1 = cA + (size_t)(t + 1) * kstep;
            const char* a2 = last ? nA : cA + (size_t)(t + 2) * kstep; const char* b2 = last ? nB : cB + (size_t)(t + 2) * kstep;
            const char* a3 = a2 + kstep; const char* b3 = b2 + kstep;
            if (last && has_next) S.a_ready(nxt);
            if constexpr (SP2) {
            PG8_LDB(B0, 0, 0); PG8_LDB(B1, 0, 1); PG8_SCHED; PG8_LDA(At, 0, 0); PG8_STAGE(PG8_SA(1, 1), a1 + hstep, voffA);
            PG8_WAIT_V(8); PG8_WAIT_L(0); PG8_BAR; PG8_MMA(0, 0, At, B0); PG8_MMA(0, 1, At, B1); PG8_BAR; PG8_SCHED;
            PG8_LDA(At, 0, 1); PG8_STAGE(PG8_SB(0, 0), b2, voffB); PG8_STAGE(PG8_SB(0, 1), b2 + hstep, voffB); PG8_STAGE(PG8_SA(0, 0), a2, voffA);
            PG8_WAIT_V(8); PG8_WAIT_L(0); PG8_BAR; PG8_MMA(1, 0, At, B0); PG8_MMA(1, 1, At, B1); PG8_BAR; PG8_SCHED;
            PG8_LDB(B0, 1, 0); PG8_LDB(B1, 1, 1); PG8_SCHED; PG8_LDA(At, 1, 0); PG8_STAGE(PG8_SA(0, 1), a2 + hstep, voffA);
            PG8_WAIT_V(8); PG8_WAIT_L(0); PG8_BAR; PG8_MMA(0, 0, At, B0); PG8_MMA(0, 1, At, B1); PG8_BAR; PG8_SCHED;
            PG8_LDA(At, 1, 1); PG8_STAGE(PG8_SB(1, 0), b3, voffB); PG8_STAGE(PG8_SB(1, 1), b3 + hstep, voffB); PG8_STAGE(PG8_SA(1, 0), a3, voffA);
            PG8_WAIT_V(8); PG8_WAIT_L(0); PG8_BAR; PG8_MMA(1, 0, At, B0); PG8_MMA(1, 1, At, B1); PG8_BAR; PG8_SCHED;
            } else {
            PG8_LDB(B0, 0, 0); PG8_SCHED; PG8_LDA(At, 0, 0); PG8_STAGE(PG8_SA(1, 1), a1 + hstep, voffA);
            PG8_WAIT_L(8); PG8_BAR; PG8_WAIT_L(0); PG8_MMA(0, 0, At, B0); PG8_BAR; PG8_SCHED;
            PG8_LDB(B1, 0, 1); PG8_STAGE(PG8_SB(0, 0), b2, voffB);
            PG8_BAR; PG8_WAIT_L(0); PG8_MMA(0, 1, At, B1); PG8_BAR;
            PG8_LDA(At, 0, 1); PG8_STAGE(PG8_SA(0, 0), a2, voffA);
            PG8_BAR; PG8_WAIT_L(0); PG8_MMA(1, 0, At, B0); PG8_BAR; PG8_SCHED;
            PG8_STAGE(PG8_SB(0, 1), b2 + hstep, voffB);
            PG8_WAIT_V(6); PG8_BAR; PG8_MMA(1, 1, At, B1); PG8_BAR;
            PG8_LDB(B0, 1, 0); PG8_SCHED; PG8_LDA(At, 1, 0); PG8_STAGE(PG8_SA(0, 1), a2 + hstep, voffA);
            PG8_WAIT_L(8); PG8_BAR; PG8_WAIT_L(0); PG8_MMA(0, 0, At, B0); PG8_BAR; PG8_SCHED;
            PG8_LDB(B1, 1, 1); PG8_STAGE(PG8_SB(1, 0), b3, voffB);
            PG8_BAR; PG8_WAIT_L(0); PG8_MMA(0, 1, At, B1); PG8_BAR;
            PG8_LDA(At, 1, 1); PG8_STAGE(PG8_SA(1, 0), a3, voffA);
            PG8_BAR; PG8_WAIT_L(0); PG8_MMA(1, 0, At, B0); PG8_BAR; PG8_SCHED;
            PG8_STAGE(PG8_SB(1, 1), b3 + hstep, voffB);
            PG8_WAIT_V(6); PG8_BAR; PG8_MMA(1, 1, At, B1); PG8_BAR;
            }
        }
        if constexpr (ALIGN_EPI) { if (wr == 0) PG8_BAR; }
        if constexpr (!Epi::AFTER_DRAIN) { E(acc, cur, wr, wc, fr, fq); S.done(cur); }
        if (!has_next) break;
#pragma unroll
        for (int a = 0; a < 2; ++a)
#pragma unroll
            for (int b = 0; b < 2; ++b)
#pragma unroll
                for (int m = 0; m < 4; ++m)
#pragma unroll
                    for (int n = 0; n < 2; ++n) acc[a][b][m][n] = (f32x4){0.f, 0.f, 0.f, 0.f};
        cur = nxt; cA = nA; cB = nB; ++ui;
        if constexpr (ALIGN_EPI) { if (wr == 1) PG8_BAR; }
    }
    PG8_WAIT_V(0);
    if constexpr (!ALIGN_EPI) { if (wr == 0) PG8_BAR; }
    PG8_BAR;
    if constexpr (Epi::AFTER_DRAIN) { E.fused(acc, cur, wr, wc, fr, fq, lds, wid, lane); S.done(cur); }
#undef PG8_SA
#undef PG8_SB
#undef PG8_STAGE
#undef PG8_LDA
#undef PG8_LDB
#undef PG8_MMA
#undef PG8_WAIT_V
#undef PG8_WAIT_L
#undef PG8_BAR
#undef PG8_SCHED
}
}

#define GAS __attribute__((address_space(1)))
#define LAS __attribute__((address_space(3)))
typedef unsigned short bf16;
typedef short bf16x8 __attribute__((ext_vector_type(8)));
typedef float f32x4 __attribute__((ext_vector_type(4)));
typedef float f32x16 __attribute__((ext_vector_type(16)));
typedef unsigned u32x4 __attribute__((ext_vector_type(4)));
typedef unsigned u32x2 __attribute__((ext_vector_type(2)));
typedef float f32x2_t __attribute__((ext_vector_type(2)));
typedef __bf16 bf16x2_t __attribute__((ext_vector_type(2)));
using pg8::Unit;

constexpr int NB = 16, SEQ = 2048, MTOK = NB * SEQ, DM = 1024, NPROJ = 2560, DEPTH = 2;
constexpr int NTT = MTOK / 256;
constexpr int ZROWS = MTOK + DEPTH * NPROJ;
constexpr float RMS_EPS = 1e-6f;
constexpr float LOG2E = 1.4426950408889634f;
constexpr float QSCALE = 0.125f * LOG2E;
constexpr int LDS_BYTES = 147456;
constexpr int LDS_MISC = 131072;
constexpr int LDS_CTL = LDS_BYTES - 512;

constexpr size_t MiB = 1u << 20;
constexpr size_t WS_CTL = 0, CTL_BYTES = 1 * MiB;
constexpr size_t WS_Z = 2 * MiB, WS_WOUT = 78 * MiB, WS_GLU = 82 * MiB, WS_TE = 83 * MiB, WS_G = 89 * MiB, WS_AT = 91 * MiB;
constexpr size_t WS_U = 92 * MiB, WS_SG = 108 * MiB, WS_AQ = 124 * MiB, WS_AK = 148 * MiB, WS_AG = 156 * MiB, WS_MQ = 180 * MiB, WS_MK = 204 * MiB, WS_MG = 212 * MiB;
constexpr size_t WS_VT = 236 * MiB, WS_KPART = 252 * MiB, WS_ROWSS = 253 * MiB, WS_YPRE = 254 * MiB, WS_Y = 270 * MiB, WS_END = 334 * MiB;
static_assert(WS_Z + (size_t)ZROWS * DM * 2 <= WS_WOUT, "Z fits");
constexpr size_t WS_NW = 1 * MiB;
constexpr int TE_ELEMS = 256 * 384, G_ELEMS = 128 * 256;
constexpr int CW_QUEUE = 1024;
constexpr int CW_SSMDONE = 8192;

__device__ __forceinline__ unsigned pk2(float lo, float hi) { f32x2_t v = {lo, hi}; bf16x2_t b = __builtin_convertvector(v, bf16x2_t); return __builtin_bit_cast(unsigned, b); }
__device__ __forceinline__ float bf2f(unsigned short x) { return __uint_as_float((unsigned)x << 16); }
__device__ __forceinline__ float bflo(unsigned w) { return __uint_as_float(w << 16); }
__device__ __forceinline__ float bfhi(unsigned w) { return __uint_as_float(w & 0xffff0000u); }
__device__ __forceinline__ float wave_sum(float v) {
#pragma unroll
    for (int o = 1; o < 64; o <<= 1) v += __shfl_xor(v, o);
    return v;
}
__device__ __forceinline__ float fast_rcp(float x) { return __builtin_amdgcn_rcpf(x); }
__device__ __forceinline__ float silu_f(float x) { return x * fast_rcp(1.f + __builtin_amdgcn_exp2f(-x * LOG2E)); }
__device__ __forceinline__ float sigmoid_f(float x) { return fast_rcp(1.f + __builtin_amdgcn_exp2f(-x * LOG2E)); }
__device__ __forceinline__ float gelu_tanh_f(float x) { const float z = 0.7978845608028654f * (x + 0.044715f * x * x * x); return x * fast_rcp(1.f + __builtin_amdgcn_exp2f(-2.f * LOG2E * z)); }
__device__ __forceinline__ float swap32_max(float m) { auto rr = __builtin_amdgcn_permlane32_swap(__float_as_uint(m), __float_as_uint(m), false, false); return fmaxf(__uint_as_float(rr[0]), __uint_as_float(rr[1])); }
__device__ __forceinline__ float swap32_sum(float m) { auto rr = __builtin_amdgcn_permlane32_swap(__float_as_uint(m), __float_as_uint(m), false, false); return __uint_as_float(rr[0]) + __uint_as_float(rr[1]); }
__device__ __forceinline__ void glds16(const void* gsrc, LAS unsigned char* ldst) {
    const unsigned dst = __builtin_amdgcn_readfirstlane((unsigned)(uintptr_t)ldst); unsigned keep;
    asm volatile("s_mov_b32 %0, m0\n\ts_mov_b32 m0, %2\n\ts_nop 0\n\tglobal_load_lds_dwordx4 %1, off\n\ts_mov_b32 m0, %0" : "=&s"(keep) : "v"(gsrc), "s"(dst) : "memory");
}
#define GLDS_WAIT() asm volatile("s_waitcnt vmcnt(0)" ::: "memory")

struct Params {
    const float* in[19]; float* out; unsigned char* ws;
};
typedef const float* const __attribute__((address_space(4))) * kargs_t;
__device__ __forceinline__ const float* kin(int i) { kargs_t ka = (kargs_t)__builtin_amdgcn_kernarg_segment_ptr(); asm volatile("" : "+s"(ka)); return ka[i]; }
struct Frame {
    LAS unsigned char* lds; int tid, lane, wave, G, bid; float* out; unsigned char* ws; unsigned* ctl;
};

__device__ __forceinline__ int proj_dest_row(int n0) {
    int slot, off;
    if (n0 < 512)       { slot = n0 >> 6; off = n0 & 63; }
    else if (n0 < 1024) { slot = 8 + ((n0 - 512) >> 6); off = n0 & 63; }
    else if (n0 < 1152) { return 2304 + (n0 - 1024); }
    else if (n0 < 1536) { slot = 16 + ((n0 - 1152) >> 6); off = (n0 - 1152) & 63; }
    else if (n0 < 1920) { slot = 22 + ((n0 - 1536) >> 6); off = (n0 - 1536) & 63; }
    else if (n0 < 2048) { slot = 28 + ((n0 - 1920) >> 6); off = (n0 - 1920) & 63; }
    else if (n0 < 2176) { return 2304 + 128 + (n0 - 2048); }
    else                { slot = 30 + ((n0 - 2176) >> 6); off = (n0 - 2176) & 63; }
    const int t = slot >> 2, wc = slot & 3;
    return 256 * t + 128 * (off >> 5) + 32 * wc;
}
__device__ __forceinline__ void p0_transpose_item(const float* W, int K, int N, const float* gk, bf16* WT, int ldk, int drow0, LAS float* scr, int k0, int n0, int lane) {
#pragma unroll 8
    for (int i = 0; i < 32; ++i) { const int kk = 2 * i + (lane >> 5); float v = W[(size_t)(k0 + kk) * N + n0 + (lane & 31)]; if (gk) v *= gk[k0 + kk]; scr[kk * 33 + (lane & 31)] = v; }
    asm volatile("s_waitcnt lgkmcnt(0)" ::: "memory");
    const int c = lane & 7;
#pragma unroll
    for (int j = 0; j < 4; ++j) { const int n = (lane >> 3) + 8 * j; const LAS float* s = scr + (8 * c) * 33 + n;
        u32x4 o; o.x = pk2(s[0 * 33], s[1 * 33]); o.y = pk2(s[2 * 33], s[3 * 33]); o.z = pk2(s[4 * 33], s[5 * 33]); o.w = pk2(s[6 * 33], s[7 * 33]);
        *(u32x4*)(WT + (size_t)(drow0 + n) * ldk + k0 + 8 * c) = o; }
    asm volatile("s_waitcnt lgkmcnt(0)" ::: "memory");
}
__device__ __forceinline__ void p0_ssm_consts(const Params& P, Frame& F, int pair) {
    const int l = pair >> 4, g = pair & 15, tid = F.tid;
    LAS float* pwr = (LAS float*)(F.lds);
    LAS float* pwi = pwr + 17 * 64;
    LAS float* bbr = pwi + 17 * 64;
    LAS float* bbi = bbr + 1024;
    LAS float* ccr = bbi + 1024;
    LAS float* cci = ccr + 1024;
    LAS float* Kt = cci + 1024;
    const float dt = expf(kin(5)[l * 16 + g]);
    const float* lre = kin(3) + (l * 16 + g) * 64; const float* lim = kin(4) + (l * 16 + g) * 64;
    for (int t = tid; t < 17 * 64; t += 512) { const int p = t & 63, lag = t >> 6; const float lr = lre[p], li = lim[p];
        const float mag = expf(lr * dt * (float)lag); float sn, cs; sincosf(li * dt * (float)lag, &sn, &cs); pwr[t] = mag * cs; pwi[t] = mag * sn; }
    for (int t = tid; t < 1024; t += 512) { const int p = t >> 4, h = t & 15; const float lr = lre[p], li = lim[p];
        const float mag = expf(lr * dt); float sn, cs; sincosf(li * dt, &sn, &cs); const float ar = mag * cs, ai = mag * sn;
        const float den = lr * lr + li * li, nr = ar - 1.f, ni = ai; const float cr = (nr * lr + ni * li) / den, ci = (ni * lr - nr * li) / den;
        const float br = kin(6)[((size_t)(l * 16 + g) * 64 + p) * 16 + h], bi = kin(7)[((size_t)(l * 16 + g) * 64 + p) * 16 + h];
        bbr[t] = cr * br - ci * bi; bbi[t] = cr * bi + ci * br; }
    for (int t = tid; t < 1024; t += 512) { ccr[t] = kin(8)[(size_t)(l * 16 + g) * 1024 + t]; cci[t] = kin(9)[(size_t)(l * 16 + g) * 1024 + t]; }
    __syncthreads();
    for (int t = tid; t < 4096; t += 512) { const int lag = t >> 8, hp = (t >> 4) & 15, h = t & 15; float s = 0.f;
        for (int p = 0; p < 64; ++p) { const float cr = ccr[hp * 64 + p], ci = cci[hp * 64 + p], pr = pwr[lag * 64 + p], pi = pwi[lag * 64 + p];
            const float xr = cr * pr - ci * pi, xi = cr * pi + ci * pr; s += xr * bbr[p * 16 + h] - xi * bbi[p * 16 + h]; }
        if (lag == 0 && hp == h) s += kin(10)[l * 256 + g * 16 + h];
        Kt[t] = s; }
    __syncthreads();
    bf16* TE = ((bf16*)(F.ws + WS_TE)) + (size_t)pair * TE_ELEMS; bf16* GM = ((bf16*)(F.ws + WS_G)) + (size_t)pair * G_ELEMS;
    for (int t = tid; t < 256 * 192; t += 512) { const int n = t / 192, kp = t % 192, k = 2 * kp; const int i = n >> 4, hp = n & 15; float v0, v1;
        if (k < 256) { const int j = k >> 4, h = k & 15; if (j <= i) { v0 = Kt[((i - j) * 16 + hp) * 16 + h]; v1 = Kt[((i - j) * 16 + hp) * 16 + h + 1]; } else { v0 = 0.f; v1 = 0.f; } }
        else { const int p = (k - 256) >> 1; const float cr = ccr[hp * 64 + p], ci = cci[hp * 64 + p], pr = pwr[(i + 1) * 64 + p], pi = pwi[(i + 1) * 64 + p];
            v0 = cr * pr - ci * pi; v1 = -(cr * pi + ci * pr); }
        *(unsigned*)(TE + (size_t)n * 384 + k) = pk2(v0, v1); }
    for (int t = tid; t < 128 * 128; t += 512) { const int n = t >> 7, kp = t & 127, k = 2 * kp; const int p = n >> 1, ri = n & 1, j = k >> 4, h = k & 15;
        const float pr = pwr[(15 - j) * 64 + p], pi = pwi[(15 - j) * 64 + p];
        float v0, v1;
        { const float br = bbr[p * 16 + h], bi = bbi[p * 16 + h]; v0 = ri ? (pr * bi + pi * br) : (pr * br - pi * bi); }
        { const float br = bbr[p * 16 + h + 1], bi = bbi[p * 16 + h + 1]; v1 = ri ? (pr * bi + pi * br) : (pr * br - pi * bi); }
        *(unsigned*)(GM + (size_t)n * 256 + k) = pk2(v0, v1); }
    if (tid < 64) { ((float*)(F.ws + WS_AT))[(size_t)pair * 128 + 2 * tid] = pwr[16 * 64 + tid]; ((float*)(F.ws + WS_AT))[(size_t)pair * 128 + 2 * tid + 1] = pwi[16 * 64 + tid]; }
    __syncthreads();
}
__device__ __forceinline__ void p0_prologue(const Params& P, Frame& F) {
    const bool split = F.G > 64;
    if (!split || F.bid < 32) { for (int pair = F.bid; pair < 32; pair += (split ? 32 : F.G)) p0_ssm_consts(P, F, pair); if (split) return; }
    const int vb = split ? F.bid - 32 : F.bid, nvb = split ? F.G - 32 : F.G;
    if (vb == 0) { float* nwp = (float*)(F.ws + WS_NW);
        for (int t = F.tid; t < DEPTH * 256; t += 512) { const int l = t >> 8, k = (t >> 6) & 3, d = t & 63;
            nwp[t] = (k == 0) ? kin(13)[l * 64 + d] * QSCALE : (k == 1) ? kin(14)[l * 64 + d] : (k == 2) ? kin(16)[l * 64 + d] * QSCALE : kin(17)[l * 64 + d]; } }
    const int gw = vb * 8 + F.wave, NGW = nvb * 8;
    LAS float* scr = (LAS float*)(F.lds + F.wave * 16384);
    constexpr int I_IN = 16 * 80, I_OUT = 16 * 32, I_GLU = 4 * 8, I_L = I_IN + I_OUT + I_GLU;
    for (int it = gw; it < DEPTH * I_L; it += NGW) {
        const int l = it / I_L; int r = it % I_L;
        if (r < I_IN) { const int kb = r / 80, nb = r % 80; p0_transpose_item(kin(2) + (size_t)l * DM * NPROJ, DM, NPROJ, kin(1) + l * DM, ((bf16*)(F.ws + WS_Z)) + (size_t)(MTOK + l * NPROJ) * DM, DM, proj_dest_row(32 * nb), scr, 64 * kb, 32 * nb, F.lane); continue; }
        r -= I_IN;
        if (r < I_OUT) { const int kb = r / 32, nb = r % 32; p0_transpose_item(kin(18) + (size_t)l * DM * DM, DM, DM, nullptr, ((bf16*)(F.ws + WS_WOUT)) + (size_t)l * DM * DM, DM, 32 * nb, scr, 64 * kb, 32 * nb, F.lane); continue; }
        r -= I_OUT;
        { const int kb = r / 8, nb = r % 8; p0_transpose_item(kin(11) + (size_t)l * 65536, 256, 256, nullptr, ((bf16*)(F.ws + WS_GLU)) + (size_t)l * 65536, 256, 32 * nb, scr, 64 * kb, 32 * nb, F.lane); }
    }
    for (int m = gw; m < MTOK; m += NGW) {
        const f32x4* xr = (const f32x4*)(kin(0) + (size_t)m * DM) + F.lane; f32x4 v[4]; float s = 0.f;
#pragma unroll
        for (int j = 0; j < 4; ++j) { v[j] = xr[64 * j]; s += (v[j].x * v[j].x + v[j].y * v[j].y) + (v[j].z * v[j].z + v[j].w * v[j].w); }
        s = wave_sum(s);
        u32x2* o8 = (u32x2*)(((bf16*)(F.ws + WS_Z)) + (size_t)m * DM) + F.lane;
#pragma unroll
        for (int j = 0; j < 4; ++j) { u32x2 w; w.x = pk2(v[j].x, v[j].y); w.y = pk2(v[j].z, v[j].w); o8[64 * j] = w; }
        if (F.lane < 4) ((float*)(F.ws + WS_ROWSS))[(size_t)m * 4 + F.lane] = (F.lane == 0) ? s : 0.f;
    }
}

__device__ __forceinline__ Frame phase_frame(const Frame& F0) {
    Frame F = F0; asm volatile("" : "+v"(F.tid)); F.lane = F.tid & 63; F.wave = __builtin_amdgcn_readfirstlane(F.tid >> 6);
    asm volatile("" : "+s"(F.ws)); F.ctl = (unsigned*)(F.ws + WS_CTL); return F;
}
struct SchedTab { const volatile LAS int* tab; int n;
    __device__ __forceinline__ bool next(int i, Unit& u) const { if (i >= n) return false; u.pm = __builtin_amdgcn_readfirstlane(tab[2 * i]); u.pn = __builtin_amdgcn_readfirstlane(tab[2 * i + 1]); return true; }
    __device__ __forceinline__ void a_ready(const Unit&) const {}
    __device__ __forceinline__ void done(const Unit&) const {}
};
__device__ __forceinline__ bool unit_p1(int G, int c, int wbase, int i, int& pm, int& pn) {
    int tok, j;
    if (G == 256) { if (i >= 5) return false; const int x = c & 7, l = c >> 3, n = i * 32 + l, tq = n / 40, rem = n % 40; j = rem >> 2; tok = 16 * x + 4 * tq + (rem & 3); }
    else { const long L = (long)i * G + c; if (L >= NTT * 10) return false; tok = (int)(L / 10); j = (int)(L % 10); }
    if (j < 9) { pm = tok; pn = wbase + j; } else { pm = wbase + 9; pn = tok; }
    return true;
}
__device__ __forceinline__ bool unit_p3(int G, int c, int i, int& pm, int& pn) {
    if (G == 256) { if (i >= 2) return false; const int x = c & 7, l = c >> 3, n = i * 32 + l, tq = n >> 4, rem = n & 15; pn = rem >> 2; pm = 16 * x + 4 * tq + (rem & 3); }
    else { const long L = (long)i * G + c; if (L >= NTT * 4) return false; pm = (int)(L / 4); pn = (int)(L % 4); }
    return true;
}
__device__ __forceinline__ bool unit_glu(int G, int c, int i, int& pm, int& pn) {
    if (G == 256) { if (i >= 1 || (c >> 3) >= 16) return false; pm = 16 * (c & 7) + (c >> 3); pn = 0; }
    else { const long L = (long)i * G + c; if (L >= NTT) return false; pm = (int)L; pn = 0; }
    return true;
}
template <int KIND>
__device__ __forceinline__ SchedTab make_sched(const Frame& F, int wbase) {
    volatile LAS int* tab = (volatile LAS int*)(F.lds + LDS_CTL + 64);
    volatile LAS int* cnt = (volatile LAS int*)(F.lds + LDS_CTL + 32);
    if (F.tid == 0) { int n = 0;
#pragma unroll 1
        for (int i = 0; i < 24; ++i) { int pm, pn; const bool ok = (KIND == 0) ? unit_p1(F.G, F.bid, wbase, i, pm, pn) : (KIND == 1) ? unit_p3(F.G, F.bid, i, pm, pn) : unit_glu(F.G, F.bid, i, pm, pn);
            if (!ok) break; tab[2 * i] = pm; tab[2 * i + 1] = pn; n = i + 1; }
        cnt[0] = n; }
    __syncthreads();
    SchedTab S; S.tab = tab; S.n = __builtin_amdgcn_readfirstlane(cnt[0]); return S;
}

struct EpiProj {
    static constexpr bool PERM = true, AFTER_DRAIN = false;
    int wbase, layer; unsigned char* ws;
    __device__ __forceinline__ void operator()(const f32x4 (&acc)[2][2][4][2], const Unit& u, int wr, int wc, int fr, int fq) const {
        const float* rowss = (const float*)(ws + WS_ROWSS);
        if (u.pm >= NTT) {
            bf16* VT = (bf16*)(ws + WS_VT);
            const int tc = u.pn * 256 + wc * 32 + 8 * fq;
            float rs[2][8];
#pragma unroll
            for (int bj = 0; bj < 2; ++bj)
#pragma unroll
                for (int e = 0; e < 8; ++e) { const f32x4 p = *(const f32x4*)(rowss + (size_t)(tc + bj * 128 + e) * 4); rs[bj][e] = rsqrtf(((p.x + p.y) + (p.z + p.w)) * (1.f / DM) + RMS_EPS); }
#pragma unroll
            for (int ai = 0; ai < 2; ++ai)
#pragma unroll
                for (int m = 0; m < 4; ++m) { const int f = ai * 128 + wr * 64 + m * 16 + fr;
#pragma unroll
                    for (int bj = 0; bj < 2; ++bj) { const f32x4 a = acc[ai][bj][m][0], b = acc[ai][bj][m][1]; u32x4 w;
                        w.x = pk2(a[0] * rs[bj][0], a[1] * rs[bj][1]); w.y = pk2(a[2] * rs[bj][2], a[3] * rs[bj][3]); w.z = pk2(b[0] * rs[bj][4], b[1] * rs[bj][5]); w.w = pk2(b[2] * rs[bj][6], b[3] * rs[bj][7]);
                        *(u32x4*)(VT + (size_t)f * MTOK + tc + bj * 128) = w; } }
            return;
        }
        const int t = u.pn - wbase;
        int kind, pitch, col, nwi = 0; size_t dsto;
        switch (t) {
            case 0: kind = 0; dsto = WS_U; pitch = 256; col = 64 * wc; break;
            case 1: kind = 1; dsto = WS_SG; pitch = 256; col = 64 * wc; break;
            case 2: kind = 2; dsto = WS_AQ; pitch = 384; col = 64 * wc; nwi = 0; break;
            case 3: if (wc < 2) { kind = 2; dsto = WS_AQ; pitch = 384; col = 64 * (4 + wc); nwi = 0; } else { kind = 2; dsto = WS_AK; pitch = 128; col = 64 * (wc - 2); nwi = 1; } break;
            case 4: kind = 1; dsto = WS_AG; pitch = 384; col = 64 * wc; break;
            case 5: if (wc < 2) { kind = 1; dsto = WS_AG; pitch = 384; col = 64 * (4 + wc); } else { kind = 2; dsto = WS_MQ; pitch = 384; col = 64 * (wc - 2); nwi = 2; } break;
            case 6: kind = 2; dsto = WS_MQ; pitch = 384; col = 64 * (2 + wc); nwi = 2; break;
            case 7: if (wc < 2) { kind = 5; dsto = WS_MK; pitch = 128; col = 64 * wc; nwi = 3; } else { kind = 1; dsto = WS_MG; pitch = 384; col = 64 * (wc - 2); } break;
            default: kind = 1; dsto = WS_MG; pitch = 384; col = 64 * (2 + wc); break;
        }
        bf16* dst = (bf16*)(ws + dsto) + col + 8 * fq; const float* nw = (const float*)(ws + WS_NW) + (layer * 4 + nwi) * 64 + 8 * fq;
        const int row0 = u.pm * 256 + wr * 64 + fr;
        if (kind == 0) rows<0>(acc, row0, dst, pitch, nw, rowss, nullptr);
        else if (kind == 1) rows<1>(acc, row0, dst, pitch, nw, rowss, nullptr);
        else if (kind == 2) rows<2>(acc, row0, dst, pitch, nw, rowss, nullptr);
        else rows<5>(acc, row0, dst, pitch, nw, rowss, (fr == 0) ? (float*)(ws + WS_KPART) + ((size_t)(u.pm * 2 + wr) * 2 + wc) * 64 + 8 * fq : nullptr);
    }
    template <int KIND>
    __device__ __forceinline__ void rows(const f32x4 (&acc)[2][2][4][2], int row0, bf16* dst, int pitch, const float* nw, const float* rowss, float* kp) const {
        f32x4 wv[2][2], ks[2][2];
        if (KIND >= 2) {
#pragma unroll
            for (int bj = 0; bj < 2; ++bj)
#pragma unroll
                for (int n = 0; n < 2; ++n) { wv[bj][n] = *(const f32x4*)(nw + 32 * bj + 4 * n); ks[bj][n] = (f32x4){0.f, 0.f, 0.f, 0.f}; }
        }
#pragma unroll
        for (int ai = 0; ai < 2; ++ai)
#pragma unroll
            for (int m = 0; m < 4; ++m) {
                const int row = row0 + ai * 128 + m * 16;
                const f32x4 p = *(const f32x4*)(rowss + (size_t)row * 4);
                const float rs = rsqrtf(((p.x + p.y) + (p.z + p.w)) * (1.f / DM) + RMS_EPS);
                f32x4 v[2][2];
#pragma unroll
                for (int bj = 0; bj < 2; ++bj)
#pragma unroll
                    for (int n = 0; n < 2; ++n) v[bj][n] = acc[ai][bj][m][n] * rs;
                if (KIND >= 2) {
                    float ss = 0.f;
#pragma unroll
                    for (int bj = 0; bj < 2; ++bj)
#pragma unroll
                        for (int n = 0; n < 2; ++n) { const f32x4 q = v[bj][n]; ss += (q[0] * q[0] + q[1] * q[1]) + (q[2] * q[2] + q[3] * q[3]); }
                    ss += __shfl_xor(ss, 16); ss += __shfl_xor(ss, 32);
                    const float hn = rsqrtf(ss * (1.f / 64.f) + RMS_EPS);
#pragma unroll
                    for (int bj = 0; bj < 2; ++bj)
#pragma unroll
                        for (int n = 0; n < 2; ++n) { v[bj][n] = v[bj][n] * wv[bj][n] * hn; if (KIND == 5) ks[bj][n] += v[bj][n]; }
                } else if (KIND == 1) {
#pragma unroll
                    for (int bj = 0; bj < 2; ++bj)
#pragma unroll
                        for (int n = 0; n < 2; ++n)
#pragma unroll
                            for (int e = 0; e < 4; ++e) v[bj][n][e] = silu_f(v[bj][n][e]);
                }
                bf16* rp = dst + (size_t)row * pitch;
#pragma unroll
                for (int bj = 0; bj < 2; ++bj) { u32x4 w; w.x = pk2(v[bj][0][0], v[bj][0][1]); w.y = pk2(v[bj][0][2], v[bj][0][3]); w.z = pk2(v[bj][1][0], v[bj][1][1]); w.w = pk2(v[bj][1][2], v[bj][1][3]);
                    *(u32x4*)(rp + 32 * bj) = w; }
                if (m & 1) asm volatile("" ::: "memory");
            }
        if (KIND == 5) {
#pragma unroll
            for (int bj = 0; bj < 2; ++bj)
#pragma unroll
                for (int n = 0; n < 2; ++n)
#pragma unroll
                    for (int e = 0; e < 4; ++e) { float s = ks[bj][n][e]; s += __shfl_xor(s, 1); s += __shfl_xor(s, 2); s += __shfl_xor(s, 4); s += __shfl_xor(s, 8); ks[bj][n][e] = s; }
            if (kp) {
#pragma unroll
                for (int bj = 0; bj < 2; ++bj)
#pragma unroll
                    for (int n = 0; n < 2; ++n) *(f32x4*)(kp + 32 * bj + 4 * n) = ks[bj][n];
            }
        }
    }
};
struct EpiGlu {
    static constexpr bool PERM = true, AFTER_DRAIN = false;
    const bf16* YPRE; const bf16* SG; const float* gb; bf16* Y;
    __device__ __forceinline__ void operator()(const f32x4 (&acc)[2][2][4][2], const Unit& u, int wr, int wc, int fr, int fq) const {
#pragma unroll
        for (int bj = 0; bj < 2; ++bj) { const int c = wc * 32 + 8 * fq + 128 * bj;
            const f32x4 b0 = *(const f32x4*)(gb + c), b1 = *(const f32x4*)(gb + c + 4);
#pragma unroll
            for (int ai = 0; ai < 2; ++ai)
#pragma unroll
                for (int m = 0; m < 4; ++m) { const int row = u.pm * 256 + ai * 128 + wr * 64 + m * 16 + fr;
                    const u32x4 yp = *(const u32x4*)(YPRE + (size_t)row * 256 + c), sg = *(const u32x4*)(SG + (size_t)row * 256 + c);
                    const f32x4 z0 = acc[ai][bj][m][0] + b0, z1 = acc[ai][bj][m][1] + b1;
                    u32x4 w;
                    w.x = pk2(bflo(yp.x) * sigmoid_f(z0[0]) * bflo(sg.x), bfhi(yp.x) * sigmoid_f(z0[1]) * bfhi(sg.x));
                    w.y = pk2(bflo(yp.y) * sigmoid_f(z0[2]) * bflo(sg.y), bfhi(yp.y) * sigmoid_f(z0[3]) * bfhi(sg.y));
                    w.z = pk2(bflo(yp.z) * sigmoid_f(z1[0]) * bflo(sg.z), bfhi(yp.z) * sigmoid_f(z1[1]) * bfhi(sg.z));
                    w.w = pk2(bflo(yp.w) * sigmoid_f(z1[2]) * bflo(sg.w), bfhi(yp.w) * sigmoid_f(z1[3]) * bfhi(sg.w));
                    *(u32x4*)(Y + (size_t)row * DM + c) = w;
                    if (m & 1) asm volatile("" ::: "memory"); } }
    }
};
struct EpiOut {
    static constexpr bool PERM = false, AFTER_DRAIN = false;
    const float* resid_f; float* out; bf16* xb; float* rowss; int write_next; LAS float* xch; int probe_skip;
    __device__ __forceinline__ void operator()(const f32x4 (&acc)[2][2][4][2], const Unit& u, int wr, int wc, int fr, int fq) const {
        const int c0 = u.pn * 256 + wc * 32 + 4 * fq;
        if (probe_skip) { asm volatile("" :: "v"(acc[0][0][0][0]), "v"(acc[1][1][3][1])); asm volatile("s_waitcnt lgkmcnt(0)" ::: "memory"); __builtin_amdgcn_s_barrier(); return; }
#pragma unroll
        for (int ai = 0; ai < 2; ++ai)
#pragma unroll
            for (int m = 0; m < 4; ++m) { const int rt = ai * 128 + wr * 64 + m * 16 + fr; const size_t off = (size_t)(u.pm * 256 + rt) * DM + c0; float ss = 0.f;
#pragma unroll
                for (int bj = 0; bj < 2; ++bj)
#pragma unroll
                    for (int n = 0; n < 2; ++n) { const size_t o2 = off + bj * 128 + n * 16; const f32x4 a4 = acc[ai][bj][m][n]; f32x4 o;
                        if (write_next) o = *(const f32x4*)(resid_f + o2) + a4;
                        else { const u32x2 rb = *(const u32x2*)(xb + o2); o[0] = bflo(rb.x) + a4[0]; o[1] = bfhi(rb.x) + a4[1]; o[2] = bflo(rb.y) + a4[2]; o[3] = bfhi(rb.y) + a4[3]; }
                        if (write_next) { u32x2 w; w.x = pk2(o[0], o[1]); w.y = pk2(o[2], o[3]); *(u32x2*)(xb + o2) = w; ss += (o[0] * o[0] + o[1] * o[1]) + (o[2] * o[2] + o[3] * o[3]); }
                        else __builtin_nontemporal_store(o, (f32x4*)(out + o2)); }
                if (write_next) { ss += __shfl_xor(ss, 16); ss += __shfl_xor(ss, 32); if (fq == 0) xch[rt * 4 + wc] = ss; }
            }
        asm volatile("s_waitcnt lgkmcnt(0)" ::: "memory"); __builtin_amdgcn_s_barrier(); asm volatile("" ::: "memory");
        if (write_next && threadIdx.x < 256) { const f32x4 p = *(const LAS f32x4*)(xch + threadIdx.x * 4); rowss[(size_t)(u.pm * 256 + threadIdx.x) * 4 + u.pn] = (p.x + p.y) + (p.z + p.w); }
    }
};

__device__ __forceinline__ int pi32(int r) { return (r & ~12) | ((r & 8) >> 1) | ((r & 4) << 1); }
template <int MODE>
__device__ __forceinline__ void attn_tile(const bf16x8 (&kf)[4], const bf16x8 (&vf)[2][2], const bf16x8 (&qf)[4], const f32x16& cv, float& l, f32x16 (&O)[2], int a, int h) {
    f32x16 S = __builtin_amdgcn_mfma_f32_32x32x16_bf16(kf[0], qf[0], cv, 0, 0, 0);
#pragma unroll
    for (int ks = 1; ks < 4; ++ks) S = __builtin_amdgcn_mfma_f32_32x32x16_bf16(kf[ks], qf[ks], S, 0, 0, 0);
    if (MODE != 0) {
#pragma unroll
        for (int i = 0; i < 16; ++i) { const int c = pi32((i & 3) + 8 * (i >> 2) + 4 * h); const bool dead = (MODE == 1) ? (c > a) : (c <= a); if (dead) S[i] = -1e30f; }
    }
    float s0 = 0.f, s1 = 0.f;
#pragma unroll
    for (int i = 0; i < 16; i += 2) { S[i] = __builtin_amdgcn_exp2f(S[i]); S[i + 1] = __builtin_amdgcn_exp2f(S[i + 1]); s0 += S[i]; s1 += S[i + 1]; }
    l += s0 + s1;
    bf16x8 pb[2];
#pragma unroll
    for (int s = 0; s < 2; ++s) { u32x4 w; w.x = pk2(S[8 * s], S[8 * s + 1]); w.y = pk2(S[8 * s + 2], S[8 * s + 3]); w.z = pk2(S[8 * s + 4], S[8 * s + 5]); w.w = pk2(S[8 * s + 6], S[8 * s + 7]); pb[s] = __builtin_bit_cast(bf16x8, w); }
#pragma unroll
    for (int dt = 0; dt < 2; ++dt)
#pragma unroll
        for (int s = 0; s < 2; ++s) O[dt] = __builtin_amdgcn_mfma_f32_32x32x16_bf16(vf[dt][s], pb[s], O[dt], 0, 0, 0);
}
template <int NK>
__device__ __forceinline__ void stage_kv(LAS unsigned char* Kimg, LAS unsigned char* Vimg, const bf16* Ksrc  , const bf16* Vsrc  ,
                                         long key_lo  , long key_min  , int wave, int lane) {
    constexpr int KP = NK * 128 / 1024, VCH = NK / 8, VP = 64 * VCH * 16 / 1024;
    for (int p = wave; p < KP; p += 8) { const int L = p * 64 + lane, r = L >> 3, s = L & 7, c = s ^ ((r >> 1) & 7); long kr = key_lo + r; if (kr < key_min) kr = key_min;
        glds16(Ksrc + (kr - key_lo) * 128 + c * 8, Kimg + p * 1024); }
    for (int p = wave; p < VP; p += 8) { const int L = p * 64 + lane, d = L / VCH, s = L % VCH, c = s ^ (d & 15); long kc = key_lo + 8 * c; if (kc < key_min) kc = key_min;
        glds16(Vsrc + (size_t)d * MTOK + (kc - key_lo), Vimg + p * 1024); }
}
template <int NK>
__device__ __forceinline__ void load_kv_frags(bf16x8 (&kf)[4], bf16x8 (&vf)[2][2], const LAS unsigned char* Kimg, const LAS unsigned char* Vimg, int row0  , int lane) {
    const int r = row0 + pi32(lane & 31), h = lane >> 5;
#pragma unroll
    for (int ks = 0; ks < 4; ++ks) kf[ks] = *(const LAS bf16x8*)(Kimg + r * 128 + (((2 * ks + h) ^ ((r >> 1) & 7)) << 4));
#pragma unroll
    for (int dt = 0; dt < 2; ++dt) { const int d = 32 * dt + (lane & 31);
#pragma unroll
        for (int s = 0; s < 2; ++s) { const int c = (row0 >> 3) + 2 * s + h; vf[dt][s] = *(const LAS bf16x8*)(Vimg + d * (NK * 2) + ((c ^ (d & 15)) << 4)); } }
}
template <int NK>
__device__ __forceinline__ void load_k_frags(bf16x8 (&kf)[4], const LAS unsigned char* Kimg, int row0, int lane) {
    const int r = row0 + pi32(lane & 31), h = lane >> 5;
#pragma unroll
    for (int ks = 0; ks < 4; ++ks) kf[ks] = *(const LAS bf16x8*)(Kimg + r * 128 + (((2 * ks + h) ^ ((r >> 1) & 7)) << 4));
}
template <int NK>
__device__ __forceinline__ void load_v_frags(bf16x8 (&vf)[2][2], const LAS unsigned char* Vimg, int row0, int lane) {
    const int h = lane >> 5;
#pragma unroll
    for (int dt = 0; dt < 2; ++dt) { const int d = 32 * dt + (lane & 31);
#pragma unroll
        for (int s = 0; s < 2; ++s) { const int c = (row0 >> 3) + 2 * s + h; vf[dt][s] = *(const LAS bf16x8*)(Vimg + d * (NK * 2) + ((c ^ (d & 15)) << 4)); } }
}
__device__ __forceinline__ f32x16 qk_tile(const bf16x8 (&kf)[4], const bf16x8 (&qf)[4], const f32x16& cv) {
    f32x16 S = __builtin_amdgcn_mfma_f32_32x32x16_bf16(kf[0], qf[0], cv, 0, 0, 0);
#pragma unroll
    for (int ks = 1; ks < 4; ++ks) S = __builtin_amdgcn_mfma_f32_32x32x16_bf16(kf[ks], qf[ks], S, 0, 0, 0);
    return S;
}
template <int MODE>
__device__ __forceinline__ void softmax_pv(f32x16& S, const bf16x8 (&vf)[2][2], float& l, f32x16 (&O)[2], int a, int h) {
    if (MODE != 0) {
#pragma unroll
        for (int i = 0; i < 16; ++i) { const int c = pi32((i & 3) + 8 * (i >> 2) + 4 * h); const bool dead = (MODE == 1) ? (c > a) : (c <= a); if (dead) S[i] = -1e30f; }
    }
    float s0 = 0.f, s1 = 0.f;
#pragma unroll
    for (int i = 0; i < 16; i += 2) { S[i] = __builtin_amdgcn_exp2f(S[i]); S[i + 1] = __builtin_amdgcn_exp2f(S[i + 1]); s0 += S[i]; s1 += S[i + 1]; }
    l += s0 + s1;
    bf16x8 pb[2];
#pragma unroll
    for (int s = 0; s < 2; ++s) { u32x4 w; w.x = pk2(S[8 * s], S[8 * s + 1]); w.y = pk2(S[8 * s + 2], S[8 * s + 3]); w.z = pk2(S[8 * s + 4], S[8 * s + 5]); w.w = pk2(S[8 * s + 6], S[8 * s + 7]); pb[s] = __builtin_bit_cast(bf16x8, w); }
#pragma unroll
    for (int dt = 0; dt < 2; ++dt)
#pragma unroll
        for (int s = 0; s < 2; ++s) O[dt] = __builtin_amdgcn_mfma_f32_32x32x16_bf16(vf[dt][s], pb[s], O[dt], 0, 0, 0);
}
template <int NK, int N, int MFIRST, int MLAST>
__device__ __forceinline__ void attn_run(const LAS unsigned char* Kimg, const LAS unsigned char* Vimg, int row0, const bf16x8 (&qf)[4], const f32x16& cv, float& l, f32x16 (&O)[2], int lane) {
    const int a = lane & 31, h = lane >> 5;
    bf16x8 kf[4], vfa[2][2], vfb[2][2];
    load_k_frags<NK>(kf, Kimg, row0, lane); load_v_frags<NK>(vfa, Vimg, row0, lane);
    f32x16 S = qk_tile(kf, qf, cv);
#pragma unroll
    for (int t = 0; t < N; ++t) {
        f32x16 Sn;
        if (t + 1 < N) { load_k_frags<NK>(kf, Kimg, row0 + 32 * (t + 1), lane); if (t & 1) load_v_frags<NK>(vfa, Vimg, row0 + 32 * (t + 1), lane); else load_v_frags<NK>(vfb, Vimg, row0 + 32 * (t + 1), lane);
            Sn = qk_tile(kf, qf, cv); }
        if (t == 0 && MFIRST != 0) { if (t & 1) softmax_pv<MFIRST>(S, vfb, l, O, a, h); else softmax_pv<MFIRST>(S, vfa, l, O, a, h); }
        else if (t == N - 1 && MLAST != 0) { if (t & 1) softmax_pv<MLAST>(S, vfb, l, O, a, h); else softmax_pv<MLAST>(S, vfa, l, O, a, h); }
        else { if (t & 1) softmax_pv<0>(S, vfb, l, O, a, h); else softmax_pv<0>(S, vfa, l, O, a, h); }
        if (t + 1 < N) S = Sn;
    }
}
template <int NK, int PVAR>
__device__ __forceinline__ void attn_run8(const LAS unsigned char* Kimg, const LAS unsigned char* Vimg, const bf16x8 (&qf)[4], const f32x16& cv, float& l, f32x16 (&O)[2], int lane) {
    const int a = lane & 31, h = lane >> 5;
    bf16x8 kf[4], vfa[2][2], vfb[2][2];
    load_k_frags<NK>(kf, Kimg, 0, lane); load_v_frags<NK>(vfa, Vimg, 0, lane);
    if (PVAR == 4) load_v_frags<NK>(vfb, Vimg, 32, lane);
#define QKT() ((PVAR == 5) ? cv : qk_tile(kf, qf, cv))
#define SMPV(S_, vf_) do { if (PVAR == 3) { bf16x8 pb[2]; _Pragma("unroll") for (int s = 0; s < 2; ++s) { u32x4 w; w.x = pk2(S_[8 * s], S_[8 * s + 1]); w.y = pk2(S_[8 * s + 2], S_[8 * s + 3]); w.z = pk2(S_[8 * s + 4], S_[8 * s + 5]); w.w = pk2(S_[8 * s + 6], S_[8 * s + 7]); pb[s] = __builtin_bit_cast(bf16x8, w); } \
        _Pragma("unroll") for (int dt = 0; dt < 2; ++dt) _Pragma("unroll") for (int s = 0; s < 2; ++s) O[dt] = __builtin_amdgcn_mfma_f32_32x32x16_bf16(vf_[dt][s], pb[s], O[dt], 0, 0, 0); } \
      else if (PVAR == 6) { _Pragma("unroll") for (int i = 0; i < 16; ++i) { l += __builtin_amdgcn_exp2f(S_[i]); } asm volatile("" :: "v"(vf_[0][0]), "v"(vf_[1][1])); } \
      else softmax_pv<0>(S_, vf_, l, O, a, h); } while (0)
    f32x16 S = QKT();
#pragma unroll 1
    for (int j = 0; j < 3; ++j) {
        { if (PVAR != 4) { load_k_frags<NK>(kf, Kimg, 64 * j + 32, lane); load_v_frags<NK>(vfb, Vimg, 64 * j + 32, lane); } f32x16 Sn = QKT(); SMPV(S, vfa); S = Sn; }
        { if (PVAR != 4) { load_k_frags<NK>(kf, Kimg, 64 * j + 64, lane); load_v_frags<NK>(vfa, Vimg, 64 * j + 64, lane); } f32x16 Sn = QKT(); SMPV(S, vfb); S = Sn; }
    }
    { if (PVAR != 4) { load_k_frags<NK>(kf, Kimg, 224, lane); load_v_frags<NK>(vfb, Vimg, 224, lane); } f32x16 Sn = QKT(); SMPV(S, vfa); S = Sn; }
    SMPV(S, vfb);
#undef QKT
#undef SMPV
}
__device__ __forceinline__ void attn_store(const f32x16 (&O)[2], float l, const bf16* gate  , bf16* y  , int h) {
    const float inv = 1.f / swap32_sum(l);
#pragma unroll
    for (int dt = 0; dt < 2; ++dt)
#pragma unroll
        for (int q = 0; q < 4; ++q) { const int d = 32 * dt + 8 * q + 4 * h; const u32x2 gv = *(const u32x2*)(gate + d);
            u32x2 w; w.x = pk2(O[dt][4 * q] * inv * bflo(gv.x), O[dt][4 * q + 1] * inv * bfhi(gv.x)); w.y = pk2(O[dt][4 * q + 2] * inv * bflo(gv.y), O[dt][4 * q + 3] * inv * bfhi(gv.y));
            *(u32x2*)(y + d) = w; }
}

template <int VAR>
__device__ __forceinline__ void moba_unit(Frame& F, int b, int kvh, int qb, int g) {
    constexpr int IMG = 32768;
    LAS unsigned char* buf0 = F.lds; LAS unsigned char* buf1 = F.lds + 2 * IMG;
    LAS float* km = (LAS float*)(F.lds + LDS_MISC + 1024);
    const int lane = F.lane, wave = F.wave, a = lane & 31, h = lane >> 5;
    const long tok0 = (long)b * SEQ + 256 * qb;
    const bf16* Kb = ((bf16*)(F.ws + WS_MK)) + (size_t)b * SEQ * 128 + kvh * 64;
    const bf16* Vb = ((bf16*)(F.ws + WS_VT)) + (size_t)(128 + kvh * 64) * MTOK + (size_t)b * SEQ;
    if (VAR != 1) stage_kv<256>(buf0, buf0 + IMG, Kb + (size_t)(256 * qb) * 128, Vb + 256 * qb, 0, 0, wave, lane);
    { const int n = F.tid >> 6, d = F.tid & 63; float s = 0.f;
      if (n < qb) { const int tile = b * 8 + n; s = ((float*)(F.ws + WS_KPART))[((size_t)(tile * 2 + 0) * 2 + kvh) * 64 + d] + ((float*)(F.ws + WS_KPART))[((size_t)(tile * 2 + 1) * 2 + kvh) * 64 + d]; }
      km[n * 64 + d] = s; }
    const size_t row = (size_t)(tok0 + 32 * wave + a);
    const bf16* qp = ((bf16*)(F.ws + WS_MQ)) + row * 384 + kvh * 192 + 8 * h;
    GLDS_WAIT(); __syncthreads();
    unsigned selmask = (VAR == 8) ? 0x7fu : 0u;
    if (qb > 0 && VAR != 8) {
        float sc[8];
#pragma unroll
        for (int n = 0; n < 8; ++n) sc[n] = 0.f;
#pragma unroll
        for (int ks = 0; ks < 4; ++ks) { const bf16x8 q0 = *(const bf16x8*)(qp + 16 * ks), q1 = *(const bf16x8*)(qp + 64 + 16 * ks), q2 = *(const bf16x8*)(qp + 128 + 16 * ks);
#pragma unroll
            for (int j = 0; j < 8; ++j) { const float qs = bf2f((unsigned short)q0[j]) + bf2f((unsigned short)q1[j]) + bf2f((unsigned short)q2[j]); const int d = 16 * ks + 8 * h + j;
#pragma unroll
                for (int n = 0; n < 7; ++n) sc[n] += qs * km[n * 64 + d]; } }
#pragma unroll
        for (int n = 0; n < 7; ++n) { sc[n] = swap32_sum(sc[n]); if (n >= qb) sc[n] = -INFINITY; }
#pragma unroll
        for (int t = 0; t < 3; ++t) { float best = -INFINITY; int bi = -1;
#pragma unroll
            for (int n = 0; n < 7; ++n) if (sc[n] > best) { best = sc[n]; bi = n; }
            if (bi >= 0) { selmask |= 1u << bi;
#pragma unroll
                for (int n = 0; n < 7; ++n) if (n == bi) sc[n] = -INFINITY; } }
    }
    float l = 0.f; f32x16 O[2]; bf16x8 qf[4];
#pragma unroll
    for (int i = 0; i < 16; ++i) { O[0][i] = 0.f; O[1][i] = 0.f; }
#pragma unroll
    for (int ks = 0; ks < 4; ++ks) qf[ks] = *(const bf16x8*)(qp + g * 64 + 16 * ks);
    asm volatile("" : "+v"(qf[0]), "+v"(qf[1]), "+v"(qf[2]), "+v"(qf[3]));
#pragma unroll 1
    for (int s = 0; s <= qb; ++s) {
        LAS unsigned char* cur = (s & 1) ? buf1 : buf0; LAS unsigned char* nxt = (s & 1) ? buf0 : buf1;
        if (s < qb && VAR != 1) stage_kv<256>(nxt, nxt + IMG, Kb + (size_t)(256 * s) * 128, Vb + 256 * s, 0, 0, wave, lane);
        if (VAR == 2) {} else if (s == 0) { if (VAR != 7) {
            f32x16 cv;
#pragma unroll
            for (int i = 0; i < 16; ++i) cv[i] = 0.f;
            int kt = 0;
#pragma unroll 1
            for (; kt + 1 < wave; kt += 2) { bf16x8 kfa[4], vfa[2][2], kfb[4], vfb[2][2]; load_kv_frags<256>(kfa, vfa, cur, cur + IMG, 32 * kt, lane); load_kv_frags<256>(kfb, vfb, cur, cur + IMG, 32 * kt + 32, lane);
                attn_tile<0>(kfa, vfa, qf, cv, l, O, a, h); attn_tile<0>(kfb, vfb, qf, cv, l, O, a, h); }
            if (kt < wave) { bf16x8 kfa[4], vfa[2][2], kfb[4], vfb[2][2]; load_kv_frags<256>(kfa, vfa, cur, cur + IMG, 32 * kt, lane); load_kv_frags<256>(kfb, vfb, cur, cur + IMG, 32 * kt + 32, lane);
                attn_tile<0>(kfa, vfa, qf, cv, l, O, a, h); attn_tile<1>(kfb, vfb, qf, cv, l, O, a, h); }
            else { bf16x8 kfa[4], vfa[2][2]; load_kv_frags<256>(kfa, vfa, cur, cur + IMG, 32 * kt, lane); attn_tile<1>(kfa, vfa, qf, cv, l, O, a, h); }
        } } else if (VAR != 9) {
            const float cinit = ((selmask >> (s - 1)) & 1u) ? 0.f : -1e30f;
            if (__any(cinit == 0.f)) {
                f32x16 cv;
#pragma unroll
                for (int i = 0; i < 16; ++i) cv[i] = cinit;
                attn_run8<256, (VAR >= 3 ? VAR : 0)>(cur, cur + IMG, qf, cv, l, O, lane);
            }
        }
        GLDS_WAIT(); __syncthreads();
    }
    attn_store(O, l, ((bf16*)(F.ws + WS_MG)) + row * 384 + (kvh * 3 + g) * 64, ((bf16*)(F.ws + (VAR ? WS_END : WS_Y))) + row * DM + 640 + (kvh * 3 + g) * 64, h);
}

__device__ __forceinline__ void swa_unit(const Params& P, Frame& F, int layer, int b, int kvh, int qblk) {
    constexpr int NK = 384;
    LAS unsigned char* Kimg = F.lds; LAS unsigned char* Vimg = F.lds + NK * 128;
    const int lane = F.lane, wave = F.wave, a = lane & 31, h = lane >> 5;
    const int q0 = 256 * qblk; const long tok0 = (long)b * SEQ + q0;
    const bf16* Kb = ((bf16*)(F.ws + WS_AK)) + ((long)b * SEQ + q0 - 128) * 128 + kvh * 64;
    const bf16* Vb = ((bf16*)(F.ws + WS_VT)) + (size_t)(kvh * 64) * MTOK + ((long)b * SEQ + q0 - 128);
    stage_kv<NK>(Kimg, Vimg, Kb, Vb, (long)q0 - 128, 0, wave, lane);
    const size_t row = (size_t)(tok0 + 32 * wave + a);
    const bf16* qp = ((bf16*)(F.ws + WS_AQ)) + row * 384 + kvh * 192 + 8 * h;
    f32x16 cv;
#pragma unroll
    for (int i = 0; i < 16; ++i) cv[i] = 0.f;
    const bool head = (q0 - 128 + 32 * wave) >= 0;
    GLDS_WAIT(); __syncthreads();
#pragma unroll 1
    for (int g = 0; g < 3; ++g) {
        bf16x8 qf[4];
#pragma unroll
        for (int ks = 0; ks < 4; ++ks) qf[ks] = *(const bf16x8*)(qp + g * 64 + 16 * ks);
        float l = 0.5f * __builtin_amdgcn_exp2f(kin(15)[layer * 6 + kvh * 3 + g] * LOG2E);
        f32x16 O[2];
#pragma unroll
        for (int i = 0; i < 16; ++i) { O[0][i] = 0.f; O[1][i] = 0.f; }
        const int r0 = 32 * wave;
        if (head) attn_run<NK, 5, 2, 1>(Kimg, Vimg, r0, qf, cv, l, O, lane);
        else {
#pragma unroll 1
            for (int kt = 4 - wave; kt < 4; ++kt) { bf16x8 kfa[4], vfa[2][2]; load_kv_frags<NK>(kfa, vfa, Kimg, Vimg, r0 + 32 * kt, lane); attn_tile<0>(kfa, vfa, qf, cv, l, O, a, h); }
            { bf16x8 kfa[4], vfa[2][2]; load_kv_frags<NK>(kfa, vfa, Kimg, Vimg, r0 + 128, lane); attn_tile<1>(kfa, vfa, qf, cv, l, O, a, h); }
        }
        attn_store(O, l, ((bf16*)(F.ws + WS_AG)) + row * 384 + (kvh * 3 + g) * 64, ((bf16*)(F.ws + WS_Y)) + row * DM + 256 + (kvh * 3 + g) * 64, h);
    }
    __syncthreads();
}

__device__ __forceinline__ void ssm_unit(Frame& F, int layer, int b, int g) {
    constexpr int APITCH = 528;
    LAS unsigned char* AU = F.lds;
    LAS unsigned char* SC = F.lds + 128 * APITCH;
    LAS float* seg = (LAS float*)(F.lds + 2 * 128 * APITCH);
    const int lane = F.lane, wave = F.wave, tid = F.tid, fr = lane & 15, fq = lane >> 4;
    const int pair = layer * 16 + g;
    const bf16* TE = ((bf16*)(F.ws + WS_TE)) + (size_t)pair * TE_ELEMS; const bf16* GM = ((bf16*)(F.ws + WS_G)) + (size_t)pair * G_ELEMS;
    u32x4 uv[8];
    { const bf16* up = ((bf16*)(F.ws + WS_U)) + (size_t)b * SEQ * 256 + g * 16;
#pragma unroll
      for (int i = 0; i < 8; ++i) { const int idx = tid + 512 * i, t = idx >> 1, hf = idx & 1; uv[i] = *(const u32x4*)(up + (size_t)t * 256 + 8 * hf); } }
    bf16x8 gf[8];
#pragma unroll
    for (int ks = 0; ks < 8; ++ks) gf[ks] = *(const bf16x8*)(GM + (size_t)(16 * wave + fr) * 256 + 32 * ks + 8 * fq);
    const float ar = ((float*)(F.ws + WS_AT))[(size_t)pair * 128 + 2 * lane], ai = ((float*)(F.ws + WS_AT))[(size_t)pair * 128 + 2 * lane + 1];
    bf16x8 tfu[2][8], tfc[2][4];
#pragma unroll
    for (int half = 0; half < 2; ++half) { const int i = half ? 15 - wave : wave, nks = (i >> 1) + 1; const bf16* tp = TE + (size_t)(16 * i + fr) * 384 + 8 * fq;
#pragma unroll
        for (int ks = 0; ks < 8; ++ks) tfu[half][ks] = *(const bf16x8*)(tp + 32 * (ks < nks ? ks : 0));
#pragma unroll
        for (int ks = 0; ks < 4; ++ks) tfc[half][ks] = *(const bf16x8*)(tp + 256 + 32 * ks); }
#pragma unroll
    for (int i = 0; i < 8; ++i) { const int idx = tid + 512 * i, t = idx >> 1, hf = idx & 1; *(LAS u32x4*)(AU + (t >> 4) * APITCH + ((t & 15) * 16 + 8 * hf) * 2) = uv[i]; }
    __syncthreads();
    {
#pragma unroll
        for (int rt = 0; rt < 8; ++rt) { f32x4 acc = {0.f, 0.f, 0.f, 0.f};
#pragma unroll
            for (int ks = 0; ks < 8; ++ks) { const bf16x8 af = *(const LAS bf16x8*)(AU + (16 * rt + fr) * APITCH + (32 * ks + 8 * fq) * 2); acc = __builtin_amdgcn_mfma_f32_16x16x32_bf16(gf[ks], af, acc, 0, 0, 0); }
            *(LAS f32x4*)(SC + (16 * rt + fr) * APITCH + (16 * wave + 4 * fq) * 4) = acc; }
    }
    __syncthreads();
    {
        float lr = 0.f, li = 0.f, locr[16], loci[16];
#pragma unroll
        for (int k = 0; k < 16; ++k) { locr[k] = lr; loci[k] = li; const f32x2_t s = *(const LAS f32x2_t*)(SC + (16 * wave + k) * APITCH + lane * 8);
            const float nr = ar * lr - ai * li + s.x, ni = ar * li + ai * lr + s.y; lr = nr; li = ni; }
        seg[(wave * 64 + lane) * 2] = lr; seg[(wave * 64 + lane) * 2 + 1] = li;
        __syncthreads();
        float a16r = ar, a16i = ai;
#pragma unroll
        for (int q = 0; q < 4; ++q) { const float tr = a16r * a16r - a16i * a16i, ti = 2.f * a16r * a16i; a16r = tr; a16i = ti; }
        float ir = 0.f, ii = 0.f;
        for (int w2 = 0; w2 < wave; ++w2) { const float sr = seg[(w2 * 64 + lane) * 2], si = seg[(w2 * 64 + lane) * 2 + 1]; const float nr = a16r * ir - a16i * ii + sr, ni = a16r * ii + a16i * ir + si; ir = nr; ii = ni; }
        float pr = 1.f, pi = 0.f;
#pragma unroll
        for (int k = 0; k < 16; ++k) { const float cr = locr[k] + pr * ir - pi * ii, ci = loci[k] + pr * ii + pi * ir;
            *(LAS unsigned*)(SC + (16 * wave + k) * APITCH + lane * 4) = pk2(cr, ci);
            const float tr = pr * ar - pi * ai, ti = pr * ai + pi * ar; pr = tr; pi = ti; }
    }
    __syncthreads();
#pragma unroll
    for (int half = 0; half < 2; ++half) {
        const int i = half ? 15 - wave : wave;
        f32x4 acc[8];
#pragma unroll
        for (int rt = 0; rt < 8; ++rt) acc[rt] = (f32x4){0.f, 0.f, 0.f, 0.f};
        const int nks = (i >> 1) + 1;
#pragma unroll
        for (int ks = 0; ks < 8; ++ks) { if (ks < nks) {
#pragma unroll
            for (int rt = 0; rt < 8; ++rt) { const bf16x8 af = *(const LAS bf16x8*)(AU + (16 * rt + fr) * APITCH + (32 * ks + 8 * fq) * 2); acc[rt] = __builtin_amdgcn_mfma_f32_16x16x32_bf16(tfu[half][ks], af, acc[rt], 0, 0, 0); } } }
#pragma unroll
        for (int ks = 0; ks < 4; ++ks) {
#pragma unroll
            for (int rt = 0; rt < 8; ++rt) { const bf16x8 af = *(const LAS bf16x8*)(SC + (16 * rt + fr) * APITCH + (32 * ks + 8 * fq) * 2); acc[rt] = __builtin_amdgcn_mfma_f32_16x16x32_bf16(tfc[half][ks], af, acc[rt], 0, 0, 0); } }
#pragma unroll
        for (int rt = 0; rt < 8; ++rt) { const int chunk = 16 * rt + fr; u32x2 w; w.x = pk2(gelu_tanh_f(acc[rt][0]), gelu_tanh_f(acc[rt][1])); w.y = pk2(gelu_tanh_f(acc[rt][2]), gelu_tanh_f(acc[rt][3]));
            __hip_atomic_store((unsigned long long*)(((bf16*)(F.ws + WS_YPRE)) + ((size_t)b * SEQ + 16 * chunk + i) * 256 + g * 16 + 4 * fq), ((unsigned long long)w.y << 32) | w.x, __ATOMIC_RELAXED, __HIP_MEMORY_SCOPE_AGENT); }
    }
    asm volatile("s_waitcnt vmcnt(0)" ::: "memory");
    __syncthreads();
    if (tid == 0) __hip_atomic_fetch_add(F.ctl + CW_SSMDONE + 64 * (layer * NB + b), 1u, __ATOMIC_RELAXED, __HIP_MEMORY_SCOPE_AGENT);
}

__device__ __forceinline__ void glu_unit(const Params& P, Frame& F, int layer, int b, int j) {
    constexpr int APITCH = 528;
    LAS unsigned char* AT_ = F.lds;
    const int lane = F.lane, wave = F.wave, tid = F.tid, fr = lane & 15, fq = lane >> 4;
    const size_t tok0 = (size_t)b * SEQ + 128 * j;
    const bf16* wp = ((bf16*)(F.ws + WS_GLU)) + (size_t)layer * 65536 + (size_t)(32 * wave + fr) * 256 + 8 * fq;
    bf16x8 wf[8][2];
#pragma unroll
    for (int ks = 0; ks < 8; ++ks) { wf[ks][0] = *(const bf16x8*)(wp + 32 * ks); wf[ks][1] = *(const bf16x8*)(wp + 16 * 256 + 32 * ks); }
    if (tid == 0) { unsigned* c = F.ctl + CW_SSMDONE + 64 * (layer * NB + b); unsigned sp = 0;
        while (__hip_atomic_load(c, __ATOMIC_RELAXED, __HIP_MEMORY_SCOPE_AGENT) < 16u) { __builtin_amdgcn_s_sleep(2); if (++sp > (1u << 22)) break; }
        __builtin_amdgcn_fence(__ATOMIC_ACQUIRE, "agent"); asm volatile("s_waitcnt vmcnt(0)" ::: "memory"); }
    __syncthreads();
    { const bf16* yp = ((bf16*)(F.ws + WS_YPRE)) + tok0 * 256;
#pragma unroll
      for (int i = 0; i < 8; ++i) { const int idx = tid + 512 * i, t = idx >> 5, c = idx & 31; const u32x4 v = *(const u32x4*)(yp + (size_t)t * 256 + 8 * c); *(LAS u32x4*)(AT_ + t * APITCH + c * 16) = v; } }
    f32x4 acc[8][2];
#pragma unroll
    for (int rt = 0; rt < 8; ++rt) { acc[rt][0] = (f32x4){0.f, 0.f, 0.f, 0.f}; acc[rt][1] = (f32x4){0.f, 0.f, 0.f, 0.f}; }
    __syncthreads();
#pragma unroll
    for (int ks = 0; ks < 8; ++ks)
#pragma unroll
        for (int rt = 0; rt < 8; ++rt) { const bf16x8 af = *(const LAS bf16x8*)(AT_ + (16 * rt + fr) * APITCH + (32 * ks + 8 * fq) * 2);
            acc[rt][0] = __builtin_amdgcn_mfma_f32_16x16x32_bf16(wf[ks][0], af, acc[rt][0], 0, 0, 0); acc[rt][1] = __builtin_amdgcn_mfma_f32_16x16x32_bf16(wf[ks][1], af, acc[rt][1], 0, 0, 0); }
    const float* gb = kin(12) + layer * 256;
#pragma unroll
    for (int nt = 0; nt < 2; ++nt) { const int n0 = 32 * wave + 16 * nt + 4 * fq; const f32x4 bv = *(const f32x4*)(gb + n0);
#pragma unroll
        for (int rt = 0; rt < 8; ++rt) { const int t = 16 * rt + fr; const u32x2 yp = *(const LAS u32x2*)(AT_ + t * APITCH + n0 * 2); const u32x2 sg = *(const u32x2*)(((bf16*)(F.ws + WS_SG)) + (tok0 + t) * 256 + n0);
            const f32x4 z = acc[rt][nt] + bv; u32x2 w;
            w.x = pk2(bflo(yp.x) * sigmoid_f(z[0]) * bflo(sg.x), bfhi(yp.x) * sigmoid_f(z[1]) * bfhi(sg.x));
            w.y = pk2(bflo(yp.y) * sigmoid_f(z[2]) * bflo(sg.y), bfhi(yp.y) * sigmoid_f(z[3]) * bfhi(sg.y));
            *(u32x2*)(((bf16*)(F.ws + WS_Y)) + (tok0 + t) * DM + n0) = w; } }
    __syncthreads();
}

__device__ __forceinline__ void mixer_phase(const Params& P, Frame& F, int qslot, int layer, int mask) {
    volatile LAS int* qw = (volatile LAS int*)(F.lds + LDS_CTL);
    unsigned* head = F.ctl + CW_QUEUE + 64 * qslot;
    for (;;) {
        if (F.tid == 0) qw[0] = (int)atomicAdd(head, 1u);
        __syncthreads();
        const int it = qw[0];
        __syncthreads();
        if (it >= 1536) break;
        Frame Fu = phase_frame(F);
#ifndef NO_MOBA
        if (it < 768 && (mask & 1)) { const int qb = 7 - it / 96, r = it % 96, b = r / 6, kvh = (r % 6) / 3, g = r % 3;
            if (mask & 8) moba_unit<1>(Fu, b, kvh, qb, g); else if (mask & 16) moba_unit<2>(Fu, b, kvh, qb, g);
#ifdef MOBA_PVAR
            else if (mask & 64) moba_unit<MOBA_PVAR>(Fu, b, kvh, qb, g);
#endif
            else moba_unit<0>(Fu, b, kvh, qb, g); }
#endif
#ifndef NO_SSM
        if (it >= 768 && it < 1024 && (mask & 2)) { const int r = it - 768; ssm_unit(Fu, layer, r >> 4, r & 15); }
#endif
#ifndef NO_SWA
        if (it >= 1024 && it < 1280 && (mask & 4)) { const int r = it - 1024; swa_unit(P, Fu, layer, r >> 4, (r >> 3) & 1, r & 7); }
#endif
        if (it >= 1280 && (mask & 32)) { const int r = it - 1280; glu_unit(P, Fu, layer, r >> 4, r & 15); }
    }
}

#define XB_TMO      128
#define XB_XCNT(j)  (256  + 64 * (j))
#define XB_XSUB(j)  (1280 + 64 * (j))
#define XB_XGEN(j)  (2304 + 64 * (j))
#define XB_TOP      3328
#define XB_TOPGEN   3392
#define XCD_BAR_WORDS 3456
#define XB_SPIN_CAP (1u << 18)

__device__ __forceinline__ unsigned xb_ld(unsigned* p)              { return __hip_atomic_load(p, __ATOMIC_RELAXED, __HIP_MEMORY_SCOPE_AGENT); }
__device__ __forceinline__ unsigned xb_add(unsigned* p, unsigned v) { return __hip_atomic_fetch_add(p, v, __ATOMIC_RELAXED, __HIP_MEMORY_SCOPE_AGENT); }
__device__ __forceinline__ unsigned xb_xcc_id() { return (unsigned)__builtin_amdgcn_s_getreg((3 << 11) | 20) & 0xFu; }
#define XB_SPIN(cond, bar) do { unsigned _sp = 0; while (cond) { __builtin_amdgcn_s_sleep(1); \
    if ((++_sp & 255u) == 0u) { if (xb_ld(&(bar)[XB_TMO])) break; if (_sp > XB_SPIN_CAP) { atomicAdd(&(bar)[XB_TMO], 1u); break; } } } } while (0)

struct XcdBarrier {
    unsigned* bar; unsigned x;
    volatile LAS unsigned* st;
};

__device__ __forceinline__ XcdBarrier xcd_barrier_post(unsigned* bar, volatile LAS unsigned* st) {
    XcdBarrier b; b.bar = bar; b.x = xb_xcc_id(); b.st = st;
    if (threadIdx.x == 0) (void)xb_add(&bar[XB_XCNT(b.x)], 1u);
    return b;
}
__device__ __forceinline__ void xcd_barrier_complete(unsigned* bar, unsigned x, unsigned& nloc, unsigned& nx) {
    const unsigned G = gridDim.x * gridDim.y * gridDim.z;
    unsigned sum, cnt, mine, sp = 0u;
    for (;;) {
        sum = 0u; cnt = 0u; mine = 0u;
#pragma unroll 1
        for (unsigned j = 0; j < 16; ++j) { const unsigned c = xb_ld(&bar[XB_XCNT(j)]); sum += c; cnt += (c > 0u) ? 1u : 0u; mine = (j == x) ? c : mine; }
        if (sum == G) break;
        __builtin_amdgcn_s_sleep(1);
        if ((++sp & 255u) == 0u) { if (xb_ld(&bar[XB_TMO])) break; if (sp > XB_SPIN_CAP) { atomicAdd(&bar[XB_TMO], 1u); break; } }
    }
    nloc = mine > 0u ? mine : 1u; nx = cnt > 0u ? cnt : 1u;
}

__device__ __forceinline__ void xcd_barrier(const XcdBarrier& b) {
    asm volatile("s_waitcnt vmcnt(0)" ::: "memory");
    __syncthreads();
    if (threadIdx.x == 0) {
        unsigned* bar = b.bar;
        __builtin_amdgcn_s_waitcnt(0);
        unsigned nloc = b.st[0], nx = b.st[1];
        if (nloc == 0u) { xcd_barrier_complete(bar, b.x, nloc, nx); b.st[0] = nloc; b.st[1] = nx; }
        const unsigned old = xb_add(&bar[XB_XSUB(b.x)], 1u);
        const unsigned gen = old / nloc;
        if (old + 1u == (gen + 1u) * nloc) {
            __builtin_amdgcn_fence(__ATOMIC_RELEASE, "agent");
            asm volatile("s_waitcnt vmcnt(0)" ::: "memory");
            const unsigned og = xb_add(&bar[XB_TOP], 1u);
            const unsigned tg = og / nx;
            if (og + 1u == (tg + 1u) * nx) xb_add(&bar[XB_TOPGEN], 1u);
            else XB_SPIN(xb_ld(&bar[XB_TOPGEN]) == tg, bar);
            __builtin_amdgcn_fence(__ATOMIC_ACQUIRE, "agent");
            xb_add(&bar[XB_XGEN(b.x)], 1u);
            asm volatile("s_waitcnt vmcnt(0)" ::: "memory");
        } else {
            XB_SPIN(xb_ld(&bar[XB_XGEN(b.x)]) == gen, bar);
            __builtin_amdgcn_fence(__ATOMIC_ACQUIRE, "agent");
            asm volatile("s_waitcnt vmcnt(0)" ::: "memory");
        }
    }
    __syncthreads();
}

constexpr int CW_BAR = 4096;
#ifndef USE_COOP_LAUNCH
#define USE_COOP_LAUNCH 0
#endif
#ifndef REP_P0
#define REP_P0 1
#endif
#ifndef REP_P1
#define REP_P1 1
#endif
#ifndef REP_MIX
#define REP_MIX 1
#endif
#ifndef REP_GLU
#define REP_GLU 1
#endif
#ifndef REP_P3L0
#define REP_P3L0 1
#endif
#ifndef REP_SYNC
#define REP_SYNC 1
#endif
#ifndef P3_PROBE_SKIP
#define P3_PROBE_SKIP 0
#endif
#ifndef MIX_EXTRA_MASK
#define MIX_EXTRA_MASK 39
#endif
#ifndef USE_CG_SYNC
#define USE_CG_SYNC 0
#endif
#define GRID_SYNC() do { for (int r_ = 0; r_ < REP_SYNC; ++r_) { if (USE_CG_SYNC) cg::this_grid().sync(); else xcd_barrier(xbar); } } while (0)
__global__ void __launch_bounds__(512, 2) mk_fwd(Params P) {
    extern __shared__ __attribute__((aligned(16))) unsigned char lds_raw[];
    Frame F;
    F.lds = (LAS unsigned char*)lds_raw; F.tid = threadIdx.x; F.lane = F.tid & 63; F.wave = __builtin_amdgcn_readfirstlane(F.tid >> 6); F.G = gridDim.x; F.bid = blockIdx.x;
    F.out = (float*)kin(19); F.ws = (unsigned char*)kin(20); F.ctl = (unsigned*)(F.ws + WS_CTL);
    if (F.tid < 128) ((LAS unsigned*)(F.lds + LDS_CTL))[F.tid] = 0u;
    __syncthreads();
    const XcdBarrier xbar = xcd_barrier_post(F.ctl + CW_BAR, (volatile LAS unsigned*)(F.lds + LDS_CTL + 16));

#ifndef NO_P0
    for (int rep = 0; rep < REP_P0; ++rep) { Frame Fp = phase_frame(F); p0_prologue(P, Fp); }
#endif
    GRID_SYNC();
#pragma unroll 1
    for (int layer = 0; layer < DEPTH; ++layer) {
#ifndef NO_P1
        for (int rep = 0; rep < REP_P1; ++rep) {
            Frame Fp = phase_frame(F);
            pg8::Gemm g{((bf16*)(Fp.ws + WS_Z)), ((bf16*)(Fp.ws + WS_Z)), ZROWS, ZROWS, DM}; const SchedTab S = make_sched<0>(Fp, NTT + 10 * layer);
            EpiProj E{NTT + 10 * layer, layer, Fp.ws};
            pg8::gemm_phase<EpiProj, SchedTab, true, true>(F.lds, g, S, E);
        }
#endif
        GRID_SYNC();
#ifndef NO_MIX
        for (int rep = 0; rep < REP_MIX; ++rep) { Frame Fp = phase_frame(F); mixer_phase(P, Fp, layer + 2 * rep, layer, rep ? MIX_EXTRA_MASK : 39); }
#endif
        GRID_SYNC();
#ifndef NO_P3
        for (int rep = 0; rep < (layer == 0 ? REP_P3L0 : 1); ++rep) {
            Frame Fp = phase_frame(F);
            pg8::Gemm g{((bf16*)(Fp.ws + WS_Y)), ((bf16*)(Fp.ws + WS_WOUT)) + (size_t)layer * DM * DM, MTOK, DM, DM}; const SchedTab S = make_sched<1>(Fp, 0);
            EpiOut E{kin(0), F.out, ((bf16*)(Fp.ws + WS_Z)), ((float*)(Fp.ws + WS_ROWSS)), layer + 1 < DEPTH ? 1 : 0, (LAS float*)(F.lds + LDS_MISC + 4096), (rep > 0 && P3_PROBE_SKIP) ? 1 : 0};
            pg8::gemm_phase<EpiOut, SchedTab, true, true>(F.lds, g, S, E);
        }
#endif
        if (layer + 1 < DEPTH) GRID_SYNC();
    }
}

extern "C" void kernel_launch(void* const* d_in, const int* in_sizes, int n_in, void* d_out, int out_size, void* d_ws, size_t ws_size, hipStream_t stream) {
    static int grid = 0;
    if (grid == 0) {
        if (n_in != 19 || out_size != MTOK * DM || ws_size < WS_END) { fprintf(stderr, "kernel_launch: unexpected problem (n_in %d out %d ws %zu)\n", n_in, out_size, ws_size); grid = -1; return; }
        int dev = 0, cus = 0, per_cu = 0;
        (void)hipGetDevice(&dev);
        (void)hipDeviceGetAttribute(&cus, hipDeviceAttributeMultiprocessorCount, dev);
        (void)hipFuncSetAttribute((const void*)mk_fwd, hipFuncAttributeMaxDynamicSharedMemorySize, LDS_BYTES);
        (void)hipOccupancyMaxActiveBlocksPerMultiprocessor(&per_cu, (const void*)mk_fwd, 512, LDS_BYTES);
        if (per_cu < 1) { fprintf(stderr, "kernel_launch: occupancy query says %d blocks per CU\n", per_cu); per_cu = 1; }
        grid = cus;
    }
    if (grid < 0) return;
    (void)hipMemsetAsync((char*)d_ws + WS_CTL, 0, CTL_BYTES, stream);
    Params p{};
    for (int i = 0; i < 19; ++i) p.in[i] = (const float*)d_in[i];
    p.out = (float*)d_out; p.ws = (unsigned char*)d_ws;
#if USE_COOP_LAUNCH
    void* args[] = {&p};
    hipError_t e = hipLaunchCooperativeKernel((const void*)mk_fwd, dim3(grid), dim3(512), args, LDS_BYTES, stream);
    if (e != hipSuccess) fprintf(stderr, "cooperative launch failed: %s (grid %d)\n", hipGetErrorString(e), grid);
#else
    hipLaunchKernelGGL(mk_fwd, dim3(grid), dim3(512), LDS_BYTES, stream, p);
    const hipError_t e = hipPeekAtLastError();
    if (e != hipSuccess) fprintf(stderr, "launch failed: %s (grid %d)\n", hipGetErrorString(e), grid);
#endif
}
```

```cpp
#include <hip/hip_runtime.h>
#include <hip/hip_cooperative_groups.h>
#include <cstdio>
#include <cstdint>
namespace cg = cooperative_groups;
namespace pg8 {
#define PG8_LAS __attribute__((address_space(3)))
typedef unsigned short bf16_t;
typedef short bf16x8 __attribute__((ext_vector_type(8)));
typedef float f32x4 __attribute__((ext_vector_type(4)));
typedef unsigned u32x4 __attribute__((ext_vector_type(4)));
constexpr int BM = 256, BK = 64, HALF = 128, HTB = HALF * BK * 2  , STAGE_BYTES = 8 * HTB, NXCD = 8, WGM = 8;

__host__ __device__ __forceinline__ int lds_byte(int r, int c) { const int st = (r >> 4) * 2 + (c >> 5), rr = r & 15, cc = c & 31, ob = rr * 64 + cc * 2; return st * 1024 + (ob ^ (((ob >> 9) & 1) << 5)); }
__host__ __device__ __forceinline__ void stage_rc(int b, int& R, int& C) { const int st = b / 1024, sb = b % 1024, swz = sb ^ (((sb >> 9) & 1) << 5); R = (st >> 1) * 16 + swz / 64; C = (st & 1) * 32 + (swz % 64) / 2; }
__host__ __device__ __forceinline__ int perm32(int rho) { const int n = rho >> 4, i = rho & 15; return 8 * (i >> 2) + 4 * n + (i & 3); }

struct Unit { int pm, pn; };
struct Gemm { const bf16_t* A; const bf16_t* Bt; int M, N, K; };

__device__ __forceinline__ unsigned cvt_pk_bf16(float lo, float hi) { unsigned r; asm volatile("v_cvt_pk_bf16_f32 %0, %1, %2" : "=v"(r) : "v"(lo), "v"(hi)); return r; }
typedef float f32x2 __attribute__((ext_vector_type(2)));
template <class Epi, class Sched, bool ALIGN_EPI = false, bool SP2 = false>
__device__ __forceinline__ void gemm_phase(PG8_LAS unsigned char* lds, const Gemm g, const Sched& S, const Epi& E) {
    int tid_ = threadIdx.x; asm volatile("" : "+v"(tid_));
    const int tid = tid_, wid = __builtin_amdgcn_readfirstlane(tid >> 6), lane = tid & 63, wr = wid >> 2, wc = wid & 3, fr = lane & 15, fq = lane >> 4;
    const int K = g.K, nt = K / BK;
    unsigned voffA[2], voffB[2];
#pragma unroll
    for (int i = 0; i < 2; ++i) { int R, C; stage_rc(tid * 16 + i * 8192, R, C); const int Rb = Epi::PERM ? ((R & ~31) + perm32(R & 31)) : R;
        voffA[i] = (unsigned)(R * K + C) * 2u; voffB[i] = (unsigned)(Rb * K + C) * 2u; }
    const size_t kstep = (size_t)(BK * 2);
    const size_t hstep = (size_t)HALF * K * 2;
    const size_t tstep = 2 * hstep;
    const unsigned ldsw = (unsigned)wid * 1024u;
    const int aoff = lds_byte(wr * 64 + fr, fq * 8), boff = lds_byte(wc * 32 + fr, fq * 8);
#define PG8_SA(b, h) (((b) * 2 + (h)) * HTB)
#define PG8_SB(b, h) ((4 + (b) * 2 + (h)) * HTB)
#define PG8_STAGE(bufoff, gbase, voff) do { _Pragma("unroll") for (int _i = 0; _i < 2; ++_i) \
        __builtin_amdgcn_global_load_lds((const unsigned*)((const char*)(gbase) + (voff)[_i]), (PG8_LAS unsigned*)(lds + (bufoff) + ldsw + _i * 8192), 16, 0, 0); } while (0)
#define PG8_LDA(dst, b, h) do { _Pragma("unroll") for (int m = 0; m < 4; ++m) _Pragma("unroll") for (int k = 0; k < 2; ++k) dst[m][k] = *(const PG8_LAS bf16x8*)(lds + PG8_SA(b, h) + aoff + m * 2048 + k * 1024); } while (0)
#define PG8_LDB(dst, b, h) do { _Pragma("unroll") for (int n = 0; n < 2; ++n) _Pragma("unroll") for (int k = 0; k < 2; ++k) dst[n][k] = *(const PG8_LAS bf16x8*)(lds + PG8_SB(b, h) + boff + n * 2048 + k * 1024); } while (0)
#define PG8_MMA(ai, bj, At, Bt) do { __builtin_amdgcn_s_setprio(1); _Pragma("unroll") for (int m = 0; m < 4; ++m) _Pragma("unroll") for (int n = 0; n < 2; ++n) _Pragma("unroll") for (int k = 0; k < 2; ++k) \
        acc[ai][bj][m][n] = __builtin_amdgcn_mfma_f32_16x16x32_bf16(Bt[n][k], At[m][k], acc[ai][bj][m][n], 0, 0, 0); __builtin_amdgcn_s_setprio(0); } while (0)
#define PG8_WAIT_V(n) asm volatile("s_waitcnt vmcnt(" #n ")" ::: "memory")
#define PG8_WAIT_L(n) asm volatile("s_waitcnt lgkmcnt(" #n ")" ::: "memory")
#define PG8_BAR __builtin_amdgcn_s_barrier()
#define PG8_SCHED __builtin_amdgcn_sched_barrier(0)
    Unit cur, nxt; int ui = 0;
    if (!S.next(0, cur)) return;
    f32x4 acc[2][2][4][2];
#pragma unroll
    for (int a = 0; a < 2; ++a)
#pragma unroll
        for (int b = 0; b < 2; ++b)
#pragma unroll
            for (int m = 0; m < 4; ++m)
#pragma unroll
                for (int n = 0; n < 2; ++n) acc[a][b][m][n] = (f32x4){0.f, 0.f, 0.f, 0.f};
    bf16x8 At[4][2], B0[2][2], B1[2][2];
    const char* cA = (const char*)g.A + (size_t)cur.pm * tstep; const char* cB = (const char*)g.Bt + (size_t)cur.pn * tstep;
    S.a_ready(cur);
    if constexpr (SP2) {
        PG8_STAGE(PG8_SB(0, 0), cB, voffB); PG8_STAGE(PG8_SB(0, 1), cB + hstep, voffB); PG8_STAGE(PG8_SA(0, 0), cA, voffA); PG8_STAGE(PG8_SA(0, 1), cA + hstep, voffA);
        if (wr == 1) PG8_BAR;
        PG8_WAIT_V(2); PG8_BAR;
        PG8_STAGE(PG8_SB(1, 0), cB + kstep, voffB); PG8_STAGE(PG8_SA(1, 0), cA + kstep, voffA); PG8_STAGE(PG8_SB(1, 1), cB + hstep + kstep, voffB);
        PG8_WAIT_V(6); PG8_BAR;
    } else {
        PG8_STAGE(PG8_SB(0, 0), cB, voffB); PG8_STAGE(PG8_SA(0, 0), cA, voffA); PG8_STAGE(PG8_SB(0, 1), cB + hstep, voffB); PG8_STAGE(PG8_SA(0, 1), cA + hstep, voffA);
        if (wr == 1) PG8_BAR;
        PG8_WAIT_V(4); PG8_BAR;
        PG8_STAGE(PG8_SB(1, 0), cB + kstep, voffB); PG8_STAGE(PG8_SA(1, 0), cA + kstep, voffA); PG8_STAGE(PG8_SB(1, 1), cB + hstep + kstep, voffB);
        PG8_WAIT_V(6); PG8_BAR;
    }
    for (;;) {
        const bool has_next = S.next(ui + 1, nxt);
        const char* nA = has_next ? (const char*)g.A + (size_t)nxt.pm * tstep : cA; const char* nB = has_next ? (const char*)g.Bt + (size_t)nxt.pn * tstep : cB;
        for (int t = 0; t < nt; t += 2) {
            const bool last = (t == nt - 2);
            const char* a1 = cA + (size_t)(t + 1) * kstep;
            const char* a2 = last ? nA : cA + (size_t)(t + 2) * kstep; const char* b2 = last ? nB : cB + (size_t)(t + 2) * kstep;
            const char* a3 = a2 + kstep; const char* b3 = b2 + kstep;
            if (last && has_next) S.a_ready(nxt);
            if constexpr (SP2) {
            PG8_LDB(B0, 0, 0); PG8_LDB(B1, 0, 1); PG8_SCHED; PG8_LDA(At, 0, 0); PG8_STAGE(PG8_SA(1, 1), a1 + hstep, voffA);
            PG8_WAIT_V(8); PG8_WAIT_L(0); PG8_BAR; PG8_MMA(0, 0, At, B0); PG8_MMA(0, 1, At, B1); PG8_BAR; PG8_SCHED;
            PG8_LDA(At, 0, 1); PG8_STAGE(PG8_SB(0, 0), b2, voffB); PG8_STAGE(PG8_SB(0, 1), b2 + hstep, voffB); PG8_STAGE(PG8_SA(0, 0), a2, voffA);
            PG8_WAIT_V(8); PG8_WAIT_L(0); PG8_BAR; PG8_MMA(1, 0, At, B0); PG8_MMA(1, 1, At, B1); PG8_BAR; PG8_SCHED;
            PG8_LDB(B0, 1, 0); PG8_LDB(B1, 1, 1); PG8_SCHED; PG8_LDA(At, 1, 0); PG8_STAGE(PG8_SA(0, 1), a2 + hstep, voffA);
            PG8_WAIT_V(8); PG8_WAIT_L(0); PG8_BAR; PG8_MMA(0, 0, At, B0); PG8_MMA(0, 1, At, B1); PG8_BAR; PG8_SCHED;
            PG8_LDA(At, 1, 1); PG8_STAGE(PG8_SB(1, 0), b3, voffB); PG8_STAGE(PG8_SB(1, 1), b3 + hstep, voffB); PG8_STAGE(PG8_SA(1, 0), a3, voffA);
            PG8_WAIT_V(8); PG8_WAIT_L(0); PG8_BAR; PG8_MMA(1, 0, At, B0); PG8_MMA(1, 1, At, B1); PG8_BAR; PG8_SCHED;
            } else {
            PG8_LDB(B0, 0, 0); PG8_SCHED; PG8_LDA(At, 0, 0); PG8_STAGE(PG8_SA(1, 1), a1 + hstep, voffA);
            PG8_WAIT_L(8); PG8_BAR; PG8_WAIT_L(0); PG8_MMA(0, 0, At, B0); PG8_BAR; PG8_SCHED;
            PG8_LDB(B1, 0, 1); PG8_STAGE(PG8_SB(0, 0), b2, voffB);
            PG8_BAR; PG8_WAIT_L(0); PG8_MMA(0, 1, At, B1); PG8_BAR;
            PG8_LDA(At, 0, 1); PG8_STAGE(PG8_SA(0, 0), a2, voffA);
            PG8_BAR; PG8_WAIT_L(0); PG8_MMA(1, 0, At, B0); PG8_BAR; PG8_SCHED;
            PG8_STAGE(PG8_SB(0, 1), b2 + hstep, voffB);
            PG8_WAIT_V(6); PG8_BAR; PG8_MMA(1, 1, At, B1); PG8_BAR;
            PG8_LDB(B0, 1, 0); PG8_SCHED; PG8_LDA(At, 1, 0); PG8_STAGE(PG8_SA(0, 1), a2 + hstep, voffA);
            PG8_WAIT_L(8); PG8_BAR; PG8_WAIT_L(0); PG8_MMA(0, 0, At, B0); PG8_BAR; PG8_SCHED;
            PG8_LDB(B1, 1, 1); PG8_STAGE(PG8_SB(1, 0), b3, voffB);
            PG8_BAR; PG8_WAIT_L(0); PG8_MMA(0, 1, At, B1); PG8_BAR;
            PG8_LDA(At, 1, 1); PG8_STAGE(PG8_SA(1, 0), a3, voffA);
            PG8_BAR; PG8_WAIT_L(0); PG8_MMA(1, 0, At, B0); PG8_BAR; PG8_SCHED;
            PG8_STAGE(PG8_SB(1, 1), b3 + hstep, voffB);
            PG8_WAIT_V(6); PG8_BAR; PG8_MMA(1, 1, At, B1); PG8_BAR;
            }
        }
        if constexpr (ALIGN_EPI) { if (wr == 0) PG8_BAR; }
        if constexpr (!Epi::AFTER_DRAIN) { E(acc, cur, wr, wc, fr, fq); S.done(cur); }
        if (!has_next) break;
#pragma unroll
        for (int a = 0; a < 2; ++a)
#pragma unroll
            for (int b = 0; b < 2; ++b)
#pragma unroll
                for (int m = 0; m < 4; ++m)
#pragma unroll
                    for (int n = 0; n < 2; ++n) acc[a][b][m][n] = (f32x4){0.f, 0.f, 0.f, 0.f};
        cur = nxt; cA = nA; cB = nB; ++ui;
        if constexpr (ALIGN_EPI) { if (wr == 1) PG8_BAR; }
    }
    PG8_WAIT_V(0);
    if constexpr (!ALIGN_EPI) { if (wr == 0) PG8_BAR; }
    PG8_BAR;
    if constexpr (Epi::AFTER_DRAIN) { E.fused(acc, cur, wr, wc, fr, fq, lds, wid, lane); S.done(cur); }
#undef PG8_SA
#undef PG8_SB
#undef PG8_STAGE
#undef PG8_LDA
#undef PG8_LDB
#undef PG8_MMA
#undef PG8_WAIT_V
#undef PG8_WAIT_L
#undef PG8_BAR
#undef PG8_SCHED
}
}

#define GAS __attribute__((address_space(1)))
#define LAS __attribute__((address_space(3)))
typedef unsigned short bf16;
typedef short bf16x8 __attribute__((ext_vector_type(8)));
typedef float f32x4 __attribute__((ext_vector_type(4)));
typedef float f32x16 __attribute__((ext_vector_type(16)));
typedef unsigned u32x4 __attribute__((ext_vector_type(4)));
typedef unsigned u32x2 __attribute__((ext_vector_type(2)));
typedef float f32x2_t __attribute__((ext_vector_type(2)));
typedef __bf16 bf16x2_t __attribute__((ext_vector_type(2)));
using pg8::Unit;

constexpr int NB = 16, SEQ = 2048, MTOK = NB * SEQ, DM = 1024, NPROJ = 2560, DEPTH = 2;
constexpr int NTT = MTOK / 256;
constexpr int ZROWS = MTOK + DEPTH * NPROJ;
constexpr float RMS_EPS = 1e-6f;
constexpr float LOG2E = 1.4426950408889634f;
constexpr float QSCALE = 0.125f * LOG2E;
constexpr int LDS_BYTES = 147456;
constexpr int LDS_MISC = 131072;
constexpr int LDS_CTL = LDS_BYTES - 512;

constexpr size_t MiB = 1u << 20;
constexpr size_t WS_CTL = 0, CTL_BYTES = 64 * 1024;
constexpr size_t WS_Z = 2 * MiB, WS_WOUT = 78 * MiB, WS_GLU = 82 * MiB, WS_TE = 83 * MiB, WS_G = 89 * MiB, WS_AT = 91 * MiB;
constexpr size_t WS_U = 92 * MiB, WS_SG = 108 * MiB, WS_AQ = 124 * MiB, WS_AK = 148 * MiB, WS_AG = 156 * MiB, WS_MQ = 180 * MiB, WS_MK = 204 * MiB, WS_MG = 212 * MiB;
constexpr size_t WS_VT = 236 * MiB, WS_KPART = 252 * MiB, WS_ROWSS = 253 * MiB, WS_YPRE = 254 * MiB, WS_Y = 270 * MiB, WS_END = 334 * MiB;
static_assert(WS_Z + (size_t)ZROWS * DM * 2 <= WS_WOUT, "Z fits");
constexpr size_t WS_NW = 1 * MiB;
constexpr int TE_ELEMS = 256 * 384, G_ELEMS = 128 * 256;
constexpr int CW_QUEUE = 1024;
constexpr int CW_SSMDONE = 8192;

__device__ __forceinline__ unsigned pk2(float lo, float hi) { f32x2_t v = {lo, hi}; bf16x2_t b = __builtin_convertvector(v, bf16x2_t); return __builtin_bit_cast(unsigned, b); }
__device__ __forceinline__ float bf2f(unsigned short x) { return __uint_as_float((unsigned)x << 16); }
__device__ __forceinline__ float bflo(unsigned w) { return __uint_as_float(w << 16); }
__device__ __forceinline__ float bfhi(unsigned w) { return __uint_as_float(w & 0xffff0000u); }
__device__ __forceinline__ float wave_sum(float v) {
#pragma unroll
    for (int o = 1; o < 64; o <<= 1) v += __shfl_xor(v, o);
    return v;
}
__device__ __forceinline__ float fast_rcp(float x) { return __builtin_amdgcn_rcpf(x); }
__device__ __forceinline__ float silu_f(float x) { return x * fast_rcp(1.f + __builtin_amdgcn_exp2f(-x * LOG2E)); }
__device__ __forceinline__ float sigmoid_f(float x) { return fast_rcp(1.f + __builtin_amdgcn_exp2f(-x * LOG2E)); }
__device__ __forceinline__ float gelu_tanh_f(float x) { const float z = 0.7978845608028654f * (x + 0.044715f * x * x * x); return x * fast_rcp(1.f + __builtin_amdgcn_exp2f(-2.f * LOG2E * z)); }
__device__ __forceinline__ float swap32_max(float m) { auto rr = __builtin_amdgcn_permlane32_swap(__float_as_uint(m), __float_as_uint(m), false, false); return fmaxf(__uint_as_float(rr[0]), __uint_as_float(rr[1])); }
__device__ __forceinline__ float swap32_sum(float m) { auto rr = __builtin_amdgcn_permlane32_swap(__float_as_uint(m), __float_as_uint(m), false, false); return __uint_as_float(rr[0]) + __uint_as_float(rr[1]); }
__device__ __forceinline__ void glds16(const void* gsrc, LAS unsigned char* ldst) {
    const unsigned dst = __builtin_amdgcn_readfirstlane((unsigned)(uintptr_t)ldst); unsigned keep;
    asm volatile("s_mov_b32 %0, m0\n\ts_mov_b32 m0, %2\n\ts_nop 0\n\tglobal_load_lds_dwordx4 %1, off\n\ts_mov_b32 m0, %0" : "=&s"(keep) : "v"(gsrc), "s"(dst) : "memory");
}
#define GLDS_WAIT() asm volatile("s_waitcnt vmcnt(0)" ::: "memory")

struct Params {
    const float* in[19]; float* out; unsigned char* ws;
};
typedef const float* const __attribute__((address_space(4))) * kargs_t;
__device__ __forceinline__ const float* kin(int i) { kargs_t ka = (kargs_t)__builtin_amdgcn_kernarg_segment_ptr(); asm volatile("" : "+s"(ka)); return ka[i]; }
struct Frame {
    LAS unsigned char* lds; int tid, lane, wave, G, bid; float* out; unsigned char* ws; unsigned* ctl;
};

__device__ __forceinline__ int proj_dest_row(int n0) {
    int slot, off;
    if (n0 < 512)       { slot = n0 >> 6; off = n0 & 63; }
    else if (n0 < 1024) { slot = 8 + ((n0 - 512) >> 6); off = n0 & 63; }
    else if (n0 < 1152) { return 2304 + (n0 - 1024); }
    else if (n0 < 1536) { slot = 16 + ((n0 - 1152) >> 6); off = (n0 - 1152) & 63; }
    else if (n0 < 1920) { slot = 22 + ((n0 - 1536) >> 6); off = (n0 - 1536) & 63; }
    else if (n0 < 2048) { slot = 28 + ((n0 - 1920) >> 6); off = (n0 - 1920) & 63; }
    else if (n0 < 2176) { return 2304 + 128 + (n0 - 2048); }
    else                { slot = 30 + ((n0 - 2176) >> 6); off = (n0 - 2176) & 63; }
    const int t = slot >> 2, wc = slot & 3;
    return 256 * t + 128 * (off >> 5) + 32 * wc;
}
__device__ __forceinline__ void p0_transpose_item(const float* W, int K, int N, const float* gk, bf16* WT, int ldk, int drow0, LAS float* scr, int k0, int n0, int lane) {
#pragma unroll 8
    for (int i = 0; i < 32; ++i) { const int kk = 2 * i + (lane >> 5); float v = W[(size_t)(k0 + kk) * N + n0 + (lane & 31)]; if (gk) v *= gk[k0 + kk]; scr[kk * 33 + (lane & 31)] = v; }
    asm volatile("s_waitcnt lgkmcnt(0)" ::: "memory");
    const int c = lane & 7;
#pragma unroll
    for (int j = 0; j < 4; ++j) { const int n = (lane >> 3) + 8 * j; const LAS float* s = scr + (8 * c) * 33 + n;
        u32x4 o; o.x = pk2(s[0 * 33], s[1 * 33]); o.y = pk2(s[2 * 33], s[3 * 33]); o.z = pk2(s[4 * 33], s[5 * 33]); o.w = pk2(s[6 * 33], s[7 * 33]);
        *(u32x4*)(WT + (size_t)(drow0 + n) * ldk + k0 + 8 * c) = o; }
    asm volatile("s_waitcnt lgkmcnt(0)" ::: "memory");
}
__device__ __forceinline__ void p0_ssm_consts(const Params& P, Frame& F, int pair) {
    const int l = pair >> 4, g = pair & 15, tid = F.tid;
    LAS float* pwr = (LAS float*)(F.lds);
    LAS float* pwi = pwr + 17 * 64;
    LAS float* bbr = pwi + 17 * 64;
    LAS float* bbi = bbr + 1024;
    LAS float* ccr = bbi + 1024;
    LAS float* cci = ccr + 1024;
    LAS float* Kt = cci + 1024;
    const float dt = expf(kin(5)[l * 16 + g]);
    const float* lre = kin(3) + (l * 16 + g) * 64; const float* lim = kin(4) + (l * 16 + g) * 64;
    for (int t = tid; t < 17 * 64; t += 512) { const int p = t & 63, lag = t >> 6; const float lr = lre[p], li = lim[p];
        const float mag = expf(lr * dt * (float)lag); float sn, cs; sincosf(li * dt * (float)lag, &sn, &cs); pwr[t] = mag * cs; pwi[t] = mag * sn; }
    for (int t = tid; t < 1024; t += 512) { const int p = t >> 4, h = t & 15; const float lr = lre[p], li = lim[p];
        const float mag = expf(lr * dt); float sn, cs; sincosf(li * dt, &sn, &cs); const float ar = mag * cs, ai = mag * sn;
        const float den = lr * lr + li * li, nr = ar - 1.f, ni = ai; const float cr = (nr * lr + ni * li) / den, ci = (ni * lr - nr * li) / den;
        const float br = kin(6)[((size_t)(l * 16 + g) * 64 + p) * 16 + h], bi = kin(7)[((size_t)(l * 16 + g) * 64 + p) * 16 + h];
        bbr[t] = cr * br - ci * bi; bbi[t] = cr * bi + ci * br; }
    for (int t = tid; t < 1024; t += 512) { ccr[t] = kin(8)[(size_t)(l * 16 + g) * 1024 + t]; cci[t] = kin(9)[(size_t)(l * 16 + g) * 1024 + t]; }
    __syncthreads();
    for (int t = tid; t < 4096; t += 512) { const int lag = t >> 8, hp = (t >> 4) & 15, h = t & 15; float s = 0.f;
        for (int p = 0; p < 64; ++p) { const float cr = ccr[hp * 64 + p], ci = cci[hp * 64 + p], pr = pwr[lag * 64 + p], pi = pwi[lag * 64 + p];
            const float xr = cr * pr - ci * pi, xi = cr * pi + ci * pr; s += xr * bbr[p * 16 + h] - xi * bbi[p * 16 + h]; }
        if (lag == 0 && hp == h) s += kin(10)[l * 256 + g * 16 + h];
        Kt[t] = s; }
    __syncthreads();
    bf16* TE = ((bf16*)(F.ws + WS_TE)) + (size_t)pair * TE_ELEMS; bf16* GM = ((bf16*)(F.ws + WS_G)) + (size_t)pair * G_ELEMS;
    for (int t = tid; t < 256 * 192; t += 512) { const int n = t / 192, kp = t % 192, k = 2 * kp; const int i = n >> 4, hp = n & 15; float v0, v1;
        if (k < 256) { const int j = k >> 4, h = k & 15; if (j <= i) { v0 = Kt[((i - j) * 16 + hp) * 16 + h]; v1 = Kt[((i - j) * 16 + hp) * 16 + h + 1]; } else { v0 = 0.f; v1 = 0.f; } }
        else { const int p = (k - 256) >> 1; const float cr = ccr[hp * 64 + p], ci = cci[hp * 64 + p], pr = pwr[(i + 1) * 64 + p], pi = pwi[(i + 1) * 64 + p];
            v0 = cr * pr - ci * pi; v1 = -(cr * pi + ci * pr); }
        *(unsigned*)(TE + (size_t)n * 384 + k) = pk2(v0, v1); }
    for (int t = tid; t < 128 * 128; t += 512) { const int n = t >> 7, kp = t & 127, k = 2 * kp; const int p = n >> 1, ri = n & 1, j = k >> 4, h = k & 15;
        const float pr = pwr[(15 - j) * 64 + p], pi = pwi[(15 - j) * 64 + p];
        float v0, v1;
        { const float br = bbr[p * 16 + h], bi = bbi[p * 16 + h]; v0 = ri ? (pr * bi + pi * br) : (pr * br - pi * bi); }
        { const float br = bbr[p * 16 + h + 1], bi = bbi[p * 16 + h + 1]; v1 = ri ? (pr * bi + pi * br) : (pr * br - pi * bi); }
        *(unsigned*)(GM + (size_t)n * 256 + k) = pk2(v0, v1); }
    if (tid < 64) { ((float*)(F.ws + WS_AT))[(size_t)pair * 128 + 2 * tid] = pwr[16 * 64 + tid]; ((float*)(F.ws + WS_AT))[(size_t)pair * 128 + 2 * tid + 1] = pwi[16 * 64 + tid]; }
    __syncthreads();
}
__device__ __forceinline__ void p0_prologue(const Params& P, Frame& F) {
    const bool split = F.G > 64;
    if (!split || F.bid < 32) { for (int pair = F.bid; pair < 32; pair += (split ? 32 : F.G)) p0_ssm_consts(P, F, pair); if (split) return; }
    const int vb = split ? F.bid - 32 : F.bid, nvb = split ? F.G - 32 : F.G;
    if (vb == 0) { float* nwp = (float*)(F.ws + WS_NW);
        for (int t = F.tid; t < DEPTH * 256; t += 512) { const int l = t >> 8, k = (t >> 6) & 3, d = t & 63;
            nwp[t] = (k == 0) ? kin(13)[l * 64 + d] * QSCALE : (k == 1) ? kin(14)[l * 64 + d] : (k == 2) ? kin(16)[l * 64 + d] * QSCALE : kin(17)[l * 64 + d]; } }
    const int gw = vb * 8 + F.wave, NGW = nvb * 8;
    LAS float* scr = (LAS float*)(F.lds + F.wave * 16384);
    constexpr int I_IN = 16 * 80, I_OUT = 16 * 32, I_GLU = 4 * 8, I_L = I_IN + I_OUT + I_GLU;
    for (int it = gw; it < DEPTH * I_L; it += NGW) {
        const int l = it / I_L; int r = it % I_L;
        if (r < I_IN) { const int kb = r / 80, nb = r % 80; p0_transpose_item(kin(2) + (size_t)l * DM * NPROJ, DM, NPROJ, kin(1) + l * DM, ((bf16*)(F.ws + WS_Z)) + (size_t)(MTOK + l * NPROJ) * DM, DM, proj_dest_row(32 * nb), scr, 64 * kb, 32 * nb, F.lane); continue; }
        r -= I_IN;
        if (r < I_OUT) { const int kb = r / 32, nb = r % 32; p0_transpose_item(kin(18) + (size_t)l * DM * DM, DM, DM, nullptr, ((bf16*)(F.ws + WS_WOUT)) + (size_t)l * DM * DM, DM, 32 * nb, scr, 64 * kb, 32 * nb, F.lane); continue; }
        r -= I_OUT;
        { const int kb = r / 8, nb = r % 8; p0_transpose_item(kin(11) + (size_t)l * 65536, 256, 256, nullptr, ((bf16*)(F.ws + WS_GLU)) + (size_t)l * 65536, 256, 32 * nb, scr, 64 * kb, 32 * nb, F.lane); }
    }
    for (int m0 = gw; m0 < MTOK; m0 += 4 * NGW) {
        f32x4 v[4][4];
#pragma unroll
        for (int q = 0; q < 4; ++q) { const int m = m0 + q * NGW; if (m < MTOK) { const f32x4* xr = (const f32x4*)(kin(0) + (size_t)m * DM) + F.lane;
#pragma unroll
            for (int j = 0; j < 4; ++j) v[q][j] = __builtin_nontemporal_load(xr + 64 * j); } }
#pragma unroll
        for (int q = 0; q < 4; ++q) { const int m = m0 + q * NGW; if (m < MTOK) { float s = 0.f;
#pragma unroll
            for (int j = 0; j < 4; ++j) s += (v[q][j].x * v[q][j].x + v[q][j].y * v[q][j].y) + (v[q][j].z * v[q][j].z + v[q][j].w * v[q][j].w);
            s = wave_sum(s);
            u32x2* o8 = (u32x2*)(((bf16*)(F.ws + WS_Z)) + (size_t)m * DM) + F.lane;
#pragma unroll
            for (int j = 0; j < 4; ++j) { u32x2 w; w.x = pk2(v[q][j].x, v[q][j].y); w.y = pk2(v[q][j].z, v[q][j].w); o8[64 * j] = w; }
            if (F.lane < 4) ((float*)(F.ws + WS_ROWSS))[(size_t)m * 4 + F.lane] = (F.lane == 0) ? s : 0.f; } }
    }
}

__device__ __forceinline__ Frame phase_frame(const Frame& F0) {
    Frame F = F0; asm volatile("" : "+v"(F.tid)); F.lane = F.tid & 63; F.wave = __builtin_amdgcn_readfirstlane(F.tid >> 6);
    asm volatile("" : "+s"(F.ws)); F.ctl = (unsigned*)(F.ws + WS_CTL); return F;
}
struct SchedTab { const volatile LAS int* tab; int n;
    __device__ __forceinline__ bool next(int i, Unit& u) const { if (i >= n) return false; u.pm = __builtin_amdgcn_readfirstlane(tab[2 * i]); u.pn = __builtin_amdgcn_readfirstlane(tab[2 * i + 1]); return true; }
    __device__ __forceinline__ void a_ready(const Unit&) const {}
    __device__ __forceinline__ void done(const Unit&) const {}
};
__device__ __forceinline__ bool unit_p1(int G, int c, int wbase, int i, int& pm, int& pn) {
    int tok, j;
    if (G == 256) { if (i >= 5) return false; const int x = c & 7, l = c >> 3, n = i * 32 + l, tq = n / 40, rem = n % 40; j = rem >> 2; tok = 16 * x + 4 * tq + (rem & 3); }
    else { const long L = (long)i * G + c; if (L >= NTT * 10) return false; tok = (int)(L / 10); j = (int)(L % 10); }
    if (j < 9) { pm = tok; pn = wbase + j; } else { pm = wbase + 9; pn = tok; }
    return true;
}
__device__ __forceinline__ bool unit_p3(int G, int c, int i, int& pm, int& pn) {
    if (G == 256) { if (i >= 2) return false; const int x = c & 7, l = c >> 3, n = i * 32 + l, tq = n >> 4, rem = n & 15; pn = rem >> 2; pm = 16 * x + 4 * tq + (rem & 3); }
    else { const long L = (long)i * G + c; if (L >= NTT * 4) return false; pm = (int)(L / 4); pn = (int)(L % 4); }
    return true;
}
__device__ __forceinline__ bool unit_glu(int G, int c, int i, int& pm, int& pn) {
    if (G == 256) { if (i >= 1 || (c >> 3) >= 16) return false; pm = 16 * (c & 7) + (c >> 3); pn = 0; }
    else { const long L = (long)i * G + c; if (L >= NTT) return false; pm = (int)L; pn = 0; }
    return true;
}
template <int KIND>
__device__ __forceinline__ SchedTab make_sched(const Frame& F, int wbase) {
    volatile LAS int* tab = (volatile LAS int*)(F.lds + LDS_CTL + 64);
    volatile LAS int* cnt = (volatile LAS int*)(F.lds + LDS_CTL + 32);
    if (F.tid == 0) { int n = 0;
#pragma unroll 1
        for (int i = 0; i < 24; ++i) { int pm, pn; const bool ok = (KIND == 0) ? unit_p1(F.G, F.bid, wbase, i, pm, pn) : (KIND == 1) ? unit_p3(F.G, F.bid, i, pm, pn) : unit_glu(F.G, F.bid, i, pm, pn);
            if (!ok) break; tab[2 * i] = pm; tab[2 * i + 1] = pn; n = i + 1; }
        cnt[0] = n; }
    __syncthreads();
    SchedTab S; S.tab = tab; S.n = __builtin_amdgcn_readfirstlane(cnt[0]); return S;
}

struct EpiProj {
    static constexpr bool PERM = true, AFTER_DRAIN = false;
    int wbase, layer; unsigned char* ws;
    __device__ __forceinline__ void operator()(const f32x4 (&acc)[2][2][4][2], const Unit& u, int wr, int wc, int fr, int fq) const {
        const float* rowss = (const float*)(ws + WS_ROWSS);
        if (u.pm >= NTT) {
            bf16* VT = (bf16*)(ws + WS_VT);
            const int tc = u.pn * 256 + wc * 32 + 8 * fq;
            float rs[2][8];
#pragma unroll
            for (int bj = 0; bj < 2; ++bj)
#pragma unroll
                for (int e = 0; e < 8; ++e) { const f32x4 p = *(const f32x4*)(rowss + (size_t)(tc + bj * 128 + e) * 4); rs[bj][e] = rsqrtf(((p.x + p.y) + (p.z + p.w)) * (1.f / DM) + RMS_EPS); }
#pragma unroll
            for (int ai = 0; ai < 2; ++ai)
#pragma unroll
                for (int m = 0; m < 4; ++m) { const int f = ai * 128 + wr * 64 + m * 16 + fr;
#pragma unroll
                    for (int bj = 0; bj < 2; ++bj) { const f32x4 a = acc[ai][bj][m][0], b = acc[ai][bj][m][1]; u32x4 w;
                        w.x = pk2(a[0] * rs[bj][0], a[1] * rs[bj][1]); w.y = pk2(a[2] * rs[bj][2], a[3] * rs[bj][3]); w.z = pk2(b[0] * rs[bj][4], b[1] * rs[bj][5]); w.w = pk2(b[2] * rs[bj][6], b[3] * rs[bj][7]);
                        *(u32x4*)(VT + ((size_t)u.pn * 256 + f) * 256 + (wc * 32 + 8 * fq + bj * 128)) = w; } }
            return;
        }
        const int t = u.pn - wbase;
        int kind, pitch, col, nwi = 0; size_t dsto;
        switch (t) {
            case 0: kind = 0; dsto = WS_U; pitch = 256; col = 64 * wc; break;
            case 1: kind = 1; dsto = WS_SG; pitch = 256; col = 64 * wc; break;
            case 2: kind = 2; dsto = WS_AQ; pitch = 384; col = 64 * wc; nwi = 0; break;
            case 3: if (wc < 2) { kind = 2; dsto = WS_AQ; pitch = 384; col = 64 * (4 + wc); nwi = 0; } else { kind = 2; dsto = WS_AK; pitch = 128; col = 64 * (wc - 2); nwi = 1; } break;
            case 4: kind = 1; dsto = WS_AG; pitch = 384; col = 64 * wc; break;
            case 5: if (wc < 2) { kind = 1; dsto = WS_AG; pitch = 384; col = 64 * (4 + wc); } else { kind = 2; dsto = WS_MQ; pitch = 384; col = 64 * (wc - 2); nwi = 2; } break;
            case 6: kind = 2; dsto = WS_MQ; pitch = 384; col = 64 * (2 + wc); nwi = 2; break;
            case 7: if (wc < 2) { kind = 5; dsto = WS_MK; pitch = 128; col = 64 * wc; nwi = 3; } else { kind = 1; dsto = WS_MG; pitch = 384; col = 64 * (wc - 2); } break;
            default: kind = 1; dsto = WS_MG; pitch = 384; col = 64 * (2 + wc); break;
        }
        bf16* dst = (bf16*)(ws + dsto) + col + 8 * fq; const float* nw = (const float*)(ws + WS_NW) + (layer * 4 + nwi) * 64 + 8 * fq;
        const int row0 = u.pm * 256 + wr * 64 + fr;
        if (kind == 0) rows<0>(acc, row0, (bf16*)(ws + WS_U) + ((size_t)(4 * wc + (fq >> 1)) * SEQ) * 16 + 8 * (fq & 1), 0, nw, rowss, nullptr);
        else if (kind == 1) rows<1>(acc, row0, dst, pitch, nw, rowss, nullptr);
        else if (kind == 2) rows<2>(acc, row0, dst, pitch, nw, rowss, nullptr);
        else rows<5>(acc, row0, dst, pitch, nw, rowss, (fr == 0) ? (float*)(ws + WS_KPART) + ((size_t)(u.pm * 2 + wr) * 2 + wc) * 64 + 8 * fq : nullptr);
    }
    template <int KIND>
    __device__ __forceinline__ void rows(const f32x4 (&acc)[2][2][4][2], int row0, bf16* dst, int pitch, const float* nw, const float* rowss, float* kp) const {
        f32x4 wv[2][2], ks[2][2];
        if (KIND >= 2) {
#pragma unroll
            for (int bj = 0; bj < 2; ++bj)
#pragma unroll
                for (int n = 0; n < 2; ++n) { wv[bj][n] = *(const f32x4*)(nw + 32 * bj + 4 * n); ks[bj][n] = (f32x4){0.f, 0.f, 0.f, 0.f}; }
        }
#pragma unroll
        for (int ai = 0; ai < 2; ++ai)
#pragma unroll
            for (int m = 0; m < 4; ++m) {
                const int row = row0 + ai * 128 + m * 16;
                const f32x4 p = *(const f32x4*)(rowss + (size_t)row * 4);
                const float rs = rsqrtf(((p.x + p.y) + (p.z + p.w)) * (1.f / DM) + RMS_EPS);
                f32x4 v[2][2];
#pragma unroll
                for (int bj = 0; bj < 2; ++bj)
#pragma unroll
                    for (int n = 0; n < 2; ++n) v[bj][n] = acc[ai][bj][m][n] * rs;
                if (KIND >= 2) {
                    float ss = 0.f;
#pragma unroll
                    for (int bj = 0; bj < 2; ++bj)
#pragma unroll
                        for (int n = 0; n < 2; ++n) { const f32x4 q = v[bj][n]; ss += (q[0] * q[0] + q[1] * q[1]) + (q[2] * q[2] + q[3] * q[3]); }
                    ss += __shfl_xor(ss, 16); ss += __shfl_xor(ss, 32);
                    const float hn = rsqrtf(ss * (1.f / 64.f) + RMS_EPS);
#pragma unroll
                    for (int bj = 0; bj < 2; ++bj)
#pragma unroll
                        for (int n = 0; n < 2; ++n) { v[bj][n] = v[bj][n] * wv[bj][n] * hn; if (KIND == 5) ks[bj][n] += v[bj][n]; }
                } else if (KIND == 1) {
#pragma unroll
                    for (int bj = 0; bj < 2; ++bj)
#pragma unroll
                        for (int n = 0; n < 2; ++n)
#pragma unroll
                            for (int e = 0; e < 4; ++e) v[bj][n][e] = silu_f(v[bj][n][e]);
                }
                bf16* rp = (KIND == 0) ? dst + ((size_t)(row >> 11) * 16 * SEQ + (row & (SEQ - 1))) * 16 : dst + (size_t)row * pitch;
#pragma unroll
                for (int bj = 0; bj < 2; ++bj) { u32x4 w; w.x = pk2(v[bj][0][0], v[bj][0][1]); w.y = pk2(v[bj][0][2], v[bj][0][3]); w.z = pk2(v[bj][1][0], v[bj][1][1]); w.w = pk2(v[bj][1][2], v[bj][1][3]);
                    *(u32x4*)(rp + (KIND == 0 ? 2 * SEQ * 16 * bj : 32 * bj)) = w; }
                if (m & 1) asm volatile("" ::: "memory");
            }
        if (KIND == 5) {
#pragma unroll
            for (int bj = 0; bj < 2; ++bj)
#pragma unroll
                for (int n = 0; n < 2; ++n)
#pragma unroll
                    for (int e = 0; e < 4; ++e) { float s = ks[bj][n][e]; s += __shfl_xor(s, 1); s += __shfl_xor(s, 2); s += __shfl_xor(s, 4); s += __shfl_xor(s, 8); ks[bj][n][e] = s; }
            if (kp) {
#pragma unroll
                for (int bj = 0; bj < 2; ++bj)
#pragma unroll
                    for (int n = 0; n < 2; ++n) *(f32x4*)(kp + 32 * bj + 4 * n) = ks[bj][n];
            }
        }
    }
};
struct EpiGlu {
    static constexpr bool PERM = true, AFTER_DRAIN = false;
    const bf16* YPRE; const bf16* SG; const float* gb; bf16* Y;
    __device__ __forceinline__ void operator()(const f32x4 (&acc)[2][2][4][2], const Unit& u, int wr, int wc, int fr, int fq) const {
#pragma unroll
        for (int bj = 0; bj < 2; ++bj) { const int c = wc * 32 + 8 * fq + 128 * bj;
            const f32x4 b0 = *(const f32x4*)(gb + c), b1 = *(const f32x4*)(gb + c + 4);
#pragma unroll
            for (int ai = 0; ai < 2; ++ai)
#pragma unroll
                for (int m = 0; m < 4; ++m) { const int row = u.pm * 256 + ai * 128 + wr * 64 + m * 16 + fr;
                    const u32x4 yp = *(const u32x4*)(YPRE + (size_t)row * 256 + c), sg = *(const u32x4*)(SG + (size_t)row * 256 + c);
                    const f32x4 z0 = acc[ai][bj][m][0] + b0, z1 = acc[ai][bj][m][1] + b1;
                    u32x4 w;
                    w.x = pk2(bflo(yp.x) * sigmoid_f(z0[0]) * bflo(sg.x), bfhi(yp.x) * sigmoid_f(z0[1]) * bfhi(sg.x));
                    w.y = pk2(bflo(yp.y) * sigmoid_f(z0[2]) * bflo(sg.y), bfhi(yp.y) * sigmoid_f(z0[3]) * bfhi(sg.y));
                    w.z = pk2(bflo(yp.z) * sigmoid_f(z1[0]) * bflo(sg.z), bfhi(yp.z) * sigmoid_f(z1[1]) * bfhi(sg.z));
                    w.w = pk2(bflo(yp.w) * sigmoid_f(z1[2]) * bflo(sg.w), bfhi(yp.w) * sigmoid_f(z1[3]) * bfhi(sg.w));
                    *(u32x4*)(Y + (size_t)row * DM + c) = w;
                    if (m & 1) asm volatile("" ::: "memory"); } }
    }
};
struct EpiOut {
    static constexpr bool PERM = false, AFTER_DRAIN = false;
    const float* resid_f; float* out; bf16* xb; float* rowss; int write_next; LAS float* xch; int probe_skip;
    __device__ __forceinline__ void operator()(const f32x4 (&acc)[2][2][4][2], const Unit& u, int wr, int wc, int fr, int fq) const {
        const int c0 = u.pn * 256 + wc * 32 + 4 * fq;
        if (probe_skip) { asm volatile("" :: "v"(acc[0][0][0][0]), "v"(acc[1][1][3][1])); asm volatile("s_waitcnt lgkmcnt(0)" ::: "memory"); __builtin_amdgcn_s_barrier(); return; }
#pragma unroll
        for (int ai = 0; ai < 2; ++ai)
#pragma unroll
            for (int m = 0; m < 4; ++m) { const int rt = ai * 128 + wr * 64 + m * 16 + fr; const size_t off = (size_t)(u.pm * 256 + rt) * DM + c0; float ss = 0.f;
#pragma unroll
                for (int bj = 0; bj < 2; ++bj)
#pragma unroll
                    for (int n = 0; n < 2; ++n) { const size_t o2 = off + bj * 128 + n * 16; const f32x4 a4 = acc[ai][bj][m][n]; f32x4 o;
                        if (write_next) o = *(const f32x4*)(resid_f + o2) + a4;
                        else { const u32x2 rb = *(const u32x2*)(xb + o2); o[0] = bflo(rb.x) + a4[0]; o[1] = bfhi(rb.x) + a4[1]; o[2] = bflo(rb.y) + a4[2]; o[3] = bfhi(rb.y) + a4[3]; }
                        if (write_next) { u32x2 w; w.x = pk2(o[0], o[1]); w.y = pk2(o[2], o[3]); *(u32x2*)(xb + o2) = w; ss += (o[0] * o[0] + o[1] * o[1]) + (o[2] * o[2] + o[3] * o[3]); }
                        else __builtin_nontemporal_store(o, (f32x4*)(out + o2)); }
                if (write_next) { ss += __shfl_xor(ss, 16); ss += __shfl_xor(ss, 32); if (fq == 0) xch[rt * 4 + wc] = ss; }
            }
        asm volatile("s_waitcnt lgkmcnt(0)" ::: "memory"); __builtin_amdgcn_s_barrier(); asm volatile("" ::: "memory");
        if (write_next && threadIdx.x < 256) { const f32x4 p = *(const LAS f32x4*)(xch + threadIdx.x * 4); rowss[(size_t)(u.pm * 256 + threadIdx.x) * 4 + u.pn] = (p.x + p.y) + (p.z + p.w); }
    }
};

__device__ __forceinline__ int pi32(int r) { return (r & ~12) | ((r & 8) >> 1) | ((r & 4) << 1); }
template <int MODE>
__device__ __forceinline__ void attn_tile(const bf16x8 (&kf)[4], const bf16x8 (&vf)[2][2], const bf16x8 (&qf)[4], const f32x16& cv, float& l, f32x16 (&O)[2], int a, int h) {
    f32x16 S = __builtin_amdgcn_mfma_f32_32x32x16_bf16(kf[0], qf[0], cv, 0, 0, 0);
#pragma unroll
    for (int ks = 1; ks < 4; ++ks) S = __builtin_amdgcn_mfma_f32_32x32x16_bf16(kf[ks], qf[ks], S, 0, 0, 0);
    if (MODE != 0) {
#pragma unroll
        for (int i = 0; i < 16; ++i) { const int c = pi32((i & 3) + 8 * (i >> 2) + 4 * h); const bool dead = (MODE == 1) ? (c > a) : (c <= a); if (dead) S[i] = -1e30f; }
    }
    float s0 = 0.f, s1 = 0.f;
#pragma unroll
    for (int i = 0; i < 16; i += 2) { S[i] = __builtin_amdgcn_exp2f(S[i]); S[i + 1] = __builtin_amdgcn_exp2f(S[i + 1]); s0 += S[i]; s1 += S[i + 1]; }
    l += s0 + s1;
    bf16x8 pb[2];
#pragma unroll
    for (int s = 0; s < 2; ++s) { u32x4 w; w.x = pk2(S[8 * s], S[8 * s + 1]); w.y = pk2(S[8 * s + 2], S[8 * s + 3]); w.z = pk2(S[8 * s + 4], S[8 * s + 5]); w.w = pk2(S[8 * s + 6], S[8 * s + 7]); pb[s] = __builtin_bit_cast(bf16x8, w); }
#pragma unroll
    for (int dt = 0; dt < 2; ++dt)
#pragma unroll
        for (int s = 0; s < 2; ++s) O[dt] = __builtin_amdgcn_mfma_f32_32x32x16_bf16(vf[dt][s], pb[s], O[dt], 0, 0, 0);
}
template <int NK>
__device__ __forceinline__ void stage_kv(LAS unsigned char* Kimg, LAS unsigned char* Vimg, const bf16* Ksrc  , const bf16* VTf  ,
                                         long tokbase  , long key_lo  , long key_min  , int wave, int lane) {
    constexpr int KP = NK * 128 / 1024, VCH = NK / 8, VP = 64 * VCH * 16 / 1024;
    for (int p = wave; p < KP; p += 8) { const int L = p * 64 + lane, r = L >> 3, s = L & 7, c = s ^ ((r >> 1) & 7); long kr = key_lo + r; if (kr < key_min) kr = key_min;
        glds16(Ksrc + (kr - key_lo) * 128 + c * 8, Kimg + p * 1024); }
    for (int p = wave; p < VP; p += 8) { const int L = p * 64 + lane, d = L / VCH, s = L % VCH, c = s ^ (d & 15); long kc = key_lo + 8 * c; if (kc < key_min) kc = key_min; const long tok = tokbase + kc;
        glds16(VTf + ((tok >> 8) * 256 + d) * 256 + (tok & 255), Vimg + p * 1024); }
}
template <int NK>
__device__ __forceinline__ void load_kv_frags(bf16x8 (&kf)[4], bf16x8 (&vf)[2][2], const LAS unsigned char* Kimg, const LAS unsigned char* Vimg, int row0  , int lane) {
    const int r = row0 + pi32(lane & 31), h = lane >> 5;
#pragma unroll
    for (int ks = 0; ks < 4; ++ks) kf[ks] = *(const LAS bf16x8*)(Kimg + r * 128 + (((2 * ks + h) ^ ((r >> 1) & 7)) << 4));
#pragma unroll
    for (int dt = 0; dt < 2; ++dt) { const int d = 32 * dt + (lane & 31);
#pragma unroll
        for (int s = 0; s < 2; ++s) { const int c = (row0 >> 3) + 2 * s + h; vf[dt][s] = *(const LAS bf16x8*)(Vimg + d * (NK * 2) + ((c ^ (d & 15)) << 4)); } }
}
template <int NK>
__device__ __forceinline__ void load_k_frags(bf16x8 (&kf)[4], const LAS unsigned char* Kimg, int row0, int lane) {
    const int r = row0 + pi32(lane & 31), h = lane >> 5;
#pragma unroll
    for (int ks = 0; ks < 4; ++ks) kf[ks] = *(const LAS bf16x8*)(Kimg + r * 128 + (((2 * ks + h) ^ ((r >> 1) & 7)) << 4));
}
template <int NK>
__device__ __forceinline__ void load_v_frags(bf16x8 (&vf)[2][2], const LAS unsigned char* Vimg, int row0, int lane) {
    const int h = lane >> 5;
#pragma unroll
    for (int dt = 0; dt < 2; ++dt) { const int d = 32 * dt + (lane & 31);
#pragma unroll
        for (int s = 0; s < 2; ++s) { const int c = (row0 >> 3) + 2 * s + h; vf[dt][s] = *(const LAS bf16x8*)(Vimg + d * (NK * 2) + ((c ^ (d & 15)) << 4)); } }
}
__device__ __forceinline__ f32x16 qk_tile(const bf16x8 (&kf)[4], const bf16x8 (&qf)[4], const f32x16& cv) {
    f32x16 S = __builtin_amdgcn_mfma_f32_32x32x16_bf16(kf[0], qf[0], cv, 0, 0, 0);
#pragma unroll
    for (int ks = 1; ks < 4; ++ks) S = __builtin_amdgcn_mfma_f32_32x32x16_bf16(kf[ks], qf[ks], S, 0, 0, 0);
    return S;
}
template <int MODE>
__device__ __forceinline__ void softmax_pv(f32x16& S, const bf16x8 (&vf)[2][2], float& l, f32x16 (&O)[2], int a, int h) {
    if (MODE != 0) {
#pragma unroll
        for (int i = 0; i < 16; ++i) { const int c = pi32((i & 3) + 8 * (i >> 2) + 4 * h); const bool dead = (MODE == 1) ? (c > a) : (c <= a); if (dead) S[i] = -1e30f; }
    }
    float s0 = 0.f, s1 = 0.f;
#pragma unroll
    for (int i = 0; i < 16; i += 2) { S[i] = __builtin_amdgcn_exp2f(S[i]); S[i + 1] = __builtin_amdgcn_exp2f(S[i + 1]); s0 += S[i]; s1 += S[i + 1]; }
    l += s0 + s1;
    bf16x8 pb[2];
#pragma unroll
    for (int s = 0; s < 2; ++s) { u32x4 w; w.x = pk2(S[8 * s], S[8 * s + 1]); w.y = pk2(S[8 * s + 2], S[8 * s + 3]); w.z = pk2(S[8 * s + 4], S[8 * s + 5]); w.w = pk2(S[8 * s + 6], S[8 * s + 7]); pb[s] = __builtin_bit_cast(bf16x8, w); }
#pragma unroll
    for (int dt = 0; dt < 2; ++dt)
#pragma unroll
        for (int s = 0; s < 2; ++s) O[dt] = __builtin_amdgcn_mfma_f32_32x32x16_bf16(vf[dt][s], pb[s], O[dt], 0, 0, 0);
}
template <int NK, int N, int MFIRST, int MLAST>
__device__ __forceinline__ void attn_run(const LAS unsigned char* Kimg, const LAS unsigned char* Vimg, int row0, const bf16x8 (&qf)[4], const f32x16& cv, float& l, f32x16 (&O)[2], int lane) {
    const int a = lane & 31, h = lane >> 5;
    bf16x8 kf[4], vfa[2][2], vfb[2][2];
    load_k_frags<NK>(kf, Kimg, row0, lane); load_v_frags<NK>(vfa, Vimg, row0, lane);
    f32x16 S = qk_tile(kf, qf, cv);
#pragma unroll
    for (int t = 0; t < N; ++t) {
        f32x16 Sn;
        if (t + 1 < N) { load_k_frags<NK>(kf, Kimg, row0 + 32 * (t + 1), lane); if (t & 1) load_v_frags<NK>(vfa, Vimg, row0 + 32 * (t + 1), lane); else load_v_frags<NK>(vfb, Vimg, row0 + 32 * (t + 1), lane);
            Sn = qk_tile(kf, qf, cv); }
        if (t == 0 && MFIRST != 0) { if (t & 1) softmax_pv<MFIRST>(S, vfb, l, O, a, h); else softmax_pv<MFIRST>(S, vfa, l, O, a, h); }
        else if (t == N - 1 && MLAST != 0) { if (t & 1) softmax_pv<MLAST>(S, vfb, l, O, a, h); else softmax_pv<MLAST>(S, vfa, l, O, a, h); }
        else { if (t & 1) softmax_pv<0>(S, vfb, l, O, a, h); else softmax_pv<0>(S, vfa, l, O, a, h); }
        if (t + 1 < N) S = Sn;
    }
}
template <int NK, int PVAR>
__device__ __forceinline__ void attn_run8(const LAS unsigned char* Kimg, const LAS unsigned char* Vimg, const bf16x8 (&qf)[4], const f32x16& cv, float& l, f32x16 (&O)[2], int lane) {
    const int a = lane & 31, h = lane >> 5;
    bf16x8 kf[4], vfa[2][2], vfb[2][2];
    load_k_frags<NK>(kf, Kimg, 0, lane); load_v_frags<NK>(vfa, Vimg, 0, lane);
    if (PVAR == 4) load_v_frags<NK>(vfb, Vimg, 32, lane);
#define QKT() ((PVAR == 5) ? cv : qk_tile(kf, qf, cv))
#define SMPV(S_, vf_) do { if (PVAR == 3) { bf16x8 pb[2]; _Pragma("unroll") for (int s = 0; s < 2; ++s) { u32x4 w; w.x = pk2(S_[8 * s], S_[8 * s + 1]); w.y = pk2(S_[8 * s + 2], S_[8 * s + 3]); w.z = pk2(S_[8 * s + 4], S_[8 * s + 5]); w.w = pk2(S_[8 * s + 6], S_[8 * s + 7]); pb[s] = __builtin_bit_cast(bf16x8, w); } \
        _Pragma("unroll") for (int dt = 0; dt < 2; ++dt) _Pragma("unroll") for (int s = 0; s < 2; ++s) O[dt] = __builtin_amdgcn_mfma_f32_32x32x16_bf16(vf_[dt][s], pb[s], O[dt], 0, 0, 0); } \
      else if (PVAR == 6) { _Pragma("unroll") for (int i = 0; i < 16; ++i) { l += __builtin_amdgcn_exp2f(S_[i]); } asm volatile("" :: "v"(vf_[0][0]), "v"(vf_[1][1])); } \
      else softmax_pv<0>(S_, vf_, l, O, a, h); } while (0)
    f32x16 S = QKT();
#pragma unroll 1
    for (int j = 0; j < 3; ++j) {
        { if (PVAR != 4) { load_k_frags<NK>(kf, Kimg, 64 * j + 32, lane); load_v_frags<NK>(vfb, Vimg, 64 * j + 32, lane); } f32x16 Sn = QKT(); SMPV(S, vfa); S = Sn; }
        { if (PVAR != 4) { load_k_frags<NK>(kf, Kimg, 64 * j + 64, lane); load_v_frags<NK>(vfa, Vimg, 64 * j + 64, lane); } f32x16 Sn = QKT(); SMPV(S, vfb); S = Sn; }
    }
    { if (PVAR != 4) { load_k_frags<NK>(kf, Kimg, 224, lane); load_v_frags<NK>(vfb, Vimg, 224, lane); } f32x16 Sn = QKT(); SMPV(S, vfa); S = Sn; }
    SMPV(S, vfb);
#undef QKT
#undef SMPV
}
__device__ __forceinline__ void attn_store(const f32x16 (&O)[2], float l, const bf16* gate  , bf16* y  , int h) {
    const float inv = 1.f / swap32_sum(l);
#pragma unroll
    for (int dt = 0; dt < 2; ++dt)
#pragma unroll
        for (int q = 0; q < 4; ++q) { const int d = 32 * dt + 8 * q + 4 * h; const u32x2 gv = *(const u32x2*)(gate + d);
            u32x2 w; w.x = pk2(O[dt][4 * q] * inv * bflo(gv.x), O[dt][4 * q + 1] * inv * bfhi(gv.x)); w.y = pk2(O[dt][4 * q + 2] * inv * bflo(gv.y), O[dt][4 * q + 3] * inv * bfhi(gv.y));
            *(u32x2*)(y + d) = w; }
}

template <int VAR>
__device__ __forceinline__ void moba_unit(Frame& F, int b, int kvh, int qb, int g) {
    constexpr int IMG = 32768;
    LAS unsigned char* buf0 = F.lds; LAS unsigned char* buf1 = F.lds + 2 * IMG;
    LAS float* km = (LAS float*)(F.lds + LDS_MISC + 1024);
    const int lane = F.lane, wave = F.wave, a = lane & 31, h = lane >> 5;
    const long tok0 = (long)b * SEQ + 256 * qb;
    const bf16* Kb = ((bf16*)(F.ws + WS_MK)) + (size_t)b * SEQ * 128 + kvh * 64;
    const bf16* Vb = ((bf16*)(F.ws + WS_VT)) + (size_t)(128 + kvh * 64) * 256; const long tokb = (long)b * SEQ;
    if (VAR != 1) stage_kv<256>(buf0, buf0 + IMG, Kb + (size_t)(256 * qb) * 128, Vb, tokb, 256 * qb, 0, wave, lane);
    { const int n = F.tid >> 6, d = F.tid & 63; float s = 0.f;
      if (n < qb) { const int tile = b * 8 + n; s = ((float*)(F.ws + WS_KPART))[((size_t)(tile * 2 + 0) * 2 + kvh) * 64 + d] + ((float*)(F.ws + WS_KPART))[((size_t)(tile * 2 + 1) * 2 + kvh) * 64 + d]; }
      km[n * 64 + d] = s; }
    const size_t row = (size_t)(tok0 + 32 * wave + a);
    const bf16* qp = ((bf16*)(F.ws + WS_MQ)) + row * 384 + kvh * 192 + 8 * h;
    GLDS_WAIT(); __syncthreads();
    unsigned selmask = (VAR == 8) ? 0x7fu : 0u;
    if (qb > 0 && VAR != 8) {
        float sc[8];
#pragma unroll
        for (int n = 0; n < 8; ++n) sc[n] = 0.f;
#pragma unroll
        for (int ks = 0; ks < 4; ++ks) { const bf16x8 q0 = *(const bf16x8*)(qp + 16 * ks), q1 = *(const bf16x8*)(qp + 64 + 16 * ks), q2 = *(const bf16x8*)(qp + 128 + 16 * ks);
#pragma unroll
            for (int j = 0; j < 8; ++j) { const float qs = bf2f((unsigned short)q0[j]) + bf2f((unsigned short)q1[j]) + bf2f((unsigned short)q2[j]); const int d = 16 * ks + 8 * h + j;
#pragma unroll
                for (int n = 0; n < 7; ++n) sc[n] += qs * km[n * 64 + d]; } }
#pragma unroll
        for (int n = 0; n < 7; ++n) { sc[n] = swap32_sum(sc[n]); if (n >= qb) sc[n] = -INFINITY; }
#pragma unroll
        for (int t = 0; t < 3; ++t) { float best = -INFINITY; int bi = -1;
#pragma unroll
            for (int n = 0; n < 7; ++n) if (sc[n] > best) { best = sc[n]; bi = n; }
            if (bi >= 0) { selmask |= 1u << bi;
#pragma unroll
                for (int n = 0; n < 7; ++n) if (n == bi) sc[n] = -INFINITY; } }
    }
    float l = 0.f; f32x16 O[2]; bf16x8 qf[4];
#pragma unroll
    for (int i = 0; i < 16; ++i) { O[0][i] = 0.f; O[1][i] = 0.f; }
#pragma unroll
    for (int ks = 0; ks < 4; ++ks) qf[ks] = *(const bf16x8*)(qp + g * 64 + 16 * ks);
    asm volatile("" : "+v"(qf[0]), "+v"(qf[1]), "+v"(qf[2]), "+v"(qf[3]));
#pragma unroll 1
    for (int s = 0; s <= qb; ++s) {
        LAS unsigned char* cur = (s & 1) ? buf1 : buf0; LAS unsigned char* nxt = (s & 1) ? buf0 : buf1;
        if (s < qb && VAR != 1) stage_kv<256>(nxt, nxt + IMG, Kb + (size_t)(256 * s) * 128, Vb, tokb, 256 * s, 0, wave, lane);
        if (VAR == 2) {} else if (s == 0) { if (VAR != 7) {
            f32x16 cv;
#pragma unroll
            for (int i = 0; i < 16; ++i) cv[i] = 0.f;
            int kt = 0;
#pragma unroll 1
            for (; kt + 1 < wave; kt += 2) { bf16x8 kfa[4], vfa[2][2], kfb[4], vfb[2][2]; load_kv_frags<256>(kfa, vfa, cur, cur + IMG, 32 * kt, lane); load_kv_frags<256>(kfb, vfb, cur, cur + IMG, 32 * kt + 32, lane);
                attn_tile<0>(kfa, vfa, qf, cv, l, O, a, h); attn_tile<0>(kfb, vfb, qf, cv, l, O, a, h); }
            if (kt < wave) { bf16x8 kfa[4], vfa[2][2], kfb[4], vfb[2][2]; load_kv_frags<256>(kfa, vfa, cur, cur + IMG, 32 * kt, lane); load_kv_frags<256>(kfb, vfb, cur, cur + IMG, 32 * kt + 32, lane);
                attn_tile<0>(kfa, vfa, qf, cv, l, O, a, h); attn_tile<1>(kfb, vfb, qf, cv, l, O, a, h); }
            else { bf16x8 kfa[4], vfa[2][2]; load_kv_frags<256>(kfa, vfa, cur, cur + IMG, 32 * kt, lane); attn_tile<1>(kfa, vfa, qf, cv, l, O, a, h); }
        } } else if (VAR != 9) {
            const float cinit = ((selmask >> (s - 1)) & 1u) ? 0.f : -1e30f;
            if (__any(cinit == 0.f)) {
                f32x16 cv;
#pragma unroll
                for (int i = 0; i < 16; ++i) cv[i] = cinit;
                attn_run8<256, (VAR >= 3 ? VAR : 0)>(cur, cur + IMG, qf, cv, l, O, lane);
            }
        }
        GLDS_WAIT(); __syncthreads();
    }
    attn_store(O, l, ((bf16*)(F.ws + WS_MG)) + row * 384 + (kvh * 3 + g) * 64, ((bf16*)(F.ws + (VAR ? WS_END : WS_Y))) + row * DM + 640 + (kvh * 3 + g) * 64, h);
}

__device__ __forceinline__ void swa_unit(const Params& P, Frame& F, int layer, int b, int kvh, int qblk) {
    constexpr int NK = 384;
    LAS unsigned char* Kimg = F.lds; LAS unsigned char* Vimg = F.lds + NK * 128;
    const int lane = F.lane, wave = F.wave, a = lane & 31, h = lane >> 5;
    const int q0 = 256 * qblk; const long tok0 = (long)b * SEQ + q0;
    const bf16* Kb = ((bf16*)(F.ws + WS_AK)) + ((long)b * SEQ + q0 - 128) * 128 + kvh * 64;
    const bf16* Vb = ((bf16*)(F.ws + WS_VT)) + (size_t)(kvh * 64) * 256;
    stage_kv<NK>(Kimg, Vimg, Kb, Vb, (long)b * SEQ, (long)q0 - 128, 0, wave, lane);
    const size_t row = (size_t)(tok0 + 32 * wave + a);
    const bf16* qp = ((bf16*)(F.ws + WS_AQ)) + row * 384 + kvh * 192 + 8 * h;
    f32x16 cv;
#pragma unroll
    for (int i = 0; i < 16; ++i) cv[i] = 0.f;
    const bool head = (q0 - 128 + 32 * wave) >= 0;
    GLDS_WAIT(); __syncthreads();
#pragma unroll 1
    for (int g = 0; g < 3; ++g) {
        bf16x8 qf[4];
#pragma unroll
        for (int ks = 0; ks < 4; ++ks) qf[ks] = *(const bf16x8*)(qp + g * 64 + 16 * ks);
        float l = 0.5f * __builtin_amdgcn_exp2f(kin(15)[layer * 6 + kvh * 3 + g] * LOG2E);
        f32x16 O[2];
#pragma unroll
        for (int i = 0; i < 16; ++i) { O[0][i] = 0.f; O[1][i] = 0.f; }
        const int r0 = 32 * wave;
        if (head) attn_run<NK, 5, 2, 1>(Kimg, Vimg, r0, qf, cv, l, O, lane);
        else {
#pragma unroll 1
            for (int kt = 4 - wave; kt < 4; ++kt) { bf16x8 kfa[4], vfa[2][2]; load_kv_frags<NK>(kfa, vfa, Kimg, Vimg, r0 + 32 * kt, lane); attn_tile<0>(kfa, vfa, qf, cv, l, O, a, h); }
            { bf16x8 kfa[4], vfa[2][2]; load_kv_frags<NK>(kfa, vfa, Kimg, Vimg, r0 + 128, lane); attn_tile<1>(kfa, vfa, qf, cv, l, O, a, h); }
        }
        attn_store(O, l, ((bf16*)(F.ws + WS_AG)) + row * 384 + (kvh * 3 + g) * 64, ((bf16*)(F.ws + WS_Y)) + row * DM + 256 + (kvh * 3 + g) * 64, h);
    }
    __syncthreads();
}

__device__ __forceinline__ void ssm_unit(Frame& F, int layer, int b, int g) {
    constexpr int APITCH = 528;
    LAS unsigned char* AU = F.lds;
    LAS unsigned char* SC = F.lds + 128 * APITCH;
    LAS float* seg = (LAS float*)(F.lds + 2 * 128 * APITCH);
    const int lane = F.lane, wave = F.wave, tid = F.tid, fr = lane & 15, fq = lane >> 4;
    const int pair = layer * 16 + g;
    const bf16* TE = ((bf16*)(F.ws + WS_TE)) + (size_t)pair * TE_ELEMS; const bf16* GM = ((bf16*)(F.ws + WS_G)) + (size_t)pair * G_ELEMS;
    u32x4 uv[8];
    { const bf16* up = ((bf16*)(F.ws + WS_U)) + (size_t)(b * 16 + g) * SEQ * 16;
#pragma unroll
      for (int i = 0; i < 8; ++i) { const int idx = tid + 512 * i; uv[i] = *(const u32x4*)(up + (size_t)idx * 8); } }
    bf16x8 gf[8];
#pragma unroll
    for (int ks = 0; ks < 8; ++ks) gf[ks] = *(const bf16x8*)(GM + (size_t)(16 * wave + fr) * 256 + 32 * ks + 8 * fq);
    const float ar = ((float*)(F.ws + WS_AT))[(size_t)pair * 128 + 2 * lane], ai = ((float*)(F.ws + WS_AT))[(size_t)pair * 128 + 2 * lane + 1];
    bf16x8 tfu[2][8], tfc[2][4];
#pragma unroll
    for (int half = 0; half < 2; ++half) { const int i = half ? 15 - wave : wave, nks = (i >> 1) + 1; const bf16* tp = TE + (size_t)(16 * i + fr) * 384 + 8 * fq;
#pragma unroll
        for (int ks = 0; ks < 8; ++ks) tfu[half][ks] = *(const bf16x8*)(tp + 32 * (ks < nks ? ks : 0));
#pragma unroll
        for (int ks = 0; ks < 4; ++ks) tfc[half][ks] = *(const bf16x8*)(tp + 256 + 32 * ks); }
#pragma unroll
    for (int i = 0; i < 8; ++i) { const int idx = tid + 512 * i, t = idx >> 1, hf = idx & 1; *(LAS u32x4*)(AU + (t >> 4) * APITCH + ((t & 15) * 16 + 8 * hf) * 2) = uv[i]; }
    __syncthreads();
    {
#pragma unroll
        for (int rt = 0; rt < 8; ++rt) { f32x4 acc = {0.f, 0.f, 0.f, 0.f};
#pragma unroll
            for (int ks = 0; ks < 8; ++ks) { const bf16x8 af = *(const LAS bf16x8*)(AU + (16 * rt + fr) * APITCH + (32 * ks + 8 * fq) * 2); acc = __builtin_amdgcn_mfma_f32_16x16x32_bf16(gf[ks], af, acc, 0, 0, 0); }
            *(LAS f32x4*)(SC + (16 * rt + fr) * APITCH + (16 * wave + 4 * fq) * 4) = acc; }
    }
    __syncthreads();
    {
        float lr = 0.f, li = 0.f, locr[16], loci[16];
#pragma unroll
        for (int k = 0; k < 16; ++k) { locr[k] = lr; loci[k] = li; const f32x2_t s = *(const LAS f32x2_t*)(SC + (16 * wave + k) * APITCH + lane * 8);
            const float nr = ar * lr - ai * li + s.x, ni = ar * li + ai * lr + s.y; lr = nr; li = ni; }
        seg[(wave * 64 + lane) * 2] = lr; seg[(wave * 64 + lane) * 2 + 1] = li;
        __syncthreads();
        float a16r = ar, a16i = ai;
#pragma unroll
        for (int q = 0; q < 4; ++q) { const float tr = a16r * a16r - a16i * a16i, ti = 2.f * a16r * a16i; a16r = tr; a16i = ti; }
        float ir = 0.f, ii = 0.f;
        for (int w2 = 0; w2 < wave; ++w2) { const float sr = seg[(w2 * 64 + lane) * 2], si = seg[(w2 * 64 + lane) * 2 + 1]; const float nr = a16r * ir - a16i * ii + sr, ni = a16r * ii + a16i * ir + si; ir = nr; ii = ni; }
        float pr = 1.f, pi = 0.f;
#pragma unroll
        for (int k = 0; k < 16; ++k) { const float cr = locr[k] + pr * ir - pi * ii, ci = loci[k] + pr * ii + pi * ir;
            *(LAS unsigned*)(SC + (16 * wave + k) * APITCH + lane * 4) = pk2(cr, ci);
            const float tr = pr * ar - pi * ai, ti = pr * ai + pi * ar; pr = tr; pi = ti; }
    }
    __syncthreads();
#pragma unroll
    for (int half = 0; half < 2; ++half) {
        const int i = half ? 15 - wave : wave;
        f32x4 acc[8];
#pragma unroll
        for (int rt = 0; rt < 8; ++rt) acc[rt] = (f32x4){0.f, 0.f, 0.f, 0.f};
        const int nks = (i >> 1) + 1;
#pragma unroll
        for (int ks = 0; ks < 8; ++ks) { if (ks < nks) {
#pragma unroll
            for (int rt = 0; rt < 8; ++rt) { const bf16x8 af = *(const LAS bf16x8*)(AU + (16 * rt + fr) * APITCH + (32 * ks + 8 * fq) * 2); acc[rt] = __builtin_amdgcn_mfma_f32_16x16x32_bf16(tfu[half][ks], af, acc[rt], 0, 0, 0); } } }
#pragma unroll
        for (int ks = 0; ks < 4; ++ks) {
#pragma unroll
            for (int rt = 0; rt < 8; ++rt) { const bf16x8 af = *(const LAS bf16x8*)(SC + (16 * rt + fr) * APITCH + (32 * ks + 8 * fq) * 2); acc[rt] = __builtin_amdgcn_mfma_f32_16x16x32_bf16(tfc[half][ks], af, acc[rt], 0, 0, 0); } }
#pragma unroll
        for (int rt = 0; rt < 8; ++rt) { const int chunk = 16 * rt + fr; u32x2 w; w.x = pk2(gelu_tanh_f(acc[rt][0]), gelu_tanh_f(acc[rt][1])); w.y = pk2(gelu_tanh_f(acc[rt][2]), gelu_tanh_f(acc[rt][3]));
            __hip_atomic_store((unsigned long long*)(((bf16*)(F.ws + WS_YPRE)) + ((size_t)(b * 16 + g) * SEQ + 16 * chunk + i) * 16 + 4 * fq), ((unsigned long long)w.y << 32) | w.x, __ATOMIC_RELAXED, __HIP_MEMORY_SCOPE_AGENT); }
    }
    asm volatile("s_waitcnt vmcnt(0)" ::: "memory");
    __syncthreads();
    if (tid == 0) __hip_atomic_fetch_add(F.ctl + CW_SSMDONE + 64 * (layer * NB + b), 1u, __ATOMIC_RELAXED, __HIP_MEMORY_SCOPE_AGENT);
}

__device__ __forceinline__ void glu_unit(const Params& P, Frame& F, int layer, int b, int j) {
    constexpr int APITCH = 528;
    LAS unsigned char* AT_ = F.lds;
    const int lane = F.lane, wave = F.wave, tid = F.tid, fr = lane & 15, fq = lane >> 4;
    const size_t tok0 = (size_t)b * SEQ + 128 * j;
    const bf16* wp = ((bf16*)(F.ws + WS_GLU)) + (size_t)layer * 65536 + (size_t)(32 * wave + fr) * 256 + 8 * fq;
    bf16x8 wf[8][2];
#pragma unroll
    for (int ks = 0; ks < 8; ++ks) { wf[ks][0] = *(const bf16x8*)(wp + 32 * ks); wf[ks][1] = *(const bf16x8*)(wp + 16 * 256 + 32 * ks); }
    if (tid == 0) { unsigned* c = F.ctl + CW_SSMDONE + 64 * (layer * NB + b); unsigned sp = 0;
        while (__hip_atomic_load(c, __ATOMIC_RELAXED, __HIP_MEMORY_SCOPE_AGENT) < 16u) { __builtin_amdgcn_s_sleep(2); if (++sp > (1u << 22)) break; }
        __builtin_amdgcn_fence(__ATOMIC_ACQUIRE, "agent"); asm volatile("s_waitcnt vmcnt(0)" ::: "memory"); }
    __syncthreads();
    { const bf16* yp = ((bf16*)(F.ws + WS_YPRE)) + ((size_t)b * 16 * SEQ + 128 * j) * 16;
#pragma unroll
      for (int i = 0; i < 8; ++i) { const int idx = tid + 512 * i, c = idx >> 7, t = idx & 127; const u32x4 v = *(const u32x4*)(yp + ((size_t)(c >> 1) * SEQ + t) * 16 + 8 * (c & 1)); *(LAS u32x4*)(AT_ + t * APITCH + c * 16) = v; } }
    f32x4 acc[8][2];
#pragma unroll
    for (int rt = 0; rt < 8; ++rt) { acc[rt][0] = (f32x4){0.f, 0.f, 0.f, 0.f}; acc[rt][1] = (f32x4){0.f, 0.f, 0.f, 0.f}; }
    __syncthreads();
#pragma unroll
    for (int ks = 0; ks < 8; ++ks)
#pragma unroll
        for (int rt = 0; rt < 8; ++rt) { const bf16x8 af = *(const LAS bf16x8*)(AT_ + (16 * rt + fr) * APITCH + (32 * ks + 8 * fq) * 2);
            acc[rt][0] = __builtin_amdgcn_mfma_f32_16x16x32_bf16(wf[ks][0], af, acc[rt][0], 0, 0, 0); acc[rt][1] = __builtin_amdgcn_mfma_f32_16x16x32_bf16(wf[ks][1], af, acc[rt][1], 0, 0, 0); }
    const float* gb = kin(12) + layer * 256;
#pragma unroll
    for (int nt = 0; nt < 2; ++nt) { const int n0 = 32 * wave + 16 * nt + 4 * fq; const f32x4 bv = *(const f32x4*)(gb + n0);
#pragma unroll
        for (int rt = 0; rt < 8; ++rt) { const int t = 16 * rt + fr; const u32x2 yp = *(const LAS u32x2*)(AT_ + t * APITCH + n0 * 2); const u32x2 sg = *(const u32x2*)(((bf16*)(F.ws + WS_SG)) + (tok0 + t) * 256 + n0);
            const f32x4 z = acc[rt][nt] + bv; u32x2 w;
            w.x = pk2(bflo(yp.x) * sigmoid_f(z[0]) * bflo(sg.x), bfhi(yp.x) * sigmoid_f(z[1]) * bfhi(sg.x));
            w.y = pk2(bflo(yp.y) * sigmoid_f(z[2]) * bflo(sg.y), bfhi(yp.y) * sigmoid_f(z[3]) * bfhi(sg.y));
            *(u32x2*)(((bf16*)(F.ws + WS_Y)) + (tok0 + t) * DM + n0) = w; } }
    __syncthreads();
}

__device__ __forceinline__ void mixer_phase(const Params& P, Frame& F, int qslot, int layer, int mask) {
    volatile LAS int* qw = (volatile LAS int*)(F.lds + LDS_CTL);
    unsigned* head = F.ctl + CW_QUEUE + 64 * qslot;
    for (;;) {
        if (F.tid == 0) qw[0] = (int)atomicAdd(head, 1u);
        __syncthreads();
        const int it = qw[0];
        __syncthreads();
        if (it >= 1536) break;
        Frame Fu = phase_frame(F);
#ifndef NO_MOBA
        if (it < 768 && (mask & 1)) { const int qb = 7 - it / 96, r = it % 96, b = r / 6, kvh = (r % 6) / 3, g = r % 3;
            if (mask & 8) moba_unit<1>(Fu, b, kvh, qb, g); else if (mask & 16) moba_unit<2>(Fu, b, kvh, qb, g);
#ifdef MOBA_PVAR
            else if (mask & 64) moba_unit<MOBA_PVAR>(Fu, b, kvh, qb, g);
#endif
            else moba_unit<0>(Fu, b, kvh, qb, g); }
#endif
#ifndef NO_SSM
        if (it >= 768 && it < 1024 && (mask & 2)) { const int r = it - 768; ssm_unit(Fu, layer, r >> 4, r & 15); }
#endif
#ifndef NO_SWA
        if (it >= 1024 && it < 1280 && (mask & 4)) { const int r = it - 1024; swa_unit(P, Fu, layer, r >> 4, (r >> 3) & 1, r & 7); }
#endif
        if (it >= 1280 && (mask & 32)) { const int r = it - 1280; glu_unit(P, Fu, layer, r >> 4, r & 15); }
    }
}

#define XB_TMO      128
#define XB_XCNT(j)  (256  + 64 * (j))
#define XB_XSUB(j)  (1280 + 64 * (j))
#define XB_XGEN(j)  (2304 + 64 * (j))
#define XB_TOP      3328
#define XB_TOPGEN   3392
#define XCD_BAR_WORDS 3456
#define XB_SPIN_CAP (1u << 18)

__device__ __forceinline__ unsigned xb_ld(unsigned* p)              { return __hip_atomic_load(p, __ATOMIC_RELAXED, __HIP_MEMORY_SCOPE_AGENT); }
__device__ __forceinline__ unsigned xb_add(unsigned* p, unsigned v) { return __hip_atomic_fetch_add(p, v, __ATOMIC_RELAXED, __HIP_MEMORY_SCOPE_AGENT); }
__device__ __forceinline__ unsigned xb_xcc_id() { return (unsigned)__builtin_amdgcn_s_getreg((3 << 11) | 20) & 0xFu; }
#define XB_SPIN(cond, bar) do { unsigned _sp = 0; while (cond) { __builtin_amdgcn_s_sleep(1); \
    if ((++_sp & 255u) == 0u) { if (xb_ld(&(bar)[XB_TMO])) break; if (_sp > XB_SPIN_CAP) { atomicAdd(&(bar)[XB_TMO], 1u); break; } } } } while (0)

struct XcdBarrier {
    unsigned* bar; unsigned x;
    volatile LAS unsigned* st;
};

__device__ __forceinline__ XcdBarrier xcd_barrier_post(unsigned* bar, volatile LAS unsigned* st) {
    XcdBarrier b; b.bar = bar; b.x = xb_xcc_id(); b.st = st;
    if (threadIdx.x == 0) (void)xb_add(&bar[XB_XCNT(b.x)], 1u);
    return b;
}
__device__ __forceinline__ void xcd_barrier_complete(unsigned* bar, unsigned x, unsigned& nloc, unsigned& nx) {
    const unsigned G = gridDim.x * gridDim.y * gridDim.z;
    unsigned sum, cnt, mine, sp = 0u;
    for (;;) {
        sum = 0u; cnt = 0u; mine = 0u;
#pragma unroll 1
        for (unsigned j = 0; j < 16; ++j) { const unsigned c = xb_ld(&bar[XB_XCNT(j)]); sum += c; cnt += (c > 0u) ? 1u : 0u; mine = (j == x) ? c : mine; }
        if (sum == G) break;
        __builtin_amdgcn_s_sleep(1);
        if ((++sp & 255u) == 0u) { if (xb_ld(&bar[XB_TMO])) break; if (sp > XB_SPIN_CAP) { atomicAdd(&bar[XB_TMO], 1u); break; } }
    }
    nloc = mine > 0u ? mine : 1u; nx = cnt > 0u ? cnt : 1u;
}

__device__ __forceinline__ void xcd_barrier(const XcdBarrier& b) {
    asm volatile("s_waitcnt vmcnt(0)" ::: "memory");
    __syncthreads();
    if (threadIdx.x == 0) {
        unsigned* bar = b.bar;
        __builtin_amdgcn_s_waitcnt(0);
        unsigned nloc = b.st[0], nx = b.st[1];
        if (nloc == 0u) { xcd_barrier_complete(bar, b.x, nloc, nx); b.st[0] = nloc; b.st[1] = nx; }
        const unsigned old = xb_add(&bar[XB_XSUB(b.x)], 1u);
        const unsigned gen = old / nloc;
        if (old + 1u == (gen + 1u) * nloc) {
            __builtin_amdgcn_fence(__ATOMIC_RELEASE, "agent");
            asm volatile("s_waitcnt vmcnt(0)" ::: "memory");
            const unsigned og = xb_add(&bar[XB_TOP], 1u);
            const unsigned tg = og / nx;
            if (og + 1u == (tg + 1u) * nx) xb_add(&bar[XB_TOPGEN], 1u);
            else XB_SPIN(xb_ld(&bar[XB_TOPGEN]) == tg, bar);
            __builtin_amdgcn_fence(__ATOMIC_ACQUIRE, "agent");
            xb_add(&bar[XB_XGEN(b.x)], 1u);
            asm volatile("s_waitcnt vmcnt(0)" ::: "memory");
        } else {
            XB_SPIN(xb_ld(&bar[XB_XGEN(b.x)]) == gen, bar);
            __builtin_amdgcn_fence(__ATOMIC_ACQUIRE, "agent");
            asm volatile("s_waitcnt vmcnt(0)" ::: "memory");
        }
    }
    __syncthreads();
}

constexpr int CW_BAR = 4096;
#ifndef USE_COOP_LAUNCH
#define USE_COOP_LAUNCH 0
#endif
#ifndef REP_P0
#define REP_P0 1
#endif
#ifndef REP_P1
#define REP_P1 1
#endif
#ifndef REP_MIX
#define REP_MIX 1
#endif
#ifndef REP_GLU
#define REP_GLU 1
#endif
#ifndef REP_P3L0
#define REP_P3L0 1
#endif
#ifndef REP_SYNC
#define REP_SYNC 1
#endif
#ifndef P3_PROBE_SKIP
#define P3_PROBE_SKIP 0
#endif
#ifndef MIX_EXTRA_MASK
#define MIX_EXTRA_MASK 39
#endif
#ifndef USE_CG_SYNC
#define USE_CG_SYNC 0
#endif
#define GRID_SYNC() do { for (int r_ = 0; r_ < REP_SYNC; ++r_) { if (USE_CG_SYNC) cg::this_grid().sync(); else xcd_barrier(xbar); } STAMP(); } while (0)
#ifdef PROBE_TS_A
#define STAMP() do { if (n_stamp == PROBE_TS_A) ts_a = __builtin_amdgcn_s_memrealtime(); if (n_stamp == PROBE_TS_B) ts_b = __builtin_amdgcn_s_memrealtime(); ++n_stamp; } while (0)
#else
#define STAMP() do {} while (0)
#endif
__global__ void __launch_bounds__(512, 2) mk_fwd(Params P) {
    extern __shared__ __attribute__((aligned(16))) unsigned char lds_raw[];
    Frame F;
    F.lds = (LAS unsigned char*)lds_raw; F.tid = threadIdx.x; F.lane = F.tid & 63; F.wave = __builtin_amdgcn_readfirstlane(F.tid >> 6); F.G = gridDim.x; F.bid = blockIdx.x;
    F.out = (float*)kin(19); F.ws = (unsigned char*)kin(20); F.ctl = (unsigned*)(F.ws + WS_CTL);
    if (F.tid < 128) ((LAS unsigned*)(F.lds + LDS_CTL))[F.tid] = 0u;
    __syncthreads();
    const XcdBarrier xbar = xcd_barrier_post(F.ctl + CW_BAR, (volatile LAS unsigned*)(F.lds + LDS_CTL + 16));

    int n_stamp = 0; unsigned long long ts_a = 0, ts_b = 0; (void)n_stamp; (void)ts_a; (void)ts_b;
    STAMP();
#ifndef NO_P0
    for (int rep = 0; rep < REP_P0; ++rep) { Frame Fp = phase_frame(F); p0_prologue(P, Fp); }
#endif
    GRID_SYNC();
#pragma unroll 1
    for (int layer = 0; layer < DEPTH; ++layer) {
#ifndef NO_P1
        for (int rep = 0; rep < REP_P1; ++rep) {
            Frame Fp = phase_frame(F);
            pg8::Gemm g{((bf16*)(Fp.ws + WS_Z)), ((bf16*)(Fp.ws + WS_Z)), ZROWS, ZROWS, DM}; const SchedTab S = make_sched<0>(Fp, NTT + 10 * layer);
            EpiProj E{NTT + 10 * layer, layer, Fp.ws};
            pg8::gemm_phase<EpiProj, SchedTab, true, true>(F.lds, g, S, E);
        }
#endif
        GRID_SYNC();
#ifndef NO_MIX
        for (int rep = 0; rep < REP_MIX; ++rep) { Frame Fp = phase_frame(F); mixer_phase(P, Fp, layer + 2 * rep, layer, rep ? MIX_EXTRA_MASK : 39); }
#endif
        GRID_SYNC();
#ifndef NO_P3
        for (int rep = 0; rep < (layer == 0 ? REP_P3L0 : 1); ++rep) {
            Frame Fp = phase_frame(F);
            pg8::Gemm g{((bf16*)(Fp.ws + WS_Y)), ((bf16*)(Fp.ws + WS_WOUT)) + (size_t)layer * DM * DM, MTOK, DM, DM}; const SchedTab S = make_sched<1>(Fp, 0);
            EpiOut E{kin(0), F.out, ((bf16*)(Fp.ws + WS_Z)), ((float*)(Fp.ws + WS_ROWSS)), layer + 1 < DEPTH ? 1 : 0, (LAS float*)(F.lds + LDS_MISC + 4096), (rep > 0 && P3_PROBE_SKIP) ? 1 : 0};
            pg8::gemm_phase<EpiOut, SchedTab, true, true>(F.lds, g, S, E);
        }
#endif
        if (layer + 1 < DEPTH) GRID_SYNC();
    }
#ifdef PROBE_TS_A
    GRID_SYNC();
    if (blockIdx.x == 0) { const unsigned long long n = (ts_b - ts_a) * PROBE_TS_MULT / PROBE_TS_DIV; for (unsigned long long i = threadIdx.x; i < n; i += 512) F.out[i] += 0.08f; }
#endif
}

extern "C" void kernel_launch(void* const* d_in, const int* in_sizes, int n_in, void* d_out, int out_size, void* d_ws, size_t ws_size, hipStream_t stream) {
    static int grid = 0;
    if (grid == 0) {
        if (n_in != 19 || out_size != MTOK * DM || ws_size < WS_END) { fprintf(stderr, "kernel_launch: unexpected problem (n_in %d out %d ws %zu)\n", n_in, out_size, ws_size); grid = -1; return; }
        int dev = 0, cus = 0, per_cu = 0;
        (void)hipGetDevice(&dev);
        (void)hipDeviceGetAttribute(&cus, hipDeviceAttributeMultiprocessorCount, dev);
        (void)hipFuncSetAttribute((const void*)mk_fwd, hipFuncAttributeMaxDynamicSharedMemorySize, LDS_BYTES);
        (void)hipOccupancyMaxActiveBlocksPerMultiprocessor(&per_cu, (const void*)mk_fwd, 512, LDS_BYTES);
        if (per_cu < 1) { fprintf(stderr, "kernel_launch: occupancy query says %d blocks per CU\n", per_cu); per_cu = 1; }
        grid = cus;
    }
    if (grid < 0) return;
    (void)hipMemsetAsync((char*)d_ws + WS_CTL, 0, CTL_BYTES, stream);
    Params p{};
    for (int i = 0; i < 19; ++i) p.in[i] = (const float*)d_in[i];
    p.out = (float*)d_out; p.ws = (unsigned char*)d_ws;
#if USE_COOP_LAUNCH
    void* args[] = {&p};
    hipError_t e = hipLaunchCooperativeKernel((const void*)mk_fwd, dim3(grid), dim3(512), args, LDS_BYTES, stream);
    if (e != hipSuccess) fprintf(stderr, "cooperative launch failed: %s (grid %d)\n", hipGetErrorString(e), grid);
#else
    hipLaunchKernelGGL(mk_fwd, dim3(grid), dim3(512), LDS_BYTES, stream, p);
    const hipError_t e = hipPeekAtLastError();
    if (e != hipSuccess) fprintf(stderr, "launch failed: %s (grid %d)\n", hipGetErrorString(e), grid);
#endif
}
```

```cpp
#include <hip/hip_runtime.h>
#include <hip/hip_cooperative_groups.h>
#include <cstdio>
#include <cstdint>
namespace cg = cooperative_groups;
namespace pg8 {
#define PG8_LAS __attribute__((address_space(3)))
typedef unsigned short bf16_t;
typedef short bf16x8 __attribute__((ext_vector_type(8)));
typedef float f32x4 __attribute__((ext_vector_type(4)));
typedef unsigned u32x4 __attribute__((ext_vector_type(4)));
constexpr int BM = 256, BK = 64, HALF = 128, HTB = HALF * BK * 2  , STAGE_BYTES = 8 * HTB, NXCD = 8, WGM = 8;

__host__ __device__ __forceinline__ int lds_byte(int r, int c) { const int st = (r >> 4) * 2 + (c >> 5), rr = r & 15, cc = c & 31, ob = rr * 64 + cc * 2; return st * 1024 + (ob ^ (((ob >> 9) & 1) << 5)); }
__host__ __device__ __forceinline__ void stage_rc(int b, int& R, int& C) { const int st = b / 1024, sb = b % 1024, swz = sb ^ (((sb >> 9) & 1) << 5); R = (st >> 1) * 16 + swz / 64; C = (st & 1) * 32 + (swz % 64) / 2; }
__host__ __device__ __forceinline__ int perm32(int rho) { const int n = rho >> 4, i = rho & 15; return 8 * (i >> 2) + 4 * n + (i & 3); }

struct Unit { int pm, pn; };
struct Gemm { const bf16_t* A; const bf16_t* Bt; int M, N, K; };

__device__ __forceinline__ unsigned cvt_pk_bf16(float lo, float hi) { unsigned r; asm volatile("v_cvt_pk_bf16_f32 %0, %1, %2" : "=v"(r) : "v"(lo), "v"(hi)); return r; }
typedef float f32x2 __attribute__((ext_vector_type(2)));
template <class Epi, class Sched, bool ALIGN_EPI = false, bool SP2 = false>
__device__ __forceinline__ void gemm_phase(PG8_LAS unsigned char* lds, const Gemm g, const Sched& S, const Epi& E) {
    int tid_ = threadIdx.x; asm volatile("" : "+v"(tid_));
    const int tid = tid_, wid = __builtin_amdgcn_readfirstlane(tid >> 6), lane = tid & 63, wr = wid >> 2, wc = wid & 3, fr = lane & 15, fq = lane >> 4;
    const int K = g.K, nt = K / BK;
    unsigned voffA[2], voffB[2];
#pragma unroll
    for (int i = 0; i < 2; ++i) { int R, C; stage_rc(tid * 16 + i * 8192, R, C); const int Rb = Epi::PERM ? ((R & ~31) + perm32(R & 31)) : R;
        voffA[i] = (unsigned)(R * K + C) * 2u; voffB[i] = (unsigned)(Rb * K + C) * 2u; }
    const size_t kstep = (size_t)(BK * 2);
    const size_t hstep = (size_t)HALF * K * 2;
    const size_t tstep = 2 * hstep;
    const unsigned ldsw = (unsigned)wid * 1024u;
    const int aoff = lds_byte(wr * 64 + fr, fq * 8), boff = lds_byte(wc * 32 + fr, fq * 8);
#define PG8_SA(b, h) (((b) * 2 + (h)) * HTB)
#define PG8_SB(b, h) ((4 + (b) * 2 + (h)) * HTB)
#define PG8_STAGE(bufoff, gbase, voff) do { _Pragma("unroll") for (int _i = 0; _i < 2; ++_i) \
        __builtin_amdgcn_global_load_lds((const unsigned*)((const char*)(gbase) + (voff)[_i]), (PG8_LAS unsigned*)(lds + (bufoff) + ldsw + _i * 8192), 16, 0, 0); } while (0)
#define PG8_LDA(dst, b, h) do { _Pragma("unroll") for (int m = 0; m < 4; ++m) _Pragma("unroll") for (int k = 0; k < 2; ++k) dst[m][k] = *(const PG8_LAS bf16x8*)(lds + PG8_SA(b, h) + aoff + m * 2048 + k * 1024); } while (0)
#define PG8_LDB(dst, b, h) do { _Pragma("unroll") for (int n = 0; n < 2; ++n) _Pragma("unroll") for (int k = 0; k < 2; ++k) dst[n][k] = *(const PG8_LAS bf16x8*)(lds + PG8_SB(b, h) + boff + n * 2048 + k * 1024); } while (0)
#define PG8_MMA(ai, bj, At, Bt) do { __builtin_amdgcn_s_setprio(1); _Pragma("unroll") for (int m = 0; m < 4; ++m) _Pragma("unroll") for (int n = 0; n < 2; ++n) _Pragma("unroll") for (int k = 0; k < 2; ++k) \
        acc[ai][bj][m][n] = __builtin_amdgcn_mfma_f32_16x16x32_bf16(Bt[n][k], At[m][k], acc[ai][bj][m][n], 0, 0, 0); __builtin_amdgcn_s_setprio(0); } while (0)
#define PG8_WAIT_V(n) asm volatile("s_waitcnt vmcnt(" #n ")" ::: "memory")
#define PG8_WAIT_L(n) asm volatile("s_waitcnt lgkmcnt(" #n ")" ::: "memory")
#define PG8_BAR __builtin_amdgcn_s_barrier()
#define PG8_SCHED __builtin_amdgcn_sched_barrier(0)
    Unit cur, nxt; int ui = 0;
    if (!S.next(0, cur)) return;
    f32x4 acc[2][2][4][2];
#pragma unroll
    for (int a = 0; a < 2; ++a)
#pragma unroll
        for (int b = 0; b < 2; ++b)
#pragma unroll
            for (int m = 0; m < 4; ++m)
#pragma unroll
                for (int n = 0; n < 2; ++n) acc[a][b][m][n] = (f32x4){0.f, 0.f, 0.f, 0.f};
    bf16x8 At[4][2], B0[2][2], B1[2][2];
    const char* cA = (const char*)g.A + (size_t)cur.pm * tstep; const char* cB = (const char*)g.Bt + (size_t)cur.pn * tstep;
    S.a_ready(cur);
    if constexpr (SP2) {
        PG8_STAGE(PG8_SB(0, 0), cB, voffB); PG8_STAGE(PG8_SB(0, 1), cB + hstep, voffB); PG8_STAGE(PG8_SA(0, 0), cA, voffA); PG8_STAGE(PG8_SA(0, 1), cA + hstep, voffA);
        if (wr == 1) PG8_BAR;
        PG8_WAIT_V(2); PG8_BAR;
        PG8_STAGE(PG8_SB(1, 0), cB + kstep, voffB); PG8_STAGE(PG8_SA(1, 0), cA + kstep, voffA); PG8_STAGE(PG8_SB(1, 1), cB + hstep + kstep, voffB);
        PG8_WAIT_V(6); PG8_BAR;
    } else {
        PG8_STAGE(PG8_SB(0, 0), cB, voffB); PG8_STAGE(PG8_SA(0, 0), cA, voffA); PG8_STAGE(PG8_SB(0, 1), cB + hstep, voffB); PG8_STAGE(PG8_SA(0, 1), cA + hstep, voffA);
        if (wr == 1) PG8_BAR;
        PG8_WAIT_V(4); PG8_BAR;
        PG8_STAGE(PG8_SB(1, 0), cB + kstep, voffB); PG8_STAGE(PG8_SA(1, 0), cA + kstep, voffA); PG8_STAGE(PG8_SB(1, 1), cB + hstep + kstep, voffB);
        PG8_WAIT_V(6); PG8_BAR;
    }
    for (;;) {
        const bool has_next = S.next(ui + 1, nxt);
        const char* nA = has_next ? (const char*)g.A + (size_t)nxt.pm * tstep : cA; const char* nB = has_next ? (const char*)g.Bt + (size_t)nxt.pn * tstep : cB;
        for (int t = 0; t < nt; t += 2) {
            const bool last = (t == nt - 2);
            const char* a1 = cA + (size_t)(t + 1) * kstep;
            const char* a2 = last ? nA : cA + (size_t)(t + 2) * kstep; const char* b2 = last ? nB : cB + (size_t)(t + 2) * kstep;
            const char* a3 = a2 + kstep; const char* b3 = b2 + kstep;
            if (last && has_next) S.a_ready(nxt);
            if constexpr (SP2) {
            PG8_LDB(B0, 0, 0); PG8_LDB(B1, 0, 1); PG8_SCHED; PG8_LDA(At, 0, 0); PG8_STAGE(PG8_SA(1, 1), a1 + hstep, voffA);
            PG8_WAIT_V(8); PG8_WAIT_L(0); PG8_BAR; PG8_MMA(0, 0, At, B0); PG8_MMA(0, 1, At, B1); PG8_BAR; PG8_SCHED;
            PG8_LDA(At, 0, 1); PG8_STAGE(PG8_SB(0, 0), b2, voffB); PG8_STAGE(PG8_SB(0, 1), b2 + hstep, voffB); PG8_STAGE(PG8_SA(0, 0), a2, voffA);
            PG8_WAIT_V(8); PG8_WAIT_L(0); PG8_BAR; PG8_MMA(1, 0, At, B0); PG8_MMA(1, 1, At, B1); PG8_BAR; PG8_SCHED;
            PG8_LDB(B0, 1, 0); PG8_LDB(B1, 1, 1); PG8_SCHED; PG8_LDA(At, 1, 0); PG8_STAGE(PG8_SA(0, 1), a2 + hstep, voffA);
            PG8_WAIT_V(8); PG8_WAIT_L(0); PG8_BAR; PG8_MMA(0, 0, At, B0); PG8_MMA(0, 1, At, B1); PG8_BAR; PG8_SCHED;
            PG8_LDA(At, 1, 1); PG8_STAGE(PG8_SB(1, 0), b3, voffB); PG8_STAGE(PG8_SB(1, 1), b3 + hstep, voffB); PG8_STAGE(PG8_SA(1, 0), a3, voffA);
            PG8_WAIT_V(8); PG8_WAIT_L(0); PG8_BAR; PG8_MMA(1, 0, At, B0); PG8_MMA(1, 1, At, B1); PG8_BAR; PG8_SCHED;
            } else {
            PG8_LDB(B0, 0, 0); PG8_SCHED; PG8_LDA(At, 0, 0); PG8_STAGE(PG8_SA(1, 1), a1 + hstep, voffA);
            PG8_WAIT_L(8); PG8_BAR; PG8_WAIT_L(0); PG8_MMA(0, 0, At, B0); PG8_BAR; PG8_SCHED;
            PG8_LDB(B1, 0, 1); PG8_STAGE(PG8_SB(0, 0), b2, voffB);
            PG8_BAR; PG8_WAIT_L(0); PG8_MMA(0, 1, At, B1); PG8_BAR;
            PG8_LDA(At, 0, 1); PG8_STAGE(PG8_SA(0, 0), a2, voffA);
            PG8_BAR; PG8_WAIT_L(0); PG8_MMA(1, 0, At, B0); PG8_BAR; PG8_SCHED;
            PG8_STAGE(PG8_SB(0, 1), b2 + hstep, voffB);
            PG8_WAIT_V(6); PG8_BAR; PG8_MMA(1, 1, At, B1); PG8_BAR;
            PG8_LDB(B0, 1, 0); PG8_SCHED; PG8_LDA(At, 1, 0); PG8_STAGE(PG8_SA(0, 1), a2 + hstep, voffA);
            PG8_WAIT_L(8); PG8_BAR; PG8_WAIT_L(0); PG8_MMA(0, 0, At, B0); PG8_BAR; PG8_SCHED;
            PG8_LDB(B1, 1, 1); PG8_STAGE(PG8_SB(1, 0), b3, voffB);
            PG8_BAR; PG8_WAIT_L(0); PG8_MMA(0, 1, At, B1); PG8_BAR;
            PG8_LDA(At, 1, 1); PG8_STAGE(PG8_SA(1, 0), a3, voffA);
            PG8_BAR; PG8_WAIT_L(0); PG8_MMA(1, 0, At, B0); PG8_BAR; PG8_SCHED;
            PG8_STAGE(PG8_SB(1, 1), b3 + hstep, voffB);
            PG8_WAIT_V(6); PG8_BAR; PG8_MMA(1, 1, At, B1); PG8_BAR;
            }
        }
        if constexpr (ALIGN_EPI) { if (wr == 0) PG8_BAR; }
        if constexpr (!Epi::AFTER_DRAIN) { E(acc, cur, wr, wc, fr, fq); S.done(cur); }
        if (!has_next) break;
#pragma unroll
        for (int a = 0; a < 2; ++a)
#pragma unroll
            for (int b = 0; b < 2; ++b)
#pragma unroll
                for (int m = 0; m < 4; ++m)
#pragma unroll
                    for (int n = 0; n < 2; ++n) acc[a][b][m][n] = (f32x4){0.f, 0.f, 0.f, 0.f};
        cur = nxt; cA = nA; cB = nB; ++ui;
        if constexpr (ALIGN_EPI) { if (wr == 1) PG8_BAR; }
    }
    PG8_WAIT_V(0);
    if constexpr (!ALIGN_EPI) { if (wr == 0) PG8_BAR; }
    PG8_BAR;
    if constexpr (Epi::AFTER_DRAIN) { E.fused(acc, cur, wr, wc, fr, fq, lds, wid, lane); S.done(cur); }
#undef PG8_SA
#undef PG8_SB
#undef PG8_STAGE
#undef PG8_LDA
#undef PG8_LDB
#undef PG8_MMA
#undef PG8_WAIT_V
#undef PG8_WAIT_L
#undef PG8_BAR
#undef PG8_SCHED
}
}

#define GAS __attribute__((address_space(1)))
#define LAS __attribute__((address_space(3)))
typedef unsigned short bf16;
typedef short bf16x8 __attribute__((ext_vector_type(8)));
typedef float f32x4 __attribute__((ext_vector_type(4)));
typedef float f32x16 __attribute__((ext_vector_type(16)));
typedef unsigned u32x4 __attribute__((ext_vector_type(4)));
typedef unsigned u32x2 __attribute__((ext_vector_type(2)));
typedef float f32x2_t __attribute__((ext_vector_type(2)));
typedef __bf16 bf16x2_t __attribute__((ext_vector_type(2)));
using pg8::Unit;

constexpr int NB = 16, SEQ = 2048, MTOK = NB * SEQ, DM = 1024, NPROJ = 2560, DEPTH = 2;
constexpr int NTT = MTOK / 256;
constexpr int ZROWS = MTOK + DEPTH * NPROJ;
constexpr float RMS_EPS = 1e-6f;
constexpr float LOG2E = 1.4426950408889634f;
constexpr float QSCALE = 0.125f * LOG2E;
constexpr int LDS_BYTES = 147456;
constexpr int LDS_MISC = 131072;
constexpr int LDS_CTL = LDS_BYTES - 512;

constexpr size_t MiB = 1u << 20;
constexpr size_t WS_CTL = 0, CTL_BYTES = 64 * 1024;
constexpr size_t WS_Z = 2 * MiB, WS_WOUT = 78 * MiB, WS_GLU = 82 * MiB, WS_TE = 83 * MiB, WS_G = 89 * MiB, WS_AT = 91 * MiB;
constexpr size_t WS_U = 92 * MiB, WS_SG = 108 * MiB, WS_AQ = 124 * MiB, WS_AK = 148 * MiB, WS_AG = 156 * MiB, WS_MQ = 180 * MiB, WS_MK = 204 * MiB, WS_MG = 212 * MiB;
constexpr size_t WS_VT = 236 * MiB, WS_KPART = 252 * MiB, WS_ROWSS = 253 * MiB, WS_YPRE = 254 * MiB, WS_Y = 270 * MiB, WS_END = 334 * MiB;
static_assert(WS_Z + (size_t)ZROWS * DM * 2 <= WS_WOUT, "Z fits");
constexpr size_t WS_NW = 1 * MiB;
constexpr int TE_ELEMS = 256 * 384, G_ELEMS = 128 * 256;
constexpr int CW_QUEUE = 1024;
constexpr int CW_SSMDONE = 8192;

__device__ __forceinline__ unsigned pk2(float lo, float hi) { f32x2_t v = {lo, hi}; bf16x2_t b = __builtin_convertvector(v, bf16x2_t); return __builtin_bit_cast(unsigned, b); }
__device__ __forceinline__ float bf2f(unsigned short x) { return __uint_as_float((unsigned)x << 16); }
__device__ __forceinline__ float bflo(unsigned w) { return __uint_as_float(w << 16); }
__device__ __forceinline__ float bfhi(unsigned w) { return __uint_as_float(w & 0xffff0000u); }
__device__ __forceinline__ float wave_sum(float v) {
#pragma unroll
    for (int o = 1; o < 64; o <<= 1) v += __shfl_xor(v, o);
    return v;
}
__device__ __forceinline__ float fast_rcp(float x) { return __builtin_amdgcn_rcpf(x); }
__device__ __forceinline__ float silu_f(float x) { return x * fast_rcp(1.f + __builtin_amdgcn_exp2f(-x * LOG2E)); }
__device__ __forceinline__ float sigmoid_f(float x) { return fast_rcp(1.f + __builtin_amdgcn_exp2f(-x * LOG2E)); }
__device__ __forceinline__ float gelu_tanh_f(float x) { const float z = 0.7978845608028654f * (x + 0.044715f * x * x * x); return x * fast_rcp(1.f + __builtin_amdgcn_exp2f(-2.f * LOG2E * z)); }
__device__ __forceinline__ float swap32_max(float m) { auto rr = __builtin_amdgcn_permlane32_swap(__float_as_uint(m), __float_as_uint(m), false, false); return fmaxf(__uint_as_float(rr[0]), __uint_as_float(rr[1])); }
__device__ __forceinline__ float swap32_sum(float m) { auto rr = __builtin_amdgcn_permlane32_swap(__float_as_uint(m), __float_as_uint(m), false, false); return __uint_as_float(rr[0]) + __uint_as_float(rr[1]); }
__device__ __forceinline__ void glds16(const void* gsrc, LAS unsigned char* ldst) {
    const unsigned dst = __builtin_amdgcn_readfirstlane((unsigned)(uintptr_t)ldst); unsigned keep;
    asm volatile("s_mov_b32 %0, m0\n\ts_mov_b32 m0, %2\n\ts_nop 0\n\tglobal_load_lds_dwordx4 %1, off\n\ts_mov_b32 m0, %0" : "=&s"(keep) : "v"(gsrc), "s"(dst) : "memory");
}
#define GLDS_WAIT() asm volatile("s_waitcnt vmcnt(0)" ::: "memory")

struct Params {
    const float* in[19]; float* out; unsigned char* ws;
};
typedef const float* const __attribute__((address_space(4))) * kargs_t;
__device__ __forceinline__ const float* kin(int i) { kargs_t ka = (kargs_t)__builtin_amdgcn_kernarg_segment_ptr(); asm volatile("" : "+s"(ka)); return ka[i]; }
struct Frame {
    LAS unsigned char* lds; int tid, lane, wave, G, bid; float* out; unsigned char* ws; unsigned* ctl;
};

__device__ __forceinline__ int proj_dest_row(int n0) {
    int slot, off;
    if (n0 < 512)       { slot = n0 >> 6; off = n0 & 63; }
    else if (n0 < 1024) { slot = 8 + ((n0 - 512) >> 6); off = n0 & 63; }
    else if (n0 < 1152) { return 2304 + (n0 - 1024); }
    else if (n0 < 1536) { slot = 16 + ((n0 - 1152) >> 6); off = (n0 - 1152) & 63; }
    else if (n0 < 1920) { slot = 22 + ((n0 - 1536) >> 6); off = (n0 - 1536) & 63; }
    else if (n0 < 2048) { slot = 28 + ((n0 - 1920) >> 6); off = (n0 - 1920) & 63; }
    else if (n0 < 2176) { return 2304 + 128 + (n0 - 2048); }
    else                { slot = 30 + ((n0 - 2176) >> 6); off = (n0 - 2176) & 63; }
    const int t = slot >> 2, wc = slot & 3;
    return 256 * t + 128 * (off >> 5) + 32 * wc;
}
__device__ __forceinline__ void p0_transpose_item(const float* W, int K, int N, const float* gk, bf16* WT, int ldk, int drow0, LAS float* scr, int k0, int n0, int lane) {
#pragma unroll 8
    for (int i = 0; i < 32; ++i) { const int kk = 2 * i + (lane >> 5); float v = W[(size_t)(k0 + kk) * N + n0 + (lane & 31)]; if (gk) v *= gk[k0 + kk]; scr[kk * 33 + (lane & 31)] = v; }
    asm volatile("s_waitcnt lgkmcnt(0)" ::: "memory");
    const int c = lane & 7;
#pragma unroll
    for (int j = 0; j < 4; ++j) { const int n = (lane >> 3) + 8 * j; const LAS float* s = scr + (8 * c) * 33 + n;
        u32x4 o; o.x = pk2(s[0 * 33], s[1 * 33]); o.y = pk2(s[2 * 33], s[3 * 33]); o.z = pk2(s[4 * 33], s[5 * 33]); o.w = pk2(s[6 * 33], s[7 * 33]);
        *(u32x4*)(WT + (size_t)(drow0 + n) * ldk + k0 + 8 * c) = o; }
    asm volatile("s_waitcnt lgkmcnt(0)" ::: "memory");
}
__device__ __forceinline__ void p0_ssm_consts(const Params& P, Frame& F, int pair) {
    const int l = pair >> 4, g = pair & 15, tid = F.tid;
    LAS float* pwr = (LAS float*)(F.lds);
    LAS float* pwi = pwr + 17 * 64;
    LAS float* bbr = pwi + 17 * 64;
    LAS float* bbi = bbr + 1024;
    LAS float* ccr = bbi + 1024;
    LAS float* cci = ccr + 1024;
    LAS float* Kt = cci + 1024;
    const float dt = expf(kin(5)[l * 16 + g]);
    const float* lre = kin(3) + (l * 16 + g) * 64; const float* lim = kin(4) + (l * 16 + g) * 64;
    for (int t = tid; t < 17 * 64; t += 512) { const int p = t & 63, lag = t >> 6; const float lr = lre[p], li = lim[p];
        const float mag = expf(lr * dt * (float)lag); float sn, cs; sincosf(li * dt * (float)lag, &sn, &cs); pwr[t] = mag * cs; pwi[t] = mag * sn; }
    for (int t = tid; t < 1024; t += 512) { const int p = t >> 4, h = t & 15; const float lr = lre[p], li = lim[p];
        const float mag = expf(lr * dt); float sn, cs; sincosf(li * dt, &sn, &cs); const float ar = mag * cs, ai = mag * sn;
        const float den = lr * lr + li * li, nr = ar - 1.f, ni = ai; const float cr = (nr * lr + ni * li) / den, ci = (ni * lr - nr * li) / den;
        const float br = kin(6)[((size_t)(l * 16 + g) * 64 + p) * 16 + h], bi = kin(7)[((size_t)(l * 16 + g) * 64 + p) * 16 + h];
        bbr[t] = cr * br - ci * bi; bbi[t] = cr * bi + ci * br; }
    for (int t = tid; t < 1024; t += 512) { ccr[t] = kin(8)[(size_t)(l * 16 + g) * 1024 + t]; cci[t] = kin(9)[(size_t)(l * 16 + g) * 1024 + t]; }
    __syncthreads();
    for (int t = tid; t < 4096; t += 512) { const int lag = t >> 8, hp = (t >> 4) & 15, h = t & 15; float s = 0.f;
        for (int p = 0; p < 64; ++p) { const float cr = ccr[hp * 64 + p], ci = cci[hp * 64 + p], pr = pwr[lag * 64 + p], pi = pwi[lag * 64 + p];
            const float xr = cr * pr - ci * pi, xi = cr * pi + ci * pr; s += xr * bbr[p * 16 + h] - xi * bbi[p * 16 + h]; }
        if (lag == 0 && hp == h) s += kin(10)[l * 256 + g * 16 + h];
        Kt[t] = s; }
    __syncthreads();
    bf16* TE = ((bf16*)(F.ws + WS_TE)) + (size_t)pair * TE_ELEMS; bf16* GM = ((bf16*)(F.ws + WS_G)) + (size_t)pair * G_ELEMS;
    for (int t = tid; t < 256 * 192; t += 512) { const int n = t / 192, kp = t % 192, k = 2 * kp; const int i = n >> 4, hp = n & 15; float v0, v1;
        if (k < 256) { const int j = k >> 4, h = k & 15; if (j <= i) { v0 = Kt[((i - j) * 16 + hp) * 16 + h]; v1 = Kt[((i - j) * 16 + hp) * 16 + h + 1]; } else { v0 = 0.f; v1 = 0.f; } }
        else { const int p = (k - 256) >> 1; const float cr = ccr[hp * 64 + p], ci = cci[hp * 64 + p], pr = pwr[(i + 1) * 64 + p], pi = pwi[(i + 1) * 64 + p];
            v0 = cr * pr - ci * pi; v1 = -(cr * pi + ci * pr); }
        *(unsigned*)(TE + (size_t)n * 384 + k) = pk2(v0, v1); }
    for (int t = tid; t < 128 * 128; t += 512) { const int n = t >> 7, kp = t & 127, k = 2 * kp; const int p = n >> 1, ri = n & 1, j = k >> 4, h = k & 15;
        const float pr = pwr[(15 - j) * 64 + p], pi = pwi[(15 - j) * 64 + p];
        float v0, v1;
        { const float br = bbr[p * 16 + h], bi = bbi[p * 16 + h]; v0 = ri ? (pr * bi + pi * br) : (pr * br - pi * bi); }
        { const float br = bbr[p * 16 + h + 1], bi = bbi[p * 16 + h + 1]; v1 = ri ? (pr * bi + pi * br) : (pr * br - pi * bi); }
        *(unsigned*)(GM + (size_t)n * 256 + k) = pk2(v0, v1); }
    if (tid < 64) { ((float*)(F.ws + WS_AT))[(size_t)pair * 128 + 2 * tid] = pwr[16 * 64 + tid]; ((float*)(F.ws + WS_AT))[(size_t)pair * 128 + 2 * tid + 1] = pwi[16 * 64 + tid]; }
    __syncthreads();
}
__device__ __forceinline__ void p0_prologue(const Params& P, Frame& F) {
    const bool split = F.G > 64;
    if (!split || F.bid < 32) { for (int pair = F.bid; pair < 32; pair += (split ? 32 : F.G)) p0_ssm_consts(P, F, pair); if (split) return; }
    const int vb = split ? F.bid - 32 : F.bid, nvb = split ? F.G - 32 : F.G;
    if (vb == 0) { float* nwp = (float*)(F.ws + WS_NW);
        for (int t = F.tid; t < DEPTH * 256; t += 512) { const int l = t >> 8, k = (t >> 6) & 3, d = t & 63;
            nwp[t] = (k == 0) ? kin(13)[l * 64 + d] * QSCALE : (k == 1) ? kin(14)[l * 64 + d] : (k == 2) ? kin(16)[l * 64 + d] * QSCALE : kin(17)[l * 64 + d]; } }
    const int gw = vb * 8 + F.wave, NGW = nvb * 8;
    LAS float* scr = (LAS float*)(F.lds + F.wave * 16384);
    constexpr int I_IN = 16 * 80, I_OUT = 16 * 32, I_GLU = 4 * 8, I_L = I_IN + I_OUT + I_GLU;
    for (int it = gw; it < DEPTH * I_L; it += NGW) {
        const int l = it / I_L; int r = it % I_L;
        if (r < I_IN) { const int kb = r / 80, nb = r % 80; p0_transpose_item(kin(2) + (size_t)l * DM * NPROJ, DM, NPROJ, kin(1) + l * DM, ((bf16*)(F.ws + WS_Z)) + (size_t)(MTOK + l * NPROJ) * DM, DM, proj_dest_row(32 * nb), scr, 64 * kb, 32 * nb, F.lane); continue; }
        r -= I_IN;
        if (r < I_OUT) { const int kb = r / 32, nb = r % 32; p0_transpose_item(kin(18) + (size_t)l * DM * DM, DM, DM, nullptr, ((bf16*)(F.ws + WS_WOUT)) + (size_t)l * DM * DM, DM, 32 * nb, scr, 64 * kb, 32 * nb, F.lane); continue; }
        r -= I_OUT;
        { const int kb = r / 8, nb = r % 8; p0_transpose_item(kin(11) + (size_t)l * 65536, 256, 256, nullptr, ((bf16*)(F.ws + WS_GLU)) + (size_t)l * 65536, 256, 32 * nb, scr, 64 * kb, 32 * nb, F.lane); }
    }
    for (int m0 = gw; m0 < MTOK; m0 += 4 * NGW) {
        f32x4 v[4][4];
#pragma unroll
        for (int q = 0; q < 4; ++q) { const int m = m0 + q * NGW; if (m < MTOK) { const f32x4* xr = (const f32x4*)(kin(0) + (size_t)m * DM) + F.lane;
#pragma unroll
            for (int j = 0; j < 4; ++j) v[q][j] = __builtin_nontemporal_load(xr + 64 * j); } }
#pragma unroll
        for (int q = 0; q < 4; ++q) { const int m = m0 + q * NGW; if (m < MTOK) { float s = 0.f;
#pragma unroll
            for (int j = 0; j < 4; ++j) s += (v[q][j].x * v[q][j].x + v[q][j].y * v[q][j].y) + (v[q][j].z * v[q][j].z + v[q][j].w * v[q][j].w);
            s = wave_sum(s);
            u32x2* o8 = (u32x2*)(((bf16*)(F.ws + WS_Z)) + (size_t)m * DM) + F.lane;
#pragma unroll
            for (int j = 0; j < 4; ++j) { u32x2 w; w.x = pk2(v[q][j].x, v[q][j].y); w.y = pk2(v[q][j].z, v[q][j].w); o8[64 * j] = w; }
            if (F.lane < 4) ((float*)(F.ws + WS_ROWSS))[(size_t)m * 4 + F.lane] = (F.lane == 0) ? s : 0.f; } }
    }
}

__device__ __forceinline__ Frame phase_frame(const Frame& F0) {
    Frame F = F0; asm volatile("" : "+v"(F.tid)); F.lane = F.tid & 63; F.wave = __builtin_amdgcn_readfirstlane(F.tid >> 6);
    asm volatile("" : "+s"(F.ws)); F.ctl = (unsigned*)(F.ws + WS_CTL); return F;
}
struct SchedTab { const volatile LAS int* tab; int n;
    __device__ __forceinline__ bool next(int i, Unit& u) const { if (i >= n) return false; u.pm = __builtin_amdgcn_readfirstlane(tab[2 * i]); u.pn = __builtin_amdgcn_readfirstlane(tab[2 * i + 1]); return true; }
    __device__ __forceinline__ void a_ready(const Unit&) const {}
    __device__ __forceinline__ void done(const Unit&) const {}
};
__device__ __forceinline__ bool unit_p1(int G, int c, int wbase, int i, int& pm, int& pn) {
    int tok, j;
    if (G == 256) { if (i >= 5) return false; const int x = c & 7, l = c >> 3, n = i * 32 + l, tq = n / 40, rem = n % 40; j = rem >> 2; tok = 16 * x + 4 * tq + (rem & 3); }
    else { const long L = (long)i * G + c; if (L >= NTT * 10) return false; tok = (int)(L / 10); j = (int)(L % 10); }
    if (j < 9) { pm = tok; pn = wbase + j; } else { pm = wbase + 9; pn = tok; }
    return true;
}
__device__ __forceinline__ bool unit_p3(int G, int c, int i, int& pm, int& pn) {
    if (G == 256) { if (i >= 2) return false; const int x = c & 7, l = c >> 3, n = i * 32 + l, tq = n >> 4, rem = n & 15; pn = rem >> 2; pm = 16 * x + 4 * tq + (rem & 3); }
    else { const long L = (long)i * G + c; if (L >= NTT * 4) return false; pm = (int)(L / 4); pn = (int)(L % 4); }
    return true;
}
__device__ __forceinline__ bool unit_glu(int G, int c, int i, int& pm, int& pn) {
    if (G == 256) { if (i >= 1 || (c >> 3) >= 16) return false; pm = 16 * (c & 7) + (c >> 3); pn = 0; }
    else { const long L = (long)i * G + c; if (L >= NTT) return false; pm = (int)L; pn = 0; }
    return true;
}
template <int KIND>
__device__ __forceinline__ SchedTab make_sched(const Frame& F, int wbase) {
    volatile LAS int* tab = (volatile LAS int*)(F.lds + LDS_CTL + 64);
    volatile LAS int* cnt = (volatile LAS int*)(F.lds + LDS_CTL + 32);
    if (F.tid == 0) { int n = 0;
#pragma unroll 1
        for (int i = 0; i < 24; ++i) { int pm, pn; const bool ok = (KIND == 0) ? unit_p1(F.G, F.bid, wbase, i, pm, pn) : (KIND == 1) ? unit_p3(F.G, F.bid, i, pm, pn) : unit_glu(F.G, F.bid, i, pm, pn);
            if (!ok) break; tab[2 * i] = pm; tab[2 * i + 1] = pn; n = i + 1; }
        cnt[0] = n; }
    __syncthreads();
    SchedTab S; S.tab = tab; S.n = __builtin_amdgcn_readfirstlane(cnt[0]); return S;
}

struct EpiProj {
    static constexpr bool PERM = true, AFTER_DRAIN = false;
    int wbase, layer; unsigned char* ws;
    __device__ __forceinline__ void operator()(const f32x4 (&acc)[2][2][4][2], const Unit& u, int wr, int wc, int fr, int fq) const {
        asm volatile("" : "+v"(fr), "+v"(fq));
        const float* rowss = (const float*)(ws + WS_ROWSS);
        if (u.pm >= NTT) {
            bf16* VT = (bf16*)(ws + WS_VT);
            const int tc = u.pn * 256 + wc * 32 + 8 * fq;
#pragma unroll
            for (int bj = 0; bj < 2; ++bj) {
                float rs[8];
                { f32x4 p[8];
#pragma unroll
                  for (int e = 0; e < 8; ++e) p[e] = *(const f32x4*)(rowss + (size_t)(tc + bj * 128 + e) * 4);
#pragma unroll
                  for (int e = 0; e < 8; ++e) rs[e] = rsqrtf(((p[e].x + p[e].y) + (p[e].z + p[e].w)) * (1.f / DM) + RMS_EPS); }
#pragma unroll
                for (int ai = 0; ai < 2; ++ai)
#pragma unroll
                    for (int m = 0; m < 4; ++m) { const int f = ai * 128 + wr * 64 + m * 16 + fr; const f32x4 a = acc[ai][bj][m][0], b = acc[ai][bj][m][1]; u32x4 w;
                        w.x = pk2(a[0] * rs[0], a[1] * rs[1]); w.y = pk2(a[2] * rs[2], a[3] * rs[3]); w.z = pk2(b[0] * rs[4], b[1] * rs[5]); w.w = pk2(b[2] * rs[6], b[3] * rs[7]);
                        *(u32x4*)(VT + ((size_t)u.pn * 256 + f) * 256 + (wc * 32 + 8 * fq + bj * 128)) = w; }
            }
            return;
        }
        const int t = u.pn - wbase;
        int kind, pitch, col, nwi = 0; size_t dsto;
        switch (t) {
            case 0: kind = 0; dsto = WS_U; pitch = 256; col = 64 * wc; break;
            case 1: kind = 1; dsto = WS_SG; pitch = 256; col = 64 * wc; break;
            case 2: kind = 2; dsto = WS_AQ; pitch = 384; col = 64 * wc; nwi = 0; break;
            case 3: if (wc < 2) { kind = 2; dsto = WS_AQ; pitch = 384; col = 64 * (4 + wc); nwi = 0; } else { kind = 2; dsto = WS_AK; pitch = 128; col = 64 * (wc - 2); nwi = 1; } break;
            case 4: kind = 1; dsto = WS_AG; pitch = 384; col = 64 * wc; break;
            case 5: if (wc < 2) { kind = 1; dsto = WS_AG; pitch = 384; col = 64 * (4 + wc); } else { kind = 2; dsto = WS_MQ; pitch = 384; col = 64 * (wc - 2); nwi = 2; } break;
            case 6: kind = 2; dsto = WS_MQ; pitch = 384; col = 64 * (2 + wc); nwi = 2; break;
            case 7: if (wc < 2) { kind = 5; dsto = WS_MK; pitch = 128; col = 64 * wc; nwi = 3; } else { kind = 1; dsto = WS_MG; pitch = 384; col = 64 * (wc - 2); } break;
            default: kind = 1; dsto = WS_MG; pitch = 384; col = 64 * (2 + wc); break;
        }
        bf16* dst = (bf16*)(ws + dsto) + col + 8 * fq; const float* nw = (const float*)(ws + WS_NW) + (layer * 4 + nwi) * 64 + 8 * fq;
        int row0 = u.pm * 256 + wr * 64 + fr; asm volatile("" : "+v"(row0));
        if (kind == 0) rows<0>(acc, row0, (bf16*)(ws + WS_U) + ((size_t)(4 * wc + (fq >> 1)) * SEQ) * 16 + 8 * (fq & 1), 0, nw, rowss, nullptr);
        else if (kind == 1) rows<1>(acc, row0, dst, pitch, nw, rowss, nullptr);
        else if (kind == 2) rows<2>(acc, row0, dst, pitch, nw, rowss, nullptr);
        else rows<5>(acc, row0, dst, pitch, nw, rowss, (fr == 0) ? (float*)(ws + WS_KPART) + ((size_t)(u.pm * 2 + wr) * 2 + wc) * 64 + 8 * fq : nullptr);
    }
    template <int KIND>
    __device__ __forceinline__ void rows(const f32x4 (&acc)[2][2][4][2], int row0, bf16* dst, int pitch, const float* nw, const float* rowss, float* kp) const {
        f32x4 wv[2][2], ks[2][2];
        if (KIND >= 2) {
#pragma unroll
            for (int bj = 0; bj < 2; ++bj)
#pragma unroll
                for (int n = 0; n < 2; ++n) { wv[bj][n] = *(const f32x4*)(nw + 32 * bj + 4 * n); ks[bj][n] = (f32x4){0.f, 0.f, 0.f, 0.f}; }
        }
#pragma unroll
        for (int ai = 0; ai < 2; ++ai) {
            float rsv[4];
            { f32x4 pr[4];
#pragma unroll
              for (int m = 0; m < 4; ++m) pr[m] = *(const f32x4*)(rowss + (size_t)(row0 + ai * 128 + m * 16) * 4);
#pragma unroll
              for (int m = 0; m < 4; ++m) { const f32x4 p = pr[m]; rsv[m] = rsqrtf(((p.x + p.y) + (p.z + p.w)) * (1.f / DM) + RMS_EPS); } }
#pragma unroll
            for (int m = 0; m < 4; ++m) {
                const int row = row0 + ai * 128 + m * 16;
                const float rs = rsv[m];
                f32x4 v[2][2];
#pragma unroll
                for (int bj = 0; bj < 2; ++bj)
#pragma unroll
                    for (int n = 0; n < 2; ++n) v[bj][n] = acc[ai][bj][m][n] * rs;
                if (KIND >= 2) {
                    float ss = 0.f;
#pragma unroll
                    for (int bj = 0; bj < 2; ++bj)
#pragma unroll
                        for (int n = 0; n < 2; ++n) { const f32x4 q = v[bj][n]; ss += (q[0] * q[0] + q[1] * q[1]) + (q[2] * q[2] + q[3] * q[3]); }
                    ss += __shfl_xor(ss, 16); ss += __shfl_xor(ss, 32);
                    const float hn = rsqrtf(ss * (1.f / 64.f) + RMS_EPS);
#pragma unroll
                    for (int bj = 0; bj < 2; ++bj)
#pragma unroll
                        for (int n = 0; n < 2; ++n) { v[bj][n] = v[bj][n] * wv[bj][n] * hn; if (KIND == 5) ks[bj][n] += v[bj][n]; }
                } else if (KIND == 1) {
#pragma unroll
                    for (int bj = 0; bj < 2; ++bj)
#pragma unroll
                        for (int n = 0; n < 2; ++n)
#pragma unroll
                            for (int e = 0; e < 4; ++e) v[bj][n][e] = silu_f(v[bj][n][e]);
                }
                bf16* rp = (KIND == 0) ? dst + ((size_t)(row >> 11) * 16 * SEQ + (row & (SEQ - 1))) * 16 : dst + (size_t)row * pitch;
#pragma unroll
                for (int bj = 0; bj < 2; ++bj) { u32x4 w; w.x = pk2(v[bj][0][0], v[bj][0][1]); w.y = pk2(v[bj][0][2], v[bj][0][3]); w.z = pk2(v[bj][1][0], v[bj][1][1]); w.w = pk2(v[bj][1][2], v[bj][1][3]);
                    *(u32x4*)(rp + (KIND == 0 ? 2 * SEQ * 16 * bj : 32 * bj)) = w; }
                if (m & 1) asm volatile("" ::: "memory");
            }
        }
        if (KIND == 5) {
#pragma unroll
            for (int bj = 0; bj < 2; ++bj)
#pragma unroll
                for (int n = 0; n < 2; ++n)
#pragma unroll
                    for (int e = 0; e < 4; ++e) { float s = ks[bj][n][e]; s += __shfl_xor(s, 1); s += __shfl_xor(s, 2); s += __shfl_xor(s, 4); s += __shfl_xor(s, 8); ks[bj][n][e] = s; }
            if (kp) {
#pragma unroll
                for (int bj = 0; bj < 2; ++bj)
#pragma unroll
                    for (int n = 0; n < 2; ++n) *(f32x4*)(kp + 32 * bj + 4 * n) = ks[bj][n];
            }
        }
    }
};
struct EpiGlu {
    static constexpr bool PERM = true, AFTER_DRAIN = false;
    const bf16* YPRE; const bf16* SG; const float* gb; bf16* Y;
    __device__ __forceinline__ void operator()(const f32x4 (&acc)[2][2][4][2], const Unit& u, int wr, int wc, int fr, int fq) const {
#pragma unroll
        for (int bj = 0; bj < 2; ++bj) { const int c = wc * 32 + 8 * fq + 128 * bj;
            const f32x4 b0 = *(const f32x4*)(gb + c), b1 = *(const f32x4*)(gb + c + 4);
#pragma unroll
            for (int ai = 0; ai < 2; ++ai)
#pragma unroll
                for (int m = 0; m < 4; ++m) { const int row = u.pm * 256 + ai * 128 + wr * 64 + m * 16 + fr;
                    const u32x4 yp = *(const u32x4*)(YPRE + (size_t)row * 256 + c), sg = *(const u32x4*)(SG + (size_t)row * 256 + c);
                    const f32x4 z0 = acc[ai][bj][m][0] + b0, z1 = acc[ai][bj][m][1] + b1;
                    u32x4 w;
                    w.x = pk2(bflo(yp.x) * sigmoid_f(z0[0]) * bflo(sg.x), bfhi(yp.x) * sigmoid_f(z0[1]) * bfhi(sg.x));
                    w.y = pk2(bflo(yp.y) * sigmoid_f(z0[2]) * bflo(sg.y), bfhi(yp.y) * sigmoid_f(z0[3]) * bfhi(sg.y));
                    w.z = pk2(bflo(yp.z) * sigmoid_f(z1[0]) * bflo(sg.z), bfhi(yp.z) * sigmoid_f(z1[1]) * bfhi(sg.z));
                    w.w = pk2(bflo(yp.w) * sigmoid_f(z1[2]) * bflo(sg.w), bfhi(yp.w) * sigmoid_f(z1[3]) * bfhi(sg.w));
                    *(u32x4*)(Y + (size_t)row * DM + c) = w;
                    if (m & 1) asm volatile("" ::: "memory"); } }
    }
};
struct EpiOut {
    static constexpr bool PERM = false, AFTER_DRAIN = false;
    const float* resid_f; float* out; bf16* xb; float* rowss; int write_next; LAS float* xch; int probe_skip;
    __device__ __forceinline__ void operator()(const f32x4 (&acc)[2][2][4][2], const Unit& u, int wr, int wc, int fr, int fq) const {
        const int c0 = u.pn * 256 + wc * 32 + 4 * fq;
        if (probe_skip) { asm volatile("" :: "v"(acc[0][0][0][0]), "v"(acc[1][1][3][1])); asm volatile("s_waitcnt lgkmcnt(0)" ::: "memory"); __builtin_amdgcn_s_barrier(); return; }
        if (write_next) {
#pragma unroll
            for (int aim = 0; aim < 4; ++aim) { const int ai = aim >> 1, mb = (aim & 1) * 2;
                f32x4 pre[2][2][2];
#pragma unroll
                for (int m2 = 0; m2 < 2; ++m2) { const size_t off = (size_t)(u.pm * 256 + ai * 128 + wr * 64 + (mb + m2) * 16 + fr) * DM + c0;
#pragma unroll
                    for (int bj = 0; bj < 2; ++bj)
#pragma unroll
                        for (int n = 0; n < 2; ++n) pre[m2][bj][n] = *(const f32x4*)(resid_f + off + bj * 128 + n * 16); }
#pragma unroll
                for (int m2 = 0; m2 < 2; ++m2) { const int m = mb + m2; const int rt = ai * 128 + wr * 64 + m * 16 + fr; const size_t off = (size_t)(u.pm * 256 + rt) * DM + c0; float ss = 0.f;
#pragma unroll
                    for (int bj = 0; bj < 2; ++bj)
#pragma unroll
                        for (int n = 0; n < 2; ++n) { const f32x4 o = pre[m2][bj][n] + acc[ai][bj][m][n];
                            u32x2 w; w.x = pk2(o[0], o[1]); w.y = pk2(o[2], o[3]); *(u32x2*)(xb + off + bj * 128 + n * 16) = w; ss += (o[0] * o[0] + o[1] * o[1]) + (o[2] * o[2] + o[3] * o[3]); }
                    ss += __shfl_xor(ss, 16); ss += __shfl_xor(ss, 32); if (fq == 0) xch[rt * 4 + wc] = ss; }
            }
        } else {
#pragma unroll
            for (int ai = 0; ai < 2; ++ai) {
                u32x2 pre[4][2][2];
#pragma unroll
                for (int m = 0; m < 4; ++m) { const size_t off = (size_t)(u.pm * 256 + ai * 128 + wr * 64 + m * 16 + fr) * DM + c0;
#pragma unroll
                    for (int bj = 0; bj < 2; ++bj)
#pragma unroll
                        for (int n = 0; n < 2; ++n) pre[m][bj][n] = *(const u32x2*)(xb + off + bj * 128 + n * 16); }
#pragma unroll
                for (int m = 0; m < 4; ++m) { const size_t off = (size_t)(u.pm * 256 + ai * 128 + wr * 64 + m * 16 + fr) * DM + c0;
#pragma unroll
                    for (int bj = 0; bj < 2; ++bj)
#pragma unroll
                        for (int n = 0; n < 2; ++n) { const u32x2 rb = pre[m][bj][n]; const f32x4 a4 = acc[ai][bj][m][n]; f32x4 o;
                            o[0] = bflo(rb.x) + a4[0]; o[1] = bfhi(rb.x) + a4[1]; o[2] = bflo(rb.y) + a4[2]; o[3] = bfhi(rb.y) + a4[3];
                            __builtin_nontemporal_store(o, (f32x4*)(out + off + bj * 128 + n * 16)); } }
            }
        }
        asm volatile("s_waitcnt lgkmcnt(0)" ::: "memory"); __builtin_amdgcn_s_barrier(); asm volatile("" ::: "memory");
        if (write_next && threadIdx.x < 256) { const f32x4 p = *(const LAS f32x4*)(xch + threadIdx.x * 4); rowss[(size_t)(u.pm * 256 + threadIdx.x) * 4 + u.pn] = (p.x + p.y) + (p.z + p.w); }
    }
};

__device__ __forceinline__ int pi32(int r) { return (r & ~12) | ((r & 8) >> 1) | ((r & 4) << 1); }
template <int MODE>
__device__ __forceinline__ void attn_tile(const bf16x8 (&kf)[4], const bf16x8 (&vf)[2][2], const bf16x8 (&qf)[4], const f32x16& cv, float& l, f32x16 (&O)[2], int a, int h) {
    f32x16 S = __builtin_amdgcn_mfma_f32_32x32x16_bf16(kf[0], qf[0], cv, 0, 0, 0);
#pragma unroll
    for (int ks = 1; ks < 4; ++ks) S = __builtin_amdgcn_mfma_f32_32x32x16_bf16(kf[ks], qf[ks], S, 0, 0, 0);
    if (MODE != 0) {
#pragma unroll
        for (int i = 0; i < 16; ++i) { const int c = pi32((i & 3) + 8 * (i >> 2) + 4 * h); const bool dead = (MODE == 1) ? (c > a) : (c <= a); if (dead) S[i] = -1e30f; }
    }
    float s0 = 0.f, s1 = 0.f;
#pragma unroll
    for (int i = 0; i < 16; i += 2) { S[i] = __builtin_amdgcn_exp2f(S[i]); S[i + 1] = __builtin_amdgcn_exp2f(S[i + 1]); s0 += S[i]; s1 += S[i + 1]; }
    l += s0 + s1;
    bf16x8 pb[2];
#pragma unroll
    for (int s = 0; s < 2; ++s) { u32x4 w; w.x = pk2(S[8 * s], S[8 * s + 1]); w.y = pk2(S[8 * s + 2], S[8 * s + 3]); w.z = pk2(S[8 * s + 4], S[8 * s + 5]); w.w = pk2(S[8 * s + 6], S[8 * s + 7]); pb[s] = __builtin_bit_cast(bf16x8, w); }
#pragma unroll
    for (int dt = 0; dt < 2; ++dt)
#pragma unroll
        for (int s = 0; s < 2; ++s) O[dt] = __builtin_amdgcn_mfma_f32_32x32x16_bf16(vf[dt][s], pb[s], O[dt], 0, 0, 0);
}
template <int NK>
__device__ __forceinline__ void stage_kv(LAS unsigned char* Kimg, LAS unsigned char* Vimg, const bf16* Ksrc  , const bf16* VTf  ,
                                         long tokbase  , long key_lo  , long key_min  , int wave, int lane) {
    constexpr int KP = NK * 128 / 1024, VCH = NK / 8, VP = 64 * VCH * 16 / 1024;
    for (int p = wave; p < KP; p += 8) { const int L = p * 64 + lane, r = L >> 3, s = L & 7, c = s ^ ((r >> 1) & 7); long kr = key_lo + r; if (kr < key_min) kr = key_min;
        glds16(Ksrc + (kr - key_lo) * 128 + c * 8, Kimg + p * 1024); }
    for (int p = wave; p < VP; p += 8) { const int L = p * 64 + lane, d = L / VCH, s = L % VCH, c = s ^ (d & 15); long kc = key_lo + 8 * c; if (kc < key_min) kc = key_min; const long tok = tokbase + kc;
        glds16(VTf + ((tok >> 8) * 256 + d) * 256 + (tok & 255), Vimg + p * 1024); }
}
template <int NK>
__device__ __forceinline__ void load_kv_frags(bf16x8 (&kf)[4], bf16x8 (&vf)[2][2], const LAS unsigned char* Kimg, const LAS unsigned char* Vimg, int row0  , int lane) {
    const int r = row0 + pi32(lane & 31), h = lane >> 5;
#pragma unroll
    for (int ks = 0; ks < 4; ++ks) kf[ks] = *(const LAS bf16x8*)(Kimg + r * 128 + (((2 * ks + h) ^ ((r >> 1) & 7)) << 4));
#pragma unroll
    for (int dt = 0; dt < 2; ++dt) { const int d = 32 * dt + (lane & 31);
#pragma unroll
        for (int s = 0; s < 2; ++s) { const int c = (row0 >> 3) + 2 * s + h; vf[dt][s] = *(const LAS bf16x8*)(Vimg + d * (NK * 2) + ((c ^ (d & 15)) << 4)); } }
}
template <int NK>
__device__ __forceinline__ void load_k_frags(bf16x8 (&kf)[4], const LAS unsigned char* Kimg, int row0, int lane) {
    const int r = row0 + pi32(lane & 31), h = lane >> 5;
#pragma unroll
    for (int ks = 0; ks < 4; ++ks) kf[ks] = *(const LAS bf16x8*)(Kimg + r * 128 + (((2 * ks + h) ^ ((r >> 1) & 7)) << 4));
}
template <int NK>
__device__ __forceinline__ void load_v_frags(bf16x8 (&vf)[2][2], const LAS unsigned char* Vimg, int row0, int lane) {
    const int h = lane >> 5;
#pragma unroll
    for (int dt = 0; dt < 2; ++dt) { const int d = 32 * dt + (lane & 31);
#pragma unroll
        for (int s = 0; s < 2; ++s) { const int c = (row0 >> 3) + 2 * s + h; vf[dt][s] = *(const LAS bf16x8*)(Vimg + d * (NK * 2) + ((c ^ (d & 15)) << 4)); } }
}
__device__ __forceinline__ f32x16 qk_tile(const bf16x8 (&kf)[4], const bf16x8 (&qf)[4], const f32x16& cv) {
    f32x16 S = __builtin_amdgcn_mfma_f32_32x32x16_bf16(kf[0], qf[0], cv, 0, 0, 0);
#pragma unroll
    for (int ks = 1; ks < 4; ++ks) S = __builtin_amdgcn_mfma_f32_32x32x16_bf16(kf[ks], qf[ks], S, 0, 0, 0);
    return S;
}
template <int MODE>
__device__ __forceinline__ void softmax_pv(f32x16& S, const bf16x8 (&vf)[2][2], float& l, f32x16 (&O)[2], int a, int h) {
    if (MODE != 0) {
#pragma unroll
        for (int i = 0; i < 16; ++i) { const int c = pi32((i & 3) + 8 * (i >> 2) + 4 * h); const bool dead = (MODE == 1) ? (c > a) : (c <= a); if (dead) S[i] = -1e30f; }
    }
    float s0 = 0.f, s1 = 0.f;
#pragma unroll
    for (int i = 0; i < 16; i += 2) { S[i] = __builtin_amdgcn_exp2f(S[i]); S[i + 1] = __builtin_amdgcn_exp2f(S[i + 1]); s0 += S[i]; s1 += S[i + 1]; }
    l += s0 + s1;
    bf16x8 pb[2];
#pragma unroll
    for (int s = 0; s < 2; ++s) { u32x4 w; w.x = pk2(S[8 * s], S[8 * s + 1]); w.y = pk2(S[8 * s + 2], S[8 * s + 3]); w.z = pk2(S[8 * s + 4], S[8 * s + 5]); w.w = pk2(S[8 * s + 6], S[8 * s + 7]); pb[s] = __builtin_bit_cast(bf16x8, w); }
#pragma unroll
    for (int dt = 0; dt < 2; ++dt)
#pragma unroll
        for (int s = 0; s < 2; ++s) O[dt] = __builtin_amdgcn_mfma_f32_32x32x16_bf16(vf[dt][s], pb[s], O[dt], 0, 0, 0);
}
template <int NK, int N, int MFIRST, int MLAST>
__device__ __forceinline__ void attn_run(const LAS unsigned char* Kimg, const LAS unsigned char* Vimg, int row0, const bf16x8 (&qf)[4], const f32x16& cv, float& l, f32x16 (&O)[2], int lane) {
    const int a = lane & 31, h = lane >> 5;
    bf16x8 kf[4], vfa[2][2], vfb[2][2];
    load_k_frags<NK>(kf, Kimg, row0, lane); load_v_frags<NK>(vfa, Vimg, row0, lane);
    f32x16 S = qk_tile(kf, qf, cv);
#pragma unroll
    for (int t = 0; t < N; ++t) {
        f32x16 Sn;
        if (t + 1 < N) { load_k_frags<NK>(kf, Kimg, row0 + 32 * (t + 1), lane); if (t & 1) load_v_frags<NK>(vfa, Vimg, row0 + 32 * (t + 1), lane); else load_v_frags<NK>(vfb, Vimg, row0 + 32 * (t + 1), lane);
            Sn = qk_tile(kf, qf, cv); }
        if (t == 0 && MFIRST != 0) { if (t & 1) softmax_pv<MFIRST>(S, vfb, l, O, a, h); else softmax_pv<MFIRST>(S, vfa, l, O, a, h); }
        else if (t == N - 1 && MLAST != 0) { if (t & 1) softmax_pv<MLAST>(S, vfb, l, O, a, h); else softmax_pv<MLAST>(S, vfa, l, O, a, h); }
        else { if (t & 1) softmax_pv<0>(S, vfb, l, O, a, h); else softmax_pv<0>(S, vfa, l, O, a, h); }
        if (t + 1 < N) S = Sn;
    }
}
template <int NK, int PVAR>
__device__ __forceinline__ void attn_run8(const LAS unsigned char* Kimg, const LAS unsigned char* Vimg, const bf16x8 (&qf)[4], const f32x16& cv, float& l, f32x16 (&O)[2], int lane) {
    const int a = lane & 31, h = lane >> 5;
    bf16x8 kf[4], vfa[2][2], vfb[2][2];
    load_k_frags<NK>(kf, Kimg, 0, lane); load_v_frags<NK>(vfa, Vimg, 0, lane);
    if (PVAR == 4) load_v_frags<NK>(vfb, Vimg, 32, lane);
#define QKT() ((PVAR == 5) ? cv : qk_tile(kf, qf, cv))
#define SMPV(S_, vf_) do { if (PVAR == 3) { bf16x8 pb[2]; _Pragma("unroll") for (int s = 0; s < 2; ++s) { u32x4 w; w.x = pk2(S_[8 * s], S_[8 * s + 1]); w.y = pk2(S_[8 * s + 2], S_[8 * s + 3]); w.z = pk2(S_[8 * s + 4], S_[8 * s + 5]); w.w = pk2(S_[8 * s + 6], S_[8 * s + 7]); pb[s] = __builtin_bit_cast(bf16x8, w); } \
        _Pragma("unroll") for (int dt = 0; dt < 2; ++dt) _Pragma("unroll") for (int s = 0; s < 2; ++s) O[dt] = __builtin_amdgcn_mfma_f32_32x32x16_bf16(vf_[dt][s], pb[s], O[dt], 0, 0, 0); } \
      else if (PVAR == 6) { _Pragma("unroll") for (int i = 0; i < 16; ++i) { l += __builtin_amdgcn_exp2f(S_[i]); } asm volatile("" :: "v"(vf_[0][0]), "v"(vf_[1][1])); } \
      else softmax_pv<0>(S_, vf_, l, O, a, h); } while (0)
    f32x16 S = QKT();
#pragma unroll 1
    for (int j = 0; j < 3; ++j) {
        { if (PVAR != 4) { load_k_frags<NK>(kf, Kimg, 64 * j + 32, lane); load_v_frags<NK>(vfb, Vimg, 64 * j + 32, lane); } f32x16 Sn = QKT(); SMPV(S, vfa); S = Sn; }
        { if (PVAR != 4) { load_k_frags<NK>(kf, Kimg, 64 * j + 64, lane); load_v_frags<NK>(vfa, Vimg, 64 * j + 64, lane); } f32x16 Sn = QKT(); SMPV(S, vfb); S = Sn; }
    }
    { if (PVAR != 4) { load_k_frags<NK>(kf, Kimg, 224, lane); load_v_frags<NK>(vfb, Vimg, 224, lane); } f32x16 Sn = QKT(); SMPV(S, vfa); S = Sn; }
    SMPV(S, vfb);
#undef QKT
#undef SMPV
}
__device__ __forceinline__ void attn_store(const f32x16 (&O)[2], float l, const bf16* gate  , bf16* y  , int h) {
    const float inv = 1.f / swap32_sum(l);
#pragma unroll
    for (int dt = 0; dt < 2; ++dt)
#pragma unroll
        for (int q = 0; q < 4; ++q) { const int d = 32 * dt + 8 * q + 4 * h; const u32x2 gv = *(const u32x2*)(gate + d);
            u32x2 w; w.x = pk2(O[dt][4 * q] * inv * bflo(gv.x), O[dt][4 * q + 1] * inv * bfhi(gv.x)); w.y = pk2(O[dt][4 * q + 2] * inv * bflo(gv.y), O[dt][4 * q + 3] * inv * bfhi(gv.y));
            *(u32x2*)(y + d) = w; }
}

template <int VAR>
__device__ __forceinline__ void moba_unit(Frame& F, int b, int kvh, int qb, int g) {
    constexpr int IMG = 32768;
    LAS unsigned char* buf0 = F.lds; LAS unsigned char* buf1 = F.lds + 2 * IMG;
    LAS float* km = (LAS float*)(F.lds + LDS_MISC + 1024);
    const int lane = F.lane, wave = F.wave, a = lane & 31, h = lane >> 5;
    const long tok0 = (long)b * SEQ + 256 * qb;
    const bf16* Kb = ((bf16*)(F.ws + WS_MK)) + (size_t)b * SEQ * 128 + kvh * 64;
    const bf16* Vb = ((bf16*)(F.ws + WS_VT)) + (size_t)(128 + kvh * 64) * 256; const long tokb = (long)b * SEQ;
    if (VAR != 1) stage_kv<256>(buf0, buf0 + IMG, Kb + (size_t)(256 * qb) * 128, Vb, tokb, 256 * qb, 0, wave, lane);
    { const int n = F.tid >> 6, d = F.tid & 63; float s = 0.f;
      if (n < qb) { const int tile = b * 8 + n; s = ((float*)(F.ws + WS_KPART))[((size_t)(tile * 2 + 0) * 2 + kvh) * 64 + d] + ((float*)(F.ws + WS_KPART))[((size_t)(tile * 2 + 1) * 2 + kvh) * 64 + d]; }
      km[n * 64 + d] = s; }
    const size_t row = (size_t)(tok0 + 32 * wave + a);
    const bf16* qp = ((bf16*)(F.ws + WS_MQ)) + row * 384 + kvh * 192 + 8 * h;
    GLDS_WAIT(); __syncthreads();
    unsigned selmask = (VAR == 8) ? 0x7fu : 0u;
    if (qb > 0 && VAR != 8) {
        float sc[8];
#pragma unroll
        for (int n = 0; n < 8; ++n) sc[n] = 0.f;
#pragma unroll
        for (int ks = 0; ks < 4; ++ks) { const bf16x8 q0 = *(const bf16x8*)(qp + 16 * ks), q1 = *(const bf16x8*)(qp + 64 + 16 * ks), q2 = *(const bf16x8*)(qp + 128 + 16 * ks);
#pragma unroll
            for (int j = 0; j < 8; ++j) { const float qs = bf2f((unsigned short)q0[j]) + bf2f((unsigned short)q1[j]) + bf2f((unsigned short)q2[j]); const int d = 16 * ks + 8 * h + j;
#pragma unroll
                for (int n = 0; n < 7; ++n) sc[n] += qs * km[n * 64 + d]; } }
#pragma unroll
        for (int n = 0; n < 7; ++n) { sc[n] = swap32_sum(sc[n]); if (n >= qb) sc[n] = -INFINITY; }
#pragma unroll
        for (int t = 0; t < 3; ++t) { float best = -INFINITY; int bi = -1;
#pragma unroll
            for (int n = 0; n < 7; ++n) if (sc[n] > best) { best = sc[n]; bi = n; }
            if (bi >= 0) { selmask |= 1u << bi;
#pragma unroll
                for (int n = 0; n < 7; ++n) if (n == bi) sc[n] = -INFINITY; } }
    }
    float l = 0.f; f32x16 O[2]; bf16x8 qf[4];
#pragma unroll
    for (int i = 0; i < 16; ++i) { O[0][i] = 0.f; O[1][i] = 0.f; }
#pragma unroll
    for (int ks = 0; ks < 4; ++ks) qf[ks] = *(const bf16x8*)(qp + g * 64 + 16 * ks);
    asm volatile("" : "+v"(qf[0]), "+v"(qf[1]), "+v"(qf[2]), "+v"(qf[3]));
#pragma unroll 1
    for (int s = 0; s <= qb; ++s) {
        LAS unsigned char* cur = (s & 1) ? buf1 : buf0; LAS unsigned char* nxt = (s & 1) ? buf0 : buf1;
        if (s < qb && VAR != 1) stage_kv<256>(nxt, nxt + IMG, Kb + (size_t)(256 * s) * 128, Vb, tokb, 256 * s, 0, wave, lane);
        if (VAR == 2) {} else if (s == 0) { if (VAR != 7) {
            f32x16 cv;
#pragma unroll
            for (int i = 0; i < 16; ++i) cv[i] = 0.f;
            int kt = 0;
#pragma unroll 1
            for (; kt + 1 < wave; kt += 2) { bf16x8 kfa[4], vfa[2][2], kfb[4], vfb[2][2]; load_kv_frags<256>(kfa, vfa, cur, cur + IMG, 32 * kt, lane); load_kv_frags<256>(kfb, vfb, cur, cur + IMG, 32 * kt + 32, lane);
                attn_tile<0>(kfa, vfa, qf, cv, l, O, a, h); attn_tile<0>(kfb, vfb, qf, cv, l, O, a, h); }
            if (kt < wave) { bf16x8 kfa[4], vfa[2][2], kfb[4], vfb[2][2]; load_kv_frags<256>(kfa, vfa, cur, cur + IMG, 32 * kt, lane); load_kv_frags<256>(kfb, vfb, cur, cur + IMG, 32 * kt + 32, lane);
                attn_tile<0>(kfa, vfa, qf, cv, l, O, a, h); attn_tile<1>(kfb, vfb, qf, cv, l, O, a, h); }
            else { bf16x8 kfa[4], vfa[2][2]; load_kv_frags<256>(kfa, vfa, cur, cur + IMG, 32 * kt, lane); attn_tile<1>(kfa, vfa, qf, cv, l, O, a, h); }
        } } else if (VAR != 9) {
            const float cinit = ((selmask >> (s - 1)) & 1u) ? 0.f : -1e30f;
            if (__any(cinit == 0.f)) {
                f32x16 cv;
#pragma unroll
                for (int i = 0; i < 16; ++i) cv[i] = cinit;
                attn_run8<256, (VAR >= 3 ? VAR : 0)>(cur, cur + IMG, qf, cv, l, O, lane);
            }
        }
        GLDS_WAIT(); __syncthreads();
    }
    attn_store(O, l, ((bf16*)(F.ws + WS_MG)) + row * 384 + (kvh * 3 + g) * 64, ((bf16*)(F.ws + (VAR ? WS_END : WS_Y))) + row * DM + 640 + (kvh * 3 + g) * 64, h);
}

__device__ __forceinline__ void swa_unit(const Params& P, Frame& F, int layer, int b, int kvh, int qblk) {
    constexpr int NK = 384;
    LAS unsigned char* Kimg = F.lds; LAS unsigned char* Vimg = F.lds + NK * 128;
    const int lane = F.lane, wave = F.wave, a = lane & 31, h = lane >> 5;
    const int q0 = 256 * qblk; const long tok0 = (long)b * SEQ + q0;
    const bf16* Kb = ((bf16*)(F.ws + WS_AK)) + ((long)b * SEQ + q0 - 128) * 128 + kvh * 64;
    const bf16* Vb = ((bf16*)(F.ws + WS_VT)) + (size_t)(kvh * 64) * 256;
    stage_kv<NK>(Kimg, Vimg, Kb, Vb, (long)b * SEQ, (long)q0 - 128, 0, wave, lane);
    const size_t row = (size_t)(tok0 + 32 * wave + a);
    const bf16* qp = ((bf16*)(F.ws + WS_AQ)) + row * 384 + kvh * 192 + 8 * h;
    f32x16 cv;
#pragma unroll
    for (int i = 0; i < 16; ++i) cv[i] = 0.f;
    const bool head = (q0 - 128 + 32 * wave) >= 0;
    GLDS_WAIT(); __syncthreads();
#pragma unroll 1
    for (int g = 0; g < 3; ++g) {
        bf16x8 qf[4];
#pragma unroll
        for (int ks = 0; ks < 4; ++ks) qf[ks] = *(const bf16x8*)(qp + g * 64 + 16 * ks);
        float l = 0.5f * __builtin_amdgcn_exp2f(kin(15)[layer * 6 + kvh * 3 + g] * LOG2E);
        f32x16 O[2];
#pragma unroll
        for (int i = 0; i < 16; ++i) { O[0][i] = 0.f; O[1][i] = 0.f; }
        const int r0 = 32 * wave;
        if (head) attn_run<NK, 5, 2, 1>(Kimg, Vimg, r0, qf, cv, l, O, lane);
        else {
#pragma unroll 1
            for (int kt = 4 - wave; kt < 4; ++kt) { bf16x8 kfa[4], vfa[2][2]; load_kv_frags<NK>(kfa, vfa, Kimg, Vimg, r0 + 32 * kt, lane); attn_tile<0>(kfa, vfa, qf, cv, l, O, a, h); }
            { bf16x8 kfa[4], vfa[2][2]; load_kv_frags<NK>(kfa, vfa, Kimg, Vimg, r0 + 128, lane); attn_tile<1>(kfa, vfa, qf, cv, l, O, a, h); }
        }
        attn_store(O, l, ((bf16*)(F.ws + WS_AG)) + row * 384 + (kvh * 3 + g) * 64, ((bf16*)(F.ws + WS_Y)) + row * DM + 256 + (kvh * 3 + g) * 64, h);
    }
    __syncthreads();
}

__device__ __forceinline__ void ssm_unit(Frame& F, int layer, int b, int g) {
    constexpr int APITCH = 528;
    LAS unsigned char* AU = F.lds;
    LAS unsigned char* SC = F.lds + 128 * APITCH;
    LAS float* seg = (LAS float*)(F.lds + 2 * 128 * APITCH);
    const int lane = F.lane, wave = F.wave, tid = F.tid, fr = lane & 15, fq = lane >> 4;
    const int pair = layer * 16 + g;
    const bf16* TE = ((bf16*)(F.ws + WS_TE)) + (size_t)pair * TE_ELEMS; const bf16* GM = ((bf16*)(F.ws + WS_G)) + (size_t)pair * G_ELEMS;
    u32x4 uv[8];
    { const bf16* up = ((bf16*)(F.ws + WS_U)) + (size_t)(b * 16 + g) * SEQ * 16;
#pragma unroll
      for (int i = 0; i < 8; ++i) { const int idx = tid + 512 * i; uv[i] = *(const u32x4*)(up + (size_t)idx * 8); } }
    bf16x8 gf[8];
#pragma unroll
    for (int ks = 0; ks < 8; ++ks) gf[ks] = *(const bf16x8*)(GM + (size_t)(16 * wave + fr) * 256 + 32 * ks + 8 * fq);
    const float ar = ((float*)(F.ws + WS_AT))[(size_t)pair * 128 + 2 * lane], ai = ((float*)(F.ws + WS_AT))[(size_t)pair * 128 + 2 * lane + 1];
    bf16x8 tfu[2][8], tfc[2][4];
#pragma unroll
    for (int half = 0; half < 2; ++half) { const int i = half ? 15 - wave : wave, nks = (i >> 1) + 1; const bf16* tp = TE + (size_t)(16 * i + fr) * 384 + 8 * fq;
#pragma unroll
        for (int ks = 0; ks < 8; ++ks) tfu[half][ks] = *(const bf16x8*)(tp + 32 * (ks < nks ? ks : 0));
#pragma unroll
        for (int ks = 0; ks < 4; ++ks) tfc[half][ks] = *(const bf16x8*)(tp + 256 + 32 * ks); }
#pragma unroll
    for (int i = 0; i < 8; ++i) { const int idx = tid + 512 * i, t = idx >> 1, hf = idx & 1; *(LAS u32x4*)(AU + (t >> 4) * APITCH + ((t & 15) * 16 + 8 * hf) * 2) = uv[i]; }
    __syncthreads();
    {
#pragma unroll
        for (int rt = 0; rt < 8; ++rt) { f32x4 acc = {0.f, 0.f, 0.f, 0.f};
#pragma unroll
            for (int ks = 0; ks < 8; ++ks) { const bf16x8 af = *(const LAS bf16x8*)(AU + (16 * rt + fr) * APITCH + (32 * ks + 8 * fq) * 2); acc = __builtin_amdgcn_mfma_f32_16x16x32_bf16(gf[ks], af, acc, 0, 0, 0); }
            *(LAS f32x4*)(SC + (16 * rt + fr) * APITCH + (16 * wave + 4 * fq) * 4) = acc; }
    }
    __syncthreads();
    {
        float lr = 0.f, li = 0.f, locr[16], loci[16];
#pragma unroll
        for (int k = 0; k < 16; ++k) { locr[k] = lr; loci[k] = li; const f32x2_t s = *(const LAS f32x2_t*)(SC + (16 * wave + k) * APITCH + lane * 8);
            const float nr = ar * lr - ai * li + s.x, ni = ar * li + ai * lr + s.y; lr = nr; li = ni; }
        seg[(wave * 64 + lane) * 2] = lr; seg[(wave * 64 + lane) * 2 + 1] = li;
        __syncthreads();
        float a16r = ar, a16i = ai;
#pragma unroll
        for (int q = 0; q < 4; ++q) { const float tr = a16r * a16r - a16i * a16i, ti = 2.f * a16r * a16i; a16r = tr; a16i = ti; }
        float ir = 0.f, ii = 0.f;
        for (int w2 = 0; w2 < wave; ++w2) { const float sr = seg[(w2 * 64 + lane) * 2], si = seg[(w2 * 64 + lane) * 2 + 1]; const float nr = a16r * ir - a16i * ii + sr, ni = a16r * ii + a16i * ir + si; ir = nr; ii = ni; }
        float pr = 1.f, pi = 0.f;
#pragma unroll
        for (int k = 0; k < 16; ++k) { const float cr = locr[k] + pr * ir - pi * ii, ci = loci[k] + pr * ii + pi * ir;
            *(LAS unsigned*)(SC + (16 * wave + k) * APITCH + lane * 4) = pk2(cr, ci);
            const float tr = pr * ar - pi * ai, ti = pr * ai + pi * ar; pr = tr; pi = ti; }
    }
    __syncthreads();
#pragma unroll
    for (int half = 0; half < 2; ++half) {
        const int i = half ? 15 - wave : wave;
        f32x4 acc[8];
#pragma unroll
        for (int rt = 0; rt < 8; ++rt) acc[rt] = (f32x4){0.f, 0.f, 0.f, 0.f};
        const int nks = (i >> 1) + 1;
#pragma unroll
        for (int ks = 0; ks < 8; ++ks) { if (ks < nks) {
#pragma unroll
            for (int rt = 0; rt < 8; ++rt) { const bf16x8 af = *(const LAS bf16x8*)(AU + (16 * rt + fr) * APITCH + (32 * ks + 8 * fq) * 2); acc[rt] = __builtin_amdgcn_mfma_f32_16x16x32_bf16(tfu[half][ks], af, acc[rt], 0, 0, 0); } } }
#pragma unroll
        for (int ks = 0; ks < 4; ++ks) {
#pragma unroll
            for (int rt = 0; rt < 8; ++rt) { const bf16x8 af = *(const LAS bf16x8*)(SC + (16 * rt + fr) * APITCH + (32 * ks + 8 * fq) * 2); acc[rt] = __builtin_amdgcn_mfma_f32_16x16x32_bf16(tfc[half][ks], af, acc[rt], 0, 0, 0); } }
#pragma unroll
        for (int rt = 0; rt < 8; ++rt) { const int chunk = 16 * rt + fr; u32x2 w; w.x = pk2(gelu_tanh_f(acc[rt][0]), gelu_tanh_f(acc[rt][1])); w.y = pk2(gelu_tanh_f(acc[rt][2]), gelu_tanh_f(acc[rt][3]));
            __hip_atomic_store((unsigned long long*)(((bf16*)(F.ws + WS_YPRE)) + ((size_t)(b * 16 + g) * SEQ + 16 * chunk + i) * 16 + 4 * fq), ((unsigned long long)w.y << 32) | w.x, __ATOMIC_RELAXED, __HIP_MEMORY_SCOPE_AGENT); }
    }
    asm volatile("s_waitcnt vmcnt(0)" ::: "memory");
    __syncthreads();
    if (tid == 0) __hip_atomic_fetch_add(F.ctl + CW_SSMDONE + 64 * (layer * NB + b), 1u, __ATOMIC_RELAXED, __HIP_MEMORY_SCOPE_AGENT);
}

__device__ __forceinline__ void glu_unit(const Params& P, Frame& F, int layer, int b, int j) {
    constexpr int APITCH = 528;
    LAS unsigned char* AT_ = F.lds;
    const int lane = F.lane, wave = F.wave, tid = F.tid, fr = lane & 15, fq = lane >> 4;
    const size_t tok0 = (size_t)b * SEQ + 128 * j;
    const bf16* wp = ((bf16*)(F.ws + WS_GLU)) + (size_t)layer * 65536 + (size_t)(32 * wave + fr) * 256 + 8 * fq;
    bf16x8 wf[8][2];
#pragma unroll
    for (int ks = 0; ks < 8; ++ks) { wf[ks][0] = *(const bf16x8*)(wp + 32 * ks); wf[ks][1] = *(const bf16x8*)(wp + 16 * 256 + 32 * ks); }
    if (tid == 0) { unsigned* c = F.ctl + CW_SSMDONE + 64 * (layer * NB + b); unsigned sp = 0;
        while (__hip_atomic_load(c, __ATOMIC_RELAXED, __HIP_MEMORY_SCOPE_AGENT) < 16u) { __builtin_amdgcn_s_sleep(2); if (++sp > (1u << 22)) break; }
        __builtin_amdgcn_fence(__ATOMIC_ACQUIRE, "agent"); asm volatile("s_waitcnt vmcnt(0)" ::: "memory"); }
    __syncthreads();
    { const bf16* yp = ((bf16*)(F.ws + WS_YPRE)) + ((size_t)b * 16 * SEQ + 128 * j) * 16;
#pragma unroll
      for (int i = 0; i < 8; ++i) { const int idx = tid + 512 * i, c = idx >> 7, t = idx & 127; const u32x4 v = *(const u32x4*)(yp + ((size_t)(c >> 1) * SEQ + t) * 16 + 8 * (c & 1)); *(LAS u32x4*)(AT_ + t * APITCH + c * 16) = v; } }
    f32x4 acc[8][2];
#pragma unroll
    for (int rt = 0; rt < 8; ++rt) { acc[rt][0] = (f32x4){0.f, 0.f, 0.f, 0.f}; acc[rt][1] = (f32x4){0.f, 0.f, 0.f, 0.f}; }
    __syncthreads();
#pragma unroll
    for (int ks = 0; ks < 8; ++ks)
#pragma unroll
        for (int rt = 0; rt < 8; ++rt) { const bf16x8 af = *(const LAS bf16x8*)(AT_ + (16 * rt + fr) * APITCH + (32 * ks + 8 * fq) * 2);
            acc[rt][0] = __builtin_amdgcn_mfma_f32_16x16x32_bf16(wf[ks][0], af, acc[rt][0], 0, 0, 0); acc[rt][1] = __builtin_amdgcn_mfma_f32_16x16x32_bf16(wf[ks][1], af, acc[rt][1], 0, 0, 0); }
    const float* gb = kin(12) + layer * 256;
#pragma unroll
    for (int nt = 0; nt < 2; ++nt) { const int n0 = 32 * wave + 16 * nt + 4 * fq; const f32x4 bv = *(const f32x4*)(gb + n0);
#pragma unroll
        for (int rt = 0; rt < 8; ++rt) { const int t = 16 * rt + fr; const u32x2 yp = *(const LAS u32x2*)(AT_ + t * APITCH + n0 * 2); const u32x2 sg = *(const u32x2*)(((bf16*)(F.ws + WS_SG)) + (tok0 + t) * 256 + n0);
            const f32x4 z = acc[rt][nt] + bv; u32x2 w;
            w.x = pk2(bflo(yp.x) * sigmoid_f(z[0]) * bflo(sg.x), bfhi(yp.x) * sigmoid_f(z[1]) * bfhi(sg.x));
            w.y = pk2(bflo(yp.y) * sigmoid_f(z[2]) * bflo(sg.y), bfhi(yp.y) * sigmoid_f(z[3]) * bfhi(sg.y));
            *(u32x2*)(((bf16*)(F.ws + WS_Y)) + (tok0 + t) * DM + n0) = w; } }
    __syncthreads();
}

__device__ __forceinline__ void mixer_phase(const Params& P, Frame& F, int qslot, int layer, int mask) {
    volatile LAS int* qw = (volatile LAS int*)(F.lds + LDS_CTL);
    unsigned* head = F.ctl + CW_QUEUE + 64 * qslot;
    for (;;) {
        if (F.tid == 0) qw[0] = (int)atomicAdd(head, 1u);
        __syncthreads();
        const int it = qw[0];
        __syncthreads();
        if (it >= 1536) break;
        Frame Fu = phase_frame(F);
#ifndef NO_MOBA
        if (it < 768 && (mask & 1)) { const int qb = 7 - it / 96, r = it % 96, b = r / 6, kvh = (r % 6) / 3, g = r % 3;
            if (mask & 8) moba_unit<1>(Fu, b, kvh, qb, g); else if (mask & 16) moba_unit<2>(Fu, b, kvh, qb, g);
#ifdef MOBA_PVAR
            else if (mask & 64) moba_unit<MOBA_PVAR>(Fu, b, kvh, qb, g);
#endif
            else moba_unit<0>(Fu, b, kvh, qb, g); }
#endif
#ifndef NO_SSM
        if (it >= 768 && it < 1024 && (mask & 2)) { const int r = it - 768; ssm_unit(Fu, layer, r >> 4, r & 15); }
#endif
#ifndef NO_SWA
        if (it >= 1024 && it < 1280 && (mask & 4)) { const int r = it - 1024; swa_unit(P, Fu, layer, r >> 4, (r >> 3) & 1, r & 7); }
#endif
        if (it >= 1280 && (mask & 32)) { const int r = it - 1280; glu_unit(P, Fu, layer, r >> 4, r & 15); }
    }
}

#define XB_TMO      128
#define XB_XCNT(j)  (256  + 64 * (j))
#define XB_XSUB(j)  (1280 + 64 * (j))
#define XB_XGEN(j)  (2304 + 64 * (j))
#define XB_TOP      3328
#define XB_TOPGEN   3392
#define XCD_BAR_WORDS 3456
#define XB_SPIN_CAP (1u << 18)

__device__ __forceinline__ unsigned xb_ld(unsigned* p)              { return __hip_atomic_load(p, __ATOMIC_RELAXED, __HIP_MEMORY_SCOPE_AGENT); }
__device__ __forceinline__ unsigned xb_add(unsigned* p, unsigned v) { return __hip_atomic_fetch_add(p, v, __ATOMIC_RELAXED, __HIP_MEMORY_SCOPE_AGENT); }
__device__ __forceinline__ unsigned xb_xcc_id() { return (unsigned)__builtin_amdgcn_s_getreg((3 << 11) | 20) & 0xFu; }
#define XB_SPIN(cond, bar) do { unsigned _sp = 0; while (cond) { __builtin_amdgcn_s_sleep(1); \
    if ((++_sp & 255u) == 0u) { if (xb_ld(&(bar)[XB_TMO])) break; if (_sp > XB_SPIN_CAP) { atomicAdd(&(bar)[XB_TMO], 1u); break; } } } } while (0)

struct XcdBarrier {
    unsigned* bar; unsigned x;
    volatile LAS unsigned* st;
};

__device__ __forceinline__ XcdBarrier xcd_barrier_post(unsigned* bar, volatile LAS unsigned* st) {
    XcdBarrier b; b.bar = bar; b.x = xb_xcc_id(); b.st = st;
    if (threadIdx.x == 0) (void)xb_add(&bar[XB_XCNT(b.x)], 1u);
    return b;
}
__device__ __forceinline__ void xcd_barrier_complete(unsigned* bar, unsigned x, unsigned& nloc, unsigned& nx) {
    const unsigned G = gridDim.x * gridDim.y * gridDim.z;
    unsigned sum, cnt, mine, sp = 0u;
    for (;;) {
        sum = 0u; cnt = 0u; mine = 0u;
#pragma unroll 1
        for (unsigned j = 0; j < 16; ++j) { const unsigned c = xb_ld(&bar[XB_XCNT(j)]); sum += c; cnt += (c > 0u) ? 1u : 0u; mine = (j == x) ? c : mine; }
        if (sum == G) break;
        __builtin_amdgcn_s_sleep(1);
        if ((++sp & 255u) == 0u) { if (xb_ld(&bar[XB_TMO])) break; if (sp > XB_SPIN_CAP) { atomicAdd(&bar[XB_TMO], 1u); break; } }
    }
    nloc = mine > 0u ? mine : 1u; nx = cnt > 0u ? cnt : 1u;
}

__device__ __forceinline__ void xcd_barrier(const XcdBarrier& b) {
    asm volatile("s_waitcnt vmcnt(0)" ::: "memory");
    __syncthreads();
    if (threadIdx.x == 0) {
        unsigned* bar = b.bar;
        __builtin_amdgcn_s_waitcnt(0);
        unsigned nloc = b.st[0], nx = b.st[1];
        if (nloc == 0u) { xcd_barrier_complete(bar, b.x, nloc, nx); b.st[0] = nloc; b.st[1] = nx; }
        const unsigned old = xb_add(&bar[XB_XSUB(b.x)], 1u);
        const unsigned gen = old / nloc;
        if (old + 1u == (gen + 1u) * nloc) {
            __builtin_amdgcn_fence(__ATOMIC_RELEASE, "agent");
            asm volatile("s_waitcnt vmcnt(0)" ::: "memory");
            const unsigned og = xb_add(&bar[XB_TOP], 1u);
            const unsigned tg = og / nx;
            if (og + 1u == (tg + 1u) * nx) xb_add(&bar[XB_TOPGEN], 1u);
            else XB_SPIN(xb_ld(&bar[XB_TOPGEN]) == tg, bar);
            __builtin_amdgcn_fence(__ATOMIC_ACQUIRE, "agent");
            xb_add(&bar[XB_XGEN(b.x)], 1u);
            asm volatile("s_waitcnt vmcnt(0)" ::: "memory");
        } else {
            XB_SPIN(xb_ld(&bar[XB_XGEN(b.x)]) == gen, bar);
            __builtin_amdgcn_fence(__ATOMIC_ACQUIRE, "agent");
            asm volatile("s_waitcnt vmcnt(0)" ::: "memory");
        }
    }
    __syncthreads();
}

constexpr int CW_BAR = 4096;
#ifndef USE_COOP_LAUNCH
#define USE_COOP_LAUNCH 0
#endif
#ifndef REP_P0
#define REP_P0 1
#endif
#ifndef REP_P1
#define REP_P1 1
#endif
#ifndef REP_MIX
#define REP_MIX 1
#endif
#ifndef REP_GLU
#define REP_GLU 1
#endif
#ifndef REP_P3L0
#define REP_P3L0 1
#endif
#ifndef REP_SYNC
#define REP_SYNC 1
#endif
#ifndef P3_PROBE_SKIP
#define P3_PROBE_SKIP 0
#endif
#ifndef MIX_EXTRA_MASK
#define MIX_EXTRA_MASK 39
#endif
#ifndef USE_CG_SYNC
#define USE_CG_SYNC 0
#endif
#define GRID_SYNC() do { for (int r_ = 0; r_ < REP_SYNC; ++r_) { if (USE_CG_SYNC) cg::this_grid().sync(); else xcd_barrier(xbar); } STAMP(); } while (0)
#ifdef PROBE_TS_A
#define STAMP() do { if (n_stamp == PROBE_TS_A) ts_a = __builtin_amdgcn_s_memrealtime(); if (n_stamp == PROBE_TS_B) ts_b = __builtin_amdgcn_s_memrealtime(); ++n_stamp; } while (0)
#else
#define STAMP() do {} while (0)
#endif
__global__ void __launch_bounds__(512, 2) mk_fwd(Params P) {
    extern __shared__ __attribute__((aligned(16))) unsigned char lds_raw[];
    Frame F;
    F.lds = (LAS unsigned char*)lds_raw; F.tid = threadIdx.x; F.lane = F.tid & 63; F.wave = __builtin_amdgcn_readfirstlane(F.tid >> 6); F.G = gridDim.x; F.bid = blockIdx.x;
    F.out = (float*)kin(19); F.ws = (unsigned char*)kin(20); F.ctl = (unsigned*)(F.ws + WS_CTL);
    if (F.tid < 128) ((LAS unsigned*)(F.lds + LDS_CTL))[F.tid] = 0u;
    __syncthreads();
    const XcdBarrier xbar = xcd_barrier_post(F.ctl + CW_BAR, (volatile LAS unsigned*)(F.lds + LDS_CTL + 16));

    int n_stamp = 0; unsigned long long ts_a = 0, ts_b = 0; (void)n_stamp; (void)ts_a; (void)ts_b;
    STAMP();
#ifndef NO_P0
    for (int rep = 0; rep < REP_P0; ++rep) { Frame Fp = phase_frame(F); p0_prologue(P, Fp); }
#endif
    GRID_SYNC();
#pragma unroll 1
    for (int layer = 0; layer < DEPTH; ++layer) {
#ifndef NO_P1
        for (int rep = 0; rep < REP_P1; ++rep) {
            Frame Fp = phase_frame(F);
            pg8::Gemm g{((bf16*)(Fp.ws + WS_Z)), ((bf16*)(Fp.ws + WS_Z)), ZROWS, ZROWS, DM}; const SchedTab S = make_sched<0>(Fp, NTT + 10 * layer);
            EpiProj E{NTT + 10 * layer, layer, Fp.ws};
            pg8::gemm_phase<EpiProj, SchedTab, true, true>(F.lds, g, S, E);
        }
#endif
        GRID_SYNC();
#ifndef NO_MIX
        for (int rep = 0; rep < REP_MIX; ++rep) { Frame Fp = phase_frame(F); mixer_phase(P, Fp, layer + 2 * rep, layer, rep ? MIX_EXTRA_MASK : 39); }
#endif
        GRID_SYNC();
#ifndef NO_P3
        for (int rep = 0; rep < (layer == 0 ? REP_P3L0 : 1); ++rep) {
            Frame Fp = phase_frame(F);
            pg8::Gemm g{((bf16*)(Fp.ws + WS_Y)), ((bf16*)(Fp.ws + WS_WOUT)) + (size_t)layer * DM * DM, MTOK, DM, DM}; const SchedTab S = make_sched<1>(Fp, 0);
            EpiOut E{kin(0), F.out, ((bf16*)(Fp.ws + WS_Z)), ((float*)(Fp.ws + WS_ROWSS)), layer + 1 < DEPTH ? 1 : 0, (LAS float*)(F.lds + LDS_MISC + 4096), (rep > 0 && P3_PROBE_SKIP) ? 1 : 0};
            pg8::gemm_phase<EpiOut, SchedTab, true, true>(F.lds, g, S, E);
        }
#endif
        if (layer + 1 < DEPTH) GRID_SYNC();
    }
#ifdef PROBE_TS_A
    GRID_SYNC();
    if (blockIdx.x == 0) { const unsigned long long n = (ts_b - ts_a) * PROBE_TS_MULT / PROBE_TS_DIV; for (unsigned long long i = threadIdx.x; i < n; i += 512) F.out[i] += 0.08f; }
#endif
}

extern "C" void kernel_launch(void* const* d_in, const int* in_sizes, int n_in, void* d_out, int out_size, void* d_ws, size_t ws_size, hipStream_t stream) {
    static int grid = 0;
    if (grid == 0) {
        if (n_in != 19 || out_size != MTOK * DM || ws_size < WS_END) { fprintf(stderr, "kernel_launch: unexpected problem (n_in %d out %d ws %zu)\n", n_in, out_size, ws_size); grid = -1; return; }
        int dev = 0, cus = 0, per_cu = 0;
        (void)hipGetDevice(&dev);
        (void)hipDeviceGetAttribute(&cus, hipDeviceAttributeMultiprocessorCount, dev);
        (void)hipFuncSetAttribute((const void*)mk_fwd, hipFuncAttributeMaxDynamicSharedMemorySize, LDS_BYTES);
        (void)hipOccupancyMaxActiveBlocksPerMultiprocessor(&per_cu, (const void*)mk_fwd, 512, LDS_BYTES);
        if (per_cu < 1) { fprintf(stderr, "kernel_launch: occupancy query says %d blocks per CU\n", per_cu); per_cu = 1; }
        grid = cus;
    }
    if (grid < 0) return;
    (void)hipMemsetAsync((char*)d_ws + WS_CTL, 0, CTL_BYTES, stream);
    Params p{};
    for (int i = 0; i < 19; ++i) p.in[i] = (const float*)d_in[i];
    p.out = (float*)d_out; p.ws = (unsigned char*)d_ws;
#if USE_COOP_LAUNCH
    void* args[] = {&p};
    hipError_t e = hipLaunchCooperativeKernel((const void*)mk_fwd, dim3(grid), dim3(512), args, LDS_BYTES, stream);
    if (e != hipSuccess) fprintf(stderr, "cooperative launch failed: %s (grid %d)\n", hipGetErrorString(e), grid);
#else
    hipLaunchKernelGGL(mk_fwd, dim3(grid), dim3(512), LDS_BYTES, stream, p);
    const hipError_t e = hipPeekAtLastError();
    if (e != hipSuccess) fprintf(stderr, "launch failed: %s (grid %d)\n", hipGetErrorString(e), grid);
#endif
}
```

```cpp
#include <hip/hip_runtime.h>
#include <hip/hip_cooperative_groups.h>
#include <cstdio>
#include <cstdint>
namespace cg = cooperative_groups;
namespace pg8 {
#define PG8_LAS __attribute__((address_space(3)))
typedef unsigned short bf16_t;
typedef short bf16x8 __attribute__((ext_vector_type(8)));
typedef float f32x4 __attribute__((ext_vector_type(4)));
typedef unsigned u32x4 __attribute__((ext_vector_type(4)));
constexpr int BM = 256, BK = 64, HALF = 128, HTB = HALF * BK * 2  , STAGE_BYTES = 8 * HTB, NXCD = 8, WGM = 8;

__host__ __device__ __forceinline__ int lds_byte(int r, int c) { const int st = (r >> 4) * 2 + (c >> 5), rr = r & 15, cc = c & 31, ob = rr * 64 + cc * 2; return st * 1024 + (ob ^ (((ob >> 9) & 1) << 5)); }
__host__ __device__ __forceinline__ void stage_rc(int b, int& R, int& C) { const int st = b / 1024, sb = b % 1024, swz = sb ^ (((sb >> 9) & 1) << 5); R = (st >> 1) * 16 + swz / 64; C = (st & 1) * 32 + (swz % 64) / 2; }
__host__ __device__ __forceinline__ int perm32(int rho) { const int n = rho >> 4, i = rho & 15; return 8 * (i >> 2) + 4 * n + (i & 3); }

struct Unit { int pm, pn; };
struct Gemm { const bf16_t* A; const bf16_t* Bt; int M, N, K; };

__device__ __forceinline__ unsigned cvt_pk_bf16(float lo, float hi) { unsigned r; asm volatile("v_cvt_pk_bf16_f32 %0, %1, %2" : "=v"(r) : "v"(lo), "v"(hi)); return r; }
typedef float f32x2 __attribute__((ext_vector_type(2)));
template <class Epi, class Sched, bool ALIGN_EPI = false, bool SP2 = false>
__device__ __forceinline__ void gemm_phase(PG8_LAS unsigned char* lds, const Gemm g, const Sched& S, const Epi& E) {
    int tid_ = threadIdx.x; asm volatile("" : "+v"(tid_));
    const int tid = tid_, wid = __builtin_amdgcn_readfirstlane(tid >> 6), lane = tid & 63, wr = wid >> 2, wc = wid & 3, fr = lane & 15, fq = lane >> 4;
    const int K = g.K, nt = K / BK;
    unsigned voffA[2], voffB[2];
#pragma unroll
    for (int i = 0; i < 2; ++i) { int R, C; stage_rc(tid * 16 + i * 8192, R, C); const int Rb = Epi::PERM ? ((R & ~31) + perm32(R & 31)) : R;
        voffA[i] = (unsigned)(R * K + C) * 2u; voffB[i] = (unsigned)(Rb * K + C) * 2u; }
    const size_t kstep = (size_t)(BK * 2);
    const size_t hstep = (size_t)HALF * K * 2;
    const size_t tstep = 2 * hstep;
    const unsigned ldsw = (unsigned)wid * 1024u;
    const int aoff = lds_byte(wr * 64 + fr, fq * 8), boff = lds_byte(wc * 32 + fr, fq * 8);
#define PG8_SA(b, h) (((b) * 2 + (h)) * HTB)
#define PG8_SB(b, h) ((4 + (b) * 2 + (h)) * HTB)
#define PG8_STAGE(bufoff, gbase, voff) do { _Pragma("unroll") for (int _i = 0; _i < 2; ++_i) \
        __builtin_amdgcn_global_load_lds((const unsigned*)((const char*)(gbase) + (voff)[_i]), (PG8_LAS unsigned*)(lds + (bufoff) + ldsw + _i * 8192), 16, 0, 0); } while (0)
#define PG8_LDA(dst, b, h) do { _Pragma("unroll") for (int m = 0; m < 4; ++m) _Pragma("unroll") for (int k = 0; k < 2; ++k) dst[m][k] = *(const PG8_LAS bf16x8*)(lds + PG8_SA(b, h) + aoff + m * 2048 + k * 1024); } while (0)
#define PG8_LDB(dst, b, h) do { _Pragma("unroll") for (int n = 0; n < 2; ++n) _Pragma("unroll") for (int k = 0; k < 2; ++k) dst[n][k] = *(const PG8_LAS bf16x8*)(lds + PG8_SB(b, h) + boff + n * 2048 + k * 1024); } while (0)
#define PG8_MMA(ai, bj, At, Bt) do { __builtin_amdgcn_s_setprio(1); _Pragma("unroll") for (int m = 0; m < 4; ++m) _Pragma("unroll") for (int n = 0; n < 2; ++n) _Pragma("unroll") for (int k = 0; k < 2; ++k) \
        acc[ai][bj][m][n] = __builtin_amdgcn_mfma_f32_16x16x32_bf16(Bt[n][k], At[m][k], acc[ai][bj][m][n], 0, 0, 0); __builtin_amdgcn_s_setprio(0); } while (0)
#define PG8_WAIT_V(n) asm volatile("s_waitcnt vmcnt(" #n ")" ::: "memory")
#define PG8_WAIT_L(n) asm volatile("s_waitcnt lgkmcnt(" #n ")" ::: "memory")
#define PG8_BAR __builtin_amdgcn_s_barrier()
#define PG8_SCHED __builtin_amdgcn_sched_barrier(0)
    Unit cur, nxt; int ui = 0;
    if (!S.next(0, cur)) return;
    f32x4 acc[2][2][4][2];
#pragma unroll
    for (int a = 0; a < 2; ++a)
#pragma unroll
        for (int b = 0; b < 2; ++b)
#pragma unroll
            for (int m = 0; m < 4; ++m)
#pragma unroll
                for (int n = 0; n < 2; ++n) acc[a][b][m][n] = (f32x4){0.f, 0.f, 0.f, 0.f};
    bf16x8 At[4][2], B0[2][2], B1[2][2];
    const char* cA = (const char*)g.A + (size_t)cur.pm * tstep; const char* cB = (const char*)g.Bt + (size_t)cur.pn * tstep;
    S.a_ready(cur);
    if constexpr (SP2) {
        PG8_STAGE(PG8_SB(0, 0), cB, voffB); PG8_STAGE(PG8_SB(0, 1), cB + hstep, voffB); PG8_STAGE(PG8_SA(0, 0), cA, voffA); PG8_STAGE(PG8_SA(0, 1), cA + hstep, voffA);
        if (wr == 1) PG8_BAR;
        PG8_WAIT_V(2); PG8_BAR;
        PG8_STAGE(PG8_SB(1, 0), cB + kstep, voffB); PG8_STAGE(PG8_SA(1, 0), cA + kstep, voffA); PG8_STAGE(PG8_SB(1, 1), cB + hstep + kstep, voffB);
        PG8_WAIT_V(6); PG8_BAR;
    } else {
        PG8_STAGE(PG8_SB(0, 0), cB, voffB); PG8_STAGE(PG8_SA(0, 0), cA, voffA); PG8_STAGE(PG8_SB(0, 1), cB + hstep, voffB); PG8_STAGE(PG8_SA(0, 1), cA + hstep, voffA);
        if (wr == 1) PG8_BAR;
        PG8_WAIT_V(4); PG8_BAR;
        PG8_STAGE(PG8_SB(1, 0), cB + kstep, voffB); PG8_STAGE(PG8_SA(1, 0), cA + kstep, voffA); PG8_STAGE(PG8_SB(1, 1), cB + hstep + kstep, voffB);
        PG8_WAIT_V(6); PG8_BAR;
    }
    for (;;) {
        const bool has_next = S.next(ui + 1, nxt);
        const char* nA = has_next ? (const char*)g.A + (size_t)nxt.pm * tstep : cA; const char* nB = has_next ? (const char*)g.Bt + (size_t)nxt.pn * tstep : cB;
        for (int t = 0; t < nt; t += 2) {
            const bool last = (t == nt - 2);
            const char* a1 = cA + (size_t)(t + 1) * kstep;
            const char* a2 = last ? nA : cA + (size_t)(t + 2) * kstep; const char* b2 = last ? nB : cB + (size_t)(t + 2) * kstep;
            const char* a3 = a2 + kstep; const char* b3 = b2 + kstep;
            if (last && has_next) S.a_ready(nxt);
            if constexpr (SP2) {
            PG8_LDB(B0, 0, 0); PG8_LDB(B1, 0, 1); PG8_SCHED; PG8_LDA(At, 0, 0); PG8_STAGE(PG8_SA(1, 1), a1 + hstep, voffA);
            PG8_WAIT_V(8); PG8_WAIT_L(0); PG8_BAR; PG8_MMA(0, 0, At, B0); PG8_MMA(0, 1, At, B1); PG8_BAR; PG8_SCHED;
            PG8_LDA(At, 0, 1); PG8_STAGE(PG8_SB(0, 0), b2, voffB); PG8_STAGE(PG8_SB(0, 1), b2 + hstep, voffB); PG8_STAGE(PG8_SA(0, 0), a2, voffA);
            PG8_WAIT_V(8); PG8_WAIT_L(0); PG8_BAR; PG8_MMA(1, 0, At, B0); PG8_MMA(1, 1, At, B1); PG8_BAR; PG8_SCHED;
            PG8_LDB(B0, 1, 0); PG8_LDB(B1, 1, 1); PG8_SCHED; PG8_LDA(At, 1, 0); PG8_STAGE(PG8_SA(0, 1), a2 + hstep, voffA);
            PG8_WAIT_V(8); PG8_WAIT_L(0); PG8_BAR; PG8_MMA(0, 0, At, B0); PG8_MMA(0, 1, At, B1); PG8_BAR; PG8_SCHED;
            PG8_LDA(At, 1, 1); PG8_STAGE(PG8_SB(1, 0), b3, voffB); PG8_STAGE(PG8_SB(1, 1), b3 + hstep, voffB); PG8_STAGE(PG8_SA(1, 0), a3, voffA);
            PG8_WAIT_V(8); PG8_WAIT_L(0); PG8_BAR; PG8_MMA(1, 0, At, B0); PG8_MMA(1, 1, At, B1); PG8_BAR; PG8_SCHED;
            } else {
            PG8_LDB(B0, 0, 0); PG8_SCHED; PG8_LDA(At, 0, 0); PG8_STAGE(PG8_SA(1, 1), a1 + hstep, voffA);
            PG8_WAIT_L(8); PG8_BAR; PG8_WAIT_L(0); PG8_MMA(0, 0, At, B0); PG8_BAR; PG8_SCHED;
            PG8_LDB(B1, 0, 1); PG8_STAGE(PG8_SB(0, 0), b2, voffB);
            PG8_BAR; PG8_WAIT_L(0); PG8_MMA(0, 1, At, B1); PG8_BAR;
            PG8_LDA(At, 0, 1); PG8_STAGE(PG8_SA(0, 0), a2, voffA);
            PG8_BAR; PG8_WAIT_L(0); PG8_MMA(1, 0, At, B0); PG8_BAR; PG8_SCHED;
            PG8_STAGE(PG8_SB(0, 1), b2 + hstep, voffB);
            PG8_WAIT_V(6); PG8_BAR; PG8_MMA(1, 1, At, B1); PG8_BAR;
            PG8_LDB(B0, 1, 0); PG8_SCHED; PG8_LDA(At, 1, 0); PG8_STAGE(PG8_SA(0, 1), a2 + hstep, voffA);
            PG8_WAIT_L(8); PG8_BAR; PG8_WAIT_L(0); PG8_MMA(0, 0, At, B0); PG8_BAR; PG8_SCHED;
            PG8_LDB(B1, 1, 1); PG8_STAGE(PG8_SB(1, 0), b3, voffB);
            PG8_BAR; PG8_WAIT_L(0); PG8_MMA(0, 1, At, B1); PG8_BAR;
            PG8_LDA(At, 1, 1); PG8_STAGE(PG8_SA(1, 0), a3, voffA);
            PG8_BAR; PG8_WAIT_L(0); PG8_MMA(1, 0, At, B0); PG8_BAR; PG8_SCHED;
            PG8_STAGE(PG8_SB(1, 1), b3 + hstep, voffB);
            PG8_WAIT_V(6); PG8_BAR; PG8_MMA(1, 1, At, B1); PG8_BAR;
            }
        }
        if constexpr (ALIGN_EPI) { if (wr == 0) PG8_BAR; }
        if constexpr (!Epi::AFTER_DRAIN) { E(acc, cur, wr, wc, fr, fq); S.done(cur); }
        if (!has_next) break;
#pragma unroll
        for (int a = 0; a < 2; ++a)
#pragma unroll
            for (int b = 0; b < 2; ++b)
#pragma unroll
                for (int m = 0; m < 4; ++m)
#pragma unroll
                    for (int n = 0; n < 2; ++n) acc[a][b][m][n] = (f32x4){0.f, 0.f, 0.f, 0.f};
        cur = nxt; cA = nA; cB = nB; ++ui;
        if constexpr (ALIGN_EPI) { if (wr == 1) PG8_BAR; }
    }
    PG8_WAIT_V(0);
    if constexpr (!ALIGN_EPI) { if (wr == 0) PG8_BAR; }
    PG8_BAR;
    if constexpr (Epi::AFTER_DRAIN) { E.fused(acc, cur, wr, wc, fr, fq, lds, wid, lane); S.done(cur); }
#undef PG8_SA
#undef PG8_SB
#undef PG8_STAGE
#undef PG8_LDA
#undef PG8_LDB
#undef PG8_MMA
#undef PG8_WAIT_V
#undef PG8_WAIT_L
#undef PG8_BAR
#undef PG8_SCHED
}
}

#define GAS __attribute__((address_space(1)))
#define LAS __attribute__((address_space(3)))
typedef unsigned short bf16;
typedef short bf16x8 __attribute__((ext_vector_type(8)));
typedef float f32x4 __attribute__((ext_vector_type(4)));
typedef float f32x16 __attribute__((ext_vector_type(16)));
typedef unsigned u32x4 __attribute__((ext_vector_type(4)));
typedef unsigned u32x2 __attribute__((ext_vector_type(2)));
typedef float f32x2_t __attribute__((ext_vector_type(2)));
typedef __bf16 bf16x2_t __attribute__((ext_vector_type(2)));
using pg8::Unit;

constexpr int NB = 16, SEQ = 2048, MTOK = NB * SEQ, DM = 1024, NPROJ = 2560, DEPTH = 2;
constexpr int NTT = MTOK / 256;
constexpr int ZROWS = MTOK + DEPTH * NPROJ;
constexpr float RMS_EPS = 1e-6f;
constexpr float LOG2E = 1.4426950408889634f;
constexpr float QSCALE = 0.125f * LOG2E;
constexpr int LDS_BYTES = 147456;
constexpr int LDS_MISC = 131072;
constexpr int LDS_CTL = LDS_BYTES - 512;

constexpr size_t MiB = 1u << 20;
constexpr size_t WS_CTL = 0, CTL_BYTES = 64 * 1024;
constexpr size_t WS_Z = 2 * MiB, WS_WOUT = 78 * MiB, WS_GLU = 82 * MiB, WS_TE = 83 * MiB, WS_G = 89 * MiB, WS_AT = 91 * MiB;
constexpr size_t WS_U = 92 * MiB, WS_SG = 108 * MiB, WS_AQ = 124 * MiB, WS_AK = 148 * MiB, WS_AG = 156 * MiB, WS_MQ = 180 * MiB, WS_MK = 204 * MiB, WS_MG = 212 * MiB;
constexpr size_t WS_VT = 236 * MiB, WS_KPART = 252 * MiB, WS_ROWSS = 253 * MiB, WS_YPRE = 254 * MiB, WS_Y = 270 * MiB, WS_END = 334 * MiB;
static_assert(WS_Z + (size_t)ZROWS * DM * 2 <= WS_WOUT, "Z fits");
constexpr size_t WS_NW = 1 * MiB;
constexpr int TE_ELEMS = 256 * 384, G_ELEMS = 128 * 256;
constexpr int CW_QUEUE = 1024;
constexpr int CW_SSMDONE = 8192;

__device__ __forceinline__ unsigned pk2(float lo, float hi) { f32x2_t v = {lo, hi}; bf16x2_t b = __builtin_convertvector(v, bf16x2_t); return __builtin_bit_cast(unsigned, b); }
__device__ __forceinline__ float bf2f(unsigned short x) { return __uint_as_float((unsigned)x << 16); }
__device__ __forceinline__ float bflo(unsigned w) { return __uint_as_float(w << 16); }
__device__ __forceinline__ float bfhi(unsigned w) { return __uint_as_float(w & 0xffff0000u); }
__device__ __forceinline__ float wave_sum(float v) {
#pragma unroll
    for (int o = 1; o < 64; o <<= 1) v += __shfl_xor(v, o);
    return v;
}
__device__ __forceinline__ float fast_rcp(float x) { return __builtin_amdgcn_rcpf(x); }
__device__ __forceinline__ float silu_f(float x) { return x * fast_rcp(1.f + __builtin_amdgcn_exp2f(-x * LOG2E)); }
__device__ __forceinline__ float sigmoid_f(float x) { return fast_rcp(1.f + __builtin_amdgcn_exp2f(-x * LOG2E)); }
__device__ __forceinline__ float gelu_tanh_f(float x) { const float z = 0.7978845608028654f * (x + 0.044715f * x * x * x); return x * fast_rcp(1.f + __builtin_amdgcn_exp2f(-2.f * LOG2E * z)); }
__device__ __forceinline__ float swap32_max(float m) { auto rr = __builtin_amdgcn_permlane32_swap(__float_as_uint(m), __float_as_uint(m), false, false); return fmaxf(__uint_as_float(rr[0]), __uint_as_float(rr[1])); }
__device__ __forceinline__ float swap32_sum(float m) { auto rr = __builtin_amdgcn_permlane32_swap(__float_as_uint(m), __float_as_uint(m), false, false); return __uint_as_float(rr[0]) + __uint_as_float(rr[1]); }
__device__ __forceinline__ void glds16(const void* gsrc, LAS unsigned char* ldst) {
    const unsigned dst = __builtin_amdgcn_readfirstlane((unsigned)(uintptr_t)ldst); unsigned keep;
    asm volatile("s_mov_b32 %0, m0\n\ts_mov_b32 m0, %2\n\ts_nop 0\n\tglobal_load_lds_dwordx4 %1, off\n\ts_mov_b32 m0, %0" : "=&s"(keep) : "v"(gsrc), "s"(dst) : "memory");
}
#define GLDS_WAIT() asm volatile("s_waitcnt vmcnt(0)" ::: "memory")

struct Params {
    const float* in[19]; float* out; unsigned char* ws;
};
typedef const float* const __attribute__((address_space(4))) * kargs_t;
__device__ __forceinline__ const float* kin(int i) { kargs_t ka = (kargs_t)__builtin_amdgcn_kernarg_segment_ptr(); asm volatile("" : "+s"(ka)); return ka[i]; }
struct Frame {
    LAS unsigned char* lds; int tid, lane, wave, G, bid; float* out; unsigned char* ws; unsigned* ctl;
};

__device__ __forceinline__ int proj_dest_row(int n0) {
    int slot, off;
    if (n0 < 512)       { slot = n0 >> 6; off = n0 & 63; }
    else if (n0 < 1024) { slot = 8 + ((n0 - 512) >> 6); off = n0 & 63; }
    else if (n0 < 1152) { return 2304 + (n0 - 1024); }
    else if (n0 < 1536) { slot = 16 + ((n0 - 1152) >> 6); off = (n0 - 1152) & 63; }
    else if (n0 < 1920) { slot = 22 + ((n0 - 1536) >> 6); off = (n0 - 1536) & 63; }
    else if (n0 < 2048) { slot = 28 + ((n0 - 1920) >> 6); off = (n0 - 1920) & 63; }
    else if (n0 < 2176) { return 2304 + 128 + (n0 - 2048); }
    else                { slot = 30 + ((n0 - 2176) >> 6); off = (n0 - 2176) & 63; }
    const int t = slot >> 2, wc = slot & 3;
    return 256 * t + 128 * (off >> 5) + 32 * wc;
}
__device__ __forceinline__ void p0_transpose_item(const float* W, int K, int N, const float* gk, bf16* WT, int ldk, int drow0, LAS float* scr, int k0, int n0, int lane) {
    float tv[32];
#pragma unroll
    for (int i = 0; i < 32; ++i) { const int kk = 2 * i + (lane >> 5); tv[i] = __builtin_nontemporal_load(W + (size_t)(k0 + kk) * N + n0 + (lane & 31)); }
#pragma unroll
    for (int i = 0; i < 32; ++i) { const int kk = 2 * i + (lane >> 5); float v = tv[i]; if (gk) v *= gk[k0 + kk]; scr[kk * 33 + (lane & 31)] = v; }
    asm volatile("s_waitcnt lgkmcnt(0)" ::: "memory");
    const int c = lane & 7;
#pragma unroll
    for (int j = 0; j < 4; ++j) { const int n = (lane >> 3) + 8 * j; const LAS float* s = scr + (8 * c) * 33 + n;
        u32x4 o; o.x = pk2(s[0 * 33], s[1 * 33]); o.y = pk2(s[2 * 33], s[3 * 33]); o.z = pk2(s[4 * 33], s[5 * 33]); o.w = pk2(s[6 * 33], s[7 * 33]);
        *(u32x4*)(WT + (size_t)(drow0 + n) * ldk + k0 + 8 * c) = o; }
    asm volatile("s_waitcnt lgkmcnt(0)" ::: "memory");
}
__device__ __forceinline__ void p0_ssm_consts(const Params& P, Frame& F, int pair) {
    const int l = pair >> 4, g = pair & 15, tid = F.tid;
    LAS float* pwr = (LAS float*)(F.lds);
    LAS float* pwi = pwr + 17 * 64;
    LAS float* bbr = pwi + 17 * 64;
    LAS float* bbi = bbr + 1024;
    LAS float* ccr = bbi + 1024;
    LAS float* cci = ccr + 1024;
    LAS float* Kt = cci + 1024;
    const float dt = expf(kin(5)[l * 16 + g]);
    const float* lre = kin(3) + (l * 16 + g) * 64; const float* lim = kin(4) + (l * 16 + g) * 64;
    for (int t = tid; t < 17 * 64; t += 512) { const int p = t & 63, lag = t >> 6; const float lr = lre[p], li = lim[p];
        const float mag = expf(lr * dt * (float)lag); float sn, cs; sincosf(li * dt * (float)lag, &sn, &cs); pwr[t] = mag * cs; pwi[t] = mag * sn; }
    for (int t = tid; t < 1024; t += 512) { const int p = t >> 4, h = t & 15; const float lr = lre[p], li = lim[p];
        const float mag = expf(lr * dt); float sn, cs; sincosf(li * dt, &sn, &cs); const float ar = mag * cs, ai = mag * sn;
        const float den = lr * lr + li * li, nr = ar - 1.f, ni = ai; const float cr = (nr * lr + ni * li) / den, ci = (ni * lr - nr * li) / den;
        const float br = kin(6)[((size_t)(l * 16 + g) * 64 + p) * 16 + h], bi = kin(7)[((size_t)(l * 16 + g) * 64 + p) * 16 + h];
        bbr[t] = cr * br - ci * bi; bbi[t] = cr * bi + ci * br; }
    for (int t = tid; t < 1024; t += 512) { ccr[t] = kin(8)[(size_t)(l * 16 + g) * 1024 + t]; cci[t] = kin(9)[(size_t)(l * 16 + g) * 1024 + t]; }
    __syncthreads();
    for (int t = tid; t < 4096; t += 512) { const int lag = t >> 8, hp = (t >> 4) & 15, h = t & 15; float s = 0.f;
        for (int p = 0; p < 64; ++p) { const float cr = ccr[hp * 64 + p], ci = cci[hp * 64 + p], pr = pwr[lag * 64 + p], pi = pwi[lag * 64 + p];
            const float xr = cr * pr - ci * pi, xi = cr * pi + ci * pr; s += xr * bbr[p * 16 + h] - xi * bbi[p * 16 + h]; }
        if (lag == 0 && hp == h) s += kin(10)[l * 256 + g * 16 + h];
        Kt[t] = s; }
    __syncthreads();
    bf16* TE = ((bf16*)(F.ws + WS_TE)) + (size_t)pair * TE_ELEMS; bf16* GM = ((bf16*)(F.ws + WS_G)) + (size_t)pair * G_ELEMS;
    for (int t = tid; t < 256 * 192; t += 512) { const int n = t / 192, kp = t % 192, k = 2 * kp; const int i = n >> 4, hp = n & 15; float v0, v1;
        if (k < 256) { const int j = k >> 4, h = k & 15; if (j <= i) { v0 = Kt[((i - j) * 16 + hp) * 16 + h]; v1 = Kt[((i - j) * 16 + hp) * 16 + h + 1]; } else { v0 = 0.f; v1 = 0.f; } }
        else { const int p = (k - 256) >> 1; const float cr = ccr[hp * 64 + p], ci = cci[hp * 64 + p], pr = pwr[(i + 1) * 64 + p], pi = pwi[(i + 1) * 64 + p];
            v0 = cr * pr - ci * pi; v1 = -(cr * pi + ci * pr); }
        *(unsigned*)(TE + (size_t)n * 384 + k) = pk2(v0, v1); }
    for (int t = tid; t < 128 * 128; t += 512) { const int n = t >> 7, kp = t & 127, k = 2 * kp; const int p = n >> 1, ri = n & 1, j = k >> 4, h = k & 15;
        const float pr = pwr[(15 - j) * 64 + p], pi = pwi[(15 - j) * 64 + p];
        float v0, v1;
        { const float br = bbr[p * 16 + h], bi = bbi[p * 16 + h]; v0 = ri ? (pr * bi + pi * br) : (pr * br - pi * bi); }
        { const float br = bbr[p * 16 + h + 1], bi = bbi[p * 16 + h + 1]; v1 = ri ? (pr * bi + pi * br) : (pr * br - pi * bi); }
        *(unsigned*)(GM + (size_t)n * 256 + k) = pk2(v0, v1); }
    if (tid < 64) { ((float*)(F.ws + WS_AT))[(size_t)pair * 128 + 2 * tid] = pwr[16 * 64 + tid]; ((float*)(F.ws + WS_AT))[(size_t)pair * 128 + 2 * tid + 1] = pwi[16 * 64 + tid]; }
    __syncthreads();
}
__device__ __forceinline__ void p0_prologue(const Params& P, Frame& F) {
    const bool split = F.G > 64;
    if (!split || F.bid < 32) { for (int pair = F.bid; pair < 32; pair += (split ? 32 : F.G)) p0_ssm_consts(P, F, pair); if (split) return; }
    const int vb = split ? F.bid - 32 : F.bid, nvb = split ? F.G - 32 : F.G;
    if (vb == 0) { float* nwp = (float*)(F.ws + WS_NW);
        for (int t = F.tid; t < DEPTH * 256; t += 512) { const int l = t >> 8, k = (t >> 6) & 3, d = t & 63;
            nwp[t] = (k == 0) ? kin(13)[l * 64 + d] * QSCALE : (k == 1) ? kin(14)[l * 64 + d] : (k == 2) ? kin(16)[l * 64 + d] * QSCALE : kin(17)[l * 64 + d]; } }
    const int gw = vb * 8 + F.wave, NGW = nvb * 8;
    LAS float* scr = (LAS float*)(F.lds + F.wave * 16384);
    constexpr int I_IN = 16 * 80, I_OUT = 16 * 32, I_GLU = 4 * 8, I_L = I_IN + I_OUT + I_GLU;
    for (int it = gw; it < DEPTH * I_L; it += NGW) {
        const int l = it / I_L; int r = it % I_L;
        if (r < I_IN) { const int kb = r / 80, nb = r % 80; p0_transpose_item(kin(2) + (size_t)l * DM * NPROJ, DM, NPROJ, kin(1) + l * DM, ((bf16*)(F.ws + WS_Z)) + (size_t)(MTOK + l * NPROJ) * DM, DM, proj_dest_row(32 * nb), scr, 64 * kb, 32 * nb, F.lane); continue; }
        r -= I_IN;
        if (r < I_OUT) { const int kb = r / 32, nb = r % 32; p0_transpose_item(kin(18) + (size_t)l * DM * DM, DM, DM, nullptr, ((bf16*)(F.ws + WS_WOUT)) + (size_t)l * DM * DM, DM, 32 * nb, scr, 64 * kb, 32 * nb, F.lane); continue; }
        r -= I_OUT;
        { const int kb = r / 8, nb = r % 8; p0_transpose_item(kin(11) + (size_t)l * 65536, 256, 256, nullptr, ((bf16*)(F.ws + WS_GLU)) + (size_t)l * 65536, 256, 32 * nb, scr, 64 * kb, 32 * nb, F.lane); }
    }
    for (int m0 = gw; m0 < MTOK; m0 += 4 * NGW) {
        f32x4 v[4][4];
#pragma unroll
        for (int q = 0; q < 4; ++q) { const int m = m0 + q * NGW; if (m < MTOK) { const f32x4* xr = (const f32x4*)(kin(0) + (size_t)m * DM) + F.lane;
#pragma unroll
            for (int j = 0; j < 4; ++j) v[q][j] = __builtin_nontemporal_load(xr + 64 * j); } }
#pragma unroll
        for (int q = 0; q < 4; ++q) { const int m = m0 + q * NGW; if (m < MTOK) { float s = 0.f;
#pragma unroll
            for (int j = 0; j < 4; ++j) s += (v[q][j].x * v[q][j].x + v[q][j].y * v[q][j].y) + (v[q][j].z * v[q][j].z + v[q][j].w * v[q][j].w);
            s = wave_sum(s);
            u32x2* o8 = (u32x2*)(((bf16*)(F.ws + WS_Z)) + (size_t)m * DM) + F.lane;
#pragma unroll
            for (int j = 0; j < 4; ++j) { u32x2 w; w.x = pk2(v[q][j].x, v[q][j].y); w.y = pk2(v[q][j].z, v[q][j].w); o8[64 * j] = w; }
            if (F.lane < 4) ((float*)(F.ws + WS_ROWSS))[(size_t)m * 4 + F.lane] = (F.lane == 0) ? s : 0.f; } }
    }
}

__device__ __forceinline__ Frame phase_frame(const Frame& F0) {
    Frame F = F0; asm volatile("" : "+v"(F.tid)); F.lane = F.tid & 63; F.wave = __builtin_amdgcn_readfirstlane(F.tid >> 6);
    asm volatile("" : "+s"(F.ws)); F.ctl = (unsigned*)(F.ws + WS_CTL); return F;
}
struct SchedTab { const volatile LAS int* tab; int n;
    __device__ __forceinline__ bool next(int i, Unit& u) const { if (i >= n) return false; u.pm = __builtin_amdgcn_readfirstlane(tab[2 * i]); u.pn = __builtin_amdgcn_readfirstlane(tab[2 * i + 1]); return true; }
    __device__ __forceinline__ void a_ready(const Unit&) const {}
    __device__ __forceinline__ void done(const Unit&) const {}
};
__device__ __forceinline__ bool unit_p1(int G, int c, int wbase, int i, int& pm, int& pn) {
    int tok, j;
    if (G == 256) { if (i >= 5) return false; const int x = c & 7, l = c >> 3, n = i * 32 + l, tq = n / 40, rem = n % 40; j = rem >> 2; tok = 16 * x + 4 * tq + (rem & 3); }
    else { const long L = (long)i * G + c; if (L >= NTT * 10) return false; tok = (int)(L / 10); j = (int)(L % 10); }
    if (j < 9) { pm = tok; pn = wbase + j; } else { pm = wbase + 9; pn = tok; }
    return true;
}
__device__ __forceinline__ bool unit_p3(int G, int c, int i, int& pm, int& pn) {
    if (G == 256) { if (i >= 2) return false; const int x = c & 7, l = c >> 3, n = i * 32 + l, tq = n >> 4, rem = n & 15; pn = rem >> 2; pm = 16 * x + 4 * tq + (rem & 3); }
    else { const long L = (long)i * G + c; if (L >= NTT * 4) return false; pm = (int)(L / 4); pn = (int)(L % 4); }
    return true;
}
__device__ __forceinline__ bool unit_glu(int G, int c, int i, int& pm, int& pn) {
    if (G == 256) { if (i >= 1 || (c >> 3) >= 16) return false; pm = 16 * (c & 7) + (c >> 3); pn = 0; }
    else { const long L = (long)i * G + c; if (L >= NTT) return false; pm = (int)L; pn = 0; }
    return true;
}
template <int KIND>
__device__ __forceinline__ SchedTab make_sched(const Frame& F, int wbase) {
    volatile LAS int* tab = (volatile LAS int*)(F.lds + LDS_CTL + 64);
    volatile LAS int* cnt = (volatile LAS int*)(F.lds + LDS_CTL + 32);
    if (F.tid == 0) { int n = 0;
#pragma unroll 1
        for (int i = 0; i < 24; ++i) { int pm, pn; const bool ok = (KIND == 0) ? unit_p1(F.G, F.bid, wbase, i, pm, pn) : (KIND == 1) ? unit_p3(F.G, F.bid, i, pm, pn) : unit_glu(F.G, F.bid, i, pm, pn);
            if (!ok) break; tab[2 * i] = pm; tab[2 * i + 1] = pn; n = i + 1; }
        cnt[0] = n; }
    __syncthreads();
    SchedTab S; S.tab = tab; S.n = __builtin_amdgcn_readfirstlane(cnt[0]); return S;
}

struct EpiProj {
    static constexpr bool PERM = true, AFTER_DRAIN = false;
    int wbase, layer; unsigned char* ws;
    __device__ __forceinline__ void operator()(const f32x4 (&acc)[2][2][4][2], const Unit& u, int wr, int wc, int fr, int fq) const {
        asm volatile("" : "+v"(fr), "+v"(fq));
        const float* rowss = (const float*)(ws + WS_ROWSS);
        if (u.pm >= NTT) {
            bf16* VT = (bf16*)(ws + WS_VT);
            const int tc = u.pn * 256 + wc * 32 + 8 * fq;
#pragma unroll
            for (int bj = 0; bj < 2; ++bj) {
                float rs[8];
                { f32x4 p[8];
#pragma unroll
                  for (int e = 0; e < 8; ++e) p[e] = *(const f32x4*)(rowss + (size_t)(tc + bj * 128 + e) * 4);
#pragma unroll
                  for (int e = 0; e < 8; ++e) rs[e] = rsqrtf(((p[e].x + p[e].y) + (p[e].z + p[e].w)) * (1.f / DM) + RMS_EPS); }
#pragma unroll
                for (int ai = 0; ai < 2; ++ai)
#pragma unroll
                    for (int m = 0; m < 4; ++m) { const int f = ai * 128 + wr * 64 + m * 16 + fr; const f32x4 a = acc[ai][bj][m][0], b = acc[ai][bj][m][1]; u32x4 w;
                        w.x = pk2(a[0] * rs[0], a[1] * rs[1]); w.y = pk2(a[2] * rs[2], a[3] * rs[3]); w.z = pk2(b[0] * rs[4], b[1] * rs[5]); w.w = pk2(b[2] * rs[6], b[3] * rs[7]);
                        *(u32x4*)(VT + ((size_t)u.pn * 256 + f) * 256 + (wc * 32 + 8 * fq + bj * 128)) = w; }
            }
            return;
        }
        const int t = u.pn - wbase;
        int kind, pitch, col, nwi = 0; size_t dsto;
        switch (t) {
            case 0: kind = 0; dsto = WS_U; pitch = 256; col = 64 * wc; break;
            case 1: kind = 1; dsto = WS_SG; pitch = 256; col = 64 * wc; break;
            case 2: kind = 2; dsto = WS_AQ; pitch = 384; col = 64 * wc; nwi = 0; break;
            case 3: if (wc < 2) { kind = 2; dsto = WS_AQ; pitch = 384; col = 64 * (4 + wc); nwi = 0; } else { kind = 2; dsto = WS_AK; pitch = 128; col = 64 * (wc - 2); nwi = 1; } break;
            case 4: kind = 1; dsto = WS_AG; pitch = 384; col = 64 * wc; break;
            case 5: if (wc < 2) { kind = 1; dsto = WS_AG; pitch = 384; col = 64 * (4 + wc); } else { kind = 2; dsto = WS_MQ; pitch = 384; col = 64 * (wc - 2); nwi = 2; } break;
            case 6: kind = 2; dsto = WS_MQ; pitch = 384; col = 64 * (2 + wc); nwi = 2; break;
            case 7: if (wc < 2) { kind = 5; dsto = WS_MK; pitch = 128; col = 64 * wc; nwi = 3; } else { kind = 1; dsto = WS_MG; pitch = 384; col = 64 * (wc - 2); } break;
            default: kind = 1; dsto = WS_MG; pitch = 384; col = 64 * (2 + wc); break;
        }
        bf16* dst = (bf16*)(ws + dsto) + col + 8 * fq; const float* nw = (const float*)(ws + WS_NW) + (layer * 4 + nwi) * 64 + 8 * fq;
        int row0 = u.pm * 256 + wr * 64 + fr; asm volatile("" : "+v"(row0));
        if (kind == 0) rows<0>(acc, row0, (bf16*)(ws + WS_U) + ((size_t)(4 * wc + (fq >> 1)) * SEQ) * 16 + 8 * (fq & 1), 0, nw, rowss, nullptr);
        else if (kind == 1) rows<1>(acc, row0, dst, pitch, nw, rowss, nullptr);
        else if (kind == 2) rows<2>(acc, row0, dst, pitch, nw, rowss, nullptr);
        else rows<5>(acc, row0, dst, pitch, nw, rowss, (fr == 0) ? (float*)(ws + WS_KPART) + ((size_t)(u.pm * 2 + wr) * 2 + wc) * 64 + 8 * fq : nullptr);
    }
    template <int KIND>
    __device__ __forceinline__ void rows(const f32x4 (&acc)[2][2][4][2], int row0, bf16* dst, int pitch, const float* nw, const float* rowss, float* kp) const {
        f32x4 wv[2][2], ks[2][2];
        if (KIND >= 2) {
#pragma unroll
            for (int bj = 0; bj < 2; ++bj)
#pragma unroll
                for (int n = 0; n < 2; ++n) { wv[bj][n] = *(const f32x4*)(nw + 32 * bj + 4 * n); ks[bj][n] = (f32x4){0.f, 0.f, 0.f, 0.f}; }
        }
#pragma unroll
        for (int ai = 0; ai < 2; ++ai) {
            float rsv[4];
            { f32x4 pr[4];
#pragma unroll
              for (int m = 0; m < 4; ++m) pr[m] = *(const f32x4*)(rowss + (size_t)(row0 + ai * 128 + m * 16) * 4);
#pragma unroll
              for (int m = 0; m < 4; ++m) { const f32x4 p = pr[m]; rsv[m] = rsqrtf(((p.x + p.y) + (p.z + p.w)) * (1.f / DM) + RMS_EPS); } }
#pragma unroll
            for (int m = 0; m < 4; ++m) {
                const int row = row0 + ai * 128 + m * 16;
                const float rs = rsv[m];
                f32x4 v[2][2];
#pragma unroll
                for (int bj = 0; bj < 2; ++bj)
#pragma unroll
                    for (int n = 0; n < 2; ++n) v[bj][n] = acc[ai][bj][m][n] * rs;
                if (KIND >= 2) {
                    float ss = 0.f;
#pragma unroll
                    for (int bj = 0; bj < 2; ++bj)
#pragma unroll
                        for (int n = 0; n < 2; ++n) { const f32x4 q = v[bj][n]; ss += (q[0] * q[0] + q[1] * q[1]) + (q[2] * q[2] + q[3] * q[3]); }
                    ss += __shfl_xor(ss, 16); ss += __shfl_xor(ss, 32);
                    const float hn = rsqrtf(ss * (1.f / 64.f) + RMS_EPS);
#pragma unroll
                    for (int bj = 0; bj < 2; ++bj)
#pragma unroll
                        for (int n = 0; n < 2; ++n) { v[bj][n] = v[bj][n] * wv[bj][n] * hn; if (KIND == 5) ks[bj][n] += v[bj][n]; }
                } else if (KIND == 1) {
#pragma unroll
                    for (int bj = 0; bj < 2; ++bj)
#pragma unroll
                        for (int n = 0; n < 2; ++n)
#pragma unroll
                            for (int e = 0; e < 4; ++e) v[bj][n][e] = silu_f(v[bj][n][e]);
                }
                bf16* rp = (KIND == 0) ? dst + ((size_t)(row >> 11) * 16 * SEQ + (row & (SEQ - 1))) * 16 : dst + (size_t)row * pitch;
#pragma unroll
                for (int bj = 0; bj < 2; ++bj) { u32x4 w; w.x = pk2(v[bj][0][0], v[bj][0][1]); w.y = pk2(v[bj][0][2], v[bj][0][3]); w.z = pk2(v[bj][1][0], v[bj][1][1]); w.w = pk2(v[bj][1][2], v[bj][1][3]);
                    *(u32x4*)(rp + (KIND == 0 ? 2 * SEQ * 16 * bj : 32 * bj)) = w; }
                if (m & 1) asm volatile("" ::: "memory");
            }
        }
        if (KIND == 5) {
#pragma unroll
            for (int bj = 0; bj < 2; ++bj)
#pragma unroll
                for (int n = 0; n < 2; ++n)
#pragma unroll
                    for (int e = 0; e < 4; ++e) { float s = ks[bj][n][e]; s += __shfl_xor(s, 1); s += __shfl_xor(s, 2); s += __shfl_xor(s, 4); s += __shfl_xor(s, 8); ks[bj][n][e] = s; }
            if (kp) {
#pragma unroll
                for (int bj = 0; bj < 2; ++bj)
#pragma unroll
                    for (int n = 0; n < 2; ++n) *(f32x4*)(kp + 32 * bj + 4 * n) = ks[bj][n];
            }
        }
    }
};
struct EpiGlu {
    static constexpr bool PERM = true, AFTER_DRAIN = false;
    const bf16* YPRE; const bf16* SG; const float* gb; bf16* Y;
    __device__ __forceinline__ void operator()(const f32x4 (&acc)[2][2][4][2], const Unit& u, int wr, int wc, int fr, int fq) const {
#pragma unroll
        for (int bj = 0; bj < 2; ++bj) { const int c = wc * 32 + 8 * fq + 128 * bj;
            const f32x4 b0 = *(const f32x4*)(gb + c), b1 = *(const f32x4*)(gb + c + 4);
#pragma unroll
            for (int ai = 0; ai < 2; ++ai)
#pragma unroll
                for (int m = 0; m < 4; ++m) { const int row = u.pm * 256 + ai * 128 + wr * 64 + m * 16 + fr;
                    const u32x4 yp = *(const u32x4*)(YPRE + (size_t)row * 256 + c), sg = *(const u32x4*)(SG + (size_t)row * 256 + c);
                    const f32x4 z0 = acc[ai][bj][m][0] + b0, z1 = acc[ai][bj][m][1] + b1;
                    u32x4 w;
                    w.x = pk2(bflo(yp.x) * sigmoid_f(z0[0]) * bflo(sg.x), bfhi(yp.x) * sigmoid_f(z0[1]) * bfhi(sg.x));
                    w.y = pk2(bflo(yp.y) * sigmoid_f(z0[2]) * bflo(sg.y), bfhi(yp.y) * sigmoid_f(z0[3]) * bfhi(sg.y));
                    w.z = pk2(bflo(yp.z) * sigmoid_f(z1[0]) * bflo(sg.z), bfhi(yp.z) * sigmoid_f(z1[1]) * bfhi(sg.z));
                    w.w = pk2(bflo(yp.w) * sigmoid_f(z1[2]) * bflo(sg.w), bfhi(yp.w) * sigmoid_f(z1[3]) * bfhi(sg.w));
                    *(u32x4*)(Y + (size_t)row * DM + c) = w;
                    if (m & 1) asm volatile("" ::: "memory"); } }
    }
};
struct EpiOut {
    static constexpr bool PERM = false, AFTER_DRAIN = false;
    const float* resid_f; float* out; bf16* xb; float* rowss; int write_next; LAS float* xch; int probe_skip;
    __device__ __forceinline__ void operator()(const f32x4 (&acc)[2][2][4][2], const Unit& u, int wr, int wc, int fr, int fq) const {
        const int c0 = u.pn * 256 + wc * 32 + 4 * fq;
        if (probe_skip) { asm volatile("" :: "v"(acc[0][0][0][0]), "v"(acc[1][1][3][1])); asm volatile("s_waitcnt lgkmcnt(0)" ::: "memory"); __builtin_amdgcn_s_barrier(); return; }
        if (write_next) {
#pragma unroll
            for (int aim = 0; aim < 4; ++aim) { const int ai = aim >> 1, mb = (aim & 1) * 2;
                f32x4 pre[2][2][2];
#pragma unroll
                for (int m2 = 0; m2 < 2; ++m2) { const size_t off = (size_t)(u.pm * 256 + ai * 128 + wr * 64 + (mb + m2) * 16 + fr) * DM + c0;
#pragma unroll
                    for (int bj = 0; bj < 2; ++bj)
#pragma unroll
                        for (int n = 0; n < 2; ++n) pre[m2][bj][n] = *(const f32x4*)(resid_f + off + bj * 128 + n * 16); }
#pragma unroll
                for (int m2 = 0; m2 < 2; ++m2) { const int m = mb + m2; const int rt = ai * 128 + wr * 64 + m * 16 + fr; const size_t off = (size_t)(u.pm * 256 + rt) * DM + c0; float ss = 0.f;
#pragma unroll
                    for (int bj = 0; bj < 2; ++bj)
#pragma unroll
                        for (int n = 0; n < 2; ++n) { const f32x4 o = pre[m2][bj][n] + acc[ai][bj][m][n];
                            u32x2 w; w.x = pk2(o[0], o[1]); w.y = pk2(o[2], o[3]); *(u32x2*)(xb + off + bj * 128 + n * 16) = w; ss += (o[0] * o[0] + o[1] * o[1]) + (o[2] * o[2] + o[3] * o[3]); }
                    ss += __shfl_xor(ss, 16); ss += __shfl_xor(ss, 32); if (fq == 0) xch[rt * 4 + wc] = ss; }
            }
        } else {
#pragma unroll
            for (int ai = 0; ai < 2; ++ai) {
                u32x2 pre[4][2][2];
#pragma unroll
                for (int m = 0; m < 4; ++m) { const size_t off = (size_t)(u.pm * 256 + ai * 128 + wr * 64 + m * 16 + fr) * DM + c0;
#pragma unroll
                    for (int bj = 0; bj < 2; ++bj)
#pragma unroll
                        for (int n = 0; n < 2; ++n) pre[m][bj][n] = *(const u32x2*)(xb + off + bj * 128 + n * 16); }
#pragma unroll
                for (int m = 0; m < 4; ++m) { const size_t off = (size_t)(u.pm * 256 + ai * 128 + wr * 64 + m * 16 + fr) * DM + c0;
#pragma unroll
                    for (int bj = 0; bj < 2; ++bj)
#pragma unroll
                        for (int n = 0; n < 2; ++n) { const u32x2 rb = pre[m][bj][n]; const f32x4 a4 = acc[ai][bj][m][n]; f32x4 o;
                            o[0] = bflo(rb.x) + a4[0]; o[1] = bfhi(rb.x) + a4[1]; o[2] = bflo(rb.y) + a4[2]; o[3] = bfhi(rb.y) + a4[3];
                            __builtin_nontemporal_store(o, (f32x4*)(out + off + bj * 128 + n * 16)); } }
            }
        }
        asm volatile("s_waitcnt lgkmcnt(0)" ::: "memory"); __builtin_amdgcn_s_barrier(); asm volatile("" ::: "memory");
        if (write_next && threadIdx.x < 256) { const f32x4 p = *(const LAS f32x4*)(xch + threadIdx.x * 4); rowss[(size_t)(u.pm * 256 + threadIdx.x) * 4 + u.pn] = (p.x + p.y) + (p.z + p.w); }
    }
};

__device__ __forceinline__ int pi32(int r) { return (r & ~12) | ((r & 8) >> 1) | ((r & 4) << 1); }
template <int MODE>
__device__ __forceinline__ void attn_tile(const bf16x8 (&kf)[4], const bf16x8 (&vf)[2][2], const bf16x8 (&qf)[4], const f32x16& cv, float& l, f32x16 (&O)[2], int a, int h) {
    f32x16 S = __builtin_amdgcn_mfma_f32_32x32x16_bf16(kf[0], qf[0], cv, 0, 0, 0);
#pragma unroll
    for (int ks = 1; ks < 4; ++ks) S = __builtin_amdgcn_mfma_f32_32x32x16_bf16(kf[ks], qf[ks], S, 0, 0, 0);
    if (MODE != 0) {
#pragma unroll
        for (int i = 0; i < 16; ++i) { const int c = pi32((i & 3) + 8 * (i >> 2) + 4 * h); const bool dead = (MODE == 1) ? (c > a) : (c <= a); if (dead) S[i] = -1e30f; }
    }
    float s0 = 0.f, s1 = 0.f;
#pragma unroll
    for (int i = 0; i < 16; i += 2) { S[i] = __builtin_amdgcn_exp2f(S[i]); S[i + 1] = __builtin_amdgcn_exp2f(S[i + 1]); s0 += S[i]; s1 += S[i + 1]; }
    l += s0 + s1;
    bf16x8 pb[2];
#pragma unroll
    for (int s = 0; s < 2; ++s) { u32x4 w; w.x = pk2(S[8 * s], S[8 * s + 1]); w.y = pk2(S[8 * s + 2], S[8 * s + 3]); w.z = pk2(S[8 * s + 4], S[8 * s + 5]); w.w = pk2(S[8 * s + 6], S[8 * s + 7]); pb[s] = __builtin_bit_cast(bf16x8, w); }
#pragma unroll
    for (int dt = 0; dt < 2; ++dt)
#pragma unroll
        for (int s = 0; s < 2; ++s) O[dt] = __builtin_amdgcn_mfma_f32_32x32x16_bf16(vf[dt][s], pb[s], O[dt], 0, 0, 0);
}
template <int NK>
__device__ __forceinline__ void stage_kv(LAS unsigned char* Kimg, LAS unsigned char* Vimg, const bf16* Ksrc  , const bf16* VTf  ,
                                         long tokbase  , long key_lo  , long key_min  , int wave, int lane) {
    constexpr int KP = NK * 128 / 1024, VCH = NK / 8, VP = 64 * VCH * 16 / 1024;
    for (int p = wave; p < KP; p += 8) { const int L = p * 64 + lane, r = L >> 3, s = L & 7, c = s ^ ((r >> 1) & 7); long kr = key_lo + r; if (kr < key_min) kr = key_min;
        glds16(Ksrc + (kr - key_lo) * 128 + c * 8, Kimg + p * 1024); }
    for (int p = wave; p < VP; p += 8) { const int L = p * 64 + lane, d = L / VCH, s = L % VCH, c = s ^ (d & 15); long kc = key_lo + 8 * c; if (kc < key_min) kc = key_min; const long tok = tokbase + kc;
        glds16(VTf + ((tok >> 8) * 256 + d) * 256 + (tok & 255), Vimg + p * 1024); }
}
template <int NK>
__device__ __forceinline__ void load_kv_frags(bf16x8 (&kf)[4], bf16x8 (&vf)[2][2], const LAS unsigned char* Kimg, const LAS unsigned char* Vimg, int row0  , int lane) {
    const int r = row0 + pi32(lane & 31), h = lane >> 5;
#pragma unroll
    for (int ks = 0; ks < 4; ++ks) kf[ks] = *(const LAS bf16x8*)(Kimg + r * 128 + (((2 * ks + h) ^ ((r >> 1) & 7)) << 4));
#pragma unroll
    for (int dt = 0; dt < 2; ++dt) { const int d = 32 * dt + (lane & 31);
#pragma unroll
        for (int s = 0; s < 2; ++s) { const int c = (row0 >> 3) + 2 * s + h; vf[dt][s] = *(const LAS bf16x8*)(Vimg + d * (NK * 2) + ((c ^ (d & 15)) << 4)); } }
}
template <int NK>
__device__ __forceinline__ void load_k_frags(bf16x8 (&kf)[4], const LAS unsigned char* Kimg, int row0, int lane) {
    const int r = row0 + pi32(lane & 31), h = lane >> 5;
#pragma unroll
    for (int ks = 0; ks < 4; ++ks) kf[ks] = *(const LAS bf16x8*)(Kimg + r * 128 + (((2 * ks + h) ^ ((r >> 1) & 7)) << 4));
}
template <int NK>
__device__ __forceinline__ void load_v_frags(bf16x8 (&vf)[2][2], const LAS unsigned char* Vimg, int row0, int lane) {
    const int h = lane >> 5;
#pragma unroll
    for (int dt = 0; dt < 2; ++dt) { const int d = 32 * dt + (lane & 31);
#pragma unroll
        for (int s = 0; s < 2; ++s) { const int c = (row0 >> 3) + 2 * s + h; vf[dt][s] = *(const LAS bf16x8*)(Vimg + d * (NK * 2) + ((c ^ (d & 15)) << 4)); } }
}
__device__ __forceinline__ f32x16 qk_tile(const bf16x8 (&kf)[4], const bf16x8 (&qf)[4], const f32x16& cv) {
    f32x16 S = __builtin_amdgcn_mfma_f32_32x32x16_bf16(kf[0], qf[0], cv, 0, 0, 0);
#pragma unroll
    for (int ks = 1; ks < 4; ++ks) S = __builtin_amdgcn_mfma_f32_32x32x16_bf16(kf[ks], qf[ks], S, 0, 0, 0);
    return S;
}
template <int MODE>
__device__ __forceinline__ void softmax_pv(f32x16& S, const bf16x8 (&vf)[2][2], float& l, f32x16 (&O)[2], int a, int h) {
    if (MODE != 0) {
#pragma unroll
        for (int i = 0; i < 16; ++i) { const int c = pi32((i & 3) + 8 * (i >> 2) + 4 * h); const bool dead = (MODE == 1) ? (c > a) : (c <= a); if (dead) S[i] = -1e30f; }
    }
    float s0 = 0.f, s1 = 0.f;
#pragma unroll
    for (int i = 0; i < 16; i += 2) { S[i] = __builtin_amdgcn_exp2f(S[i]); S[i + 1] = __builtin_amdgcn_exp2f(S[i + 1]); s0 += S[i]; s1 += S[i + 1]; }
    l += s0 + s1;
    bf16x8 pb[2];
#pragma unroll
    for (int s = 0; s < 2; ++s) { u32x4 w; w.x = pk2(S[8 * s], S[8 * s + 1]); w.y = pk2(S[8 * s + 2], S[8 * s + 3]); w.z = pk2(S[8 * s + 4], S[8 * s + 5]); w.w = pk2(S[8 * s + 6], S[8 * s + 7]); pb[s] = __builtin_bit_cast(bf16x8, w); }
#pragma unroll
    for (int dt = 0; dt < 2; ++dt)
#pragma unroll
        for (int s = 0; s < 2; ++s) O[dt] = __builtin_amdgcn_mfma_f32_32x32x16_bf16(vf[dt][s], pb[s], O[dt], 0, 0, 0);
}
template <int NK, int N, int MFIRST, int MLAST>
__device__ __forceinline__ void attn_run(const LAS unsigned char* Kimg, const LAS unsigned char* Vimg, int row0, const bf16x8 (&qf)[4], const f32x16& cv, float& l, f32x16 (&O)[2], int lane) {
    const int a = lane & 31, h = lane >> 5;
    bf16x8 kf[4], vfa[2][2], vfb[2][2];
    load_k_frags<NK>(kf, Kimg, row0, lane); load_v_frags<NK>(vfa, Vimg, row0, lane);
    f32x16 S = qk_tile(kf, qf, cv);
#pragma unroll
    for (int t = 0; t < N; ++t) {
        f32x16 Sn;
        if (t + 1 < N) { load_k_frags<NK>(kf, Kimg, row0 + 32 * (t + 1), lane); if (t & 1) load_v_frags<NK>(vfa, Vimg, row0 + 32 * (t + 1), lane); else load_v_frags<NK>(vfb, Vimg, row0 + 32 * (t + 1), lane);
            Sn = qk_tile(kf, qf, cv); }
        if (t == 0 && MFIRST != 0) { if (t & 1) softmax_pv<MFIRST>(S, vfb, l, O, a, h); else softmax_pv<MFIRST>(S, vfa, l, O, a, h); }
        else if (t == N - 1 && MLAST != 0) { if (t & 1) softmax_pv<MLAST>(S, vfb, l, O, a, h); else softmax_pv<MLAST>(S, vfa, l, O, a, h); }
        else { if (t & 1) softmax_pv<0>(S, vfb, l, O, a, h); else softmax_pv<0>(S, vfa, l, O, a, h); }
        if (t + 1 < N) S = Sn;
    }
}
template <int NK, int PVAR>
__device__ __forceinline__ void attn_run8(const LAS unsigned char* Kimg, const LAS unsigned char* Vimg, const bf16x8 (&qf)[4], const f32x16& cv, float& l, f32x16 (&O)[2], int lane) {
    const int a = lane & 31, h = lane >> 5;
    bf16x8 kf[4], vfa[2][2], vfb[2][2];
    load_k_frags<NK>(kf, Kimg, 0, lane); load_v_frags<NK>(vfa, Vimg, 0, lane);
    if (PVAR == 4) load_v_frags<NK>(vfb, Vimg, 32, lane);
#define QKT() ((PVAR == 5) ? cv : qk_tile(kf, qf, cv))
#define SMPV(S_, vf_) do { if (PVAR == 3) { bf16x8 pb[2]; _Pragma("unroll") for (int s = 0; s < 2; ++s) { u32x4 w; w.x = pk2(S_[8 * s], S_[8 * s + 1]); w.y = pk2(S_[8 * s + 2], S_[8 * s + 3]); w.z = pk2(S_[8 * s + 4], S_[8 * s + 5]); w.w = pk2(S_[8 * s + 6], S_[8 * s + 7]); pb[s] = __builtin_bit_cast(bf16x8, w); } \
        _Pragma("unroll") for (int dt = 0; dt < 2; ++dt) _Pragma("unroll") for (int s = 0; s < 2; ++s) O[dt] = __builtin_amdgcn_mfma_f32_32x32x16_bf16(vf_[dt][s], pb[s], O[dt], 0, 0, 0); } \
      else if (PVAR == 6) { _Pragma("unroll") for (int i = 0; i < 16; ++i) { l += __builtin_amdgcn_exp2f(S_[i]); } asm volatile("" :: "v"(vf_[0][0]), "v"(vf_[1][1])); } \
      else softmax_pv<0>(S_, vf_, l, O, a, h); } while (0)
    f32x16 S = QKT();
#pragma unroll 1
    for (int j = 0; j < 3; ++j) {
        { if (PVAR != 4) { load_k_frags<NK>(kf, Kimg, 64 * j + 32, lane); load_v_frags<NK>(vfb, Vimg, 64 * j + 32, lane); } f32x16 Sn = QKT(); SMPV(S, vfa); S = Sn; }
        { if (PVAR != 4) { load_k_frags<NK>(kf, Kimg, 64 * j + 64, lane); load_v_frags<NK>(vfa, Vimg, 64 * j + 64, lane); } f32x16 Sn = QKT(); SMPV(S, vfb); S = Sn; }
    }
    { if (PVAR != 4) { load_k_frags<NK>(kf, Kimg, 224, lane); load_v_frags<NK>(vfb, Vimg, 224, lane); } f32x16 Sn = QKT(); SMPV(S, vfa); S = Sn; }
    SMPV(S, vfb);
#undef QKT
#undef SMPV
}
__device__ __forceinline__ void attn_store(const f32x16 (&O)[2], float l, const bf16* gate  , bf16* y  , int h) {
    u32x2 gv[2][4];
#pragma unroll
    for (int dt = 0; dt < 2; ++dt)
#pragma unroll
        for (int q = 0; q < 4; ++q) gv[dt][q] = *(const u32x2*)(gate + 32 * dt + 8 * q + 4 * h);
    const float inv = 1.f / swap32_sum(l);
#pragma unroll
    for (int dt = 0; dt < 2; ++dt)
#pragma unroll
        for (int q = 0; q < 4; ++q) { const int d = 32 * dt + 8 * q + 4 * h; const u32x2 g2 = gv[dt][q];
            u32x2 w; w.x = pk2(O[dt][4 * q] * inv * bflo(g2.x), O[dt][4 * q + 1] * inv * bfhi(g2.x)); w.y = pk2(O[dt][4 * q + 2] * inv * bflo(g2.y), O[dt][4 * q + 3] * inv * bfhi(g2.y));
            *(u32x2*)(y + d) = w; }
}

template <int VAR>
__device__ __forceinline__ void moba_unit(Frame& F, int b, int kvh, int qb, int g) {
    constexpr int IMG = 32768;
    LAS unsigned char* buf0 = F.lds; LAS unsigned char* buf1 = F.lds + 2 * IMG;
    LAS float* km = (LAS float*)(F.lds + LDS_MISC + 1024);
    const int lane = F.lane, wave = F.wave, a = lane & 31, h = lane >> 5;
    const long tok0 = (long)b * SEQ + 256 * qb;
    const bf16* Kb = ((bf16*)(F.ws + WS_MK)) + (size_t)b * SEQ * 128 + kvh * 64;
    const bf16* Vb = ((bf16*)(F.ws + WS_VT)) + (size_t)(128 + kvh * 64) * 256; const long tokb = (long)b * SEQ;
    if (VAR != 1) stage_kv<256>(buf0, buf0 + IMG, Kb + (size_t)(256 * qb) * 128, Vb, tokb, 256 * qb, 0, wave, lane);
    { const int n = F.tid >> 6, d = F.tid & 63; float s = 0.f;
      if (n < qb) { const int tile = b * 8 + n; s = ((float*)(F.ws + WS_KPART))[((size_t)(tile * 2 + 0) * 2 + kvh) * 64 + d] + ((float*)(F.ws + WS_KPART))[((size_t)(tile * 2 + 1) * 2 + kvh) * 64 + d]; }
      km[n * 64 + d] = s; }
    const size_t row = (size_t)(tok0 + 32 * wave + a);
    const bf16* qp = ((bf16*)(F.ws + WS_MQ)) + row * 384 + kvh * 192 + 8 * h;
    GLDS_WAIT(); __syncthreads();
    unsigned selmask = (VAR == 8) ? 0x7fu : 0u;
    if (qb > 0 && VAR != 8) {
        float sc[8];
#pragma unroll
        for (int n = 0; n < 8; ++n) sc[n] = 0.f;
#pragma unroll
        for (int ks = 0; ks < 4; ++ks) { const bf16x8 q0 = *(const bf16x8*)(qp + 16 * ks), q1 = *(const bf16x8*)(qp + 64 + 16 * ks), q2 = *(const bf16x8*)(qp + 128 + 16 * ks);
#pragma unroll
            for (int j = 0; j < 8; ++j) { const float qs = bf2f((unsigned short)q0[j]) + bf2f((unsigned short)q1[j]) + bf2f((unsigned short)q2[j]); const int d = 16 * ks + 8 * h + j;
#pragma unroll
                for (int n = 0; n < 7; ++n) sc[n] += qs * km[n * 64 + d]; } }
#pragma unroll
        for (int n = 0; n < 7; ++n) { sc[n] = swap32_sum(sc[n]); if (n >= qb) sc[n] = -INFINITY; }
#pragma unroll
        for (int t = 0; t < 3; ++t) { float best = -INFINITY; int bi = -1;
#pragma unroll
            for (int n = 0; n < 7; ++n) if (sc[n] > best) { best = sc[n]; bi = n; }
            if (bi >= 0) { selmask |= 1u << bi;
#pragma unroll
                for (int n = 0; n < 7; ++n) if (n == bi) sc[n] = -INFINITY; } }
    }
    float l = 0.f; f32x16 O[2]; bf16x8 qf[4];
#pragma unroll
    for (int i = 0; i < 16; ++i) { O[0][i] = 0.f; O[1][i] = 0.f; }
#pragma unroll
    for (int ks = 0; ks < 4; ++ks) qf[ks] = *(const bf16x8*)(qp + g * 64 + 16 * ks);
    asm volatile("" : "+v"(qf[0]), "+v"(qf[1]), "+v"(qf[2]), "+v"(qf[3]));
#pragma unroll 1
    for (int s = 0; s <= qb; ++s) {
        LAS unsigned char* cur = (s & 1) ? buf1 : buf0; LAS unsigned char* nxt = (s & 1) ? buf0 : buf1;
        if (s < qb && VAR != 1) stage_kv<256>(nxt, nxt + IMG, Kb + (size_t)(256 * s) * 128, Vb, tokb, 256 * s, 0, wave, lane);
        if (VAR == 2) {} else if (s == 0) { if (VAR != 7) {
            f32x16 cv;
#pragma unroll
            for (int i = 0; i < 16; ++i) cv[i] = 0.f;
            int kt = 0;
#pragma unroll 1
            for (; kt + 1 < wave; kt += 2) { bf16x8 kfa[4], vfa[2][2], kfb[4], vfb[2][2]; load_kv_frags<256>(kfa, vfa, cur, cur + IMG, 32 * kt, lane); load_kv_frags<256>(kfb, vfb, cur, cur + IMG, 32 * kt + 32, lane);
                attn_tile<0>(kfa, vfa, qf, cv, l, O, a, h); attn_tile<0>(kfb, vfb, qf, cv, l, O, a, h); }
            if (kt < wave) { bf16x8 kfa[4], vfa[2][2], kfb[4], vfb[2][2]; load_kv_frags<256>(kfa, vfa, cur, cur + IMG, 32 * kt, lane); load_kv_frags<256>(kfb, vfb, cur, cur + IMG, 32 * kt + 32, lane);
                attn_tile<0>(kfa, vfa, qf, cv, l, O, a, h); attn_tile<1>(kfb, vfb, qf, cv, l, O, a, h); }
            else { bf16x8 kfa[4], vfa[2][2]; load_kv_frags<256>(kfa, vfa, cur, cur + IMG, 32 * kt, lane); attn_tile<1>(kfa, vfa, qf, cv, l, O, a, h); }
        } } else if (VAR != 9) {
            const float cinit = ((selmask >> (s - 1)) & 1u) ? 0.f : -1e30f;
            if (__any(cinit == 0.f)) {
                f32x16 cv;
#pragma unroll
                for (int i = 0; i < 16; ++i) cv[i] = cinit;
                attn_run8<256, (VAR >= 3 ? VAR : 0)>(cur, cur + IMG, qf, cv, l, O, lane);
            }
        }
        GLDS_WAIT(); __syncthreads();
    }
    attn_store(O, l, ((bf16*)(F.ws + WS_MG)) + row * 384 + (kvh * 3 + g) * 64, ((bf16*)(F.ws + (VAR ? WS_END : WS_Y))) + row * DM + 640 + (kvh * 3 + g) * 64, h);
}

__device__ __forceinline__ void swa_unit(const Params& P, Frame& F, int layer, int b, int kvh, int qblk) {
    constexpr int NK = 384;
    LAS unsigned char* Kimg = F.lds; LAS unsigned char* Vimg = F.lds + NK * 128;
    const int lane = F.lane, wave = F.wave, a = lane & 31, h = lane >> 5;
    const int q0 = 256 * qblk; const long tok0 = (long)b * SEQ + q0;
    const bf16* Kb = ((bf16*)(F.ws + WS_AK)) + ((long)b * SEQ + q0 - 128) * 128 + kvh * 64;
    const bf16* Vb = ((bf16*)(F.ws + WS_VT)) + (size_t)(kvh * 64) * 256;
    stage_kv<NK>(Kimg, Vimg, Kb, Vb, (long)b * SEQ, (long)q0 - 128, 0, wave, lane);
    const size_t row = (size_t)(tok0 + 32 * wave + a);
    const bf16* qp = ((bf16*)(F.ws + WS_AQ)) + row * 384 + kvh * 192 + 8 * h;
    f32x16 cv;
#pragma unroll
    for (int i = 0; i < 16; ++i) cv[i] = 0.f;
    const bool head = (q0 - 128 + 32 * wave) >= 0;
    GLDS_WAIT(); __syncthreads();
#pragma unroll 1
    for (int g = 0; g < 3; ++g) {
        bf16x8 qf[4];
#pragma unroll
        for (int ks = 0; ks < 4; ++ks) qf[ks] = *(const bf16x8*)(qp + g * 64 + 16 * ks);
        float l = 0.5f * __builtin_amdgcn_exp2f(kin(15)[layer * 6 + kvh * 3 + g] * LOG2E);
        f32x16 O[2];
#pragma unroll
        for (int i = 0; i < 16; ++i) { O[0][i] = 0.f; O[1][i] = 0.f; }
        const int r0 = 32 * wave;
        if (head) attn_run<NK, 5, 2, 1>(Kimg, Vimg, r0, qf, cv, l, O, lane);
        else {
#pragma unroll 1
            for (int kt = 4 - wave; kt < 4; ++kt) { bf16x8 kfa[4], vfa[2][2]; load_kv_frags<NK>(kfa, vfa, Kimg, Vimg, r0 + 32 * kt, lane); attn_tile<0>(kfa, vfa, qf, cv, l, O, a, h); }
            { bf16x8 kfa[4], vfa[2][2]; load_kv_frags<NK>(kfa, vfa, Kimg, Vimg, r0 + 128, lane); attn_tile<1>(kfa, vfa, qf, cv, l, O, a, h); }
        }
        attn_store(O, l, ((bf16*)(F.ws + WS_AG)) + row * 384 + (kvh * 3 + g) * 64, ((bf16*)(F.ws + WS_Y)) + row * DM + 256 + (kvh * 3 + g) * 64, h);
    }
    __syncthreads();
}

__device__ __forceinline__ void ssm_unit(Frame& F, int layer, int b, int g) {
    constexpr int APITCH = 528;
    LAS unsigned char* AU = F.lds;
    LAS unsigned char* SC = F.lds + 128 * APITCH;
    LAS float* seg = (LAS float*)(F.lds + 2 * 128 * APITCH);
    const int lane = F.lane, wave = F.wave, tid = F.tid, fr = lane & 15, fq = lane >> 4;
    const int pair = layer * 16 + g;
    const bf16* TE = ((bf16*)(F.ws + WS_TE)) + (size_t)pair * TE_ELEMS; const bf16* GM = ((bf16*)(F.ws + WS_G)) + (size_t)pair * G_ELEMS;
    u32x4 uv[8];
    { const bf16* up = ((bf16*)(F.ws + WS_U)) + (size_t)(b * 16 + g) * SEQ * 16;
#pragma unroll
      for (int i = 0; i < 8; ++i) { const int idx = tid + 512 * i; uv[i] = *(const u32x4*)(up + (size_t)idx * 8); } }
    bf16x8 gf[8];
#pragma unroll
    for (int ks = 0; ks < 8; ++ks) gf[ks] = *(const bf16x8*)(GM + (size_t)(16 * wave + fr) * 256 + 32 * ks + 8 * fq);
    const float ar = ((float*)(F.ws + WS_AT))[(size_t)pair * 128 + 2 * lane], ai = ((float*)(F.ws + WS_AT))[(size_t)pair * 128 + 2 * lane + 1];
    bf16x8 tfu[2][8], tfc[2][4];
#pragma unroll
    for (int half = 0; half < 2; ++half) { const int i = half ? 15 - wave : wave, nks = (i >> 1) + 1; const bf16* tp = TE + (size_t)(16 * i + fr) * 384 + 8 * fq;
#pragma unroll
        for (int ks = 0; ks < 8; ++ks) tfu[half][ks] = *(const bf16x8*)(tp + 32 * (ks < nks ? ks : 0));
#pragma unroll
        for (int ks = 0; ks < 4; ++ks) tfc[half][ks] = *(const bf16x8*)(tp + 256 + 32 * ks); }
#pragma unroll
    for (int i = 0; i < 8; ++i) { const int idx = tid + 512 * i, t = idx >> 1, hf = idx & 1; *(LAS u32x4*)(AU + (t >> 4) * APITCH + ((t & 15) * 16 + 8 * hf) * 2) = uv[i]; }
    __syncthreads();
    {
#pragma unroll
        for (int rt = 0; rt < 8; ++rt) { f32x4 acc = {0.f, 0.f, 0.f, 0.f};
#pragma unroll
            for (int ks = 0; ks < 8; ++ks) { const bf16x8 af = *(const LAS bf16x8*)(AU + (16 * rt + fr) * APITCH + (32 * ks + 8 * fq) * 2); acc = __builtin_amdgcn_mfma_f32_16x16x32_bf16(gf[ks], af, acc, 0, 0, 0); }
            *(LAS f32x4*)(SC + (16 * rt + fr) * APITCH + (16 * wave + 4 * fq) * 4) = acc; }
    }
    __syncthreads();
    {
        float lr = 0.f, li = 0.f, locr[16], loci[16];
#pragma unroll
        for (int k = 0; k < 16; ++k) { locr[k] = lr; loci[k] = li; const f32x2_t s = *(const LAS f32x2_t*)(SC + (16 * wave + k) * APITCH + lane * 8);
            const float nr = ar * lr - ai * li + s.x, ni = ar * li + ai * lr + s.y; lr = nr; li = ni; }
        seg[(wave * 64 + lane) * 2] = lr; seg[(wave * 64 + lane) * 2 + 1] = li;
        __syncthreads();
        float a16r = ar, a16i = ai;
#pragma unroll
        for (int q = 0; q < 4; ++q) { const float tr = a16r * a16r - a16i * a16i, ti = 2.f * a16r * a16i; a16r = tr; a16i = ti; }
        float ir = 0.f, ii = 0.f;
        for (int w2 = 0; w2 < wave; ++w2) { const float sr = seg[(w2 * 64 + lane) * 2], si = seg[(w2 * 64 + lane) * 2 + 1]; const float nr = a16r * ir - a16i * ii + sr, ni = a16r * ii + a16i * ir + si; ir = nr; ii = ni; }
        float pr = 1.f, pi = 0.f;
#pragma unroll
        for (int k = 0; k < 16; ++k) { const float cr = locr[k] + pr * ir - pi * ii, ci = loci[k] + pr * ii + pi * ir;
            *(LAS unsigned*)(SC + (16 * wave + k) * APITCH + lane * 4) = pk2(cr, ci);
            const float tr = pr * ar - pi * ai, ti = pr * ai + pi * ar; pr = tr; pi = ti; }
    }
    __syncthreads();
#pragma unroll
    for (int half = 0; half < 2; ++half) {
        const int i = half ? 15 - wave : wave;
        f32x4 acc[8];
#pragma unroll
        for (int rt = 0; rt < 8; ++rt) acc[rt] = (f32x4){0.f, 0.f, 0.f, 0.f};
        const int nks = (i >> 1) + 1;
#pragma unroll
        for (int ks = 0; ks < 8; ++ks) { if (ks < nks) {
#pragma unroll
            for (int rt = 0; rt < 8; ++rt) { const bf16x8 af = *(const LAS bf16x8*)(AU + (16 * rt + fr) * APITCH + (32 * ks + 8 * fq) * 2); acc[rt] = __builtin_amdgcn_mfma_f32_16x16x32_bf16(tfu[half][ks], af, acc[rt], 0, 0, 0); } } }
#pragma unroll
        for (int ks = 0; ks < 4; ++ks) {
#pragma unroll
            for (int rt = 0; rt < 8; ++rt) { const bf16x8 af = *(const LAS bf16x8*)(SC + (16 * rt + fr) * APITCH + (32 * ks + 8 * fq) * 2); acc[rt] = __builtin_amdgcn_mfma_f32_16x16x32_bf16(tfc[half][ks], af, acc[rt], 0, 0, 0); } }
#pragma unroll
        for (int rt = 0; rt < 8; ++rt) { const int chunk = 16 * rt + fr; u32x2 w; w.x = pk2(gelu_tanh_f(acc[rt][0]), gelu_tanh_f(acc[rt][1])); w.y = pk2(gelu_tanh_f(acc[rt][2]), gelu_tanh_f(acc[rt][3]));
            __hip_atomic_store((unsigned long long*)(((bf16*)(F.ws + WS_YPRE)) + ((size_t)(b * 16 + g) * SEQ + 16 * chunk + i) * 16 + 4 * fq), ((unsigned long long)w.y << 32) | w.x, __ATOMIC_RELAXED, __HIP_MEMORY_SCOPE_AGENT); }
    }
    asm volatile("s_waitcnt vmcnt(0)" ::: "memory");
    __syncthreads();
    if (tid == 0) __hip_atomic_fetch_add(F.ctl + CW_SSMDONE + 64 * (layer * NB + b), 1u, __ATOMIC_RELAXED, __HIP_MEMORY_SCOPE_AGENT);
}

__device__ __forceinline__ void glu_unit(const Params& P, Frame& F, int layer, int b, int j) {
    constexpr int APITCH = 528;
    LAS unsigned char* AT_ = F.lds;
    const int lane = F.lane, wave = F.wave, tid = F.tid, fr = lane & 15, fq = lane >> 4;
    const size_t tok0 = (size_t)b * SEQ + 128 * j;
    const bf16* wp = ((bf16*)(F.ws + WS_GLU)) + (size_t)layer * 65536 + (size_t)(32 * wave + fr) * 256 + 8 * fq;
    bf16x8 wf[8][2];
#pragma unroll
    for (int ks = 0; ks < 8; ++ks) { wf[ks][0] = *(const bf16x8*)(wp + 32 * ks); wf[ks][1] = *(const bf16x8*)(wp + 16 * 256 + 32 * ks); }
    if (tid == 0) { unsigned* c = F.ctl + CW_SSMDONE + 64 * (layer * NB + b); unsigned sp = 0;
        while (__hip_atomic_load(c, __ATOMIC_RELAXED, __HIP_MEMORY_SCOPE_AGENT) < 16u) { __builtin_amdgcn_s_sleep(2); if (++sp > (1u << 22)) break; }
        __builtin_amdgcn_fence(__ATOMIC_ACQUIRE, "agent"); asm volatile("s_waitcnt vmcnt(0)" ::: "memory"); }
    __syncthreads();
    { const bf16* yp = ((bf16*)(F.ws + WS_YPRE)) + ((size_t)b * 16 * SEQ + 128 * j) * 16;
#pragma unroll
      for (int i = 0; i < 8; ++i) { const int idx = tid + 512 * i, c = idx >> 7, t = idx & 127; const u32x4 v = *(const u32x4*)(yp + ((size_t)(c >> 1) * SEQ + t) * 16 + 8 * (c & 1)); *(LAS u32x4*)(AT_ + t * APITCH + c * 16) = v; } }
    f32x4 acc[8][2];
#pragma unroll
    for (int rt = 0; rt < 8; ++rt) { acc[rt][0] = (f32x4){0.f, 0.f, 0.f, 0.f}; acc[rt][1] = (f32x4){0.f, 0.f, 0.f, 0.f}; }
    __syncthreads();
#pragma unroll
    for (int ks = 0; ks < 8; ++ks)
#pragma unroll
        for (int rt = 0; rt < 8; ++rt) { const bf16x8 af = *(const LAS bf16x8*)(AT_ + (16 * rt + fr) * APITCH + (32 * ks + 8 * fq) * 2);
            acc[rt][0] = __builtin_amdgcn_mfma_f32_16x16x32_bf16(wf[ks][0], af, acc[rt][0], 0, 0, 0); acc[rt][1] = __builtin_amdgcn_mfma_f32_16x16x32_bf16(wf[ks][1], af, acc[rt][1], 0, 0, 0); }
    const float* gb = kin(12) + layer * 256;
#pragma unroll
    for (int nt = 0; nt < 2; ++nt) { const int n0 = 32 * wave + 16 * nt + 4 * fq; const f32x4 bv = *(const f32x4*)(gb + n0);
#pragma unroll
        for (int rt = 0; rt < 8; ++rt) { const int t = 16 * rt + fr; const u32x2 yp = *(const LAS u32x2*)(AT_ + t * APITCH + n0 * 2); const u32x2 sg = *(const u32x2*)(((bf16*)(F.ws + WS_SG)) + (tok0 + t) * 256 + n0);
            const f32x4 z = acc[rt][nt] + bv; u32x2 w;
            w.x = pk2(bflo(yp.x) * sigmoid_f(z[0]) * bflo(sg.x), bfhi(yp.x) * sigmoid_f(z[1]) * bfhi(sg.x));
            w.y = pk2(bflo(yp.y) * sigmoid_f(z[2]) * bflo(sg.y), bfhi(yp.y) * sigmoid_f(z[3]) * bfhi(sg.y));
            *(u32x2*)(((bf16*)(F.ws + WS_Y)) + (tok0 + t) * DM + n0) = w; } }
    __syncthreads();
}

__device__ __forceinline__ void mixer_phase(const Params& P, Frame& F, int qslot, int layer, int mask) {
    volatile LAS int* qw = (volatile LAS int*)(F.lds + LDS_CTL);
    unsigned* head = F.ctl + CW_QUEUE + 64 * qslot;
    for (;;) {
        if (F.tid == 0) qw[0] = (int)atomicAdd(head, 1u);
        __syncthreads();
        const int it = qw[0];
        __syncthreads();
        if (it >= 1536) break;
        Frame Fu = phase_frame(F);
#ifndef NO_MOBA
        if (it < 768 && (mask & 1)) { const int qb = 7 - it / 96, r = it % 96, b = r / 6, kvh = (r % 6) / 3, g = r % 3;
            if (mask & 8) moba_unit<1>(Fu, b, kvh, qb, g); else if (mask & 16) moba_unit<2>(Fu, b, kvh, qb, g);
#ifdef MOBA_PVAR
            else if (mask & 64) moba_unit<MOBA_PVAR>(Fu, b, kvh, qb, g);
#endif
            else moba_unit<0>(Fu, b, kvh, qb, g); }
#endif
#ifndef NO_SSM
        if (it >= 768 && it < 1024 && (mask & 2)) { const int r = it - 768; ssm_unit(Fu, layer, r >> 4, r & 15); }
#endif
#ifndef NO_SWA
        if (it >= 1024 && it < 1280 && (mask & 4)) { const int r = it - 1024; swa_unit(P, Fu, layer, r >> 4, (r >> 3) & 1, r & 7); }
#endif
        if (it >= 1280 && (mask & 32)) { const int r = it - 1280; glu_unit(P, Fu, layer, r >> 4, r & 15); }
    }
}

#define XB_TMO      128
#define XB_XCNT(j)  (256  + 64 * (j))
#define XB_XSUB(j)  (1280 + 64 * (j))
#define XB_XGEN(j)  (2304 + 64 * (j))
#define XB_TOP      3328
#define XB_TOPGEN   3392
#define XCD_BAR_WORDS 3456
#define XB_SPIN_CAP (1u << 18)

__device__ __forceinline__ unsigned xb_ld(unsigned* p)              { return __hip_atomic_load(p, __ATOMIC_RELAXED, __HIP_MEMORY_SCOPE_AGENT); }
__device__ __forceinline__ unsigned xb_add(unsigned* p, unsigned v) { return __hip_atomic_fetch_add(p, v, __ATOMIC_RELAXED, __HIP_MEMORY_SCOPE_AGENT); }
__device__ __forceinline__ unsigned xb_xcc_id() { return (unsigned)__builtin_amdgcn_s_getreg((3 << 11) | 20) & 0xFu; }
#define XB_SPIN(cond, bar) do { unsigned _sp = 0; while (cond) { __builtin_amdgcn_s_sleep(1); \
    if ((++_sp & 255u) == 0u) { if (xb_ld(&(bar)[XB_TMO])) break; if (_sp > XB_SPIN_CAP) { atomicAdd(&(bar)[XB_TMO], 1u); break; } } } } while (0)

struct XcdBarrier {
    unsigned* bar; unsigned x;
    volatile LAS unsigned* st;
};

__device__ __forceinline__ XcdBarrier xcd_barrier_post(unsigned* bar, volatile LAS unsigned* st) {
    XcdBarrier b; b.bar = bar; b.x = xb_xcc_id(); b.st = st;
    if (threadIdx.x == 0) (void)xb_add(&bar[XB_XCNT(b.x)], 1u);
    return b;
}
__device__ __forceinline__ void xcd_barrier_complete(unsigned* bar, unsigned x, unsigned& nloc, unsigned& nx) {
    const unsigned G = gridDim.x * gridDim.y * gridDim.z;
    unsigned sum, cnt, mine, sp = 0u;
    for (;;) {
        sum = 0u; cnt = 0u; mine = 0u;
#pragma unroll 1
        for (unsigned j = 0; j < 16; ++j) { const unsigned c = xb_ld(&bar[XB_XCNT(j)]); sum += c; cnt += (c > 0u) ? 1u : 0u; mine = (j == x) ? c : mine; }
        if (sum == G) break;
        __builtin_amdgcn_s_sleep(1);
        if ((++sp & 255u) == 0u) { if (xb_ld(&bar[XB_TMO])) break; if (sp > XB_SPIN_CAP) { atomicAdd(&bar[XB_TMO], 1u); break; } }
    }
    nloc = mine > 0u ? mine : 1u; nx = cnt > 0u ? cnt : 1u;
}

__device__ __forceinline__ void xcd_barrier(const XcdBarrier& b) {
    asm volatile("s_waitcnt vmcnt(0)" ::: "memory");
    __syncthreads();
    if (threadIdx.x == 0) {
        unsigned* bar = b.bar;
        __builtin_amdgcn_s_waitcnt(0);
        unsigned nloc = b.st[0], nx = b.st[1];
        if (nloc == 0u) { xcd_barrier_complete(bar, b.x, nloc, nx); b.st[0] = nloc; b.st[1] = nx; }
        const unsigned old = xb_add(&bar[XB_XSUB(b.x)], 1u);
        const unsigned gen = old / nloc;
        if (old + 1u == (gen + 1u) * nloc) {
            __builtin_amdgcn_fence(__ATOMIC_RELEASE, "agent");
            asm volatile("s_waitcnt vmcnt(0)" ::: "memory");
            const unsigned og = xb_add(&bar[XB_TOP], 1u);
            const unsigned tg = og / nx;
            if (og + 1u == (tg + 1u) * nx) xb_add(&bar[XB_TOPGEN], 1u);
            else XB_SPIN(xb_ld(&bar[XB_TOPGEN]) == tg, bar);
            __builtin_amdgcn_fence(__ATOMIC_ACQUIRE, "agent");
            xb_add(&bar[XB_XGEN(b.x)], 1u);
            asm volatile("s_waitcnt vmcnt(0)" ::: "memory");
        } else {
            XB_SPIN(xb_ld(&bar[XB_XGEN(b.x)]) == gen, bar);
            __builtin_amdgcn_fence(__ATOMIC_ACQUIRE, "agent");
            asm volatile("s_waitcnt vmcnt(0)" ::: "memory");
        }
    }
    __syncthreads();
}

constexpr int CW_BAR = 4096;
#ifndef USE_COOP_LAUNCH
#define USE_COOP_LAUNCH 0
#endif
#ifndef REP_P0
#define REP_P0 1
#endif
#ifndef REP_P1
#define REP_P1 1
#endif
#ifndef REP_MIX
#define REP_MIX 1
#endif
#ifndef REP_GLU
#define REP_GLU 1
#endif
#ifndef REP_P3L0
#define REP_P3L0 1
#endif
#ifndef REP_SYNC
#define REP_SYNC 1
#endif
#ifndef P3_PROBE_SKIP
#define P3_PROBE_SKIP 0
#endif
#ifndef MIX_EXTRA_MASK
#define MIX_EXTRA_MASK 39
#endif
#ifndef USE_CG_SYNC
#define USE_CG_SYNC 0
#endif
#define GRID_SYNC() do { for (int r_ = 0; r_ < REP_SYNC; ++r_) { if (USE_CG_SYNC) cg::this_grid().sync(); else xcd_barrier(xbar); } STAMP(); } while (0)
#ifdef PROBE_TS_A
#define STAMP() do { if (n_stamp == PROBE_TS_A) ts_a = __builtin_amdgcn_s_memrealtime(); if (n_stamp == PROBE_TS_B) ts_b = __builtin_amdgcn_s_memrealtime(); ++n_stamp; } while (0)
#else
#define STAMP() do {} while (0)
#endif
__global__ void __launch_bounds__(512, 2) mk_fwd(Params P) {
    extern __shared__ __attribute__((aligned(16))) unsigned char lds_raw[];
    Frame F;
    F.lds = (LAS unsigned char*)lds_raw; F.tid = threadIdx.x; F.lane = F.tid & 63; F.wave = __builtin_amdgcn_readfirstlane(F.tid >> 6); F.G = gridDim.x; F.bid = blockIdx.x;
    F.out = (float*)kin(19); F.ws = (unsigned char*)kin(20); F.ctl = (unsigned*)(F.ws + WS_CTL);
    if (F.tid < 128) ((LAS unsigned*)(F.lds + LDS_CTL))[F.tid] = 0u;
    __syncthreads();
    const XcdBarrier xbar = xcd_barrier_post(F.ctl + CW_BAR, (volatile LAS unsigned*)(F.lds + LDS_CTL + 16));

    int n_stamp = 0; unsigned long long ts_a = 0, ts_b = 0; (void)n_stamp; (void)ts_a; (void)ts_b;
    STAMP();
#ifndef NO_P0
    for (int rep = 0; rep < REP_P0; ++rep) { Frame Fp = phase_frame(F); p0_prologue(P, Fp); }
#endif
    GRID_SYNC();
#pragma unroll 1
    for (int layer = 0; layer < DEPTH; ++layer) {
#ifndef NO_P1
        for (int rep = 0; rep < REP_P1; ++rep) {
            Frame Fp = phase_frame(F);
            pg8::Gemm g{((bf16*)(Fp.ws + WS_Z)), ((bf16*)(Fp.ws + WS_Z)), ZROWS, ZROWS, DM}; const SchedTab S = make_sched<0>(Fp, NTT + 10 * layer);
            EpiProj E{NTT + 10 * layer, layer, Fp.ws};
            pg8::gemm_phase<EpiProj, SchedTab, true, true>(F.lds, g, S, E);
        }
#endif
        GRID_SYNC();
#ifndef NO_MIX
        for (int rep = 0; rep < REP_MIX; ++rep) { Frame Fp = phase_frame(F); mixer_phase(P, Fp, layer + 2 * rep, layer, rep ? MIX_EXTRA_MASK : 39); }
#endif
        GRID_SYNC();
#ifndef NO_P3
        for (int rep = 0; rep < (layer == 0 ? REP_P3L0 : 1); ++rep) {
            Frame Fp = phase_frame(F);
            pg8::Gemm g{((bf16*)(Fp.ws + WS_Y)), ((bf16*)(Fp.ws + WS_WOUT)) + (size_t)layer * DM * DM, MTOK, DM, DM}; const SchedTab S = make_sched<1>(Fp, 0);
            EpiOut E{kin(0), F.out, ((bf16*)(Fp.ws + WS_Z)), ((float*)(Fp.ws + WS_ROWSS)), layer + 1 < DEPTH ? 1 : 0, (LAS float*)(F.lds + LDS_MISC + 4096), (rep > 0 && P3_PROBE_SKIP) ? 1 : 0};
            pg8::gemm_phase<EpiOut, SchedTab, true, true>(F.lds, g, S, E);
        }
#endif
        if (layer + 1 < DEPTH) GRID_SYNC();
    }
#ifdef PROBE_TS_A
    GRID_SYNC();
    if (blockIdx.x == 0) { const unsigned long long n = (ts_b - ts_a) * PROBE_TS_MULT / PROBE_TS_DIV; for (unsigned long long i = threadIdx.x; i < n; i += 512) F.out[i] += 0.08f; }
#endif
}

extern "C" void kernel_launch(void* const* d_in, const int* in_sizes, int n_in, void* d_out, int out_size, void* d_ws, size_t ws_size, hipStream_t stream) {
    static int grid = 0;
    if (grid == 0) {
        if (n_in != 19 || out_size != MTOK * DM || ws_size < WS_END) { fprintf(stderr, "kernel_launch: unexpected problem (n_in %d out %d ws %zu)\n", n_in, out_size, ws_size); grid = -1; return; }
        int dev = 0, cus = 0, per_cu = 0;
        (void)hipGetDevice(&dev);
        (void)hipDeviceGetAttribute(&cus, hipDeviceAttributeMultiprocessorCount, dev);
        (void)hipFuncSetAttribute((const void*)mk_fwd, hipFuncAttributeMaxDynamicSharedMemorySize, LDS_BYTES);
        (void)hipOccupancyMaxActiveBlocksPerMultiprocessor(&per_cu, (const void*)mk_fwd, 512, LDS_BYTES);
        if (per_cu < 1) { fprintf(stderr, "kernel_launch: occupancy query says %d blocks per CU\n", per_cu); per_cu = 1; }
        grid = cus;
    }
    if (grid < 0) return;
    (void)hipMemsetAsync((char*)d_ws + WS_CTL, 0, CTL_BYTES, stream);
    Params p{};
    for (int i = 0; i < 19; ++i) p.in[i] = (const float*)d_in[i];
    p.out = (float*)d_out; p.ws = (unsigned char*)d_ws;
#if USE_COOP_LAUNCH
    void* args[] = {&p};
    hipError_t e = hipLaunchCooperativeKernel((const void*)mk_fwd, dim3(grid), dim3(512), args, LDS_BYTES, stream);
    if (e != hipSuccess) fprintf(stderr, "cooperative launch failed: %s (grid %d)\n", hipGetErrorString(e), grid);
#else
    hipLaunchKernelGGL(mk_fwd, dim3(grid), dim3(512), LDS_BYTES, stream, p);
    const hipError_t e = hipPeekAtLastError();
    if (e != hipSuccess) fprintf(stderr, "launch failed: %s (grid %d)\n", hipGetErrorString(e), grid);
#endif
}
```

```cpp
#include <hip/hip_runtime.h>
#include <hip/hip_cooperative_groups.h>
#include <cstdio>
#include <cstdint>
namespace cg = cooperative_groups;
namespace pg8 {
#define PG8_LAS __attribute__((address_space(3)))
typedef unsigned short bf16_t;
typedef short bf16x8 __attribute__((ext_vector_type(8)));
typedef float f32x4 __attribute__((ext_vector_type(4)));
typedef unsigned u32x4 __attribute__((ext_vector_type(4)));
constexpr int BM = 256, BK = 64, HALF = 128, HTB = HALF * BK * 2  , STAGE_BYTES = 8 * HTB, NXCD = 8, WGM = 8;

__host__ __device__ __forceinline__ int lds_byte(int r, int c) { const int st = (r >> 4) * 2 + (c >> 5), rr = r & 15, cc = c & 31, ob = rr * 64 + cc * 2; return st * 1024 + (ob ^ (((ob >> 9) & 1) << 5)); }
__host__ __device__ __forceinline__ void stage_rc(int b, int& R, int& C) { const int st = b / 1024, sb = b % 1024, swz = sb ^ (((sb >> 9) & 1) << 5); R = (st >> 1) * 16 + swz / 64; C = (st & 1) * 32 + (swz % 64) / 2; }
__host__ __device__ __forceinline__ int perm32(int rho) { const int n = rho >> 4, i = rho & 15; return 8 * (i >> 2) + 4 * n + (i & 3); }

struct Unit { int pm, pn; };
struct Gemm { const bf16_t* A; const bf16_t* Bt; int M, N, K; };

__device__ __forceinline__ unsigned cvt_pk_bf16(float lo, float hi) { unsigned r; asm volatile("v_cvt_pk_bf16_f32 %0, %1, %2" : "=v"(r) : "v"(lo), "v"(hi)); return r; }
typedef float f32x2 __attribute__((ext_vector_type(2)));
template <class Epi, class Sched, bool ALIGN_EPI = false, bool SP2 = false>
__device__ __forceinline__ void gemm_phase(PG8_LAS unsigned char* lds, const Gemm g, const Sched& S, const Epi& E) {
    int tid_ = threadIdx.x; asm volatile("" : "+v"(tid_));
    const int tid = tid_, wid = __builtin_amdgcn_readfirstlane(tid >> 6), lane = tid & 63, wr = wid >> 2, wc = wid & 3, fr = lane & 15, fq = lane >> 4;
    const int K = g.K, nt = K / BK;
    unsigned voffA[2], voffB[2];
#pragma unroll
    for (int i = 0; i < 2; ++i) { int R, C; stage_rc(tid * 16 + i * 8192, R, C); const int Rb = Epi::PERM ? ((R & ~31) + perm32(R & 31)) : R;
        voffA[i] = (unsigned)(R * K + C) * 2u; voffB[i] = (unsigned)(Rb * K + C) * 2u; }
    const size_t kstep = (size_t)(BK * 2);
    const size_t hstep = (size_t)HALF * K * 2;
    const size_t tstep = 2 * hstep;
    const unsigned ldsw = (unsigned)wid * 1024u;
    const int aoff = lds_byte(wr * 64 + fr, fq * 8), boff = lds_byte(wc * 32 + fr, fq * 8);
#define PG8_SA(b, h) (((b) * 2 + (h)) * HTB)
#define PG8_SB(b, h) ((4 + (b) * 2 + (h)) * HTB)
#define PG8_STAGE(bufoff, gbase, voff) do { _Pragma("unroll") for (int _i = 0; _i < 2; ++_i) \
        __builtin_amdgcn_global_load_lds((const unsigned*)((const char*)(gbase) + (voff)[_i]), (PG8_LAS unsigned*)(lds + (bufoff) + ldsw + _i * 8192), 16, 0, 0); } while (0)
#define PG8_LDA(dst, b, h) do { _Pragma("unroll") for (int m = 0; m < 4; ++m) _Pragma("unroll") for (int k = 0; k < 2; ++k) dst[m][k] = *(const PG8_LAS bf16x8*)(lds + PG8_SA(b, h) + aoff + m * 2048 + k * 1024); } while (0)
#define PG8_LDB(dst, b, h) do { _Pragma("unroll") for (int n = 0; n < 2; ++n) _Pragma("unroll") for (int k = 0; k < 2; ++k) dst[n][k] = *(const PG8_LAS bf16x8*)(lds + PG8_SB(b, h) + boff + n * 2048 + k * 1024); } while (0)
#define PG8_MMA(ai, bj, At, Bt) do { __builtin_amdgcn_s_setprio(1); _Pragma("unroll") for (int m = 0; m < 4; ++m) _Pragma("unroll") for (int n = 0; n < 2; ++n) _Pragma("unroll") for (int k = 0; k < 2; ++k) \
        acc[ai][bj][m][n] = __builtin_amdgcn_mfma_f32_16x16x32_bf16(Bt[n][k], At[m][k], acc[ai][bj][m][n], 0, 0, 0); __builtin_amdgcn_s_setprio(0); } while (0)
#define PG8_WAIT_V(n) asm volatile("s_waitcnt vmcnt(" #n ")" ::: "memory")
#define PG8_WAIT_L(n) asm volatile("s_waitcnt lgkmcnt(" #n ")" ::: "memory")
#define PG8_BAR __builtin_amdgcn_s_barrier()
#define PG8_SCHED __builtin_amdgcn_sched_barrier(0)
    Unit cur, nxt; int ui = 0;
    if (!S.next(0, cur)) return;
    f32x4 acc[2][2][4][2];
#pragma unroll
    for (int a = 0; a < 2; ++a)
#pragma unroll
        for (int b = 0; b < 2; ++b)
#pragma unroll
            for (int m = 0; m < 4; ++m)
#pragma unroll
                for (int n = 0; n < 2; ++n) acc[a][b][m][n] = (f32x4){0.f, 0.f, 0.f, 0.f};
    bf16x8 At[4][2], B0[2][2], B1[2][2];
    const char* cA = (const char*)g.A + (size_t)cur.pm * tstep; const char* cB = (const char*)g.Bt + (size_t)cur.pn * tstep;
    S.a_ready(cur);
    if constexpr (SP2) {
        PG8_STAGE(PG8_SB(0, 0), cB, voffB); PG8_STAGE(PG8_SB(0, 1), cB + hstep, voffB); PG8_STAGE(PG8_SA(0, 0), cA, voffA); PG8_STAGE(PG8_SA(0, 1), cA + hstep, voffA);
        if (wr == 1) PG8_BAR;
        PG8_WAIT_V(2); PG8_BAR;
        PG8_STAGE(PG8_SB(1, 0), cB + kstep, voffB); PG8_STAGE(PG8_SA(1, 0), cA + kstep, voffA); PG8_STAGE(PG8_SB(1, 1), cB + hstep + kstep, voffB);
        PG8_WAIT_V(6); PG8_BAR;
    } else {
        PG8_STAGE(PG8_SB(0, 0), cB, voffB); PG8_STAGE(PG8_SA(0, 0), cA, voffA); PG8_STAGE(PG8_SB(0, 1), cB + hstep, voffB); PG8_STAGE(PG8_SA(0, 1), cA + hstep, voffA);
        if (wr == 1) PG8_BAR;
        PG8_WAIT_V(4); PG8_BAR;
        PG8_STAGE(PG8_SB(1, 0), cB + kstep, voffB); PG8_STAGE(PG8_SA(1, 0), cA + kstep, voffA); PG8_STAGE(PG8_SB(1, 1), cB + hstep + kstep, voffB);
        PG8_WAIT_V(6); PG8_BAR;
    }
    for (;;) {
        const bool has_next = S.next(ui + 1, nxt);
        const char* nA = has_next ? (const char*)g.A + (size_t)nxt.pm * tstep : cA; const char* nB = has_next ? (const char*)g.Bt + (size_t)nxt.pn * tstep : cB;
        for (int t = 0; t < nt; t += 2) {
            const bool last = (t == nt - 2);
            const char* a1 = cA + (size_t)(t + 1) * kstep;
            const char* a2 = last ? nA : cA + (size_t)(t + 2) * kstep; const char* b2 = last ? nB : cB + (size_t)(t + 2) * kstep;
            const char* a3 = a2 + kstep; const char* b3 = b2 + kstep;
            if (last && has_next) S.a_ready(nxt);
            if constexpr (SP2) {
            PG8_LDB(B0, 0, 0); PG8_LDB(B1, 0, 1); PG8_SCHED; PG8_LDA(At, 0, 0); PG8_STAGE(PG8_SA(1, 1), a1 + hstep, voffA);
            PG8_WAIT_V(8); PG8_WAIT_L(0); PG8_BAR; PG8_MMA(0, 0, At, B0); PG8_MMA(0, 1, At, B1); PG8_BAR; PG8_SCHED;
            PG8_LDA(At, 0, 1); PG8_STAGE(PG8_SB(0, 0), b2, voffB); PG8_STAGE(PG8_SB(0, 1), b2 + hstep, voffB); PG8_STAGE(PG8_SA(0, 0), a2, voffA);
            PG8_WAIT_V(8); PG8_WAIT_L(0); PG8_BAR; PG8_MMA(1, 0, At, B0); PG8_MMA(1, 1, At, B1); PG8_BAR; PG8_SCHED;
            PG8_LDB(B0, 1, 0); PG8_LDB(B1, 1, 1); PG8_SCHED; PG8_LDA(At, 1, 0); PG8_STAGE(PG8_SA(0, 1), a2 + hstep, voffA);
            PG8_WAIT_V(8); PG8_WAIT_L(0); PG8_BAR; PG8_MMA(0, 0, At, B0); PG8_MMA(0, 1, At, B1); PG8_BAR; PG8_SCHED;
            PG8_LDA(At, 1, 1); PG8_STAGE(PG8_SB(1, 0), b3, voffB); PG8_STAGE(PG8_SB(1, 1), b3 + hstep, voffB); PG8_STAGE(PG8_SA(1, 0), a3, voffA);
            PG8_WAIT_V(8); PG8_WAIT_L(0); PG8_BAR; PG8_MMA(1, 0, At, B0); PG8_MMA(1, 1, At, B1); PG8_BAR; PG8_SCHED;
            } else {
            PG8_LDB(B0, 0, 0); PG8_SCHED; PG8_LDA(At, 0, 0); PG8_STAGE(PG8_SA(1, 1), a1 + hstep, voffA);
            PG8_WAIT_L(8); PG8_BAR; PG8_WAIT_L(0); PG8_MMA(0, 0, At, B0); PG8_BAR; PG8_SCHED;
            PG8_LDB(B1, 0, 1); PG8_STAGE(PG8_SB(0, 0), b2, voffB);
            PG8_BAR; PG8_WAIT_L(0); PG8_MMA(0, 1, At, B1); PG8_BAR;
            PG8_LDA(At, 0, 1); PG8_STAGE(PG8_SA(0, 0), a2, voffA);
            PG8_BAR; PG8_WAIT_L(0); PG8_MMA(1, 0, At, B0); PG8_BAR; PG8_SCHED;
            PG8_STAGE(PG8_SB(0, 1), b2 + hstep, voffB);
            PG8_WAIT_V(6); PG8_BAR; PG8_MMA(1, 1, At, B1); PG8_BAR;
            PG8_LDB(B0, 1, 0); PG8_SCHED; PG8_LDA(At, 1, 0); PG8_STAGE(PG8_SA(0, 1), a2 + hstep, voffA);
            PG8_WAIT_L(8); PG8_BAR; PG8_WAIT_L(0); PG8_MMA(0, 0, At, B0); PG8_BAR; PG8_SCHED;
            PG8_LDB(B1, 1, 1); PG8_STAGE(PG8_SB(1, 0), b3, voffB);
            PG8_BAR; PG8_WAIT_L(0); PG8_MMA(0, 1, At, B1); PG8_BAR;
            PG8_LDA(At, 1, 1); PG8_STAGE(PG8_SA(1, 0), a3, voffA);
            PG8_BAR; PG8_WAIT_L(0); PG8_MMA(1, 0, At, B0); PG8_BAR; PG8_SCHED;
            PG8_STAGE(PG8_SB(1, 1), b3 + hstep, voffB);
            PG8_WAIT_V(6); PG8_BAR; PG8_MMA(1, 1, At, B1); PG8_BAR;
            }
        }
        if constexpr (ALIGN_EPI) { if (wr == 0) PG8_BAR; }
        if constexpr (!Epi::AFTER_DRAIN) { E(acc, cur, wr, wc, fr, fq); S.done(cur); }
        if (!has_next) break;
#pragma unroll
        for (int a = 0; a < 2; ++a)
#pragma unroll
            for (int b = 0; b < 2; ++b)
#pragma unroll
                for (int m = 0; m < 4; ++m)
#pragma unroll
                    for (int n = 0; n < 2; ++n) acc[a][b][m][n] = (f32x4){0.f, 0.f, 0.f, 0.f};
        cur = nxt; cA = nA; cB = nB; ++ui;
        if constexpr (ALIGN_EPI) { if (wr == 1) PG8_BAR; }
    }
    PG8_WAIT_V(0);
    if constexpr (!ALIGN_EPI) { if (wr == 0) PG8_BAR; }
    PG8_BAR;
    if constexpr (Epi::AFTER_DRAIN) { E.fused(acc, cur, wr, wc, fr, fq, lds, wid, lane); S.done(cur); }
#undef PG8_SA
#undef PG8_SB
#undef PG8_STAGE
#undef PG8_LDA
#undef PG8_LDB
#undef PG8_MMA
#undef PG8_WAIT_V
#undef PG8_WAIT_L
#undef PG8_BAR
#undef PG8_SCHED
}
}

#define GAS __attribute__((address_space(1)))
#define LAS __attribute__((address_space(3)))
typedef unsigned short bf16;
typedef short bf16x8 __attribute__((ext_vector_type(8)));
typedef float f32x4 __attribute__((ext_vector_type(4)));
typedef float f32x16 __attribute__((ext_vector_type(16)));
typedef unsigned u32x4 __attribute__((ext_vector_type(4)));
typedef unsigned u32x2 __attribute__((ext_vector_type(2)));
typedef float f32x2_t __attribute__((ext_vector_type(2)));
typedef __bf16 bf16x2_t __attribute__((ext_vector_type(2)));
using pg8::Unit;

constexpr int NB = 16, SEQ = 2048, MTOK = NB * SEQ, DM = 1024, NPROJ = 2560, DEPTH = 2;
constexpr int NTT = MTOK / 256;
constexpr int ZROWS = MTOK + DEPTH * NPROJ;
constexpr float RMS_EPS = 1e-6f;
constexpr float LOG2E = 1.4426950408889634f;
constexpr float QSCALE = 0.125f * LOG2E;
constexpr int LDS_BYTES = 147456;
constexpr int LDS_MISC = 131072;
constexpr int LDS_CTL = LDS_BYTES - 512;

constexpr size_t MiB = 1u << 20;
constexpr size_t WS_CTL = 0, CTL_BYTES = 64 * 1024;
constexpr size_t WS_Z = 2 * MiB, WS_WOUT = 78 * MiB, WS_GLU = 82 * MiB, WS_TE = 83 * MiB, WS_G = 89 * MiB, WS_AT = 91 * MiB;
constexpr size_t WS_U = 92 * MiB, WS_SG = 108 * MiB, WS_AQ = 124 * MiB, WS_AK = 148 * MiB, WS_AG = 156 * MiB, WS_MQ = 180 * MiB, WS_MK = 204 * MiB, WS_MG = 212 * MiB;
constexpr size_t WS_VT = 236 * MiB, WS_KPART = 252 * MiB, WS_ROWSS = 253 * MiB, WS_YPRE = 254 * MiB, WS_Y = 270 * MiB, WS_END = 334 * MiB;
static_assert(WS_Z + (size_t)ZROWS * DM * 2 <= WS_WOUT, "Z fits");
constexpr size_t WS_NW = 1 * MiB;
constexpr int TE_ELEMS = 256 * 384, G_ELEMS = 128 * 256;
constexpr int CW_QUEUE = 1024;
constexpr int CW_SSMDONE = 8192;

__device__ __forceinline__ unsigned pk2(float lo, float hi) { f32x2_t v = {lo, hi}; bf16x2_t b = __builtin_convertvector(v, bf16x2_t); return __builtin_bit_cast(unsigned, b); }
__device__ __forceinline__ float bf2f(unsigned short x) { return __uint_as_float((unsigned)x << 16); }
__device__ __forceinline__ float bflo(unsigned w) { return __uint_as_float(w << 16); }
__device__ __forceinline__ float bfhi(unsigned w) { return __uint_as_float(w & 0xffff0000u); }
__device__ __forceinline__ float wave_sum(float v) {
#pragma unroll
    for (int o = 1; o < 64; o <<= 1) v += __shfl_xor(v, o);
    return v;
}
__device__ __forceinline__ float fast_rcp(float x) { return __builtin_amdgcn_rcpf(x); }
__device__ __forceinline__ float silu_f(float x) { return x * fast_rcp(1.f + __builtin_amdgcn_exp2f(-x * LOG2E)); }
__device__ __forceinline__ float sigmoid_f(float x) { return fast_rcp(1.f + __builtin_amdgcn_exp2f(-x * LOG2E)); }
__device__ __forceinline__ float gelu_tanh_f(float x) { const float z = 0.7978845608028654f * (x + 0.044715f * x * x * x); return x * fast_rcp(1.f + __builtin_amdgcn_exp2f(-2.f * LOG2E * z)); }
__device__ __forceinline__ float swap32_max(float m) { auto rr = __builtin_amdgcn_permlane32_swap(__float_as_uint(m), __float_as_uint(m), false, false); return fmaxf(__uint_as_float(rr[0]), __uint_as_float(rr[1])); }
__device__ __forceinline__ float swap32_sum(float m) { auto rr = __builtin_amdgcn_permlane32_swap(__float_as_uint(m), __float_as_uint(m), false, false); return __uint_as_float(rr[0]) + __uint_as_float(rr[1]); }
__device__ __forceinline__ void glds16(const void* gsrc, LAS unsigned char* ldst) {
    const unsigned dst = __builtin_amdgcn_readfirstlane((unsigned)(uintptr_t)ldst); unsigned keep;
    asm volatile("s_mov_b32 %0, m0\n\ts_mov_b32 m0, %2\n\ts_nop 0\n\tglobal_load_lds_dwordx4 %1, off\n\ts_mov_b32 m0, %0" : "=&s"(keep) : "v"(gsrc), "s"(dst) : "memory");
}
#define GLDS_WAIT() asm volatile("s_waitcnt vmcnt(0)" ::: "memory")

struct Params {
    const float* in[19]; float* out; unsigned char* ws;
};
typedef const float* const __attribute__((address_space(4))) * kargs_t;
__device__ __forceinline__ const float* kin(int i) { kargs_t ka = (kargs_t)__builtin_amdgcn_kernarg_segment_ptr(); asm volatile("" : "+s"(ka)); return ka[i]; }
struct Frame {
    LAS unsigned char* lds; int tid, lane, wave, G, bid; float* out; unsigned char* ws; unsigned* ctl;
};

__device__ __forceinline__ int proj_dest_row(int n0) {
    int slot, off;
    if (n0 < 512)       { slot = n0 >> 6; off = n0 & 63; }
    else if (n0 < 1024) { slot = 8 + ((n0 - 512) >> 6); off = n0 & 63; }
    else if (n0 < 1152) { return 2304 + (n0 - 1024); }
    else if (n0 < 1536) { slot = 16 + ((n0 - 1152) >> 6); off = (n0 - 1152) & 63; }
    else if (n0 < 1920) { slot = 22 + ((n0 - 1536) >> 6); off = (n0 - 1536) & 63; }
    else if (n0 < 2048) { slot = 28 + ((n0 - 1920) >> 6); off = (n0 - 1920) & 63; }
    else if (n0 < 2176) { return 2304 + 128 + (n0 - 2048); }
    else                { slot = 30 + ((n0 - 2176) >> 6); off = (n0 - 2176) & 63; }
    const int t = slot >> 2, wc = slot & 3;
    return 256 * t + 128 * (off >> 5) + 32 * wc;
}
__device__ __forceinline__ void p0_transpose_item(const float* W, int K, int N, const float* gk, bf16* WT, int ldk, int drow0, LAS float* scr, int k0, int n0, int lane) {
    float tv[32];
#pragma unroll
    for (int i = 0; i < 32; ++i) { const int kk = 2 * i + (lane >> 5); tv[i] = __builtin_nontemporal_load(W + (size_t)(k0 + kk) * N + n0 + (lane & 31)); }
#pragma unroll
    for (int i = 0; i < 32; ++i) { const int kk = 2 * i + (lane >> 5); float v = tv[i]; if (gk) v *= gk[k0 + kk]; scr[kk * 33 + (lane & 31)] = v; }
    asm volatile("s_waitcnt lgkmcnt(0)" ::: "memory");
    const int c = lane & 7;
#pragma unroll
    for (int j = 0; j < 4; ++j) { const int n = (lane >> 3) + 8 * j; const LAS float* s = scr + (8 * c) * 33 + n;
        u32x4 o; o.x = pk2(s[0 * 33], s[1 * 33]); o.y = pk2(s[2 * 33], s[3 * 33]); o.z = pk2(s[4 * 33], s[5 * 33]); o.w = pk2(s[6 * 33], s[7 * 33]);
        *(u32x4*)(WT + (size_t)(drow0 + n) * ldk + k0 + 8 * c) = o; }
    asm volatile("s_waitcnt lgkmcnt(0)" ::: "memory");
}
__device__ __forceinline__ void p0_ssm_consts(const Params& P, Frame& F, int pair) {
    const int l = pair >> 4, g = pair & 15, tid = F.tid;
    LAS float* pwr = (LAS float*)(F.lds);
    LAS float* pwi = pwr + 17 * 64;
    LAS float* bbr = pwi + 17 * 64;
    LAS float* bbi = bbr + 1024;
    LAS float* ccr = bbi + 1024;
    LAS float* cci = ccr + 1024;
    LAS float* Kt = cci + 1024;
    const float dt = expf(kin(5)[l * 16 + g]);
    const float* lre = kin(3) + (l * 16 + g) * 64; const float* lim = kin(4) + (l * 16 + g) * 64;
    for (int t = tid; t < 17 * 64; t += 512) { const int p = t & 63, lag = t >> 6; const float lr = lre[p], li = lim[p];
        const float mag = expf(lr * dt * (float)lag); float sn, cs; sincosf(li * dt * (float)lag, &sn, &cs); pwr[t] = mag * cs; pwi[t] = mag * sn; }
    for (int t = tid; t < 1024; t += 512) { const int p = t >> 4, h = t & 15; const float lr = lre[p], li = lim[p];
        const float mag = expf(lr * dt); float sn, cs; sincosf(li * dt, &sn, &cs); const float ar = mag * cs, ai = mag * sn;
        const float den = lr * lr + li * li, nr = ar - 1.f, ni = ai; const float cr = (nr * lr + ni * li) / den, ci = (ni * lr - nr * li) / den;
        const float br = kin(6)[((size_t)(l * 16 + g) * 64 + p) * 16 + h], bi = kin(7)[((size_t)(l * 16 + g) * 64 + p) * 16 + h];
        bbr[t] = cr * br - ci * bi; bbi[t] = cr * bi + ci * br; }
    for (int t = tid; t < 1024; t += 512) { ccr[t] = kin(8)[(size_t)(l * 16 + g) * 1024 + t]; cci[t] = kin(9)[(size_t)(l * 16 + g) * 1024 + t]; }
    __syncthreads();
    for (int t = tid; t < 4096; t += 512) { const int lag = t >> 8, hp = (t >> 4) & 15, h = t & 15; float s = 0.f;
        for (int p = 0; p < 64; ++p) { const float cr = ccr[hp * 64 + p], ci = cci[hp * 64 + p], pr = pwr[lag * 64 + p], pi = pwi[lag * 64 + p];
            const float xr = cr * pr - ci * pi, xi = cr * pi + ci * pr; s += xr * bbr[p * 16 + h] - xi * bbi[p * 16 + h]; }
        if (lag == 0 && hp == h) s += kin(10)[l * 256 + g * 16 + h];
        Kt[t] = s; }
    __syncthreads();
    bf16* TE = ((bf16*)(F.ws + WS_TE)) + (size_t)pair * TE_ELEMS; bf16* GM = ((bf16*)(F.ws + WS_G)) + (size_t)pair * G_ELEMS;
    for (int t = tid; t < 256 * 192; t += 512) { const int n = t / 192, kp = t % 192, k = 2 * kp; const int i = n >> 4, hp = n & 15; float v0, v1;
        if (k < 256) { const int j = k >> 4, h = k & 15; if (j <= i) { v0 = Kt[((i - j) * 16 + hp) * 16 + h]; v1 = Kt[((i - j) * 16 + hp) * 16 + h + 1]; } else { v0 = 0.f; v1 = 0.f; } }
        else { const int p = (k - 256) >> 1; const float cr = ccr[hp * 64 + p], ci = cci[hp * 64 + p], pr = pwr[(i + 1) * 64 + p], pi = pwi[(i + 1) * 64 + p];
            v0 = cr * pr - ci * pi; v1 = -(cr * pi + ci * pr); }
        *(unsigned*)(TE + (size_t)n * 384 + k) = pk2(v0, v1); }
    for (int t = tid; t < 128 * 128; t += 512) { const int n = t >> 7, kp = t & 127, k = 2 * kp; const int p = n >> 1, ri = n & 1, j = k >> 4, h = k & 15;
        const float pr = pwr[(15 - j) * 64 + p], pi = pwi[(15 - j) * 64 + p];
        float v0, v1;
        { const float br = bbr[p * 16 + h], bi = bbi[p * 16 + h]; v0 = ri ? (pr * bi + pi * br) : (pr * br - pi * bi); }
        { const float br = bbr[p * 16 + h + 1], bi = bbi[p * 16 + h + 1]; v1 = ri ? (pr * bi + pi * br) : (pr * br - pi * bi); }
        *(unsigned*)(GM + (size_t)n * 256 + k) = pk2(v0, v1); }
    if (tid < 64) { ((float*)(F.ws + WS_AT))[(size_t)pair * 128 + 2 * tid] = pwr[16 * 64 + tid]; ((float*)(F.ws + WS_AT))[(size_t)pair * 128 + 2 * tid + 1] = pwi[16 * 64 + tid]; }
    __syncthreads();
}
__device__ __forceinline__ void p0_prologue(const Params& P, Frame& F) {
    const bool split = F.G > 64;
    if (!split || F.bid < 32) { for (int pair = F.bid; pair < 32; pair += (split ? 32 : F.G)) p0_ssm_consts(P, F, pair); if (split) return; }
    const int vb = split ? F.bid - 32 : F.bid, nvb = split ? F.G - 32 : F.G;
    if (vb == 0) { float* nwp = (float*)(F.ws + WS_NW);
        for (int t = F.tid; t < DEPTH * 256; t += 512) { const int l = t >> 8, k = (t >> 6) & 3, d = t & 63;
            nwp[t] = (k == 0) ? kin(13)[l * 64 + d] * QSCALE : (k == 1) ? kin(14)[l * 64 + d] : (k == 2) ? kin(16)[l * 64 + d] * QSCALE : kin(17)[l * 64 + d]; } }
    const int gw = vb * 8 + F.wave, NGW = nvb * 8;
    LAS float* scr = (LAS float*)(F.lds + F.wave * 16384);
    constexpr int I_IN = 16 * 80, I_OUT = 16 * 32, I_GLU = 4 * 8, I_L = I_IN + I_OUT + I_GLU;
    for (int it = gw; it < DEPTH * I_L; it += NGW) {
        const int l = it / I_L; int r = it % I_L;
        if (r < I_IN) { const int kb = r / 80, nb = r % 80; p0_transpose_item(kin(2) + (size_t)l * DM * NPROJ, DM, NPROJ, kin(1) + l * DM, ((bf16*)(F.ws + WS_Z)) + (size_t)(MTOK + l * NPROJ) * DM, DM, proj_dest_row(32 * nb), scr, 64 * kb, 32 * nb, F.lane); continue; }
        r -= I_IN;
        if (r < I_OUT) { const int kb = r / 32, nb = r % 32; p0_transpose_item(kin(18) + (size_t)l * DM * DM, DM, DM, nullptr, ((bf16*)(F.ws + WS_WOUT)) + (size_t)l * DM * DM, DM, 32 * nb, scr, 64 * kb, 32 * nb, F.lane); continue; }
        r -= I_OUT;
        { const int kb = r / 8, nb = r % 8; p0_transpose_item(kin(11) + (size_t)l * 65536, 256, 256, nullptr, ((bf16*)(F.ws + WS_GLU)) + (size_t)l * 65536, 256, 32 * nb, scr, 64 * kb, 32 * nb, F.lane); }
    }
    for (int m0 = gw; m0 < MTOK; m0 += 4 * NGW) {
        f32x4 v[4][4];
#pragma unroll
        for (int q = 0; q < 4; ++q) { const int m = m0 + q * NGW; if (m < MTOK) { const f32x4* xr = (const f32x4*)(kin(0) + (size_t)m * DM) + F.lane;
#pragma unroll
            for (int j = 0; j < 4; ++j) v[q][j] = __builtin_nontemporal_load(xr + 64 * j); } }
#pragma unroll
        for (int q = 0; q < 4; ++q) { const int m = m0 + q * NGW; if (m < MTOK) { float s = 0.f;
#pragma unroll
            for (int j = 0; j < 4; ++j) s += (v[q][j].x * v[q][j].x + v[q][j].y * v[q][j].y) + (v[q][j].z * v[q][j].z + v[q][j].w * v[q][j].w);
            s = wave_sum(s);
            u32x2* o8 = (u32x2*)(((bf16*)(F.ws + WS_Z)) + (size_t)m * DM) + F.lane;
#pragma unroll
            for (int j = 0; j < 4; ++j) { u32x2 w; w.x = pk2(v[q][j].x, v[q][j].y); w.y = pk2(v[q][j].z, v[q][j].w); o8[64 * j] = w; }
            if (F.lane < 4) ((float*)(F.ws + WS_ROWSS))[(size_t)m * 4 + F.lane] = (F.lane == 0) ? s : 0.f; } }
    }
}

__device__ __forceinline__ Frame phase_frame(const Frame& F0) {
    Frame F = F0; asm volatile("" : "+v"(F.tid)); F.lane = F.tid & 63; F.wave = __builtin_amdgcn_readfirstlane(F.tid >> 6);
    asm volatile("" : "+s"(F.ws)); F.ctl = (unsigned*)(F.ws + WS_CTL); return F;
}
struct SchedTab { const volatile LAS int* tab; int n;
    __device__ __forceinline__ bool next(int i, Unit& u) const { if (i >= n) return false; u.pm = __builtin_amdgcn_readfirstlane(tab[2 * i]); u.pn = __builtin_amdgcn_readfirstlane(tab[2 * i + 1]); return true; }
    __device__ __forceinline__ void a_ready(const Unit&) const {}
    __device__ __forceinline__ void done(const Unit&) const {}
};
__device__ __forceinline__ bool unit_p1(int G, int c, int wbase, int i, int& pm, int& pn) {
    int tok, j;
    if (G == 256) { if (i >= 5) return false; const int x = c & 7, l = c >> 3, n = i * 32 + l, tq = n / 40, rem = n % 40; j = rem >> 2; tok = 16 * x + 4 * tq + (rem & 3); }
    else { const long L = (long)i * G + c; if (L >= NTT * 10) return false; tok = (int)(L / 10); j = (int)(L % 10); }
    if (j < 9) { pm = tok; pn = wbase + j; } else { pm = wbase + 9; pn = tok; }
    return true;
}
__device__ __forceinline__ bool unit_p3(int G, int c, int i, int& pm, int& pn) {
    if (G == 256) { if (i >= 2) return false; const int x = c & 7, l = c >> 3, n = i * 32 + l, tq = n >> 4, rem = n & 15; pn = rem >> 2; pm = 16 * x + 4 * tq + (rem & 3); }
    else { const long L = (long)i * G + c; if (L >= NTT * 4) return false; pm = (int)(L / 4); pn = (int)(L % 4); }
    return true;
}
__device__ __forceinline__ bool unit_glu(int G, int c, int i, int& pm, int& pn) {
    if (G == 256) { if (i >= 1 || (c >> 3) >= 16) return false; pm = 16 * (c & 7) + (c >> 3); pn = 0; }
    else { const long L = (long)i * G + c; if (L >= NTT) return false; pm = (int)L; pn = 0; }
    return true;
}
template <int KIND>
__device__ __forceinline__ SchedTab make_sched(const Frame& F, int wbase) {
    volatile LAS int* tab = (volatile LAS int*)(F.lds + LDS_CTL + 64);
    volatile LAS int* cnt = (volatile LAS int*)(F.lds + LDS_CTL + 32);
    if (F.tid == 0) { int n = 0;
#pragma unroll 1
        for (int i = 0; i < 24; ++i) { int pm, pn; const bool ok = (KIND == 0) ? unit_p1(F.G, F.bid, wbase, i, pm, pn) : (KIND == 1) ? unit_p3(F.G, F.bid, i, pm, pn) : unit_glu(F.G, F.bid, i, pm, pn);
            if (!ok) break; tab[2 * i] = pm; tab[2 * i + 1] = pn; n = i + 1; }
        cnt[0] = n; }
    __syncthreads();
    SchedTab S; S.tab = tab; S.n = __builtin_amdgcn_readfirstlane(cnt[0]); return S;
}

struct EpiProj {
    static constexpr bool PERM = true, AFTER_DRAIN = false;
    int wbase, layer; unsigned char* ws;
    __device__ __forceinline__ void operator()(const f32x4 (&acc)[2][2][4][2], const Unit& u, int wr, int wc, int fr, int fq) const {
        asm volatile("" : "+v"(fr), "+v"(fq));
        const float* rowss = (const float*)(ws + WS_ROWSS);
        if (u.pm >= NTT) {
            bf16* VT = (bf16*)(ws + WS_VT);
            const int tc = u.pn * 256 + wc * 32 + 8 * fq;
#pragma unroll
            for (int bj = 0; bj < 2; ++bj) {
                float rs[8];
                { f32x4 p[8];
#pragma unroll
                  for (int e = 0; e < 8; ++e) p[e] = *(const f32x4*)(rowss + (size_t)(tc + bj * 128 + e) * 4);
#pragma unroll
                  for (int e = 0; e < 8; ++e) rs[e] = rsqrtf(((p[e].x + p[e].y) + (p[e].z + p[e].w)) * (1.f / DM) + RMS_EPS); }
#pragma unroll
                for (int ai = 0; ai < 2; ++ai)
#pragma unroll
                    for (int m = 0; m < 4; ++m) { const int f = ai * 128 + wr * 64 + m * 16 + fr; const f32x4 a = acc[ai][bj][m][0], b = acc[ai][bj][m][1]; u32x4 w;
                        w.x = pk2(a[0] * rs[0], a[1] * rs[1]); w.y = pk2(a[2] * rs[2], a[3] * rs[3]); w.z = pk2(b[0] * rs[4], b[1] * rs[5]); w.w = pk2(b[2] * rs[6], b[3] * rs[7]);
                        *(u32x4*)(VT + ((size_t)u.pn * 256 + f) * 256 + (wc * 32 + 8 * fq + bj * 128)) = w; }
            }
            return;
        }
        const int t = u.pn - wbase;
        int kind, pitch, col, nwi = 0; size_t dsto;
        switch (t) {
            case 0: kind = 0; dsto = WS_U; pitch = 256; col = 64 * wc; break;
            case 1: kind = 1; dsto = WS_SG; pitch = 256; col = 64 * wc; break;
            case 2: kind = 2; dsto = WS_AQ; pitch = 384; col = 64 * wc; nwi = 0; break;
            case 3: if (wc < 2) { kind = 2; dsto = WS_AQ; pitch = 384; col = 64 * (4 + wc); nwi = 0; } else { kind = 2; dsto = WS_AK; pitch = 128; col = 64 * (wc - 2); nwi = 1; } break;
            case 4: kind = 1; dsto = WS_AG; pitch = 384; col = 64 * wc; break;
            case 5: if (wc < 2) { kind = 1; dsto = WS_AG; pitch = 384; col = 64 * (4 + wc); } else { kind = 2; dsto = WS_MQ; pitch = 384; col = 64 * (wc - 2); nwi = 2; } break;
            case 6: kind = 2; dsto = WS_MQ; pitch = 384; col = 64 * (2 + wc); nwi = 2; break;
            case 7: if (wc < 2) { kind = 5; dsto = WS_MK; pitch = 128; col = 64 * wc; nwi = 3; } else { kind = 1; dsto = WS_MG; pitch = 384; col = 64 * (wc - 2); } break;
            default: kind = 1; dsto = WS_MG; pitch = 384; col = 64 * (2 + wc); break;
        }
        bf16* dst = (bf16*)(ws + dsto) + col + 8 * fq; const float* nw = (const float*)(ws + WS_NW) + (layer * 4 + nwi) * 64 + 8 * fq;
        int row0 = u.pm * 256 + wr * 64 + fr; asm volatile("" : "+v"(row0));
        if (kind == 0) rows<0>(acc, row0, (bf16*)(ws + WS_U) + ((size_t)(4 * wc + (fq >> 1)) * SEQ) * 16 + 8 * (fq & 1), 0, nw, rowss, nullptr);
        else if (kind == 1) rows<1>(acc, row0, dst, pitch, nw, rowss, nullptr);
        else if (kind == 2) rows<2>(acc, row0, dst, pitch, nw, rowss, nullptr);
        else rows<5>(acc, row0, dst, pitch, nw, rowss, (fr == 0) ? (float*)(ws + WS_KPART) + ((size_t)(u.pm * 2 + wr) * 2 + wc) * 64 + 8 * fq : nullptr);
    }
    template <int KIND>
    __device__ __forceinline__ void rows(const f32x4 (&acc)[2][2][4][2], int row0, bf16* dst, int pitch, const float* nw, const float* rowss, float* kp) const {
        f32x4 wv[2][2], ks[2][2];
        if (KIND >= 2) {
#pragma unroll
            for (int bj = 0; bj < 2; ++bj)
#pragma unroll
                for (int n = 0; n < 2; ++n) { wv[bj][n] = *(const f32x4*)(nw + 32 * bj + 4 * n); ks[bj][n] = (f32x4){0.f, 0.f, 0.f, 0.f}; }
        }
#pragma unroll
        for (int ai = 0; ai < 2; ++ai) {
            float rsv[4];
            { f32x4 pr[4];
#pragma unroll
              for (int m = 0; m < 4; ++m) pr[m] = *(const f32x4*)(rowss + (size_t)(row0 + ai * 128 + m * 16) * 4);
#pragma unroll
              for (int m = 0; m < 4; ++m) { const f32x4 p = pr[m]; rsv[m] = rsqrtf(((p.x + p.y) + (p.z + p.w)) * (1.f / DM) + RMS_EPS); } }
#pragma unroll
            for (int m = 0; m < 4; ++m) {
                const int row = row0 + ai * 128 + m * 16;
                const float rs = rsv[m];
                f32x4 v[2][2];
#pragma unroll
                for (int bj = 0; bj < 2; ++bj)
#pragma unroll
                    for (int n = 0; n < 2; ++n) v[bj][n] = acc[ai][bj][m][n] * rs;
                if (KIND >= 2) {
                    float ss = 0.f;
#pragma unroll
                    for (int bj = 0; bj < 2; ++bj)
#pragma unroll
                        for (int n = 0; n < 2; ++n) { const f32x4 q = v[bj][n]; ss += (q[0] * q[0] + q[1] * q[1]) + (q[2] * q[2] + q[3] * q[3]); }
                    ss += __shfl_xor(ss, 16); ss += __shfl_xor(ss, 32);
                    const float hn = rsqrtf(ss * (1.f / 64.f) + RMS_EPS);
#pragma unroll
                    for (int bj = 0; bj < 2; ++bj)
#pragma unroll
                        for (int n = 0; n < 2; ++n) { v[bj][n] = v[bj][n] * wv[bj][n] * hn; if (KIND == 5) ks[bj][n] += v[bj][n]; }
                } else if (KIND == 1) {
#pragma unroll
                    for (int bj = 0; bj < 2; ++bj)
#pragma unroll
                        for (int n = 0; n < 2; ++n)
#pragma unroll
                            for (int e = 0; e < 4; ++e) v[bj][n][e] = silu_f(v[bj][n][e]);
                }
                bf16* rp = (KIND == 0) ? dst + ((size_t)(row >> 11) * 16 * SEQ + (row & (SEQ - 1))) * 16 : dst + (size_t)row * pitch;
#pragma unroll
                for (int bj = 0; bj < 2; ++bj) { u32x4 w; w.x = pk2(v[bj][0][0], v[bj][0][1]); w.y = pk2(v[bj][0][2], v[bj][0][3]); w.z = pk2(v[bj][1][0], v[bj][1][1]); w.w = pk2(v[bj][1][2], v[bj][1][3]);
                    *(u32x4*)(rp + (KIND == 0 ? 2 * SEQ * 16 * bj : 32 * bj)) = w; }
                if (m & 1) asm volatile("" ::: "memory");
            }
        }
        if (KIND == 5) {
#pragma unroll
            for (int bj = 0; bj < 2; ++bj)
#pragma unroll
                for (int n = 0; n < 2; ++n)
#pragma unroll
                    for (int e = 0; e < 4; ++e) { float s = ks[bj][n][e]; s += __shfl_xor(s, 1); s += __shfl_xor(s, 2); s += __shfl_xor(s, 4); s += __shfl_xor(s, 8); ks[bj][n][e] = s; }
            if (kp) {
#pragma unroll
                for (int bj = 0; bj < 2; ++bj)
#pragma unroll
                    for (int n = 0; n < 2; ++n) *(f32x4*)(kp + 32 * bj + 4 * n) = ks[bj][n];
            }
        }
    }
};
struct EpiGlu {
    static constexpr bool PERM = true, AFTER_DRAIN = false;
    const bf16* YPRE; const bf16* SG; const float* gb; bf16* Y;
    __device__ __forceinline__ void operator()(const f32x4 (&acc)[2][2][4][2], const Unit& u, int wr, int wc, int fr, int fq) const {
#pragma unroll
        for (int bj = 0; bj < 2; ++bj) { const int c = wc * 32 + 8 * fq + 128 * bj;
            const f32x4 b0 = *(const f32x4*)(gb + c), b1 = *(const f32x4*)(gb + c + 4);
#pragma unroll
            for (int ai = 0; ai < 2; ++ai)
#pragma unroll
                for (int m = 0; m < 4; ++m) { const int row = u.pm * 256 + ai * 128 + wr * 64 + m * 16 + fr;
                    const u32x4 yp = *(const u32x4*)(YPRE + (size_t)row * 256 + c), sg = *(const u32x4*)(SG + (size_t)row * 256 + c);
                    const f32x4 z0 = acc[ai][bj][m][0] + b0, z1 = acc[ai][bj][m][1] + b1;
                    u32x4 w;
                    w.x = pk2(bflo(yp.x) * sigmoid_f(z0[0]) * bflo(sg.x), bfhi(yp.x) * sigmoid_f(z0[1]) * bfhi(sg.x));
                    w.y = pk2(bflo(yp.y) * sigmoid_f(z0[2]) * bflo(sg.y), bfhi(yp.y) * sigmoid_f(z0[3]) * bfhi(sg.y));
                    w.z = pk2(bflo(yp.z) * sigmoid_f(z1[0]) * bflo(sg.z), bfhi(yp.z) * sigmoid_f(z1[1]) * bfhi(sg.z));
                    w.w = pk2(bflo(yp.w) * sigmoid_f(z1[2]) * bflo(sg.w), bfhi(yp.w) * sigmoid_f(z1[3]) * bfhi(sg.w));
                    *(u32x4*)(Y + (size_t)row * DM + c) = w;
                    if (m & 1) asm volatile("" ::: "memory"); } }
    }
};
struct EpiOut {
    static constexpr bool PERM = false, AFTER_DRAIN = false;
    const float* resid_f; float* out; bf16* xb; float* rowss; int write_next; LAS float* xch; int probe_skip;
    __device__ __forceinline__ void operator()(const f32x4 (&acc)[2][2][4][2], const Unit& u, int wr, int wc, int fr, int fq) const {
        const int c0 = u.pn * 256 + wc * 32 + 4 * fq;
        if (probe_skip) { asm volatile("" :: "v"(acc[0][0][0][0]), "v"(acc[1][1][3][1])); asm volatile("s_waitcnt lgkmcnt(0)" ::: "memory"); __builtin_amdgcn_s_barrier(); return; }
        if (write_next) {
#pragma unroll
            for (int ai = 0; ai < 2; ++ai) {
                u32x2 pre[4][2][2];
#pragma unroll
                for (int m = 0; m < 4; ++m) { const size_t off = (size_t)(u.pm * 256 + ai * 128 + wr * 64 + m * 16 + fr) * DM + c0;
#pragma unroll
                    for (int bj = 0; bj < 2; ++bj)
#pragma unroll
                        for (int n = 0; n < 2; ++n) pre[m][bj][n] = *(const u32x2*)(xb + off + bj * 128 + n * 16); }
#pragma unroll
                for (int m = 0; m < 4; ++m) { const int rt = ai * 128 + wr * 64 + m * 16 + fr; const size_t off = (size_t)(u.pm * 256 + rt) * DM + c0; float ss = 0.f;
#pragma unroll
                    for (int bj = 0; bj < 2; ++bj)
#pragma unroll
                        for (int n = 0; n < 2; ++n) { const u32x2 rb = pre[m][bj][n]; const f32x4 a4 = acc[ai][bj][m][n]; f32x4 o;
                            o[0] = bflo(rb.x) + a4[0]; o[1] = bfhi(rb.x) + a4[1]; o[2] = bflo(rb.y) + a4[2]; o[3] = bfhi(rb.y) + a4[3];
                            u32x2 w; w.x = pk2(o[0], o[1]); w.y = pk2(o[2], o[3]); *(u32x2*)(xb + off + bj * 128 + n * 16) = w; ss += (o[0] * o[0] + o[1] * o[1]) + (o[2] * o[2] + o[3] * o[3]); }
                    ss += __shfl_xor(ss, 16); ss += __shfl_xor(ss, 32); if (fq == 0) xch[rt * 4 + wc] = ss; }
            }
        } else {
#pragma unroll
            for (int ai = 0; ai < 2; ++ai) {
                u32x2 pre[4][2][2];
#pragma unroll
                for (int m = 0; m < 4; ++m) { const size_t off = (size_t)(u.pm * 256 + ai * 128 + wr * 64 + m * 16 + fr) * DM + c0;
#pragma unroll
                    for (int bj = 0; bj < 2; ++bj)
#pragma unroll
                        for (int n = 0; n < 2; ++n) pre[m][bj][n] = *(const u32x2*)(xb + off + bj * 128 + n * 16); }
#pragma unroll
                for (int m = 0; m < 4; ++m) { const size_t off = (size_t)(u.pm * 256 + ai * 128 + wr * 64 + m * 16 + fr) * DM + c0;
#pragma unroll
                    for (int bj = 0; bj < 2; ++bj)
#pragma unroll
                        for (int n = 0; n < 2; ++n) { const u32x2 rb = pre[m][bj][n]; const f32x4 a4 = acc[ai][bj][m][n]; f32x4 o;
                            o[0] = bflo(rb.x) + a4[0]; o[1] = bfhi(rb.x) + a4[1]; o[2] = bflo(rb.y) + a4[2]; o[3] = bfhi(rb.y) + a4[3];
                            __builtin_nontemporal_store(o, (f32x4*)(out + off + bj * 128 + n * 16)); } }
            }
        }
        asm volatile("s_waitcnt lgkmcnt(0)" ::: "memory"); __builtin_amdgcn_s_barrier(); asm volatile("" ::: "memory");
        if (write_next && threadIdx.x < 256) { const f32x4 p = *(const LAS f32x4*)(xch + threadIdx.x * 4); rowss[(size_t)(u.pm * 256 + threadIdx.x) * 4 + u.pn] = (p.x + p.y) + (p.z + p.w); }
    }
};

__device__ __forceinline__ int pi32(int r) { return (r & ~12) | ((r & 8) >> 1) | ((r & 4) << 1); }
template <int MODE>
__device__ __forceinline__ void attn_tile(const bf16x8 (&kf)[4], const bf16x8 (&vf)[2][2], const bf16x8 (&qf)[4], const f32x16& cv, float& l, f32x16 (&O)[2], int a, int h) {
    f32x16 S = __builtin_amdgcn_mfma_f32_32x32x16_bf16(kf[0], qf[0], cv, 0, 0, 0);
#pragma unroll
    for (int ks = 1; ks < 4; ++ks) S = __builtin_amdgcn_mfma_f32_32x32x16_bf16(kf[ks], qf[ks], S, 0, 0, 0);
    if (MODE != 0) {
#pragma unroll
        for (int i = 0; i < 16; ++i) { const int c = pi32((i & 3) + 8 * (i >> 2) + 4 * h); const bool dead = (MODE == 1) ? (c > a) : (c <= a); if (dead) S[i] = -1e30f; }
    }
    float s0 = 0.f, s1 = 0.f;
#pragma unroll
    for (int i = 0; i < 16; i += 2) { S[i] = __builtin_amdgcn_exp2f(S[i]); S[i + 1] = __builtin_amdgcn_exp2f(S[i + 1]); s0 += S[i]; s1 += S[i + 1]; }
    l += s0 + s1;
    bf16x8 pb[2];
#pragma unroll
    for (int s = 0; s < 2; ++s) { u32x4 w; w.x = pk2(S[8 * s], S[8 * s + 1]); w.y = pk2(S[8 * s + 2], S[8 * s + 3]); w.z = pk2(S[8 * s + 4], S[8 * s + 5]); w.w = pk2(S[8 * s + 6], S[8 * s + 7]); pb[s] = __builtin_bit_cast(bf16x8, w); }
#pragma unroll
    for (int dt = 0; dt < 2; ++dt)
#pragma unroll
        for (int s = 0; s < 2; ++s) O[dt] = __builtin_amdgcn_mfma_f32_32x32x16_bf16(vf[dt][s], pb[s], O[dt], 0, 0, 0);
}
template <int NK>
__device__ __forceinline__ void stage_kv(LAS unsigned char* Kimg, LAS unsigned char* Vimg, const bf16* Ksrc  , const bf16* VTf  ,
                                         long tokbase  , long key_lo  , long key_min  , int wave, int lane) {
    constexpr int KP = NK * 128 / 1024, VCH = NK / 8, VP = 64 * VCH * 16 / 1024;
    for (int p = wave; p < KP; p += 8) { const int L = p * 64 + lane, r = L >> 3, s = L & 7, c = s ^ ((r >> 1) & 7); long kr = key_lo + r; if (kr < key_min) kr = key_min;
        glds16(Ksrc + (kr - key_lo) * 128 + c * 8, Kimg + p * 1024); }
    for (int p = wave; p < VP; p += 8) { const int L = p * 64 + lane, d = L / VCH, s = L % VCH, c = s ^ (d & 15); long kc = key_lo + 8 * c; if (kc < key_min) kc = key_min; const long tok = tokbase + kc;
        glds16(VTf + ((tok >> 8) * 256 + d) * 256 + (tok & 255), Vimg + p * 1024); }
}
template <int NK>
__device__ __forceinline__ void load_kv_frags(bf16x8 (&kf)[4], bf16x8 (&vf)[2][2], const LAS unsigned char* Kimg, const LAS unsigned char* Vimg, int row0  , int lane) {
    const int r = row0 + pi32(lane & 31), h = lane >> 5;
#pragma unroll
    for (int ks = 0; ks < 4; ++ks) kf[ks] = *(const LAS bf16x8*)(Kimg + r * 128 + (((2 * ks + h) ^ ((r >> 1) & 7)) << 4));
#pragma unroll
    for (int dt = 0; dt < 2; ++dt) { const int d = 32 * dt + (lane & 31);
#pragma unroll
        for (int s = 0; s < 2; ++s) { const int c = (row0 >> 3) + 2 * s + h; vf[dt][s] = *(const LAS bf16x8*)(Vimg + d * (NK * 2) + ((c ^ (d & 15)) << 4)); } }
}
template <int NK>
__device__ __forceinline__ void load_k_frags(bf16x8 (&kf)[4], const LAS unsigned char* Kimg, int row0, int lane) {
    const int r = row0 + pi32(lane & 31), h = lane >> 5;
#pragma unroll
    for (int ks = 0; ks < 4; ++ks) kf[ks] = *(const LAS bf16x8*)(Kimg + r * 128 + (((2 * ks + h) ^ ((r >> 1) & 7)) << 4));
}
template <int NK>
__device__ __forceinline__ void load_v_frags(bf16x8 (&vf)[2][2], const LAS unsigned char* Vimg, int row0, int lane) {
    const int h = lane >> 5;
#pragma unroll
    for (int dt = 0; dt < 2; ++dt) { const int d = 32 * dt + (lane & 31);
#pragma unroll
        for (int s = 0; s < 2; ++s) { const int c = (row0 >> 3) + 2 * s + h; vf[dt][s] = *(const LAS bf16x8*)(Vimg + d * (NK * 2) + ((c ^ (d & 15)) << 4)); } }
}
__device__ __forceinline__ f32x16 qk_tile(const bf16x8 (&kf)[4], const bf16x8 (&qf)[4], const f32x16& cv) {
    f32x16 S = __builtin_amdgcn_mfma_f32_32x32x16_bf16(kf[0], qf[0], cv, 0, 0, 0);
#pragma unroll
    for (int ks = 1; ks < 4; ++ks) S = __builtin_amdgcn_mfma_f32_32x32x16_bf16(kf[ks], qf[ks], S, 0, 0, 0);
    return S;
}
template <int MODE>
__device__ __forceinline__ void softmax_pv(f32x16& S, const bf16x8 (&vf)[2][2], float& l, f32x16 (&O)[2], int a, int h) {
    if (MODE != 0) {
#pragma unroll
        for (int i = 0; i < 16; ++i) { const int c = pi32((i & 3) + 8 * (i >> 2) + 4 * h); const bool dead = (MODE == 1) ? (c > a) : (c <= a); if (dead) S[i] = -1e30f; }
    }
    float s0 = 0.f, s1 = 0.f;
#pragma unroll
    for (int i = 0; i < 16; i += 2) { S[i] = __builtin_amdgcn_exp2f(S[i]); S[i + 1] = __builtin_amdgcn_exp2f(S[i + 1]); s0 += S[i]; s1 += S[i + 1]; }
    l += s0 + s1;
    bf16x8 pb[2];
#pragma unroll
    for (int s = 0; s < 2; ++s) { u32x4 w; w.x = pk2(S[8 * s], S[8 * s + 1]); w.y = pk2(S[8 * s + 2], S[8 * s + 3]); w.z = pk2(S[8 * s + 4], S[8 * s + 5]); w.w = pk2(S[8 * s + 6], S[8 * s + 7]); pb[s] = __builtin_bit_cast(bf16x8, w); }
#pragma unroll
    for (int dt = 0; dt < 2; ++dt)
#pragma unroll
        for (int s = 0; s < 2; ++s) O[dt] = __builtin_amdgcn_mfma_f32_32x32x16_bf16(vf[dt][s], pb[s], O[dt], 0, 0, 0);
}
template <int NK, int N, int MFIRST, int MLAST>
__device__ __forceinline__ void attn_run(const LAS unsigned char* Kimg, const LAS unsigned char* Vimg, int row0, const bf16x8 (&qf)[4], const f32x16& cv, float& l, f32x16 (&O)[2], int lane) {
    const int a = lane & 31, h = lane >> 5;
    bf16x8 kf[4], vfa[2][2], vfb[2][2];
    load_k_frags<NK>(kf, Kimg, row0, lane); load_v_frags<NK>(vfa, Vimg, row0, lane);
    f32x16 S = qk_tile(kf, qf, cv);
#pragma unroll
    for (int t = 0; t < N; ++t) {
        f32x16 Sn;
        if (t + 1 < N) { load_k_frags<NK>(kf, Kimg, row0 + 32 * (t + 1), lane); if (t & 1) load_v_frags<NK>(vfa, Vimg, row0 + 32 * (t + 1), lane); else load_v_frags<NK>(vfb, Vimg, row0 + 32 * (t + 1), lane);
            Sn = qk_tile(kf, qf, cv); }
        if (t == 0 && MFIRST != 0) { if (t & 1) softmax_pv<MFIRST>(S, vfb, l, O, a, h); else softmax_pv<MFIRST>(S, vfa, l, O, a, h); }
        else if (t == N - 1 && MLAST != 0) { if (t & 1) softmax_pv<MLAST>(S, vfb, l, O, a, h); else softmax_pv<MLAST>(S, vfa, l, O, a, h); }
        else { if (t & 1) softmax_pv<0>(S, vfb, l, O, a, h); else softmax_pv<0>(S, vfa, l, O, a, h); }
        if (t + 1 < N) S = Sn;
    }
}
template <int NK, int PVAR>
__device__ __forceinline__ void attn_run8(const LAS unsigned char* Kimg, const LAS unsigned char* Vimg, const bf16x8 (&qf)[4], const f32x16& cv, float& l, f32x16 (&O)[2], int lane) {
    const int a = lane & 31, h = lane >> 5;
    bf16x8 kf[4], vfa[2][2], vfb[2][2];
    load_k_frags<NK>(kf, Kimg, 0, lane); load_v_frags<NK>(vfa, Vimg, 0, lane);
    if (PVAR == 4) load_v_frags<NK>(vfb, Vimg, 32, lane);
#define QKT() ((PVAR == 5) ? cv : qk_tile(kf, qf, cv))
#define SMPV(S_, vf_) do { if (PVAR == 3) { bf16x8 pb[2]; _Pragma("unroll") for (int s = 0; s < 2; ++s) { u32x4 w; w.x = pk2(S_[8 * s], S_[8 * s + 1]); w.y = pk2(S_[8 * s + 2], S_[8 * s + 3]); w.z = pk2(S_[8 * s + 4], S_[8 * s + 5]); w.w = pk2(S_[8 * s + 6], S_[8 * s + 7]); pb[s] = __builtin_bit_cast(bf16x8, w); } \
        _Pragma("unroll") for (int dt = 0; dt < 2; ++dt) _Pragma("unroll") for (int s = 0; s < 2; ++s) O[dt] = __builtin_amdgcn_mfma_f32_32x32x16_bf16(vf_[dt][s], pb[s], O[dt], 0, 0, 0); } \
      else if (PVAR == 6) { _Pragma("unroll") for (int i = 0; i < 16; ++i) { l += __builtin_amdgcn_exp2f(S_[i]); } asm volatile("" :: "v"(vf_[0][0]), "v"(vf_[1][1])); } \
      else softmax_pv<0>(S_, vf_, l, O, a, h); } while (0)
    f32x16 S = QKT();
#pragma unroll 1
    for (int j = 0; j < 3; ++j) {
        { if (PVAR != 4) { load_k_frags<NK>(kf, Kimg, 64 * j + 32, lane); load_v_frags<NK>(vfb, Vimg, 64 * j + 32, lane); } f32x16 Sn = QKT(); SMPV(S, vfa); S = Sn; }
        { if (PVAR != 4) { load_k_frags<NK>(kf, Kimg, 64 * j + 64, lane); load_v_frags<NK>(vfa, Vimg, 64 * j + 64, lane); } f32x16 Sn = QKT(); SMPV(S, vfb); S = Sn; }
    }
    { if (PVAR != 4) { load_k_frags<NK>(kf, Kimg, 224, lane); load_v_frags<NK>(vfb, Vimg, 224, lane); } f32x16 Sn = QKT(); SMPV(S, vfa); S = Sn; }
    SMPV(S, vfb);
#undef QKT
#undef SMPV
}
template <int NK>
__device__ __forceinline__ void attn_run_own(const LAS unsigned char* Kimg, const LAS unsigned char* Vimg, int w, const bf16x8 (&qf)[4], const f32x16& cv, float& l, f32x16 (&O)[2], int lane) {
    const int a = lane & 31, h = lane >> 5;
    bf16x8 kf[4], vfa[2][2], vfb[2][2];
    load_k_frags<NK>(kf, Kimg, 0, lane); load_v_frags<NK>(vfa, Vimg, 0, lane);
    f32x16 S = qk_tile(kf, qf, cv);
    int t = 0;
#pragma unroll 1
    for (; t + 2 <= w; t += 2) {
        { load_k_frags<NK>(kf, Kimg, 32 * t + 32, lane); load_v_frags<NK>(vfb, Vimg, 32 * t + 32, lane); f32x16 Sn = qk_tile(kf, qf, cv); softmax_pv<0>(S, vfa, l, O, a, h); S = Sn; }
        { load_k_frags<NK>(kf, Kimg, 32 * t + 64, lane); load_v_frags<NK>(vfa, Vimg, 32 * t + 64, lane); f32x16 Sn = qk_tile(kf, qf, cv); softmax_pv<0>(S, vfb, l, O, a, h); S = Sn; }
    }
    if (t < w) { load_k_frags<NK>(kf, Kimg, 32 * t + 32, lane); load_v_frags<NK>(vfb, Vimg, 32 * t + 32, lane); f32x16 Sn = qk_tile(kf, qf, cv); softmax_pv<0>(S, vfa, l, O, a, h); softmax_pv<1>(Sn, vfb, l, O, a, h); }
    else softmax_pv<1>(S, vfa, l, O, a, h);
}
__device__ __forceinline__ void attn_store(const f32x16 (&O)[2], float l, const bf16* gate  , bf16* y  , int h) {
    u32x2 gv[2][4];
#pragma unroll
    for (int dt = 0; dt < 2; ++dt)
#pragma unroll
        for (int q = 0; q < 4; ++q) gv[dt][q] = *(const u32x2*)(gate + 32 * dt + 8 * q + 4 * h);
    const float inv = 1.f / swap32_sum(l);
#pragma unroll
    for (int dt = 0; dt < 2; ++dt)
#pragma unroll
        for (int q = 0; q < 4; ++q) { const int d = 32 * dt + 8 * q + 4 * h; const u32x2 g2 = gv[dt][q];
            u32x2 w; w.x = pk2(O[dt][4 * q] * inv * bflo(g2.x), O[dt][4 * q + 1] * inv * bfhi(g2.x)); w.y = pk2(O[dt][4 * q + 2] * inv * bflo(g2.y), O[dt][4 * q + 3] * inv * bfhi(g2.y));
            *(u32x2*)(y + d) = w; }
}

template <int VAR>
__device__ __forceinline__ void moba_unit(Frame& F, int b, int kvh, int qb, int g) {
    constexpr int IMG = 32768;
    LAS unsigned char* buf0 = F.lds; LAS unsigned char* buf1 = F.lds + 2 * IMG;
    LAS float* km = (LAS float*)(F.lds + LDS_MISC + 1024);
    const int lane = F.lane, wave = F.wave, a = lane & 31, h = lane >> 5;
    const long tok0 = (long)b * SEQ + 256 * qb;
    const bf16* Kb = ((bf16*)(F.ws + WS_MK)) + (size_t)b * SEQ * 128 + kvh * 64;
    const bf16* Vb = ((bf16*)(F.ws + WS_VT)) + (size_t)(128 + kvh * 64) * 256; const long tokb = (long)b * SEQ;
    unsigned kvoff[4], vvoff[4];
#pragma unroll
    for (int i = 0; i < 4; ++i) { const int L = (wave + 8 * i) * 64 + lane; { const int r = L >> 3, s = L & 7, c = s ^ ((r >> 1) & 7); kvoff[i] = (unsigned)(r * 128 + c * 8) * 2u; }
        { const int d = L >> 5, s = L & 31, c = s ^ (d & 15); vvoff[i] = (unsigned)(d * 256 + 8 * c) * 2u; } }
    const char* Kbytes = (const char*)Kb; const char* Vbytes = (const char*)(Vb + (size_t)(tokb >> 8) * 65536);
#define MOBA_STAGE(dstK, blk) do { _Pragma("unroll") for (int i_ = 0; i_ < 4; ++i_) { glds16(Kbytes + (size_t)(blk) * 65536 + kvoff[i_], (dstK) + (wave + 8 * i_) * 1024); \
        glds16(Vbytes + (size_t)(blk) * 131072 + vvoff[i_], (dstK) + IMG + (wave + 8 * i_) * 1024); } } while (0)
    if (VAR != 1) MOBA_STAGE(buf0, qb);
    { const int n = F.tid >> 6, d = F.tid & 63; float s = 0.f;
      if (n < qb) { const int tile = b * 8 + n; s = ((float*)(F.ws + WS_KPART))[((size_t)(tile * 2 + 0) * 2 + kvh) * 64 + d] + ((float*)(F.ws + WS_KPART))[((size_t)(tile * 2 + 1) * 2 + kvh) * 64 + d]; }
      km[n * 64 + d] = s; }
    const size_t row = (size_t)(tok0 + 32 * wave + a);
    const bf16* qp = ((bf16*)(F.ws + WS_MQ)) + row * 384 + kvh * 192 + 8 * h;
    GLDS_WAIT(); __syncthreads();
    unsigned selmask = (VAR == 8) ? 0x7fu : 0u;
    if (qb > 0 && VAR != 8) {
        float sc[8];
#pragma unroll
        for (int n = 0; n < 8; ++n) sc[n] = 0.f;
#pragma unroll
        for (int ks = 0; ks < 4; ++ks) { const bf16x8 q0 = *(const bf16x8*)(qp + 16 * ks), q1 = *(const bf16x8*)(qp + 64 + 16 * ks), q2 = *(const bf16x8*)(qp + 128 + 16 * ks);
#pragma unroll
            for (int j = 0; j < 8; ++j) { const float qs = bf2f((unsigned short)q0[j]) + bf2f((unsigned short)q1[j]) + bf2f((unsigned short)q2[j]); const int d = 16 * ks + 8 * h + j;
#pragma unroll
                for (int n = 0; n < 7; ++n) sc[n] += qs * km[n * 64 + d]; } }
#pragma unroll
        for (int n = 0; n < 7; ++n) { sc[n] = swap32_sum(sc[n]); if (n >= qb) sc[n] = -INFINITY; }
#pragma unroll
        for (int t = 0; t < 3; ++t) { float best = -INFINITY; int bi = -1;
#pragma unroll
            for (int n = 0; n < 7; ++n) if (sc[n] > best) { best = sc[n]; bi = n; }
            if (bi >= 0) { selmask |= 1u << bi;
#pragma unroll
                for (int n = 0; n < 7; ++n) if (n == bi) sc[n] = -INFINITY; } }
    }
    float l = 0.f; f32x16 O[2]; bf16x8 qf[4];
#pragma unroll
    for (int i = 0; i < 16; ++i) { O[0][i] = 0.f; O[1][i] = 0.f; }
#pragma unroll
    for (int ks = 0; ks < 4; ++ks) qf[ks] = *(const bf16x8*)(qp + g * 64 + 16 * ks);
    asm volatile("" : "+v"(qf[0]), "+v"(qf[1]), "+v"(qf[2]), "+v"(qf[3]));
#pragma unroll 1
    for (int s = 0; s <= qb; ++s) {
        LAS unsigned char* cur = (s & 1) ? buf1 : buf0; LAS unsigned char* nxt = (s & 1) ? buf0 : buf1;
        if (s < qb && VAR != 1) MOBA_STAGE(nxt, s);
        if (VAR == 2) {} else if (s == 0) { if (VAR != 7) {
            f32x16 cv;
#pragma unroll
            for (int i = 0; i < 16; ++i) cv[i] = 0.f;
            attn_run_own<256>(cur, cur + IMG, wave, qf, cv, l, O, lane);
        } } else if (VAR != 9) {
            const float cinit = ((selmask >> (s - 1)) & 1u) ? 0.f : -1e30f;
            if (__any(cinit == 0.f)) {
                f32x16 cv;
#pragma unroll
                for (int i = 0; i < 16; ++i) cv[i] = cinit;
                attn_run8<256, (VAR >= 3 ? VAR : 0)>(cur, cur + IMG, qf, cv, l, O, lane);
            }
        }
        GLDS_WAIT(); __syncthreads();
    }
    attn_store(O, l, ((bf16*)(F.ws + WS_MG)) + row * 384 + (kvh * 3 + g) * 64, ((bf16*)(F.ws + (VAR ? WS_END : WS_Y))) + row * DM + 640 + (kvh * 3 + g) * 64, h);
#undef MOBA_STAGE
}

__device__ __forceinline__ void swa_unit(const Params& P, Frame& F, int layer, int b, int kvh, int qblk) {
    constexpr int NK = 384;
    LAS unsigned char* Kimg = F.lds; LAS unsigned char* Vimg = F.lds + NK * 128;
    const int lane = F.lane, wave = F.wave, a = lane & 31, h = lane >> 5;
    const int q0 = 256 * qblk; const long tok0 = (long)b * SEQ + q0;
    const bf16* Kb = ((bf16*)(F.ws + WS_AK)) + ((long)b * SEQ + q0 - 128) * 128 + kvh * 64;
    const bf16* Vb = ((bf16*)(F.ws + WS_VT)) + (size_t)(kvh * 64) * 256;
    stage_kv<NK>(Kimg, Vimg, Kb, Vb, (long)b * SEQ, (long)q0 - 128, 0, wave, lane);
    const size_t row = (size_t)(tok0 + 32 * wave + a);
    const bf16* qp = ((bf16*)(F.ws + WS_AQ)) + row * 384 + kvh * 192 + 8 * h;
    f32x16 cv;
#pragma unroll
    for (int i = 0; i < 16; ++i) cv[i] = 0.f;
    const bool head = (q0 - 128 + 32 * wave) >= 0;
    GLDS_WAIT(); __syncthreads();
#pragma unroll 1
    for (int g = 0; g < 3; ++g) {
        bf16x8 qf[4];
#pragma unroll
        for (int ks = 0; ks < 4; ++ks) qf[ks] = *(const bf16x8*)(qp + g * 64 + 16 * ks);
        float l = 0.5f * __builtin_amdgcn_exp2f(kin(15)[layer * 6 + kvh * 3 + g] * LOG2E);
        f32x16 O[2];
#pragma unroll
        for (int i = 0; i < 16; ++i) { O[0][i] = 0.f; O[1][i] = 0.f; }
        const int r0 = 32 * wave;
        if (head) attn_run<NK, 5, 2, 1>(Kimg, Vimg, r0, qf, cv, l, O, lane);
        else {
#pragma unroll 1
            for (int kt = 4 - wave; kt < 4; ++kt) { bf16x8 kfa[4], vfa[2][2]; load_kv_frags<NK>(kfa, vfa, Kimg, Vimg, r0 + 32 * kt, lane); attn_tile<0>(kfa, vfa, qf, cv, l, O, a, h); }
            { bf16x8 kfa[4], vfa[2][2]; load_kv_frags<NK>(kfa, vfa, Kimg, Vimg, r0 + 128, lane); attn_tile<1>(kfa, vfa, qf, cv, l, O, a, h); }
        }
        attn_store(O, l, ((bf16*)(F.ws + WS_AG)) + row * 384 + (kvh * 3 + g) * 64, ((bf16*)(F.ws + WS_Y)) + row * DM + 256 + (kvh * 3 + g) * 64, h);
    }
    __syncthreads();
}

__device__ __forceinline__ void ssm_unit(Frame& F, int layer, int b, int g) {
    constexpr int APITCH = 528;
    LAS unsigned char* AU = F.lds;
    LAS unsigned char* SC = F.lds + 128 * APITCH;
    LAS float* seg = (LAS float*)(F.lds + 2 * 128 * APITCH);
    const int lane = F.lane, wave = F.wave, tid = F.tid, fr = lane & 15, fq = lane >> 4;
    const int pair = layer * 16 + g;
    const bf16* TE = ((bf16*)(F.ws + WS_TE)) + (size_t)pair * TE_ELEMS; const bf16* GM = ((bf16*)(F.ws + WS_G)) + (size_t)pair * G_ELEMS;
    u32x4 uv[8];
    { const bf16* up = ((bf16*)(F.ws + WS_U)) + (size_t)(b * 16 + g) * SEQ * 16;
#pragma unroll
      for (int i = 0; i < 8; ++i) { const int idx = tid + 512 * i; uv[i] = *(const u32x4*)(up + (size_t)idx * 8); } }
    bf16x8 gf[8];
#pragma unroll
    for (int ks = 0; ks < 8; ++ks) gf[ks] = *(const bf16x8*)(GM + (size_t)(16 * wave + fr) * 256 + 32 * ks + 8 * fq);
    const float ar = ((float*)(F.ws + WS_AT))[(size_t)pair * 128 + 2 * lane], ai = ((float*)(F.ws + WS_AT))[(size_t)pair * 128 + 2 * lane + 1];
    bf16x8 tfu[2][8], tfc[2][4];
#pragma unroll
    for (int half = 0; half < 2; ++half) { const int i = half ? 15 - wave : wave, nks = (i >> 1) + 1; const bf16* tp = TE + (size_t)(16 * i + fr) * 384 + 8 * fq;
#pragma unroll
        for (int ks = 0; ks < 8; ++ks) tfu[half][ks] = *(const bf16x8*)(tp + 32 * (ks < nks ? ks : 0));
#pragma unroll
        for (int ks = 0; ks < 4; ++ks) tfc[half][ks] = *(const bf16x8*)(tp + 256 + 32 * ks); }
#pragma unroll
    for (int i = 0; i < 8; ++i) { const int idx = tid + 512 * i, t = idx >> 1, hf = idx & 1; *(LAS u32x4*)(AU + (t >> 4) * APITCH + ((t & 15) * 16 + 8 * hf) * 2) = uv[i]; }
    __syncthreads();
    {
#pragma unroll
        for (int rt = 0; rt < 8; ++rt) { f32x4 acc = {0.f, 0.f, 0.f, 0.f};
#pragma unroll
            for (int ks = 0; ks < 8; ++ks) { const bf16x8 af = *(const LAS bf16x8*)(AU + (16 * rt + fr) * APITCH + (32 * ks + 8 * fq) * 2); acc = __builtin_amdgcn_mfma_f32_16x16x32_bf16(gf[ks], af, acc, 0, 0, 0); }
            *(LAS f32x4*)(SC + (16 * rt + fr) * APITCH + (16 * wave + 4 * fq) * 4) = acc; }
    }
    __syncthreads();
    {
        float lr = 0.f, li = 0.f, locr[16], loci[16];
#pragma unroll
        for (int k = 0; k < 16; ++k) { locr[k] = lr; loci[k] = li; const f32x2_t s = *(const LAS f32x2_t*)(SC + (16 * wave + k) * APITCH + lane * 8);
            const float nr = ar * lr - ai * li + s.x, ni = ar * li + ai * lr + s.y; lr = nr; li = ni; }
        seg[(wave * 64 + lane) * 2] = lr; seg[(wave * 64 + lane) * 2 + 1] = li;
        __syncthreads();
        float a16r = ar, a16i = ai;
#pragma unroll
        for (int q = 0; q < 4; ++q) { const float tr = a16r * a16r - a16i * a16i, ti = 2.f * a16r * a16i; a16r = tr; a16i = ti; }
        float ir = 0.f, ii = 0.f;
        for (int w2 = 0; w2 < wave; ++w2) { const float sr = seg[(w2 * 64 + lane) * 2], si = seg[(w2 * 64 + lane) * 2 + 1]; const float nr = a16r * ir - a16i * ii + sr, ni = a16r * ii + a16i * ir + si; ir = nr; ii = ni; }
        float pr = 1.f, pi = 0.f;
#pragma unroll
        for (int k = 0; k < 16; ++k) { const float cr = locr[k] + pr * ir - pi * ii, ci = loci[k] + pr * ii + pi * ir;
            *(LAS unsigned*)(SC + (16 * wave + k) * APITCH + lane * 4) = pk2(cr, ci);
            const float tr = pr * ar - pi * ai, ti = pr * ai + pi * ar; pr = tr; pi = ti; }
    }
    __syncthreads();
#pragma unroll
    for (int half = 0; half < 2; ++half) {
        const int i = half ? 15 - wave : wave;
        f32x4 acc[8];
#pragma unroll
        for (int rt = 0; rt < 8; ++rt) acc[rt] = (f32x4){0.f, 0.f, 0.f, 0.f};
        const int nks = (i >> 1) + 1;
#pragma unroll
        for (int ks = 0; ks < 8; ++ks) { if (ks < nks) {
#pragma unroll
            for (int rt = 0; rt < 8; ++rt) { const bf16x8 af = *(const LAS bf16x8*)(AU + (16 * rt + fr) * APITCH + (32 * ks + 8 * fq) * 2); acc[rt] = __builtin_amdgcn_mfma_f32_16x16x32_bf16(tfu[half][ks], af, acc[rt], 0, 0, 0); } } }
#pragma unroll
        for (int ks = 0; ks < 4; ++ks) {
#pragma unroll
            for (int rt = 0; rt < 8; ++rt) { const bf16x8 af = *(const LAS bf16x8*)(SC + (16 * rt + fr) * APITCH + (32 * ks + 8 * fq) * 2); acc[rt] = __builtin_amdgcn_mfma_f32_16x16x32_bf16(tfc[half][ks], af, acc[rt], 0, 0, 0); } }
#pragma unroll
        for (int rt = 0; rt < 8; ++rt) { const int chunk = 16 * rt + fr; u32x2 w; w.x = pk2(gelu_tanh_f(acc[rt][0]), gelu_tanh_f(acc[rt][1])); w.y = pk2(gelu_tanh_f(acc[rt][2]), gelu_tanh_f(acc[rt][3]));
            __hip_atomic_store((unsigned long long*)(((bf16*)(F.ws + WS_YPRE)) + ((size_t)(b * 16 + g) * SEQ + 16 * chunk + i) * 16 + 4 * fq), ((unsigned long long)w.y << 32) | w.x, __ATOMIC_RELAXED, __HIP_MEMORY_SCOPE_AGENT); }
    }
    asm volatile("s_waitcnt vmcnt(0)" ::: "memory");
    __syncthreads();
    if (tid == 0) __hip_atomic_fetch_add(F.ctl + CW_SSMDONE + 64 * (layer * NB + b), 1u, __ATOMIC_RELAXED, __HIP_MEMORY_SCOPE_AGENT);
}

__device__ __forceinline__ void glu_unit(const Params& P, Frame& F, int layer, int b, int j) {
    constexpr int APITCH = 528;
    LAS unsigned char* AT_ = F.lds;
    const int lane = F.lane, wave = F.wave, tid = F.tid, fr = lane & 15, fq = lane >> 4;
    const size_t tok0 = (size_t)b * SEQ + 128 * j;
    const bf16* wp = ((bf16*)(F.ws + WS_GLU)) + (size_t)layer * 65536 + (size_t)(32 * wave + fr) * 256 + 8 * fq;
    bf16x8 wf[8][2];
#pragma unroll
    for (int ks = 0; ks < 8; ++ks) { wf[ks][0] = *(const bf16x8*)(wp + 32 * ks); wf[ks][1] = *(const bf16x8*)(wp + 16 * 256 + 32 * ks); }
    if (tid == 0) { unsigned* c = F.ctl + CW_SSMDONE + 64 * (layer * NB + b); unsigned sp = 0;
        while (__hip_atomic_load(c, __ATOMIC_RELAXED, __HIP_MEMORY_SCOPE_AGENT) < 16u) { __builtin_amdgcn_s_sleep(2); if (++sp > (1u << 22)) break; }
        __builtin_amdgcn_fence(__ATOMIC_ACQUIRE, "agent"); asm volatile("s_waitcnt vmcnt(0)" ::: "memory"); }
    __syncthreads();
    { const bf16* yp = ((bf16*)(F.ws + WS_YPRE)) + ((size_t)b * 16 * SEQ + 128 * j) * 16;
#pragma unroll
      for (int i = 0; i < 8; ++i) { const int idx = tid + 512 * i, c = idx >> 7, t = idx & 127; const u32x4 v = *(const u32x4*)(yp + ((size_t)(c >> 1) * SEQ + t) * 16 + 8 * (c & 1)); *(LAS u32x4*)(AT_ + t * APITCH + c * 16) = v; } }
    f32x4 acc[8][2];
#pragma unroll
    for (int rt = 0; rt < 8; ++rt) { acc[rt][0] = (f32x4){0.f, 0.f, 0.f, 0.f}; acc[rt][1] = (f32x4){0.f, 0.f, 0.f, 0.f}; }
    __syncthreads();
#pragma unroll
    for (int ks = 0; ks < 8; ++ks)
#pragma unroll
        for (int rt = 0; rt < 8; ++rt) { const bf16x8 af = *(const LAS bf16x8*)(AT_ + (16 * rt + fr) * APITCH + (32 * ks + 8 * fq) * 2);
            acc[rt][0] = __builtin_amdgcn_mfma_f32_16x16x32_bf16(wf[ks][0], af, acc[rt][0], 0, 0, 0); acc[rt][1] = __builtin_amdgcn_mfma_f32_16x16x32_bf16(wf[ks][1], af, acc[rt][1], 0, 0, 0); }
    const float* gb = kin(12) + layer * 256;
#pragma unroll
    for (int nt = 0; nt < 2; ++nt) { const int n0 = 32 * wave + 16 * nt + 4 * fq; const f32x4 bv = *(const f32x4*)(gb + n0);
#pragma unroll
        for (int rt = 0; rt < 8; ++rt) { const int t = 16 * rt + fr; const u32x2 yp = *(const LAS u32x2*)(AT_ + t * APITCH + n0 * 2); const u32x2 sg = *(const u32x2*)(((bf16*)(F.ws + WS_SG)) + (tok0 + t) * 256 + n0);
            const f32x4 z = acc[rt][nt] + bv; u32x2 w;
            w.x = pk2(bflo(yp.x) * sigmoid_f(z[0]) * bflo(sg.x), bfhi(yp.x) * sigmoid_f(z[1]) * bfhi(sg.x));
            w.y = pk2(bflo(yp.y) * sigmoid_f(z[2]) * bflo(sg.y), bfhi(yp.y) * sigmoid_f(z[3]) * bfhi(sg.y));
            *(u32x2*)(((bf16*)(F.ws + WS_Y)) + (tok0 + t) * DM + n0) = w; } }
    __syncthreads();
}

__device__ __forceinline__ void mixer_phase(const Params& P, Frame& F, int qslot, int layer, int mask) {
    volatile LAS int* qw = (volatile LAS int*)(F.lds + LDS_CTL);
    unsigned* head = F.ctl + CW_QUEUE + 64 * qslot;
    for (;;) {
        if (F.tid == 0) qw[0] = (int)atomicAdd(head, 1u);
        __syncthreads();
        const int it = qw[0];
        __syncthreads();
        if (it >= 1536) break;
        Frame Fu = phase_frame(F);
#ifndef NO_MOBA
        if (it < 768 && (mask & 1)) { const int qb = 7 - it / 96, r = it % 96, b = r / 6, kvh = (r % 6) / 3, g = r % 3;
            if (mask & 8) moba_unit<1>(Fu, b, kvh, qb, g); else if (mask & 16) moba_unit<2>(Fu, b, kvh, qb, g);
#ifdef MOBA_PVAR
            else if (mask & 64) moba_unit<MOBA_PVAR>(Fu, b, kvh, qb, g);
#endif
            else moba_unit<0>(Fu, b, kvh, qb, g); }
#endif
#ifndef NO_SSM
        if (it >= 768 && it < 1024 && (mask & 2)) { const int r = it - 768; ssm_unit(Fu, layer, r >> 4, r & 15); }
#endif
#ifndef NO_SWA
        if (it >= 1024 && it < 1280 && (mask & 4)) { const int r = it - 1024; swa_unit(P, Fu, layer, r >> 4, (r >> 3) & 1, r & 7); }
#endif
        if (it >= 1280 && (mask & 32)) { const int r = it - 1280; glu_unit(P, Fu, layer, r >> 4, r & 15); }
    }
}

#define XB_TMO      128
#define XB_XCNT(j)  (256  + 64 * (j))
#define XB_XSUB(j)  (1280 + 64 * (j))
#define XB_XGEN(j)  (2304 + 64 * (j))
#define XB_TOP      3328
#define XB_TOPGEN   3392
#define XCD_BAR_WORDS 3456
#define XB_SPIN_CAP (1u << 18)

__device__ __forceinline__ unsigned xb_ld(unsigned* p)              { return __hip_atomic_load(p, __ATOMIC_RELAXED, __HIP_MEMORY_SCOPE_AGENT); }
__device__ __forceinline__ unsigned xb_add(unsigned* p, unsigned v) { return __hip_atomic_fetch_add(p, v, __ATOMIC_RELAXED, __HIP_MEMORY_SCOPE_AGENT); }
__device__ __forceinline__ unsigned xb_xcc_id() { return (unsigned)__builtin_amdgcn_s_getreg((3 << 11) | 20) & 0xFu; }
#define XB_SPIN(cond, bar) do { unsigned _sp = 0; while (cond) { __builtin_amdgcn_s_sleep(1); \
    if ((++_sp & 255u) == 0u) { if (xb_ld(&(bar)[XB_TMO])) break; if (_sp > XB_SPIN_CAP) { atomicAdd(&(bar)[XB_TMO], 1u); break; } } } } while (0)

struct XcdBarrier {
    unsigned* bar; unsigned x;
    volatile LAS unsigned* st;
};

__device__ __forceinline__ XcdBarrier xcd_barrier_post(unsigned* bar, volatile LAS unsigned* st) {
    XcdBarrier b; b.bar = bar; b.x = xb_xcc_id(); b.st = st;
    if (threadIdx.x == 0) (void)xb_add(&bar[XB_XCNT(b.x)], 1u);
    return b;
}
__device__ __forceinline__ void xcd_barrier_complete(unsigned* bar, unsigned x, unsigned& nloc, unsigned& nx) {
    const unsigned G = gridDim.x * gridDim.y * gridDim.z;
    unsigned sum, cnt, mine, sp = 0u;
    for (;;) {
        sum = 0u; cnt = 0u; mine = 0u;
#pragma unroll 1
        for (unsigned j = 0; j < 16; ++j) { const unsigned c = xb_ld(&bar[XB_XCNT(j)]); sum += c; cnt += (c > 0u) ? 1u : 0u; mine = (j == x) ? c : mine; }
        if (sum == G) break;
        __builtin_amdgcn_s_sleep(1);
        if ((++sp & 255u) == 0u) { if (xb_ld(&bar[XB_TMO])) break; if (sp > XB_SPIN_CAP) { atomicAdd(&bar[XB_TMO], 1u); break; } }
    }
    nloc = mine > 0u ? mine : 1u; nx = cnt > 0u ? cnt : 1u;
}

__device__ __forceinline__ void xcd_barrier(const XcdBarrier& b) {
    asm volatile("s_waitcnt vmcnt(0)" ::: "memory");
    __syncthreads();
    if (threadIdx.x == 0) {
        unsigned* bar = b.bar;
        __builtin_amdgcn_s_waitcnt(0);
        unsigned nloc = b.st[0], nx = b.st[1];
        if (nloc == 0u) { xcd_barrier_complete(bar, b.x, nloc, nx); b.st[0] = nloc; b.st[1] = nx; }
        const unsigned old = xb_add(&bar[XB_XSUB(b.x)], 1u);
        const unsigned gen = old / nloc;
        if (old + 1u == (gen + 1u) * nloc) {
            __builtin_amdgcn_fence(__ATOMIC_RELEASE, "agent");
            asm volatile("s_waitcnt vmcnt(0)" ::: "memory");
            const unsigned og = xb_add(&bar[XB_TOP], 1u);
            const unsigned tg = og / nx;
            if (og + 1u == (tg + 1u) * nx) xb_add(&bar[XB_TOPGEN], 1u);
            else XB_SPIN(xb_ld(&bar[XB_TOPGEN]) == tg, bar);
            __builtin_amdgcn_fence(__ATOMIC_ACQUIRE, "agent");
            xb_add(&bar[XB_XGEN(b.x)], 1u);
            asm volatile("s_waitcnt vmcnt(0)" ::: "memory");
        } else {
            XB_SPIN(xb_ld(&bar[XB_XGEN(b.x)]) == gen, bar);
            __builtin_amdgcn_fence(__ATOMIC_ACQUIRE, "agent");
            asm volatile("s_waitcnt vmcnt(0)" ::: "memory");
        }
    }
    __syncthreads();
}

constexpr int CW_BAR = 4096;
#ifndef USE_COOP_LAUNCH
#define USE_COOP_LAUNCH 0
#endif
#ifndef REP_P0
#define REP_P0 1
#endif
#ifndef REP_P1
#define REP_P1 1
#endif
#ifndef REP_MIX
#define REP_MIX 1
#endif
#ifndef REP_GLU
#define REP_GLU 1
#endif
#ifndef REP_P3L0
#define REP_P3L0 1
#endif
#ifndef REP_SYNC
#define REP_SYNC 1
#endif
#ifndef P3_PROBE_SKIP
#define P3_PROBE_SKIP 0
#endif
#ifndef MIX_EXTRA_MASK
#define MIX_EXTRA_MASK 39
#endif
#ifndef USE_CG_SYNC
#define USE_CG_SYNC 0
#endif
#define GRID_SYNC() do { for (int r_ = 0; r_ < REP_SYNC; ++r_) { if (USE_CG_SYNC) cg::this_grid().sync(); else xcd_barrier(xbar); } STAMP(); } while (0)
#ifdef PROBE_TS_A
#define STAMP() do { if (n_stamp == PROBE_TS_A) ts_a = __builtin_amdgcn_s_memrealtime(); if (n_stamp == PROBE_TS_B) ts_b = __builtin_amdgcn_s_memrealtime(); ++n_stamp; } while (0)
#else
#define STAMP() do {} while (0)
#endif
__global__ void __launch_bounds__(512, 2) mk_fwd(Params P) {
    extern __shared__ __attribute__((aligned(16))) unsigned char lds_raw[];
    Frame F;
    F.lds = (LAS unsigned char*)lds_raw; F.tid = threadIdx.x; F.lane = F.tid & 63; F.wave = __builtin_amdgcn_readfirstlane(F.tid >> 6); F.G = gridDim.x; F.bid = blockIdx.x;
    F.out = (float*)kin(19); F.ws = (unsigned char*)kin(20); F.ctl = (unsigned*)(F.ws + WS_CTL);
    if (F.tid < 128) ((LAS unsigned*)(F.lds + LDS_CTL))[F.tid] = 0u;
    __syncthreads();
    const XcdBarrier xbar = xcd_barrier_post(F.ctl + CW_BAR, (volatile LAS unsigned*)(F.lds + LDS_CTL + 16));

    int n_stamp = 0; unsigned long long ts_a = 0, ts_b = 0; (void)n_stamp; (void)ts_a; (void)ts_b;
    STAMP();
#ifndef NO_P0
    for (int rep = 0; rep < REP_P0; ++rep) { Frame Fp = phase_frame(F); p0_prologue(P, Fp); }
#endif
    GRID_SYNC();
#pragma unroll 1
    for (int layer = 0; layer < DEPTH; ++layer) {
#ifndef NO_P1
        for (int rep = 0; rep < REP_P1; ++rep) {
            Frame Fp = phase_frame(F);
            pg8::Gemm g{((bf16*)(Fp.ws + WS_Z)), ((bf16*)(Fp.ws + WS_Z)), ZROWS, ZROWS, DM}; const SchedTab S = make_sched<0>(Fp, NTT + 10 * layer);
            EpiProj E{NTT + 10 * layer, layer, Fp.ws};
            pg8::gemm_phase<EpiProj, SchedTab, true, true>(F.lds, g, S, E);
        }
#endif
        GRID_SYNC();
#ifndef NO_MIX
        for (int rep = 0; rep < REP_MIX; ++rep) { Frame Fp = phase_frame(F); mixer_phase(P, Fp, layer + 2 * rep, layer, rep ? MIX_EXTRA_MASK : 39); }
#endif
        GRID_SYNC();
#ifndef NO_P3
        {
            Frame Fp = phase_frame(F);
            pg8::Gemm g{((bf16*)(Fp.ws + WS_Y)), ((bf16*)(Fp.ws + WS_WOUT)) + (size_t)layer * DM * DM, MTOK, DM, DM}; const SchedTab S = make_sched<1>(Fp, 0);
            EpiOut E{kin(0), F.out, ((bf16*)(Fp.ws + WS_Z)), ((float*)(Fp.ws + WS_ROWSS)), layer + 1 < DEPTH ? 1 : 0, (LAS float*)(F.lds + LDS_MISC + 4096), 0};
            pg8::gemm_phase<EpiOut, SchedTab, true, true>(F.lds, g, S, E);
        }
#endif
        if (layer + 1 < DEPTH) GRID_SYNC();
    }
#ifdef PROBE_TS_A
    GRID_SYNC();
    if (blockIdx.x == 0) { const unsigned long long n = (ts_b - ts_a) * PROBE_TS_MULT / PROBE_TS_DIV; for (unsigned long long i = threadIdx.x; i < n; i += 512) F.out[i] += 0.08f; }
#endif
}

extern "C" void kernel_launch(void* const* d_in, const int* in_sizes, int n_in, void* d_out, int out_size, void* d_ws, size_t ws_size, hipStream_t stream) {
    static int grid = 0;
    if (grid == 0) {
        if (n_in != 19 || out_size != MTOK * DM || ws_size < WS_END) { fprintf(stderr, "kernel_launch: unexpected problem (n_in %d out %d ws %zu)\n", n_in, out_size, ws_size); grid = -1; return; }
        int dev = 0, cus = 0, per_cu = 0;
        (void)hipGetDevice(&dev);
        (void)hipDeviceGetAttribute(&cus, hipDeviceAttributeMultiprocessorCount, dev);
        (void)hipFuncSetAttribute((const void*)mk_fwd, hipFuncAttributeMaxDynamicSharedMemorySize, LDS_BYTES);
        (void)hipOccupancyMaxActiveBlocksPerMultiprocessor(&per_cu, (const void*)mk_fwd, 512, LDS_BYTES);
        if (per_cu < 1) { fprintf(stderr, "kernel_launch: occupancy query says %d blocks per CU\n", per_cu); per_cu = 1; }
        grid = cus;
    }
    if (grid < 0) return;
    (void)hipMemsetAsync((char*)d_ws + WS_CTL, 0, CTL_BYTES, stream);
    Params p{};
    for (int i = 0; i < 19; ++i) p.in[i] = (const float*)d_in[i];
    p.out = (float*)d_out; p.ws = (unsigned char*)d_ws;
#if USE_COOP_LAUNCH
    void* args[] = {&p};
    hipError_t e = hipLaunchCooperativeKernel((const void*)mk_fwd, dim3(grid), dim3(512), args, LDS_BYTES, stream);
    if (e != hipSuccess) fprintf(stderr, "cooperative launch failed: %s (grid %d)\n", hipGetErrorString(e), grid);
#else
    hipLaunchKernelGGL(mk_fwd, dim3(grid), dim3(512), LDS_BYTES, stream, p);
    const hipError_t e = hipPeekAtLastError();
    if (e != hipSuccess) fprintf(stderr, "launch failed: %s (grid %d)\n", hipGetErrorString(e), grid);
#endif
}
```

```cpp
#include <hip/hip_runtime.h>
#include <hip/hip_cooperative_groups.h>
#include <cstdio>
#include <cstdint>
namespace cg = cooperative_groups;
namespace pg8 {
#define PG8_LAS __attribute__((address_space(3)))
typedef unsigned short bf16_t;
typedef short bf16x8 __attribute__((ext_vector_type(8)));
typedef float f32x4 __attribute__((ext_vector_type(4)));
typedef unsigned u32x4 __attribute__((ext_vector_type(4)));
constexpr int BM = 256, BK = 64, HALF = 128, HTB = HALF * BK * 2  , STAGE_BYTES = 8 * HTB, NXCD = 8, WGM = 8;

__host__ __device__ __forceinline__ int lds_byte(int r, int c) { const int st = (r >> 4) * 2 + (c >> 5), rr = r & 15, cc = c & 31, ob = rr * 64 + cc * 2; return st * 1024 + (ob ^ (((ob >> 9) & 1) << 5)); }
__host__ __device__ __forceinline__ void stage_rc(int b, int& R, int& C) { const int st = b / 1024, sb = b % 1024, swz = sb ^ (((sb >> 9) & 1) << 5); R = (st >> 1) * 16 + swz / 64; C = (st & 1) * 32 + (swz % 64) / 2; }
__host__ __device__ __forceinline__ int perm32(int rho) { const int n = rho >> 4, i = rho & 15; return 8 * (i >> 2) + 4 * n + (i & 3); }

struct Unit { int pm, pn; };
struct Gemm { const bf16_t* A; const bf16_t* Bt; int M, N, K; };

__device__ __forceinline__ unsigned cvt_pk_bf16(float lo, float hi) { unsigned r; asm volatile("v_cvt_pk_bf16_f32 %0, %1, %2" : "=v"(r) : "v"(lo), "v"(hi)); return r; }
typedef float f32x2 __attribute__((ext_vector_type(2)));
template <class Epi, class Sched, bool ALIGN_EPI = false, bool SP2 = false>
__device__ __forceinline__ void gemm_phase(PG8_LAS unsigned char* lds, const Gemm g, const Sched& S, const Epi& E) {
    int tid_ = threadIdx.x; asm volatile("" : "+v"(tid_));
    const int tid = tid_, wid = __builtin_amdgcn_readfirstlane(tid >> 6), lane = tid & 63, wr = wid >> 2, wc = wid & 3, fr = lane & 15, fq = lane >> 4;
    const int K = g.K, nt = K / BK;
    unsigned voffA[2], voffB[2];
#pragma unroll
    for (int i = 0; i < 2; ++i) { int R, C; stage_rc(tid * 16 + i * 8192, R, C); const int Rb = Epi::PERM ? ((R & ~31) + perm32(R & 31)) : R;
        voffA[i] = (unsigned)(R * K + C) * 2u; voffB[i] = (unsigned)(Rb * K + C) * 2u; }
    const size_t kstep = (size_t)(BK * 2);
    const size_t hstep = (size_t)HALF * K * 2;
    const size_t tstep = 2 * hstep;
    const unsigned ldsw = (unsigned)wid * 1024u;
    const int aoff = lds_byte(wr * 64 + fr, fq * 8), boff = lds_byte(wc * 32 + fr, fq * 8);
#define PG8_SA(b, h) (((b) * 2 + (h)) * HTB)
#define PG8_SB(b, h) ((4 + (b) * 2 + (h)) * HTB)
#define PG8_STAGE(bufoff, gbase, voff) do { _Pragma("unroll") for (int _i = 0; _i < 2; ++_i) \
        __builtin_amdgcn_global_load_lds((const unsigned*)((const char*)(gbase) + (voff)[_i]), (PG8_LAS unsigned*)(lds + (bufoff) + ldsw + _i * 8192), 16, 0, 0); } while (0)
#define PG8_LDA(dst, b, h) do { _Pragma("unroll") for (int m = 0; m < 4; ++m) _Pragma("unroll") for (int k = 0; k < 2; ++k) dst[m][k] = *(const PG8_LAS bf16x8*)(lds + PG8_SA(b, h) + aoff + m * 2048 + k * 1024); } while (0)
#define PG8_LDB(dst, b, h) do { _Pragma("unroll") for (int n = 0; n < 2; ++n) _Pragma("unroll") for (int k = 0; k < 2; ++k) dst[n][k] = *(const PG8_LAS bf16x8*)(lds + PG8_SB(b, h) + boff + n * 2048 + k * 1024); } while (0)
#define PG8_MMA(ai, bj, At, Bt) do { __builtin_amdgcn_s_setprio(1); _Pragma("unroll") for (int m = 0; m < 4; ++m) _Pragma("unroll") for (int n = 0; n < 2; ++n) _Pragma("unroll") for (int k = 0; k < 2; ++k) \
        acc[ai][bj][m][n] = __builtin_amdgcn_mfma_f32_16x16x32_bf16(Bt[n][k], At[m][k], acc[ai][bj][m][n], 0, 0, 0); __builtin_amdgcn_s_setprio(0); } while (0)
#define PG8_WAIT_V(n) asm volatile("s_waitcnt vmcnt(" #n ")" ::: "memory")
#define PG8_WAIT_L(n) asm volatile("s_waitcnt lgkmcnt(" #n ")" ::: "memory")
#define PG8_BAR __builtin_amdgcn_s_barrier()
#define PG8_SCHED __builtin_amdgcn_sched_barrier(0)
    Unit cur, nxt; int ui = 0;
    if (!S.next(0, cur)) return;
    f32x4 acc[2][2][4][2];
#pragma unroll
    for (int a = 0; a < 2; ++a)
#pragma unroll
        for (int b = 0; b < 2; ++b)
#pragma unroll
            for (int m = 0; m < 4; ++m)
#pragma unroll
                for (int n = 0; n < 2; ++n) acc[a][b][m][n] = (f32x4){0.f, 0.f, 0.f, 0.f};
    bf16x8 At[4][2], B0[2][2], B1[2][2];
    const char* cA = (const char*)g.A + (size_t)cur.pm * tstep; const char* cB = (const char*)g.Bt + (size_t)cur.pn * tstep;
    S.a_ready(cur);
    if constexpr (SP2) {
        PG8_STAGE(PG8_SB(0, 0), cB, voffB); PG8_STAGE(PG8_SB(0, 1), cB + hstep, voffB); PG8_STAGE(PG8_SA(0, 0), cA, voffA); PG8_STAGE(PG8_SA(0, 1), cA + hstep, voffA);
        if (wr == 1) PG8_BAR;
        PG8_WAIT_V(2); PG8_BAR;
        PG8_STAGE(PG8_SB(1, 0), cB + kstep, voffB); PG8_STAGE(PG8_SA(1, 0), cA + kstep, voffA); PG8_STAGE(PG8_SB(1, 1), cB + hstep + kstep, voffB);
        PG8_WAIT_V(6); PG8_BAR;
    } else {
        PG8_STAGE(PG8_SB(0, 0), cB, voffB); PG8_STAGE(PG8_SA(0, 0), cA, voffA); PG8_STAGE(PG8_SB(0, 1), cB + hstep, voffB); PG8_STAGE(PG8_SA(0, 1), cA + hstep, voffA);
        if (wr == 1) PG8_BAR;
        PG8_WAIT_V(4); PG8_BAR;
        PG8_STAGE(PG8_SB(1, 0), cB + kstep, voffB); PG8_STAGE(PG8_SA(1, 0), cA + kstep, voffA); PG8_STAGE(PG8_SB(1, 1), cB + hstep + kstep, voffB);
        PG8_WAIT_V(6); PG8_BAR;
    }
    for (;;) {
        const bool has_next = S.next(ui + 1, nxt);
        const char* nA = has_next ? (const char*)g.A + (size_t)nxt.pm * tstep : cA; const char* nB = has_next ? (const char*)g.Bt + (size_t)nxt.pn * tstep : cB;
        for (int t = 0; t < nt; t += 2) {
            const bool last = (t == nt - 2);
            const char* a1 = cA + (size_t)(t + 1) * kstep;
            const char* a2 = last ? nA : cA + (size_t)(t + 2) * kstep; const char* b2 = last ? nB : cB + (size_t)(t + 2) * kstep;
            const char* a3 = a2 + kstep; const char* b3 = b2 + kstep;
            if (last && has_next) S.a_ready(nxt);
            if constexpr (SP2) {
            PG8_LDB(B0, 0, 0); PG8_LDB(B1, 0, 1); PG8_SCHED; PG8_LDA(At, 0, 0); PG8_STAGE(PG8_SA(1, 1), a1 + hstep, voffA);
            PG8_WAIT_V(8); PG8_WAIT_L(0); PG8_BAR; PG8_MMA(0, 0, At, B0); PG8_MMA(0, 1, At, B1); PG8_BAR; PG8_SCHED;
            PG8_LDA(At, 0, 1); PG8_STAGE(PG8_SB(0, 0), b2, voffB); PG8_STAGE(PG8_SB(0, 1), b2 + hstep, voffB); PG8_STAGE(PG8_SA(0, 0), a2, voffA);
            PG8_WAIT_V(8); PG8_WAIT_L(0); PG8_BAR; PG8_MMA(1, 0, At, B0); PG8_MMA(1, 1, At, B1); PG8_BAR; PG8_SCHED;
            PG8_LDB(B0, 1, 0); PG8_LDB(B1, 1, 1); PG8_SCHED; PG8_LDA(At, 1, 0); PG8_STAGE(PG8_SA(0, 1), a2 + hstep, voffA);
            PG8_WAIT_V(8); PG8_WAIT_L(0); PG8_BAR; PG8_MMA(0, 0, At, B0); PG8_MMA(0, 1, At, B1); PG8_BAR; PG8_SCHED;
            PG8_LDA(At, 1, 1); PG8_STAGE(PG8_SB(1, 0), b3, voffB); PG8_STAGE(PG8_SB(1, 1), b3 + hstep, voffB); PG8_STAGE(PG8_SA(1, 0), a3, voffA);
            PG8_WAIT_V(8); PG8_WAIT_L(0); PG8_BAR; PG8_MMA(1, 0, At, B0); PG8_MMA(1, 1, At, B1); PG8_BAR; PG8_SCHED;
            } else {
            PG8_LDB(B0, 0, 0); PG8_SCHED; PG8_LDA(At, 0, 0); PG8_STAGE(PG8_SA(1, 1), a1 + hstep, voffA);
            PG8_WAIT_L(8); PG8_BAR; PG8_WAIT_L(0); PG8_MMA(0, 0, At, B0); PG8_BAR; PG8_SCHED;
            PG8_LDB(B1, 0, 1); PG8_STAGE(PG8_SB(0, 0), b2, voffB);
            PG8_BAR; PG8_WAIT_L(0); PG8_MMA(0, 1, At, B1); PG8_BAR;
            PG8_LDA(At, 0, 1); PG8_STAGE(PG8_SA(0, 0), a2, voffA);
            PG8_BAR; PG8_WAIT_L(0); PG8_MMA(1, 0, At, B0); PG8_BAR; PG8_SCHED;
            PG8_STAGE(PG8_SB(0, 1), b2 + hstep, voffB);
            PG8_WAIT_V(6); PG8_BAR; PG8_MMA(1, 1, At, B1); PG8_BAR;
            PG8_LDB(B0, 1, 0); PG8_SCHED; PG8_LDA(At, 1, 0); PG8_STAGE(PG8_SA(0, 1), a2 + hstep, voffA);
            PG8_WAIT_L(8); PG8_BAR; PG8_WAIT_L(0); PG8_MMA(0, 0, At, B0); PG8_BAR; PG8_SCHED;
            PG8_LDB(B1, 1, 1); PG8_STAGE(PG8_SB(1, 0), b3, voffB);
            PG8_BAR; PG8_WAIT_L(0); PG8_MMA(0, 1, At, B1); PG8_BAR;
            PG8_LDA(At, 1, 1); PG8_STAGE(PG8_SA(1, 0), a3, voffA);
            PG8_BAR; PG8_WAIT_L(0); PG8_MMA(1, 0, At, B0); PG8_BAR; PG8_SCHED;
            PG8_STAGE(PG8_SB(1, 1), b3 + hstep, voffB);
            PG8_WAIT_V(6); PG8_BAR; PG8_MMA(1, 1, At, B1); PG8_BAR;
            }
        }
        if constexpr (ALIGN_EPI) { if (wr == 0) PG8_BAR; }
        if constexpr (!Epi::AFTER_DRAIN) { E(acc, cur, wr, wc, fr, fq); S.done(cur); }
        if (!has_next) break;
#pragma unroll
        for (int a = 0; a < 2; ++a)
#pragma unroll
            for (int b = 0; b < 2; ++b)
#pragma unroll
                for (int m = 0; m < 4; ++m)
#pragma unroll
                    for (int n = 0; n < 2; ++n) acc[a][b][m][n] = (f32x4){0.f, 0.f, 0.f, 0.f};
        cur = nxt; cA = nA; cB = nB; ++ui;
        if constexpr (ALIGN_EPI) { if (wr == 1) PG8_BAR; }
    }
    PG8_WAIT_V(0);
    if constexpr (!ALIGN_EPI) { if (wr == 0) PG8_BAR; }
    PG8_BAR;
    if constexpr (Epi::AFTER_DRAIN) { E.fused(acc, cur, wr, wc, fr, fq, lds, wid, lane); S.done(cur); }
#undef PG8_SA
#undef PG8_SB
#undef PG8_STAGE
#undef PG8_LDA
#undef PG8_LDB
#undef PG8_MMA
#undef PG8_WAIT_V
#undef PG8_WAIT_L
#undef PG8_BAR
#undef PG8_SCHED
}
}

#define GAS __attribute__((address_space(1)))
#define LAS __attribute__((address_space(3)))
typedef unsigned short bf16;
typedef short bf16x8 __attribute__((ext_vector_type(8)));
typedef float f32x4 __attribute__((ext_vector_type(4)));
typedef float f32x16 __attribute__((ext_vector_type(16)));
typedef unsigned u32x4 __attribute__((ext_vector_type(4)));
typedef unsigned u32x2 __attribute__((ext_vector_type(2)));
typedef float f32x2_t __attribute__((ext_vector_type(2)));
typedef __bf16 bf16x2_t __attribute__((ext_vector_type(2)));
using pg8::Unit;

constexpr int NB = 16, SEQ = 2048, MTOK = NB * SEQ, DM = 1024, NPROJ = 2560, DEPTH = 2;
constexpr int NTT = MTOK / 256;
constexpr int ZROWS = MTOK + DEPTH * NPROJ;
constexpr float RMS_EPS = 1e-6f;
constexpr float LOG2E = 1.4426950408889634f;
constexpr float QSCALE = 0.125f * LOG2E;
constexpr int LDS_BYTES = 147456;
constexpr int LDS_MISC = 131072;
constexpr int LDS_CTL = LDS_BYTES - 512;

constexpr size_t MiB = 1u << 20;
constexpr size_t WS_CTL = 0, CTL_BYTES = 64 * 1024;
constexpr size_t WS_Z = 2 * MiB, WS_WOUT = 78 * MiB, WS_GLU = 82 * MiB, WS_TE = 83 * MiB, WS_G = 89 * MiB, WS_AT = 91 * MiB;
constexpr size_t WS_U = 92 * MiB, WS_SG = 108 * MiB, WS_AQ = 124 * MiB, WS_AK = 148 * MiB, WS_AG = 156 * MiB, WS_MQ = 180 * MiB, WS_MK = 204 * MiB, WS_MG = 212 * MiB;
constexpr size_t WS_VT = 236 * MiB, WS_KPART = 252 * MiB, WS_ROWSS = 253 * MiB, WS_YPRE = 254 * MiB, WS_Y = 270 * MiB, WS_END = 334 * MiB;
static_assert(WS_Z + (size_t)ZROWS * DM * 2 <= WS_WOUT, "Z fits");
constexpr size_t WS_NW = 1 * MiB;
constexpr int TE_ELEMS = 256 * 384, G_ELEMS = 128 * 256;
constexpr int CW_QUEUE = 1024;
constexpr int CW_SSMDONE = 8192;

__device__ __forceinline__ unsigned pk2(float lo, float hi) { f32x2_t v = {lo, hi}; bf16x2_t b = __builtin_convertvector(v, bf16x2_t); return __builtin_bit_cast(unsigned, b); }
__device__ __forceinline__ float bf2f(unsigned short x) { return __uint_as_float((unsigned)x << 16); }
__device__ __forceinline__ float bflo(unsigned w) { return __uint_as_float(w << 16); }
__device__ __forceinline__ float bfhi(unsigned w) { return __uint_as_float(w & 0xffff0000u); }
__device__ __forceinline__ float wave_sum(float v) {
#pragma unroll
    for (int o = 1; o < 64; o <<= 1) v += __shfl_xor(v, o);
    return v;
}
__device__ __forceinline__ float fast_rcp(float x) { return __builtin_amdgcn_rcpf(x); }
__device__ __forceinline__ float silu_f(float x) { return x * fast_rcp(1.f + __builtin_amdgcn_exp2f(-x * LOG2E)); }
__device__ __forceinline__ float sigmoid_f(float x) { return fast_rcp(1.f + __builtin_amdgcn_exp2f(-x * LOG2E)); }
__device__ __forceinline__ float gelu_tanh_f(float x) { const float z = 0.7978845608028654f * (x + 0.044715f * x * x * x); return x * fast_rcp(1.f + __builtin_amdgcn_exp2f(-2.f * LOG2E * z)); }
__device__ __forceinline__ float swap32_max(float m) { auto rr = __builtin_amdgcn_permlane32_swap(__float_as_uint(m), __float_as_uint(m), false, false); return fmaxf(__uint_as_float(rr[0]), __uint_as_float(rr[1])); }
__device__ __forceinline__ float swap32_sum(float m) { auto rr = __builtin_amdgcn_permlane32_swap(__float_as_uint(m), __float_as_uint(m), false, false); return __uint_as_float(rr[0]) + __uint_as_float(rr[1]); }
__device__ __forceinline__ void glds16(const void* gsrc, LAS unsigned char* ldst) {
    const unsigned dst = __builtin_amdgcn_readfirstlane((unsigned)(uintptr_t)ldst); unsigned keep;
    asm volatile("s_mov_b32 %0, m0\n\ts_mov_b32 m0, %2\n\ts_nop 0\n\tglobal_load_lds_dwordx4 %1, off\n\ts_mov_b32 m0, %0" : "=&s"(keep) : "v"(gsrc), "s"(dst) : "memory");
}
#define GLDS_WAIT() asm volatile("s_waitcnt vmcnt(0)" ::: "memory")

struct Params {
    const float* in[19]; float* out; unsigned char* ws;
};
typedef const float* const __attribute__((address_space(4))) * kargs_t;
__device__ __forceinline__ const float* kin(int i) { kargs_t ka = (kargs_t)__builtin_amdgcn_kernarg_segment_ptr(); asm volatile("" : "+s"(ka)); return ka[i]; }
struct Frame {
    LAS unsigned char* lds; int tid, lane, wave, G, bid; float* out; unsigned char* ws; unsigned* ctl;
};

__device__ __forceinline__ int proj_dest_row(int n0) {
    int slot, off;
    if (n0 < 512)       { slot = n0 >> 6; off = n0 & 63; }
    else if (n0 < 1024) { slot = 8 + ((n0 - 512) >> 6); off = n0 & 63; }
    else if (n0 < 1152) { return 2304 + (n0 - 1024); }
    else if (n0 < 1536) { slot = 16 + ((n0 - 1152) >> 6); off = (n0 - 1152) & 63; }
    else if (n0 < 1920) { slot = 22 + ((n0 - 1536) >> 6); off = (n0 - 1536) & 63; }
    else if (n0 < 2048) { slot = 28 + ((n0 - 1920) >> 6); off = (n0 - 1920) & 63; }
    else if (n0 < 2176) { return 2304 + 128 + (n0 - 2048); }
    else                { slot = 30 + ((n0 - 2176) >> 6); off = (n0 - 2176) & 63; }
    const int t = slot >> 2, wc = slot & 3;
    return 256 * t + 128 * (off >> 5) + 32 * wc;
}
__device__ __forceinline__ void p0_transpose_item(const float* W, int K, int N, const float* gk, bf16* WT, int ldk, int drow0, LAS float* scr, int k0, int n0, int lane) {
    float tv[32];
#pragma unroll
    for (int i = 0; i < 32; ++i) { const int kk = 2 * i + (lane >> 5); tv[i] = __builtin_nontemporal_load(W + (size_t)(k0 + kk) * N + n0 + (lane & 31)); }
#pragma unroll
    for (int i = 0; i < 32; ++i) { const int kk = 2 * i + (lane >> 5); float v = tv[i]; if (gk) v *= gk[k0 + kk]; scr[kk * 33 + (lane & 31)] = v; }
    asm volatile("s_waitcnt lgkmcnt(0)" ::: "memory");
    const int c = lane & 7;
#pragma unroll
    for (int j = 0; j < 4; ++j) { const int n = (lane >> 3) + 8 * j; const LAS float* s = scr + (8 * c) * 33 + n;
        u32x4 o; o.x = pk2(s[0 * 33], s[1 * 33]); o.y = pk2(s[2 * 33], s[3 * 33]); o.z = pk2(s[4 * 33], s[5 * 33]); o.w = pk2(s[6 * 33], s[7 * 33]);
        *(u32x4*)(WT + (size_t)(drow0 + n) * ldk + k0 + 8 * c) = o; }
    asm volatile("s_waitcnt lgkmcnt(0)" ::: "memory");
}
__device__ __forceinline__ void p0_ssm_consts(const Params& P, Frame& F, int pair) {
    const int l = pair >> 4, g = pair & 15, tid = F.tid;
    LAS float* pwr = (LAS float*)(F.lds);
    LAS float* pwi = pwr + 17 * 64;
    LAS float* bbr = pwi + 17 * 64;
    LAS float* bbi = bbr + 1024;
    LAS float* ccr = bbi + 1024;
    LAS float* cci = ccr + 1024;
    LAS float* Kt = cci + 1024;
    const float dt = expf(kin(5)[l * 16 + g]);
    const float* lre = kin(3) + (l * 16 + g) * 64; const float* lim = kin(4) + (l * 16 + g) * 64;
    for (int t = tid; t < 17 * 64; t += 512) { const int p = t & 63, lag = t >> 6; const float lr = lre[p], li = lim[p];
        const float mag = expf(lr * dt * (float)lag); float sn, cs; sincosf(li * dt * (float)lag, &sn, &cs); pwr[t] = mag * cs; pwi[t] = mag * sn; }
    for (int t = tid; t < 1024; t += 512) { const int p = t >> 4, h = t & 15; const float lr = lre[p], li = lim[p];
        const float mag = expf(lr * dt); float sn, cs; sincosf(li * dt, &sn, &cs); const float ar = mag * cs, ai = mag * sn;
        const float den = lr * lr + li * li, nr = ar - 1.f, ni = ai; const float cr = (nr * lr + ni * li) / den, ci = (ni * lr - nr * li) / den;
        const float br = kin(6)[((size_t)(l * 16 + g) * 64 + p) * 16 + h], bi = kin(7)[((size_t)(l * 16 + g) * 64 + p) * 16 + h];
        bbr[t] = cr * br - ci * bi; bbi[t] = cr * bi + ci * br; }
    for (int t = tid; t < 1024; t += 512) { ccr[t] = kin(8)[(size_t)(l * 16 + g) * 1024 + t]; cci[t] = kin(9)[(size_t)(l * 16 + g) * 1024 + t]; }
    __syncthreads();
    for (int t = tid; t < 4096; t += 512) { const int lag = t >> 8, hp = (t >> 4) & 15, h = t & 15; float s = 0.f;
        for (int p = 0; p < 64; ++p) { const float cr = ccr[hp * 64 + p], ci = cci[hp * 64 + p], pr = pwr[lag * 64 + p], pi = pwi[lag * 64 + p];
            const float xr = cr * pr - ci * pi, xi = cr * pi + ci * pr; s += xr * bbr[p * 16 + h] - xi * bbi[p * 16 + h]; }
        if (lag == 0 && hp == h) s += kin(10)[l * 256 + g * 16 + h];
        Kt[t] = s; }
    __syncthreads();
    bf16* TE = ((bf16*)(F.ws + WS_TE)) + (size_t)pair * TE_ELEMS; bf16* GM = ((bf16*)(F.ws + WS_G)) + (size_t)pair * G_ELEMS;
    for (int t = tid; t < 256 * 192; t += 512) { const int n = t / 192, kp = t % 192, k = 2 * kp; const int i = n >> 4, hp = n & 15; float v0, v1;
        if (k < 256) { const int j = k >> 4, h = k & 15; if (j <= i) { v0 = Kt[((i - j) * 16 + hp) * 16 + h]; v1 = Kt[((i - j) * 16 + hp) * 16 + h + 1]; } else { v0 = 0.f; v1 = 0.f; } }
        else { const int p = (k - 256) >> 1; const float cr = ccr[hp * 64 + p], ci = cci[hp * 64 + p], pr = pwr[(i + 1) * 64 + p], pi = pwi[(i + 1) * 64 + p];
            v0 = cr * pr - ci * pi; v1 = -(cr * pi + ci * pr); }
        *(unsigned*)(TE + (size_t)n * 384 + k) = pk2(v0, v1); }
    for (int t = tid; t < 128 * 128; t += 512) { const int n = t >> 7, kp = t & 127, k = 2 * kp; const int p = n >> 1, ri = n & 1, j = k >> 4, h = k & 15;
        const float pr = pwr[(15 - j) * 64 + p], pi = pwi[(15 - j) * 64 + p];
        float v0, v1;
        { const float br = bbr[p * 16 + h], bi = bbi[p * 16 + h]; v0 = ri ? (pr * bi + pi * br) : (pr * br - pi * bi); }
        { const float br = bbr[p * 16 + h + 1], bi = bbi[p * 16 + h + 1]; v1 = ri ? (pr * bi + pi * br) : (pr * br - pi * bi); }
        *(unsigned*)(GM + (size_t)n * 256 + k) = pk2(v0, v1); }
    if (tid < 64) { ((float*)(F.ws + WS_AT))[(size_t)pair * 128 + 2 * tid] = pwr[16 * 64 + tid]; ((float*)(F.ws + WS_AT))[(size_t)pair * 128 + 2 * tid + 1] = pwi[16 * 64 + tid]; }
    __syncthreads();
}
__device__ __forceinline__ void p0_prologue(const Params& P, Frame& F) {
    const bool split = F.G > 64;
    if (!split || F.bid < 32) { for (int pair = F.bid; pair < 32; pair += (split ? 32 : F.G)) p0_ssm_consts(P, F, pair); if (split) return; }
    const int vb = split ? F.bid - 32 : F.bid, nvb = split ? F.G - 32 : F.G;
    if (vb == 0) { float* nwp = (float*)(F.ws + WS_NW);
        for (int t = F.tid; t < DEPTH * 256; t += 512) { const int l = t >> 8, k = (t >> 6) & 3, d = t & 63;
            nwp[t] = (k == 0) ? kin(13)[l * 64 + d] * QSCALE : (k == 1) ? kin(14)[l * 64 + d] : (k == 2) ? kin(16)[l * 64 + d] * QSCALE : kin(17)[l * 64 + d]; } }
    const int gw = vb * 8 + F.wave, NGW = nvb * 8;
    LAS float* scr = (LAS float*)(F.lds + F.wave * 16384);
    constexpr int I_IN = 16 * 80, I_OUT = 16 * 32, I_GLU = 4 * 8, I_L = I_IN + I_OUT + I_GLU;
    for (int it = gw; it < DEPTH * I_L; it += NGW) {
        const int l = it / I_L; int r = it % I_L;
        if (r < I_IN) { const int kb = r / 80, nb = r % 80; p0_transpose_item(kin(2) + (size_t)l * DM * NPROJ, DM, NPROJ, kin(1) + l * DM, ((bf16*)(F.ws + WS_Z)) + (size_t)(MTOK + l * NPROJ) * DM, DM, proj_dest_row(32 * nb), scr, 64 * kb, 32 * nb, F.lane); continue; }
        r -= I_IN;
        if (r < I_OUT) { const int kb = r / 32, nb = r % 32; p0_transpose_item(kin(18) + (size_t)l * DM * DM, DM, DM, nullptr, ((bf16*)(F.ws + WS_WOUT)) + (size_t)l * DM * DM, DM, 32 * nb, scr, 64 * kb, 32 * nb, F.lane); continue; }
        r -= I_OUT;
        { const int kb = r / 8, nb = r % 8; p0_transpose_item(kin(11) + (size_t)l * 65536, 256, 256, nullptr, ((bf16*)(F.ws + WS_GLU)) + (size_t)l * 65536, 256, 32 * nb, scr, 64 * kb, 32 * nb, F.lane); }
    }
    for (int m0 = gw; m0 < MTOK; m0 += 4 * NGW) {
        f32x4 v[4][4];
#pragma unroll
        for (int q = 0; q < 4; ++q) { const int m = m0 + q * NGW; if (m < MTOK) { const f32x4* xr = (const f32x4*)(kin(0) + (size_t)m * DM) + F.lane;
#pragma unroll
            for (int j = 0; j < 4; ++j) v[q][j] = __builtin_nontemporal_load(xr + 64 * j); } }
#pragma unroll
        for (int q = 0; q < 4; ++q) { const int m = m0 + q * NGW; if (m < MTOK) { float s = 0.f;
#pragma unroll
            for (int j = 0; j < 4; ++j) s += (v[q][j].x * v[q][j].x + v[q][j].y * v[q][j].y) + (v[q][j].z * v[q][j].z + v[q][j].w * v[q][j].w);
            s = wave_sum(s);
            u32x2* o8 = (u32x2*)(((bf16*)(F.ws + WS_Z)) + (size_t)m * DM) + F.lane;
#pragma unroll
            for (int j = 0; j < 4; ++j) { u32x2 w; w.x = pk2(v[q][j].x, v[q][j].y); w.y = pk2(v[q][j].z, v[q][j].w); o8[64 * j] = w; }
            if (F.lane < 4) ((float*)(F.ws + WS_ROWSS))[(size_t)m * 4 + F.lane] = (F.lane == 0) ? s : 0.f; } }
    }
}

__device__ __forceinline__ Frame phase_frame(const Frame& F0) {
    Frame F = F0; asm volatile("" : "+v"(F.tid)); F.lane = F.tid & 63; F.wave = __builtin_amdgcn_readfirstlane(F.tid >> 6);
    asm volatile("" : "+s"(F.ws)); F.ctl = (unsigned*)(F.ws + WS_CTL); return F;
}
struct SchedTab { const volatile LAS int* tab; int n;
    __device__ __forceinline__ bool next(int i, Unit& u) const { if (i >= n) return false; u.pm = __builtin_amdgcn_readfirstlane(tab[2 * i]); u.pn = __builtin_amdgcn_readfirstlane(tab[2 * i + 1]); return true; }
    __device__ __forceinline__ void a_ready(const Unit&) const {}
    __device__ __forceinline__ void done(const Unit&) const {}
};
__device__ __forceinline__ bool unit_p1(int G, int c, int wbase, int i, int& pm, int& pn) {
    int tok, j;
    if (G == 256) { if (i >= 5) return false; const int x = c & 7, l = c >> 3, n = i * 32 + l, tq = n / 40, rem = n % 40; j = rem >> 2; tok = 16 * x + 4 * tq + (rem & 3); }
    else { const long L = (long)i * G + c; if (L >= NTT * 10) return false; tok = (int)(L / 10); j = (int)(L % 10); }
    if (j < 9) { pm = tok; pn = wbase + j; } else { pm = wbase + 9; pn = tok; }
    return true;
}
__device__ __forceinline__ bool unit_p3(int G, int c, int i, int& pm, int& pn) {
    if (G == 256) { if (i >= 2) return false; const int x = c & 7, l = c >> 3, n = i * 32 + l, tq = n >> 4, rem = n & 15; pn = rem >> 2; pm = 16 * x + 4 * tq + (rem & 3); }
    else { const long L = (long)i * G + c; if (L >= NTT * 4) return false; pm = (int)(L / 4); pn = (int)(L % 4); }
    return true;
}
__device__ __forceinline__ bool unit_glu(int G, int c, int i, int& pm, int& pn) {
    if (G == 256) { if (i >= 1 || (c >> 3) >= 16) return false; pm = 16 * (c & 7) + (c >> 3); pn = 0; }
    else { const long L = (long)i * G + c; if (L >= NTT) return false; pm = (int)L; pn = 0; }
    return true;
}
template <int KIND>
__device__ __forceinline__ SchedTab make_sched(const Frame& F, int wbase) {
    volatile LAS int* tab = (volatile LAS int*)(F.lds + LDS_CTL + 64);
    volatile LAS int* cnt = (volatile LAS int*)(F.lds + LDS_CTL + 32);
    if (F.tid == 0) { int n = 0;
#pragma unroll 1
        for (int i = 0; i < 24; ++i) { int pm, pn; const bool ok = (KIND == 0) ? unit_p1(F.G, F.bid, wbase, i, pm, pn) : (KIND == 1) ? unit_p3(F.G, F.bid, i, pm, pn) : unit_glu(F.G, F.bid, i, pm, pn);
            if (!ok) break; tab[2 * i] = pm; tab[2 * i + 1] = pn; n = i + 1; }
        cnt[0] = n; }
    __syncthreads();
    SchedTab S; S.tab = tab; S.n = __builtin_amdgcn_readfirstlane(cnt[0]); return S;
}

struct EpiProj {
    static constexpr bool PERM = true, AFTER_DRAIN = false;
    int wbase, layer; unsigned char* ws;
    __device__ __forceinline__ void operator()(const f32x4 (&acc)[2][2][4][2], const Unit& u, int wr, int wc, int fr, int fq) const {
        asm volatile("" : "+v"(fr), "+v"(fq));
        const float* rowss = (const float*)(ws + WS_ROWSS);
        if (u.pm >= NTT) {
            bf16* VT = (bf16*)(ws + WS_VT);
            const int tc = u.pn * 256 + wc * 32 + 8 * fq;
#pragma unroll
            for (int bj = 0; bj < 2; ++bj) {
                float rs[8];
                { f32x4 p[8];
#pragma unroll
                  for (int e = 0; e < 8; ++e) p[e] = *(const f32x4*)(rowss + (size_t)(tc + bj * 128 + e) * 4);
#pragma unroll
                  for (int e = 0; e < 8; ++e) rs[e] = rsqrtf(((p[e].x + p[e].y) + (p[e].z + p[e].w)) * (1.f / DM) + RMS_EPS); }
#pragma unroll
                for (int ai = 0; ai < 2; ++ai)
#pragma unroll
                    for (int m = 0; m < 4; ++m) { const int f = ai * 128 + wr * 64 + m * 16 + fr; const f32x4 a = acc[ai][bj][m][0], b = acc[ai][bj][m][1]; u32x4 w;
                        w.x = pk2(a[0] * rs[0], a[1] * rs[1]); w.y = pk2(a[2] * rs[2], a[3] * rs[3]); w.z = pk2(b[0] * rs[4], b[1] * rs[5]); w.w = pk2(b[2] * rs[6], b[3] * rs[7]);
                        *(u32x4*)(VT + ((size_t)u.pn * 256 + f) * 256 + (wc * 32 + 8 * fq + bj * 128)) = w; }
            }
            return;
        }
        const int t = u.pn - wbase;
        int kind, pitch, col, nwi = 0; size_t dsto;
        switch (t) {
            case 0: kind = 0; dsto = WS_U; pitch = 256; col = 64 * wc; break;
            case 1: kind = 1; dsto = WS_SG; pitch = 256; col = 64 * wc; break;
            case 2: kind = 2; dsto = WS_AQ; pitch = 384; col = 64 * wc; nwi = 0; break;
            case 3: if (wc < 2) { kind = 2; dsto = WS_AQ; pitch = 384; col = 64 * (4 + wc); nwi = 0; } else { kind = 2; dsto = WS_AK; pitch = 128; col = 64 * (wc - 2); nwi = 1; } break;
            case 4: kind = 1; dsto = WS_AG; pitch = 384; col = 64 * wc; break;
            case 5: if (wc < 2) { kind = 1; dsto = WS_AG; pitch = 384; col = 64 * (4 + wc); } else { kind = 2; dsto = WS_MQ; pitch = 384; col = 64 * (wc - 2); nwi = 2; } break;
            case 6: kind = 2; dsto = WS_MQ; pitch = 384; col = 64 * (2 + wc); nwi = 2; break;
            case 7: if (wc < 2) { kind = 5; dsto = WS_MK; pitch = 128; col = 64 * wc; nwi = 3; } else { kind = 1; dsto = WS_MG; pitch = 384; col = 64 * (wc - 2); } break;
            default: kind = 1; dsto = WS_MG; pitch = 384; col = 64 * (2 + wc); break;
        }
        bf16* dst = (bf16*)(ws + dsto) + col + 8 * fq; const float* nw = (const float*)(ws + WS_NW) + (layer * 4 + nwi) * 64 + 8 * fq;
        int row0 = u.pm * 256 + wr * 64 + fr; asm volatile("" : "+v"(row0));
        if (kind == 0) rows<0>(acc, row0, (bf16*)(ws + WS_U) + ((size_t)(4 * wc + (fq >> 1)) * SEQ) * 16 + 8 * (fq & 1), 0, nw, rowss, nullptr);
        else if (kind == 1) rows<1>(acc, row0, dst, pitch, nw, rowss, nullptr);
        else if (kind == 2) rows<2>(acc, row0, dst, pitch, nw, rowss, nullptr);
        else rows<5>(acc, row0, dst, pitch, nw, rowss, (fr == 0) ? (float*)(ws + WS_KPART) + ((size_t)(u.pm * 2 + wr) * 2 + wc) * 64 + 8 * fq : nullptr);
    }
    template <int KIND>
    __device__ __forceinline__ void rows(const f32x4 (&acc)[2][2][4][2], int row0, bf16* dst, int pitch, const float* nw, const float* rowss, float* kp) const {
        f32x4 wv[2][2], ks[2][2];
        if (KIND >= 2) {
#pragma unroll
            for (int bj = 0; bj < 2; ++bj)
#pragma unroll
                for (int n = 0; n < 2; ++n) { wv[bj][n] = *(const f32x4*)(nw + 32 * bj + 4 * n); ks[bj][n] = (f32x4){0.f, 0.f, 0.f, 0.f}; }
        }
#pragma unroll
        for (int ai = 0; ai < 2; ++ai) {
            float rsv[4];
            { f32x4 pr[4];
#pragma unroll
              for (int m = 0; m < 4; ++m) pr[m] = *(const f32x4*)(rowss + (size_t)(row0 + ai * 128 + m * 16) * 4);
#pragma unroll
              for (int m = 0; m < 4; ++m) { const f32x4 p = pr[m]; rsv[m] = rsqrtf(((p.x + p.y) + (p.z + p.w)) * (1.f / DM) + RMS_EPS); } }
#pragma unroll
            for (int m = 0; m < 4; ++m) {
                const int row = row0 + ai * 128 + m * 16;
                const float rs = rsv[m];
                f32x4 v[2][2];
#pragma unroll
                for (int bj = 0; bj < 2; ++bj)
#pragma unroll
                    for (int n = 0; n < 2; ++n) v[bj][n] = acc[ai][bj][m][n] * rs;
                if (KIND >= 2) {
                    float ss = 0.f;
#pragma unroll
                    for (int bj = 0; bj < 2; ++bj)
#pragma unroll
                        for (int n = 0; n < 2; ++n) { const f32x4 q = v[bj][n]; ss += (q[0] * q[0] + q[1] * q[1]) + (q[2] * q[2] + q[3] * q[3]); }
                    ss += __shfl_xor(ss, 16); ss += __shfl_xor(ss, 32);
                    const float hn = rsqrtf(ss * (1.f / 64.f) + RMS_EPS);
#pragma unroll
                    for (int bj = 0; bj < 2; ++bj)
#pragma unroll
                        for (int n = 0; n < 2; ++n) { v[bj][n] = v[bj][n] * wv[bj][n] * hn; if (KIND == 5) ks[bj][n] += v[bj][n]; }
                } else if (KIND == 1) {
#pragma unroll
                    for (int bj = 0; bj < 2; ++bj)
#pragma unroll
                        for (int n = 0; n < 2; ++n)
#pragma unroll
                            for (int e = 0; e < 4; ++e) v[bj][n][e] = silu_f(v[bj][n][e]);
                }
                bf16* rp = (KIND == 0) ? dst + ((size_t)(row >> 11) * 16 * SEQ + (row & (SEQ - 1))) * 16 : dst + (size_t)row * pitch;
#pragma unroll
                for (int bj = 0; bj < 2; ++bj) { u32x4 w; w.x = pk2(v[bj][0][0], v[bj][0][1]); w.y = pk2(v[bj][0][2], v[bj][0][3]); w.z = pk2(v[bj][1][0], v[bj][1][1]); w.w = pk2(v[bj][1][2], v[bj][1][3]);
                    *(u32x4*)(rp + (KIND == 0 ? 2 * SEQ * 16 * bj : 32 * bj)) = w; }
                if (m & 1) asm volatile("" ::: "memory");
            }
        }
        if (KIND == 5) {
#pragma unroll
            for (int bj = 0; bj < 2; ++bj)
#pragma unroll
                for (int n = 0; n < 2; ++n)
#pragma unroll
                    for (int e = 0; e < 4; ++e) { float s = ks[bj][n][e]; s += __shfl_xor(s, 1); s += __shfl_xor(s, 2); s += __shfl_xor(s, 4); s += __shfl_xor(s, 8); ks[bj][n][e] = s; }
            if (kp) {
#pragma unroll
                for (int bj = 0; bj < 2; ++bj)
#pragma unroll
                    for (int n = 0; n < 2; ++n) *(f32x4*)(kp + 32 * bj + 4 * n) = ks[bj][n];
            }
        }
    }
};
struct EpiGlu {
    static constexpr bool PERM = true, AFTER_DRAIN = false;
    const bf16* YPRE; const bf16* SG; const float* gb; bf16* Y;
    __device__ __forceinline__ void operator()(const f32x4 (&acc)[2][2][4][2], const Unit& u, int wr, int wc, int fr, int fq) const {
#pragma unroll
        for (int bj = 0; bj < 2; ++bj) { const int c = wc * 32 + 8 * fq + 128 * bj;
            const f32x4 b0 = *(const f32x4*)(gb + c), b1 = *(const f32x4*)(gb + c + 4);
#pragma unroll
            for (int ai = 0; ai < 2; ++ai)
#pragma unroll
                for (int m = 0; m < 4; ++m) { const int row = u.pm * 256 + ai * 128 + wr * 64 + m * 16 + fr;
                    const u32x4 yp = *(const u32x4*)(YPRE + (size_t)row * 256 + c), sg = *(const u32x4*)(SG + (size_t)row * 256 + c);
                    const f32x4 z0 = acc[ai][bj][m][0] + b0, z1 = acc[ai][bj][m][1] + b1;
                    u32x4 w;
                    w.x = pk2(bflo(yp.x) * sigmoid_f(z0[0]) * bflo(sg.x), bfhi(yp.x) * sigmoid_f(z0[1]) * bfhi(sg.x));
                    w.y = pk2(bflo(yp.y) * sigmoid_f(z0[2]) * bflo(sg.y), bfhi(yp.y) * sigmoid_f(z0[3]) * bfhi(sg.y));
                    w.z = pk2(bflo(yp.z) * sigmoid_f(z1[0]) * bflo(sg.z), bfhi(yp.z) * sigmoid_f(z1[1]) * bfhi(sg.z));
                    w.w = pk2(bflo(yp.w) * sigmoid_f(z1[2]) * bflo(sg.w), bfhi(yp.w) * sigmoid_f(z1[3]) * bfhi(sg.w));
                    *(u32x4*)(Y + (size_t)row * DM + c) = w;
                    if (m & 1) asm volatile("" ::: "memory"); } }
    }
};
struct EpiOut {
    static constexpr bool PERM = false, AFTER_DRAIN = false;
    const float* resid_f; float* out; bf16* xb; float* rowss; int write_next; LAS float* xch; int probe_skip;
    __device__ __forceinline__ void operator()(const f32x4 (&acc)[2][2][4][2], const Unit& u, int wr, int wc, int fr, int fq) const {
        const int c0 = u.pn * 256 + wc * 32 + 4 * fq;
        if (probe_skip) { asm volatile("" :: "v"(acc[0][0][0][0]), "v"(acc[1][1][3][1])); asm volatile("s_waitcnt lgkmcnt(0)" ::: "memory"); __builtin_amdgcn_s_barrier(); return; }
        if (write_next) {
#pragma unroll
            for (int ai = 0; ai < 2; ++ai) {
                u32x2 pre[4][2][2];
#pragma unroll
                for (int m = 0; m < 4; ++m) { const size_t off = (size_t)(u.pm * 256 + ai * 128 + wr * 64 + m * 16 + fr) * DM + c0;
#pragma unroll
                    for (int bj = 0; bj < 2; ++bj)
#pragma unroll
                        for (int n = 0; n < 2; ++n) pre[m][bj][n] = *(const u32x2*)(xb + off + bj * 128 + n * 16); }
#pragma unroll
                for (int m = 0; m < 4; ++m) { const int rt = ai * 128 + wr * 64 + m * 16 + fr; const size_t off = (size_t)(u.pm * 256 + rt) * DM + c0; float ss = 0.f;
#pragma unroll
                    for (int bj = 0; bj < 2; ++bj)
#pragma unroll
                        for (int n = 0; n < 2; ++n) { const u32x2 rb = pre[m][bj][n]; const f32x4 a4 = acc[ai][bj][m][n]; f32x4 o;
                            o[0] = bflo(rb.x) + a4[0]; o[1] = bfhi(rb.x) + a4[1]; o[2] = bflo(rb.y) + a4[2]; o[3] = bfhi(rb.y) + a4[3];
                            u32x2 w; w.x = pk2(o[0], o[1]); w.y = pk2(o[2], o[3]); *(u32x2*)(xb + off + bj * 128 + n * 16) = w; ss += (o[0] * o[0] + o[1] * o[1]) + (o[2] * o[2] + o[3] * o[3]); }
                    ss += __shfl_xor(ss, 16); ss += __shfl_xor(ss, 32); if (fq == 0) xch[rt * 4 + wc] = ss; }
            }
        } else {
#pragma unroll
            for (int ai = 0; ai < 2; ++ai) {
                u32x2 pre[4][2][2];
#pragma unroll
                for (int m = 0; m < 4; ++m) { const size_t off = (size_t)(u.pm * 256 + ai * 128 + wr * 64 + m * 16 + fr) * DM + c0;
#pragma unroll
                    for (int bj = 0; bj < 2; ++bj)
#pragma unroll
                        for (int n = 0; n < 2; ++n) pre[m][bj][n] = *(const u32x2*)(xb + off + bj * 128 + n * 16); }
#pragma unroll
                for (int m = 0; m < 4; ++m) { const size_t off = (size_t)(u.pm * 256 + ai * 128 + wr * 64 + m * 16 + fr) * DM + c0;
#pragma unroll
                    for (int bj = 0; bj < 2; ++bj)
#pragma unroll
                        for (int n = 0; n < 2; ++n) { const u32x2 rb = pre[m][bj][n]; const f32x4 a4 = acc[ai][bj][m][n]; f32x4 o;
                            o[0] = bflo(rb.x) + a4[0]; o[1] = bfhi(rb.x) + a4[1]; o[2] = bflo(rb.y) + a4[2]; o[3] = bfhi(rb.y) + a4[3];
                            __builtin_nontemporal_store(o, (f32x4*)(out + off + bj * 128 + n * 16)); } }
            }
        }
        asm volatile("s_waitcnt lgkmcnt(0)" ::: "memory"); __builtin_amdgcn_s_barrier(); asm volatile("" ::: "memory");
        if (write_next && threadIdx.x < 256) { const f32x4 p = *(const LAS f32x4*)(xch + threadIdx.x * 4); rowss[(size_t)(u.pm * 256 + threadIdx.x) * 4 + u.pn] = (p.x + p.y) + (p.z + p.w); }
    }
};

__device__ __forceinline__ int pi32(int r) { return (r & ~12) | ((r & 8) >> 1) | ((r & 4) << 1); }
template <int MODE>
__device__ __forceinline__ void attn_tile(const bf16x8 (&kf)[4], const bf16x8 (&vf)[2][2], const bf16x8 (&qf)[4], const f32x16& cv, float& l, f32x16 (&O)[2], int a, int h) {
    f32x16 S = __builtin_amdgcn_mfma_f32_32x32x16_bf16(kf[0], qf[0], cv, 0, 0, 0);
#pragma unroll
    for (int ks = 1; ks < 4; ++ks) S = __builtin_amdgcn_mfma_f32_32x32x16_bf16(kf[ks], qf[ks], S, 0, 0, 0);
    if (MODE != 0) {
#pragma unroll
        for (int i = 0; i < 16; ++i) { const int c = pi32((i & 3) + 8 * (i >> 2) + 4 * h); const bool dead = (MODE == 1) ? (c > a) : (c <= a); if (dead) S[i] = -1e30f; }
    }
    float s0 = 0.f, s1 = 0.f;
#pragma unroll
    for (int i = 0; i < 16; i += 2) { S[i] = __builtin_amdgcn_exp2f(S[i]); S[i + 1] = __builtin_amdgcn_exp2f(S[i + 1]); s0 += S[i]; s1 += S[i + 1]; }
    l += s0 + s1;
    bf16x8 pb[2];
#pragma unroll
    for (int s = 0; s < 2; ++s) { u32x4 w; w.x = pk2(S[8 * s], S[8 * s + 1]); w.y = pk2(S[8 * s + 2], S[8 * s + 3]); w.z = pk2(S[8 * s + 4], S[8 * s + 5]); w.w = pk2(S[8 * s + 6], S[8 * s + 7]); pb[s] = __builtin_bit_cast(bf16x8, w); }
#pragma unroll
    for (int dt = 0; dt < 2; ++dt)
#pragma unroll
        for (int s = 0; s < 2; ++s) O[dt] = __builtin_amdgcn_mfma_f32_32x32x16_bf16(vf[dt][s], pb[s], O[dt], 0, 0, 0);
}
template <int NK>
__device__ __forceinline__ void stage_kv(LAS unsigned char* Kimg, LAS unsigned char* Vimg, const bf16* Ksrc  , const bf16* VTf  ,
                                         long tokbase  , long key_lo  , long key_min  , int wave, int lane) {
    constexpr int KP = NK * 128 / 1024, VCH = NK / 8, VP = 64 * VCH * 16 / 1024;
    for (int p = wave; p < KP; p += 8) { const int L = p * 64 + lane, r = L >> 3, s = L & 7, c = s ^ ((r >> 1) & 7); long kr = key_lo + r; if (kr < key_min) kr = key_min;
        glds16(Ksrc + (kr - key_lo) * 128 + c * 8, Kimg + p * 1024); }
    for (int p = wave; p < VP; p += 8) { const int L = p * 64 + lane, d = L / VCH, s = L % VCH, c = s ^ (d & 15); long kc = key_lo + 8 * c; if (kc < key_min) kc = key_min; const long tok = tokbase + kc;
        glds16(VTf + ((tok >> 8) * 256 + d) * 256 + (tok & 255), Vimg + p * 1024); }
}
template <int NK>
__device__ __forceinline__ void load_kv_frags(bf16x8 (&kf)[4], bf16x8 (&vf)[2][2], const LAS unsigned char* Kimg, const LAS unsigned char* Vimg, int row0  , int lane) {
    const int r = row0 + pi32(lane & 31), h = lane >> 5;
#pragma unroll
    for (int ks = 0; ks < 4; ++ks) kf[ks] = *(const LAS bf16x8*)(Kimg + r * 128 + (((2 * ks + h) ^ ((r >> 1) & 7)) << 4));
#pragma unroll
    for (int dt = 0; dt < 2; ++dt) { const int d = 32 * dt + (lane & 31);
#pragma unroll
        for (int s = 0; s < 2; ++s) { const int c = (row0 >> 3) + 2 * s + h; vf[dt][s] = *(const LAS bf16x8*)(Vimg + d * (NK * 2) + ((c ^ (d & 15)) << 4)); } }
}
template <int NK>
__device__ __forceinline__ void load_k_frags(bf16x8 (&kf)[4], const LAS unsigned char* Kimg, int row0, int lane) {
    const int r = row0 + pi32(lane & 31), h = lane >> 5;
#pragma unroll
    for (int ks = 0; ks < 4; ++ks) kf[ks] = *(const LAS bf16x8*)(Kimg + r * 128 + (((2 * ks + h) ^ ((r >> 1) & 7)) << 4));
}
template <int NK>
__device__ __forceinline__ void load_v_frags(bf16x8 (&vf)[2][2], const LAS unsigned char* Vimg, int row0, int lane) {
    const int h = lane >> 5;
#pragma unroll
    for (int dt = 0; dt < 2; ++dt) { const int d = 32 * dt + (lane & 31);
#pragma unroll
        for (int s = 0; s < 2; ++s) { const int c = (row0 >> 3) + 2 * s + h; vf[dt][s] = *(const LAS bf16x8*)(Vimg + d * (NK * 2) + ((c ^ (d & 15)) << 4)); } }
}
__device__ __forceinline__ f32x16 qk_tile(const bf16x8 (&kf)[4], const bf16x8 (&qf)[4], const f32x16& cv) {
    f32x16 S = __builtin_amdgcn_mfma_f32_32x32x16_bf16(kf[0], qf[0], cv, 0, 0, 0);
#pragma unroll
    for (int ks = 1; ks < 4; ++ks) S = __builtin_amdgcn_mfma_f32_32x32x16_bf16(kf[ks], qf[ks], S, 0, 0, 0);
    return S;
}
template <int MODE>
__device__ __forceinline__ void softmax_pv(f32x16& S, const bf16x8 (&vf)[2][2], float& l, f32x16 (&O)[2], int a, int h) {
    if (MODE != 0) {
#pragma unroll
        for (int i = 0; i < 16; ++i) { const int c = pi32((i & 3) + 8 * (i >> 2) + 4 * h); const bool dead = (MODE == 1) ? (c > a) : (c <= a); if (dead) S[i] = -1e30f; }
    }
    float s0 = 0.f, s1 = 0.f;
#pragma unroll
    for (int i = 0; i < 16; i += 2) { S[i] = __builtin_amdgcn_exp2f(S[i]); S[i + 1] = __builtin_amdgcn_exp2f(S[i + 1]); s0 += S[i]; s1 += S[i + 1]; }
    l += s0 + s1;
    bf16x8 pb[2];
#pragma unroll
    for (int s = 0; s < 2; ++s) { u32x4 w; w.x = pk2(S[8 * s], S[8 * s + 1]); w.y = pk2(S[8 * s + 2], S[8 * s + 3]); w.z = pk2(S[8 * s + 4], S[8 * s + 5]); w.w = pk2(S[8 * s + 6], S[8 * s + 7]); pb[s] = __builtin_bit_cast(bf16x8, w); }
#pragma unroll
    for (int dt = 0; dt < 2; ++dt)
#pragma unroll
        for (int s = 0; s < 2; ++s) O[dt] = __builtin_amdgcn_mfma_f32_32x32x16_bf16(vf[dt][s], pb[s], O[dt], 0, 0, 0);
}
template <int NK, int N, int MFIRST, int MLAST>
__device__ __forceinline__ void attn_run(const LAS unsigned char* Kimg, const LAS unsigned char* Vimg, int row0, const bf16x8 (&qf)[4], const f32x16& cv, float& l, f32x16 (&O)[2], int lane) {
    const int a = lane & 31, h = lane >> 5;
    bf16x8 kf[4], vfa[2][2], vfb[2][2];
    load_k_frags<NK>(kf, Kimg, row0, lane); load_v_frags<NK>(vfa, Vimg, row0, lane);
    f32x16 S = qk_tile(kf, qf, cv);
#pragma unroll
    for (int t = 0; t < N; ++t) {
        f32x16 Sn;
        if (t + 1 < N) { load_k_frags<NK>(kf, Kimg, row0 + 32 * (t + 1), lane); if (t & 1) load_v_frags<NK>(vfa, Vimg, row0 + 32 * (t + 1), lane); else load_v_frags<NK>(vfb, Vimg, row0 + 32 * (t + 1), lane);
            Sn = qk_tile(kf, qf, cv); }
        if (t == 0 && MFIRST != 0) { if (t & 1) softmax_pv<MFIRST>(S, vfb, l, O, a, h); else softmax_pv<MFIRST>(S, vfa, l, O, a, h); }
        else if (t == N - 1 && MLAST != 0) { if (t & 1) softmax_pv<MLAST>(S, vfb, l, O, a, h); else softmax_pv<MLAST>(S, vfa, l, O, a, h); }
        else { if (t & 1) softmax_pv<0>(S, vfb, l, O, a, h); else softmax_pv<0>(S, vfa, l, O, a, h); }
        if (t + 1 < N) S = Sn;
    }
}
template <int NK, int PVAR>
__device__ __forceinline__ void attn_run8(const LAS unsigned char* Kimg, const LAS unsigned char* Vimg, const bf16x8 (&qf)[4], const f32x16& cv, float& l, f32x16 (&O)[2], int lane) {
    const int a = lane & 31, h = lane >> 5;
    bf16x8 kf[4], vfa[2][2], vfb[2][2];
    load_k_frags<NK>(kf, Kimg, 0, lane); load_v_frags<NK>(vfa, Vimg, 0, lane);
    if (PVAR == 4) load_v_frags<NK>(vfb, Vimg, 32, lane);
#define QKT() ((PVAR == 5) ? cv : qk_tile(kf, qf, cv))
#define SMPV(S_, vf_) do { if (PVAR == 3) { bf16x8 pb[2]; _Pragma("unroll") for (int s = 0; s < 2; ++s) { u32x4 w; w.x = pk2(S_[8 * s], S_[8 * s + 1]); w.y = pk2(S_[8 * s + 2], S_[8 * s + 3]); w.z = pk2(S_[8 * s + 4], S_[8 * s + 5]); w.w = pk2(S_[8 * s + 6], S_[8 * s + 7]); pb[s] = __builtin_bit_cast(bf16x8, w); } \
        _Pragma("unroll") for (int dt = 0; dt < 2; ++dt) _Pragma("unroll") for (int s = 0; s < 2; ++s) O[dt] = __builtin_amdgcn_mfma_f32_32x32x16_bf16(vf_[dt][s], pb[s], O[dt], 0, 0, 0); } \
      else if (PVAR == 6) { _Pragma("unroll") for (int i = 0; i < 16; ++i) { l += __builtin_amdgcn_exp2f(S_[i]); } asm volatile("" :: "v"(vf_[0][0]), "v"(vf_[1][1])); } \
      else softmax_pv<0>(S_, vf_, l, O, a, h); } while (0)
    f32x16 S = QKT();
#pragma unroll 1
    for (int j = 0; j < 3; ++j) {
        { if (PVAR != 4) { load_k_frags<NK>(kf, Kimg, 64 * j + 32, lane); load_v_frags<NK>(vfb, Vimg, 64 * j + 32, lane); } f32x16 Sn = QKT(); SMPV(S, vfa); S = Sn; }
        { if (PVAR != 4) { load_k_frags<NK>(kf, Kimg, 64 * j + 64, lane); load_v_frags<NK>(vfa, Vimg, 64 * j + 64, lane); } f32x16 Sn = QKT(); SMPV(S, vfb); S = Sn; }
    }
    { if (PVAR != 4) { load_k_frags<NK>(kf, Kimg, 224, lane); load_v_frags<NK>(vfb, Vimg, 224, lane); } f32x16 Sn = QKT(); SMPV(S, vfa); S = Sn; }
    SMPV(S, vfb);
#undef QKT
#undef SMPV
}
template <int NK>
__device__ __forceinline__ void attn_run_own(const LAS unsigned char* Kimg, const LAS unsigned char* Vimg, int w, const bf16x8 (&qf)[4], const f32x16& cv, float& l, f32x16 (&O)[2], int lane) {
    const int a = lane & 31, h = lane >> 5;
    bf16x8 kf[4], vfa[2][2], vfb[2][2];
    load_k_frags<NK>(kf, Kimg, 0, lane); load_v_frags<NK>(vfa, Vimg, 0, lane);
    f32x16 S = qk_tile(kf, qf, cv);
    int t = 0;
#pragma unroll 1
    for (; t + 2 <= w; t += 2) {
        { load_k_frags<NK>(kf, Kimg, 32 * t + 32, lane); load_v_frags<NK>(vfb, Vimg, 32 * t + 32, lane); f32x16 Sn = qk_tile(kf, qf, cv); softmax_pv<0>(S, vfa, l, O, a, h); S = Sn; }
        { load_k_frags<NK>(kf, Kimg, 32 * t + 64, lane); load_v_frags<NK>(vfa, Vimg, 32 * t + 64, lane); f32x16 Sn = qk_tile(kf, qf, cv); softmax_pv<0>(S, vfb, l, O, a, h); S = Sn; }
    }
    if (t < w) { load_k_frags<NK>(kf, Kimg, 32 * t + 32, lane); load_v_frags<NK>(vfb, Vimg, 32 * t + 32, lane); f32x16 Sn = qk_tile(kf, qf, cv); softmax_pv<0>(S, vfa, l, O, a, h); softmax_pv<1>(Sn, vfb, l, O, a, h); }
    else softmax_pv<1>(S, vfa, l, O, a, h);
}
__device__ __forceinline__ void attn_store(const f32x16 (&O)[2], float l, const bf16* gate  , bf16* y  , int h) {
    u32x2 gv[2][4];
#pragma unroll
    for (int dt = 0; dt < 2; ++dt)
#pragma unroll
        for (int q = 0; q < 4; ++q) gv[dt][q] = *(const u32x2*)(gate + 32 * dt + 8 * q + 4 * h);
    const float inv = 1.f / swap32_sum(l);
#pragma unroll
    for (int dt = 0; dt < 2; ++dt)
#pragma unroll
        for (int q = 0; q < 4; ++q) { const int d = 32 * dt + 8 * q + 4 * h; const u32x2 g2 = gv[dt][q];
            u32x2 w; w.x = pk2(O[dt][4 * q] * inv * bflo(g2.x), O[dt][4 * q + 1] * inv * bfhi(g2.x)); w.y = pk2(O[dt][4 * q + 2] * inv * bflo(g2.y), O[dt][4 * q + 3] * inv * bfhi(g2.y));
            *(u32x2*)(y + d) = w; }
}

template <int VAR>
__device__ __forceinline__ void moba_unit(Frame& F, int b, int kvh, int qb, int g) {
    constexpr int IMG = 32768;
    LAS unsigned char* buf0 = F.lds; LAS unsigned char* buf1 = F.lds + 2 * IMG;
    LAS float* km = (LAS float*)(F.lds + LDS_MISC + 1024);
    const int lane = F.lane, wave = F.wave, a = lane & 31, h = lane >> 5;
    const long tok0 = (long)b * SEQ + 256 * qb;
    const bf16* Kb = ((bf16*)(F.ws + WS_MK)) + (size_t)b * SEQ * 128 + kvh * 64;
    const bf16* Vb = ((bf16*)(F.ws + WS_VT)) + (size_t)(128 + kvh * 64) * 256; const long tokb = (long)b * SEQ;
    unsigned kvoff[4], vvoff[4];
#pragma unroll
    for (int i = 0; i < 4; ++i) { const int L = (wave + 8 * i) * 64 + lane; { const int r = L >> 3, s = L & 7, c = s ^ ((r >> 1) & 7); kvoff[i] = (unsigned)(r * 128 + c * 8) * 2u; }
        { const int d = L >> 5, s = L & 31, c = s ^ (d & 15); vvoff[i] = (unsigned)(d * 256 + 8 * c) * 2u; } }
    const char* Kbytes = (const char*)Kb; const char* Vbytes = (const char*)(Vb + (size_t)(tokb >> 8) * 65536);
#define MOBA_STAGE(dstK, blk) do { _Pragma("unroll") for (int i_ = 0; i_ < 4; ++i_) { glds16(Kbytes + (size_t)(blk) * 65536 + kvoff[i_], (dstK) + (wave + 8 * i_) * 1024); \
        glds16(Vbytes + (size_t)(blk) * 131072 + vvoff[i_], (dstK) + IMG + (wave + 8 * i_) * 1024); } } while (0)
    if (VAR != 1) MOBA_STAGE(buf0, qb);
    { const int n = F.tid >> 6, d = F.tid & 63; float s = 0.f;
      if (n < qb) { const int tile = b * 8 + n; s = ((float*)(F.ws + WS_KPART))[((size_t)(tile * 2 + 0) * 2 + kvh) * 64 + d] + ((float*)(F.ws + WS_KPART))[((size_t)(tile * 2 + 1) * 2 + kvh) * 64 + d]; }
      km[n * 64 + d] = s; }
    const size_t row = (size_t)(tok0 + 32 * wave + a);
    const bf16* qp = ((bf16*)(F.ws + WS_MQ)) + row * 384 + kvh * 192 + 8 * h;
    GLDS_WAIT(); __syncthreads();
    unsigned selmask = (VAR == 8) ? 0x7fu : 0u;
    if (qb > 0 && VAR != 8) {
        float sc[8];
#pragma unroll
        for (int n = 0; n < 8; ++n) sc[n] = 0.f;
#pragma unroll
        for (int ks = 0; ks < 4; ++ks) { const bf16x8 q0 = *(const bf16x8*)(qp + 16 * ks), q1 = *(const bf16x8*)(qp + 64 + 16 * ks), q2 = *(const bf16x8*)(qp + 128 + 16 * ks);
#pragma unroll
            for (int j = 0; j < 8; ++j) { const float qs = bf2f((unsigned short)q0[j]) + bf2f((unsigned short)q1[j]) + bf2f((unsigned short)q2[j]); const int d = 16 * ks + 8 * h + j;
#pragma unroll
                for (int n = 0; n < 7; ++n) sc[n] += qs * km[n * 64 + d]; } }
#pragma unroll
        for (int n = 0; n < 7; ++n) { sc[n] = swap32_sum(sc[n]); if (n >= qb) sc[n] = -INFINITY; }
#pragma unroll
        for (int t = 0; t < 3; ++t) { float best = -INFINITY; int bi = -1;
#pragma unroll
            for (int n = 0; n < 7; ++n) if (sc[n] > best) { best = sc[n]; bi = n; }
            if (bi >= 0) { selmask |= 1u << bi;
#pragma unroll
                for (int n = 0; n < 7; ++n) if (n == bi) sc[n] = -INFINITY; } }
    }
    float l = 0.f; f32x16 O[2]; bf16x8 qf[4];
#pragma unroll
    for (int i = 0; i < 16; ++i) { O[0][i] = 0.f; O[1][i] = 0.f; }
#pragma unroll
    for (int ks = 0; ks < 4; ++ks) qf[ks] = *(const bf16x8*)(qp + g * 64 + 16 * ks);
    asm volatile("" : "+v"(qf[0]), "+v"(qf[1]), "+v"(qf[2]), "+v"(qf[3]));
#pragma unroll 1
    for (int s = 0; s <= qb; ++s) {
        LAS unsigned char* cur = (s & 1) ? buf1 : buf0; LAS unsigned char* nxt = (s & 1) ? buf0 : buf1;
        if (s < qb && VAR != 1) MOBA_STAGE(nxt, s);
        if (VAR == 2) {} else if (s == 0) { if (VAR != 7) {
            f32x16 cv;
#pragma unroll
            for (int i = 0; i < 16; ++i) cv[i] = 0.f;
            attn_run_own<256>(cur, cur + IMG, wave, qf, cv, l, O, lane);
        } } else if (VAR != 9) {
            const float cinit = ((selmask >> (s - 1)) & 1u) ? 0.f : -1e30f;
            if (__any(cinit == 0.f)) {
                f32x16 cv;
#pragma unroll
                for (int i = 0; i < 16; ++i) cv[i] = cinit;
                attn_run8<256, (VAR >= 3 ? VAR : 0)>(cur, cur + IMG, qf, cv, l, O, lane);
            }
        }
        GLDS_WAIT(); __syncthreads();
    }
    attn_store(O, l, ((bf16*)(F.ws + WS_MG)) + row * 384 + (kvh * 3 + g) * 64, ((bf16*)(F.ws + (VAR ? WS_END : WS_Y))) + row * DM + 640 + (kvh * 3 + g) * 64, h);
#undef MOBA_STAGE
}

__device__ __forceinline__ void swa_unit(const Params& P, Frame& F, int layer, int b, int kvh, int qblk) {
    constexpr int NK = 384;
    LAS unsigned char* Kimg = F.lds; LAS unsigned char* Vimg = F.lds + NK * 128;
    const int lane = F.lane, wave = F.wave, a = lane & 31, h = lane >> 5;
    const int q0 = 256 * qblk; const long tok0 = (long)b * SEQ + q0;
    const bf16* Kb = ((bf16*)(F.ws + WS_AK)) + ((long)b * SEQ + q0 - 128) * 128 + kvh * 64;
    const bf16* Vb = ((bf16*)(F.ws + WS_VT)) + (size_t)(kvh * 64) * 256;
    stage_kv<NK>(Kimg, Vimg, Kb, Vb, (long)b * SEQ, (long)q0 - 128, 0, wave, lane);
    const size_t row = (size_t)(tok0 + 32 * wave + a);
    const bf16* qp = ((bf16*)(F.ws + WS_AQ)) + row * 384 + kvh * 192 + 8 * h;
    f32x16 cv;
#pragma unroll
    for (int i = 0; i < 16; ++i) cv[i] = 0.f;
    const bool head = (q0 - 128 + 32 * wave) >= 0;
    bf16x8 qfa[3][4]; float sink[3];
#pragma unroll
    for (int g = 0; g < 3; ++g) { sink[g] = kin(15)[layer * 6 + kvh * 3 + g];
#pragma unroll
        for (int ks = 0; ks < 4; ++ks) qfa[g][ks] = *(const bf16x8*)(qp + g * 64 + 16 * ks); }
    asm volatile("" : "+v"(qfa[0][0]), "+v"(qfa[0][1]), "+v"(qfa[0][2]), "+v"(qfa[0][3]), "+v"(qfa[1][0]), "+v"(qfa[1][1]), "+v"(qfa[1][2]), "+v"(qfa[1][3]), "+v"(qfa[2][0]), "+v"(qfa[2][1]), "+v"(qfa[2][2]), "+v"(qfa[2][3]));
    GLDS_WAIT(); __syncthreads();
#pragma unroll
    for (int g = 0; g < 3; ++g) {
        bf16x8 qf[4];
#pragma unroll
        for (int ks = 0; ks < 4; ++ks) qf[ks] = qfa[g][ks];
        float l = 0.5f * __builtin_amdgcn_exp2f(sink[g] * LOG2E);
        f32x16 O[2];
#pragma unroll
        for (int i = 0; i < 16; ++i) { O[0][i] = 0.f; O[1][i] = 0.f; }
        const int r0 = 32 * wave;
        if (head) attn_run<NK, 5, 2, 1>(Kimg, Vimg, r0, qf, cv, l, O, lane);
        else {
#pragma unroll 1
            for (int kt = 4 - wave; kt < 4; ++kt) { bf16x8 kfa[4], vfa[2][2]; load_kv_frags<NK>(kfa, vfa, Kimg, Vimg, r0 + 32 * kt, lane); attn_tile<0>(kfa, vfa, qf, cv, l, O, a, h); }
            { bf16x8 kfa[4], vfa[2][2]; load_kv_frags<NK>(kfa, vfa, Kimg, Vimg, r0 + 128, lane); attn_tile<1>(kfa, vfa, qf, cv, l, O, a, h); }
        }
        attn_store(O, l, ((bf16*)(F.ws + WS_AG)) + row * 384 + (kvh * 3 + g) * 64, ((bf16*)(F.ws + WS_Y)) + row * DM + 256 + (kvh * 3 + g) * 64, h);
    }
    __syncthreads();
}

__device__ __forceinline__ void ssm_unit(Frame& F, int layer, int b, int g) {
    constexpr int APITCH = 528;
    LAS unsigned char* AU = F.lds;
    LAS unsigned char* SC = F.lds + 128 * APITCH;
    LAS float* seg = (LAS float*)(F.lds + 2 * 128 * APITCH);
    const int lane = F.lane, wave = F.wave, tid = F.tid, fr = lane & 15, fq = lane >> 4;
    const int pair = layer * 16 + g;
    const bf16* TE = ((bf16*)(F.ws + WS_TE)) + (size_t)pair * TE_ELEMS; const bf16* GM = ((bf16*)(F.ws + WS_G)) + (size_t)pair * G_ELEMS;
    u32x4 uv[8];
    { const bf16* up = ((bf16*)(F.ws + WS_U)) + (size_t)(b * 16 + g) * SEQ * 16;
#pragma unroll
      for (int i = 0; i < 8; ++i) { const int idx = tid + 512 * i; uv[i] = *(const u32x4*)(up + (size_t)idx * 8); } }
    bf16x8 gf[8];
#pragma unroll
    for (int ks = 0; ks < 8; ++ks) gf[ks] = *(const bf16x8*)(GM + (size_t)(16 * wave + fr) * 256 + 32 * ks + 8 * fq);
    const float ar = ((float*)(F.ws + WS_AT))[(size_t)pair * 128 + 2 * lane], ai = ((float*)(F.ws + WS_AT))[(size_t)pair * 128 + 2 * lane + 1];
    bf16x8 tfu[2][8], tfc[2][4];
#pragma unroll
    for (int half = 0; half < 2; ++half) { const int i = half ? 15 - wave : wave, nks = (i >> 1) + 1; const bf16* tp = TE + (size_t)(16 * i + fr) * 384 + 8 * fq;
#pragma unroll
        for (int ks = 0; ks < 8; ++ks) tfu[half][ks] = *(const bf16x8*)(tp + 32 * (ks < nks ? ks : 0));
#pragma unroll
        for (int ks = 0; ks < 4; ++ks) tfc[half][ks] = *(const bf16x8*)(tp + 256 + 32 * ks); }
#pragma unroll
    for (int i = 0; i < 8; ++i) { const int idx = tid + 512 * i, t = idx >> 1, hf = idx & 1; *(LAS u32x4*)(AU + (t >> 4) * APITCH + ((t & 15) * 16 + 8 * hf) * 2) = uv[i]; }
    __syncthreads();
    {
#pragma unroll
        for (int rt = 0; rt < 8; ++rt) { f32x4 acc = {0.f, 0.f, 0.f, 0.f};
#pragma unroll
            for (int ks = 0; ks < 8; ++ks) { const bf16x8 af = *(const LAS bf16x8*)(AU + (16 * rt + fr) * APITCH + (32 * ks + 8 * fq) * 2); acc = __builtin_amdgcn_mfma_f32_16x16x32_bf16(gf[ks], af, acc, 0, 0, 0); }
            *(LAS f32x4*)(SC + (16 * rt + fr) * APITCH + (16 * wave + 4 * fq) * 4) = acc; }
    }
    __syncthreads();
    {
        float lr = 0.f, li = 0.f, locr[16], loci[16];
#pragma unroll
        for (int k = 0; k < 16; ++k) { locr[k] = lr; loci[k] = li; const f32x2_t s = *(const LAS f32x2_t*)(SC + (16 * wave + k) * APITCH + lane * 8);
            const float nr = ar * lr - ai * li + s.x, ni = ar * li + ai * lr + s.y; lr = nr; li = ni; }
        seg[(wave * 64 + lane) * 2] = lr; seg[(wave * 64 + lane) * 2 + 1] = li;
        __syncthreads();
        float a16r = ar, a16i = ai;
#pragma unroll
        for (int q = 0; q < 4; ++q) { const float tr = a16r * a16r - a16i * a16i, ti = 2.f * a16r * a16i; a16r = tr; a16i = ti; }
        float ir = 0.f, ii = 0.f;
        for (int w2 = 0; w2 < wave; ++w2) { const float sr = seg[(w2 * 64 + lane) * 2], si = seg[(w2 * 64 + lane) * 2 + 1]; const float nr = a16r * ir - a16i * ii + sr, ni = a16r * ii + a16i * ir + si; ir = nr; ii = ni; }
        float pr = 1.f, pi = 0.f;
#pragma unroll
        for (int k = 0; k < 16; ++k) { const float cr = locr[k] + pr * ir - pi * ii, ci = loci[k] + pr * ii + pi * ir;
            *(LAS unsigned*)(SC + (16 * wave + k) * APITCH + lane * 4) = pk2(cr, ci);
            const float tr = pr * ar - pi * ai, ti = pr * ai + pi * ar; pr = tr; pi = ti; }
    }
    __syncthreads();
#pragma unroll
    for (int half = 0; half < 2; ++half) {
        const int i = half ? 15 - wave : wave;
        f32x4 acc[8];
#pragma unroll
        for (int rt = 0; rt < 8; ++rt) acc[rt] = (f32x4){0.f, 0.f, 0.f, 0.f};
        const int nks = (i >> 1) + 1;
#pragma unroll
        for (int ks = 0; ks < 8; ++ks) { if (ks < nks) {
#pragma unroll
            for (int rt = 0; rt < 8; ++rt) { const bf16x8 af = *(const LAS bf16x8*)(AU + (16 * rt + fr) * APITCH + (32 * ks + 8 * fq) * 2); acc[rt] = __builtin_amdgcn_mfma_f32_16x16x32_bf16(tfu[half][ks], af, acc[rt], 0, 0, 0); } } }
#pragma unroll
        for (int ks = 0; ks < 4; ++ks) {
#pragma unroll
            for (int rt = 0; rt < 8; ++rt) { const bf16x8 af = *(const LAS bf16x8*)(SC + (16 * rt + fr) * APITCH + (32 * ks + 8 * fq) * 2); acc[rt] = __builtin_amdgcn_mfma_f32_16x16x32_bf16(tfc[half][ks], af, acc[rt], 0, 0, 0); } }
#pragma unroll
        for (int rt = 0; rt < 8; ++rt) { const int chunk = 16 * rt + fr; u32x2 w; w.x = pk2(gelu_tanh_f(acc[rt][0]), gelu_tanh_f(acc[rt][1])); w.y = pk2(gelu_tanh_f(acc[rt][2]), gelu_tanh_f(acc[rt][3]));
            __hip_atomic_store((unsigned long long*)(((bf16*)(F.ws + WS_YPRE)) + ((size_t)(b * 16 + g) * SEQ + 16 * chunk + i) * 16 + 4 * fq), ((unsigned long long)w.y << 32) | w.x, __ATOMIC_RELAXED, __HIP_MEMORY_SCOPE_AGENT); }
    }
    asm volatile("s_waitcnt vmcnt(0)" ::: "memory");
    __syncthreads();
    if (tid == 0) __hip_atomic_fetch_add(F.ctl + CW_SSMDONE + 64 * (layer * NB + b), 1u, __ATOMIC_RELAXED, __HIP_MEMORY_SCOPE_AGENT);
}

__device__ __forceinline__ void glu_unit(const Params& P, Frame& F, int layer, int b, int j) {
    constexpr int APITCH = 528;
    LAS unsigned char* AT_ = F.lds;
    const int lane = F.lane, wave = F.wave, tid = F.tid, fr = lane & 15, fq = lane >> 4;
    const size_t tok0 = (size_t)b * SEQ + 128 * j;
    const bf16* wp = ((bf16*)(F.ws + WS_GLU)) + (size_t)layer * 65536 + (size_t)(32 * wave + fr) * 256 + 8 * fq;
    bf16x8 wf[8][2];
#pragma unroll
    for (int ks = 0; ks < 8; ++ks) { wf[ks][0] = *(const bf16x8*)(wp + 32 * ks); wf[ks][1] = *(const bf16x8*)(wp + 16 * 256 + 32 * ks); }
    if (tid == 0) { unsigned* c = F.ctl + CW_SSMDONE + 64 * (layer * NB + b); unsigned sp = 0;
        while (__hip_atomic_load(c, __ATOMIC_RELAXED, __HIP_MEMORY_SCOPE_AGENT) < 16u) { __builtin_amdgcn_s_sleep(2); if (++sp > (1u << 22)) break; }
        __builtin_amdgcn_fence(__ATOMIC_ACQUIRE, "agent"); asm volatile("s_waitcnt vmcnt(0)" ::: "memory"); }
    __syncthreads();
    { const bf16* yp = ((bf16*)(F.ws + WS_YPRE)) + ((size_t)b * 16 * SEQ + 128 * j) * 16;
#pragma unroll
      for (int i = 0; i < 8; ++i) { const int idx = tid + 512 * i, c = idx >> 7, t = idx & 127; const u32x4 v = *(const u32x4*)(yp + ((size_t)(c >> 1) * SEQ + t) * 16 + 8 * (c & 1)); *(LAS u32x4*)(AT_ + t * APITCH + c * 16) = v; } }
    f32x4 acc[8][2];
#pragma unroll
    for (int rt = 0; rt < 8; ++rt) { acc[rt][0] = (f32x4){0.f, 0.f, 0.f, 0.f}; acc[rt][1] = (f32x4){0.f, 0.f, 0.f, 0.f}; }
    __syncthreads();
#pragma unroll
    for (int ks = 0; ks < 8; ++ks)
#pragma unroll
        for (int rt = 0; rt < 8; ++rt) { const bf16x8 af = *(const LAS bf16x8*)(AT_ + (16 * rt + fr) * APITCH + (32 * ks + 8 * fq) * 2);
            acc[rt][0] = __builtin_amdgcn_mfma_f32_16x16x32_bf16(wf[ks][0], af, acc[rt][0], 0, 0, 0); acc[rt][1] = __builtin_amdgcn_mfma_f32_16x16x32_bf16(wf[ks][1], af, acc[rt][1], 0, 0, 0); }
    const float* gb = kin(12) + layer * 256;
#pragma unroll
    for (int nt = 0; nt < 2; ++nt) { const int n0 = 32 * wave + 16 * nt + 4 * fq; const f32x4 bv = *(const f32x4*)(gb + n0);
#pragma unroll
        for (int rt = 0; rt < 8; ++rt) { const int t = 16 * rt + fr; const u32x2 yp = *(const LAS u32x2*)(AT_ + t * APITCH + n0 * 2); const u32x2 sg = *(const u32x2*)(((bf16*)(F.ws + WS_SG)) + (tok0 + t) * 256 + n0);
            const f32x4 z = acc[rt][nt] + bv; u32x2 w;
            w.x = pk2(bflo(yp.x) * sigmoid_f(z[0]) * bflo(sg.x), bfhi(yp.x) * sigmoid_f(z[1]) * bfhi(sg.x));
            w.y = pk2(bflo(yp.y) * sigmoid_f(z[2]) * bflo(sg.y), bfhi(yp.y) * sigmoid_f(z[3]) * bfhi(sg.y));
            *(u32x2*)(((bf16*)(F.ws + WS_Y)) + (tok0 + t) * DM + n0) = w; } }
    __syncthreads();
}

__device__ __forceinline__ void mixer_phase(const Params& P, Frame& F, int qslot, int layer, int mask) {
    volatile LAS int* qw = (volatile LAS int*)(F.lds + LDS_CTL);
    unsigned* head = F.ctl + CW_QUEUE + 64 * qslot;
    for (;;) {
        if (F.tid == 0) qw[0] = (int)atomicAdd(head, 1u);
        __syncthreads();
        const int it = qw[0];
        __syncthreads();
        if (it >= 1536) break;
        Frame Fu = phase_frame(F);
#ifndef NO_MOBA
        if (it < 768 && (mask & 1)) { const int qb = 7 - it / 96, r = it % 96, b = r / 6, kvh = (r % 6) / 3, g = r % 3;
            if (mask & 8) moba_unit<1>(Fu, b, kvh, qb, g); else if (mask & 16) moba_unit<2>(Fu, b, kvh, qb, g);
#ifdef MOBA_PVAR
            else if (mask & 64) moba_unit<MOBA_PVAR>(Fu, b, kvh, qb, g);
#endif
            else moba_unit<0>(Fu, b, kvh, qb, g); }
#endif
#ifndef NO_SSM
        if (it >= 768 && it < 1024 && (mask & 2)) { const int r = it - 768; ssm_unit(Fu, layer, r >> 4, r & 15); }
#endif
#ifndef NO_SWA
        if (it >= 1024 && it < 1280 && (mask & 4)) { const int r = it - 1024; swa_unit(P, Fu, layer, r >> 4, (r >> 3) & 1, r & 7); }
#endif
        if (it >= 1280 && (mask & 32)) { const int r = it - 1280; glu_unit(P, Fu, layer, r >> 4, r & 15); }
    }
}

#define XB_TMO      128
#define XB_XCNT(j)  (256  + 64 * (j))
#define XB_XSUB(j)  (1280 + 64 * (j))
#define XB_XGEN(j)  (2304 + 64 * (j))
#define XB_TOP      3328
#define XB_TOPGEN   3392
#define XCD_BAR_WORDS 3456
#define XB_SPIN_CAP (1u << 18)

__device__ __forceinline__ unsigned xb_ld(unsigned* p)              { return __hip_atomic_load(p, __ATOMIC_RELAXED, __HIP_MEMORY_SCOPE_AGENT); }
__device__ __forceinline__ unsigned xb_add(unsigned* p, unsigned v) { return __hip_atomic_fetch_add(p, v, __ATOMIC_RELAXED, __HIP_MEMORY_SCOPE_AGENT); }
__device__ __forceinline__ unsigned xb_xcc_id() { return (unsigned)__builtin_amdgcn_s_getreg((3 << 11) | 20) & 0xFu; }
#define XB_SPIN(cond, bar) do { unsigned _sp = 0; while (cond) { __builtin_amdgcn_s_sleep(1); \
    if ((++_sp & 255u) == 0u) { if (xb_ld(&(bar)[XB_TMO])) break; if (_sp > XB_SPIN_CAP) { atomicAdd(&(bar)[XB_TMO], 1u); break; } } } } while (0)

struct XcdBarrier {
    unsigned* bar; unsigned x;
    volatile LAS unsigned* st;
};

__device__ __forceinline__ XcdBarrier xcd_barrier_post(unsigned* bar, volatile LAS unsigned* st) {
    XcdBarrier b; b.bar = bar; b.x = xb_xcc_id(); b.st = st;
    if (threadIdx.x == 0) (void)xb_add(&bar[XB_XCNT(b.x)], 1u);
    return b;
}
__device__ __forceinline__ void xcd_barrier_complete(unsigned* bar, unsigned x, unsigned& nloc, unsigned& nx) {
    const unsigned G = gridDim.x * gridDim.y * gridDim.z;
    unsigned sum, cnt, mine, sp = 0u;
    for (;;) {
        sum = 0u; cnt = 0u; mine = 0u;
#pragma unroll 1
        for (unsigned j = 0; j < 16; ++j) { const unsigned c = xb_ld(&bar[XB_XCNT(j)]); sum += c; cnt += (c > 0u) ? 1u : 0u; mine = (j == x) ? c : mine; }
        if (sum == G) break;
        __builtin_amdgcn_s_sleep(1);
        if ((++sp & 255u) == 0u) { if (xb_ld(&bar[XB_TMO])) break; if (sp > XB_SPIN_CAP) { atomicAdd(&bar[XB_TMO], 1u); break; } }
    }
    nloc = mine > 0u ? mine : 1u; nx = cnt > 0u ? cnt : 1u;
}

__device__ __forceinline__ void xcd_barrier(const XcdBarrier& b) {
    asm volatile("s_waitcnt vmcnt(0)" ::: "memory");
    __syncthreads();
    if (threadIdx.x == 0) {
        unsigned* bar = b.bar;
        __builtin_amdgcn_s_waitcnt(0);
        unsigned nloc = b.st[0], nx = b.st[1];
        if (nloc == 0u) { xcd_barrier_complete(bar, b.x, nloc, nx); b.st[0] = nloc; b.st[1] = nx; }
        const unsigned old = xb_add(&bar[XB_XSUB(b.x)], 1u);
        const unsigned gen = old / nloc;
        if (old + 1u == (gen + 1u) * nloc) {
            __builtin_amdgcn_fence(__ATOMIC_RELEASE, "agent");
            asm volatile("s_waitcnt vmcnt(0)" ::: "memory");
            const unsigned og = xb_add(&bar[XB_TOP], 1u);
            const unsigned tg = og / nx;
            if (og + 1u == (tg + 1u) * nx) xb_add(&bar[XB_TOPGEN], 1u);
            else XB_SPIN(xb_ld(&bar[XB_TOPGEN]) == tg, bar);
            __builtin_amdgcn_fence(__ATOMIC_ACQUIRE, "agent");
            xb_add(&bar[XB_XGEN(b.x)], 1u);
            asm volatile("s_waitcnt vmcnt(0)" ::: "memory");
        } else {
            XB_SPIN(xb_ld(&bar[XB_XGEN(b.x)]) == gen, bar);
            __builtin_amdgcn_fence(__ATOMIC_ACQUIRE, "agent");
            asm volatile("s_waitcnt vmcnt(0)" ::: "memory");
        }
    }
    __syncthreads();
}

constexpr int CW_BAR = 4096;
#ifndef USE_COOP_LAUNCH
#define USE_COOP_LAUNCH 0
#endif
#ifndef REP_P0
#define REP_P0 1
#endif
#ifndef REP_P1
#define REP_P1 1
#endif
#ifndef REP_MIX
#define REP_MIX 1
#endif
#ifndef REP_GLU
#define REP_GLU 1
#endif
#ifndef REP_P3L0
#define REP_P3L0 1
#endif
#ifndef REP_SYNC
#define REP_SYNC 1
#endif
#ifndef P3_PROBE_SKIP
#define P3_PROBE_SKIP 0
#endif
#ifndef MIX_EXTRA_MASK
#define MIX_EXTRA_MASK 39
#endif
#ifndef USE_CG_SYNC
#define USE_CG_SYNC 0
#endif
#define GRID_SYNC() do { for (int r_ = 0; r_ < REP_SYNC; ++r_) { if (USE_CG_SYNC) cg::this_grid().sync(); else xcd_barrier(xbar); } STAMP(); } while (0)
#ifdef PROBE_TS_A
#define STAMP() do { if (n_stamp == PROBE_TS_A) ts_a = __builtin_amdgcn_s_memrealtime(); if (n_stamp == PROBE_TS_B) ts_b = __builtin_amdgcn_s_memrealtime(); ++n_stamp; } while (0)
#else
#define STAMP() do {} while (0)
#endif
__global__ void __launch_bounds__(512, 2) mk_fwd(Params P) {
    extern __shared__ __attribute__((aligned(16))) unsigned char lds_raw[];
    Frame F;
    F.lds = (LAS unsigned char*)lds_raw; F.tid = threadIdx.x; F.lane = F.tid & 63; F.wave = __builtin_amdgcn_readfirstlane(F.tid >> 6); F.G = gridDim.x; F.bid = blockIdx.x;
    F.out = (float*)kin(19); F.ws = (unsigned char*)kin(20); F.ctl = (unsigned*)(F.ws + WS_CTL);
    if (F.tid < 128) ((LAS unsigned*)(F.lds + LDS_CTL))[F.tid] = 0u;
    __syncthreads();
    const XcdBarrier xbar = xcd_barrier_post(F.ctl + CW_BAR, (volatile LAS unsigned*)(F.lds + LDS_CTL + 16));

    int n_stamp = 0; unsigned long long ts_a = 0, ts_b = 0; (void)n_stamp; (void)ts_a; (void)ts_b;
    STAMP();
#ifndef NO_P0
    for (int rep = 0; rep < REP_P0; ++rep) { Frame Fp = phase_frame(F); p0_prologue(P, Fp); }
#endif
    GRID_SYNC();
#pragma unroll 1
    for (int layer = 0; layer < DEPTH; ++layer) {
#ifndef NO_P1
        for (int rep = 0; rep < REP_P1; ++rep) {
            Frame Fp = phase_frame(F);
            pg8::Gemm g{((bf16*)(Fp.ws + WS_Z)), ((bf16*)(Fp.ws + WS_Z)), ZROWS, ZROWS, DM}; const SchedTab S = make_sched<0>(Fp, NTT + 10 * layer);
            EpiProj E{NTT + 10 * layer, layer, Fp.ws};
            pg8::gemm_phase<EpiProj, SchedTab, true, true>(F.lds, g, S, E);
        }
#endif
        GRID_SYNC();
#ifndef NO_MIX
        for (int rep = 0; rep < REP_MIX; ++rep) { Frame Fp = phase_frame(F); mixer_phase(P, Fp, layer + 2 * rep, layer, rep ? MIX_EXTRA_MASK : 39); }
#endif
        GRID_SYNC();
#ifndef NO_P3
        {
            Frame Fp = phase_frame(F);
            pg8::Gemm g{((bf16*)(Fp.ws + WS_Y)), ((bf16*)(Fp.ws + WS_WOUT)) + (size_t)layer * DM * DM, MTOK, DM, DM}; const SchedTab S = make_sched<1>(Fp, 0);
            EpiOut E{kin(0), F.out, ((bf16*)(Fp.ws + WS_Z)), ((float*)(Fp.ws + WS_ROWSS)), layer + 1 < DEPTH ? 1 : 0, (LAS float*)(F.lds + LDS_MISC + 4096), 0};
            pg8::gemm_phase<EpiOut, SchedTab, true, true>(F.lds, g, S, E);
        }
#endif
        if (layer + 1 < DEPTH) GRID_SYNC();
    }
#ifdef PROBE_TS_A
    GRID_SYNC();
    if (blockIdx.x == 0) { const unsigned long long n = (ts_b - ts_a) * PROBE_TS_MULT / PROBE_TS_DIV; for (unsigned long long i = threadIdx.x; i < n; i += 512) F.out[i] += 0.08f; }
#endif
}

extern "C" void kernel_launch(void* const* d_in, const int* in_sizes, int n_in, void* d_out, int out_size, void* d_ws, size_t ws_size, hipStream_t stream) {
    static int grid = 0;
    if (grid == 0) {
        if (n_in != 19 || out_size != MTOK * DM || ws_size < WS_END) { fprintf(stderr, "kernel_launch: unexpected problem (n_in %d out %d ws %zu)\n", n_in, out_size, ws_size); grid = -1; return; }
        int dev = 0, cus = 0, per_cu = 0;
        (void)hipGetDevice(&dev);
        (void)hipDeviceGetAttribute(&cus, hipDeviceAttributeMultiprocessorCount, dev);
        (void)hipFuncSetAttribute((const void*)mk_fwd, hipFuncAttributeMaxDynamicSharedMemorySize, LDS_BYTES);
        (void)hipOccupancyMaxActiveBlocksPerMultiprocessor(&per_cu, (const void*)mk_fwd, 512, LDS_BYTES);
        if (per_cu < 1) { fprintf(stderr, "kernel_launch: occupancy query says %d blocks per CU\n", per_cu); per_cu = 1; }
        grid = cus;
    }
    if (grid < 0) return;
    (void)hipMemsetAsync((char*)d_ws + WS_CTL, 0, CTL_BYTES, stream);
    Params p{};
    for (int i = 0; i < 19; ++i) p.in[i] = (const float*)d_in[i];
    p.out = (float*)d_out; p.ws = (unsigned char*)d_ws;
#if USE_COOP_LAUNCH
    void* args[] = {&p};
    hipError_t e = hipLaunchCooperativeKernel((const void*)mk_fwd, dim3(grid), dim3(512), args, LDS_BYTES, stream);
    if (e != hipSuccess) fprintf(stderr, "cooperative launch failed: %s (grid %d)\n", hipGetErrorString(e), grid);
#else
    hipLaunchKernelGGL(mk_fwd, dim3(grid), dim3(512), LDS_BYTES, stream, p);
    const hipError_t e = hipPeekAtLastError();
    if (e != hipSuccess) fprintf(stderr, "launch failed: %s (grid %d)\n", hipGetErrorString(e), grid);
#endif
}
```

```cpp
#include <hip/hip_runtime.h>
#include <hip/hip_cooperative_groups.h>
#include <cstdio>
#include <cstdint>
namespace cg = cooperative_groups;
namespace pg8 {
#define PG8_LAS __attribute__((address_space(3)))
typedef unsigned short bf16_t;
typedef short bf16x8 __attribute__((ext_vector_type(8)));
typedef float f32x4 __attribute__((ext_vector_type(4)));
typedef unsigned u32x4 __attribute__((ext_vector_type(4)));
constexpr int BM = 256, BK = 64, HALF = 128, HTB = HALF * BK * 2  , STAGE_BYTES = 8 * HTB, NXCD = 8, WGM = 8;

__host__ __device__ __forceinline__ int lds_byte(int r, int c) { const int st = (r >> 4) * 2 + (c >> 5), rr = r & 15, cc = c & 31, ob = rr * 64 + cc * 2; return st * 1024 + (ob ^ (((ob >> 9) & 1) << 5)); }
__host__ __device__ __forceinline__ void stage_rc(int b, int& R, int& C) { const int st = b / 1024, sb = b % 1024, swz = sb ^ (((sb >> 9) & 1) << 5); R = (st >> 1) * 16 + swz / 64; C = (st & 1) * 32 + (swz % 64) / 2; }
__host__ __device__ __forceinline__ int perm32(int rho) { const int n = rho >> 4, i = rho & 15; return 8 * (i >> 2) + 4 * n + (i & 3); }

struct Unit { int pm, pn; };
struct Gemm { const bf16_t* A; const bf16_t* Bt; int M, N, K; };

__device__ __forceinline__ unsigned cvt_pk_bf16(float lo, float hi) { unsigned r; asm volatile("v_cvt_pk_bf16_f32 %0, %1, %2" : "=v"(r) : "v"(lo), "v"(hi)); return r; }
typedef float f32x2 __attribute__((ext_vector_type(2)));
template <class Epi, class Sched, bool ALIGN_EPI = false, bool SP2 = false>
__device__ __forceinline__ void gemm_phase(PG8_LAS unsigned char* lds, const Gemm g, const Sched& S, const Epi& E) {
    int tid_ = threadIdx.x; asm volatile("" : "+v"(tid_));
    const int tid = tid_, wid = __builtin_amdgcn_readfirstlane(tid >> 6), lane = tid & 63, wr = wid >> 2, wc = wid & 3, fr = lane & 15, fq = lane >> 4;
    const int K = g.K, nt = K / BK;
    unsigned voffA[2], voffB[2];
#pragma unroll
    for (int i = 0; i < 2; ++i) { int R, C; stage_rc(tid * 16 + i * 8192, R, C); const int Rb = Epi::PERM ? ((R & ~31) + perm32(R & 31)) : R;
        voffA[i] = (unsigned)(R * K + C) * 2u; voffB[i] = (unsigned)(Rb * K + C) * 2u; }
    const size_t kstep = (size_t)(BK * 2);
    const size_t hstep = (size_t)HALF * K * 2;
    const size_t tstep = 2 * hstep;
    const unsigned ldsw = (unsigned)wid * 1024u;
    const int aoff = lds_byte(wr * 64 + fr, fq * 8), boff = lds_byte(wc * 32 + fr, fq * 8);
#define PG8_SA(b, h) (((b) * 2 + (h)) * HTB)
#define PG8_SB(b, h) ((4 + (b) * 2 + (h)) * HTB)
#define PG8_STAGE(bufoff, gbase, voff) do { _Pragma("unroll") for (int _i = 0; _i < 2; ++_i) \
        __builtin_amdgcn_global_load_lds((const unsigned*)((const char*)(gbase) + (voff)[_i]), (PG8_LAS unsigned*)(lds + (bufoff) + ldsw + _i * 8192), 16, 0, 0); } while (0)
#define PG8_LDA(dst, b, h) do { _Pragma("unroll") for (int m = 0; m < 4; ++m) _Pragma("unroll") for (int k = 0; k < 2; ++k) dst[m][k] = *(const PG8_LAS bf16x8*)(lds + PG8_SA(b, h) + aoff + m * 2048 + k * 1024); } while (0)
#define PG8_LDB(dst, b, h) do { _Pragma("unroll") for (int n = 0; n < 2; ++n) _Pragma("unroll") for (int k = 0; k < 2; ++k) dst[n][k] = *(const PG8_LAS bf16x8*)(lds + PG8_SB(b, h) + boff + n * 2048 + k * 1024); } while (0)
#define PG8_MMA(ai, bj, At, Bt) do { __builtin_amdgcn_s_setprio(1); _Pragma("unroll") for (int m = 0; m < 4; ++m) _Pragma("unroll") for (int n = 0; n < 2; ++n) _Pragma("unroll") for (int k = 0; k < 2; ++k) \
        acc[ai][bj][m][n] = __builtin_amdgcn_mfma_f32_16x16x32_bf16(Bt[n][k], At[m][k], acc[ai][bj][m][n], 0, 0, 0); __builtin_amdgcn_s_setprio(0); } while (0)
#define PG8_WAIT_V(n) asm volatile("s_waitcnt vmcnt(" #n ")" ::: "memory")
#define PG8_WAIT_L(n) asm volatile("s_waitcnt lgkmcnt(" #n ")" ::: "memory")
#define PG8_BAR __builtin_amdgcn_s_barrier()
#define PG8_SCHED __builtin_amdgcn_sched_barrier(0)
    Unit cur, nxt; int ui = 0;
    if (!S.next(0, cur)) return;
    f32x4 acc[2][2][4][2];
#pragma unroll
    for (int a = 0; a < 2; ++a)
#pragma unroll
        for (int b = 0; b < 2; ++b)
#pragma unroll
            for (int m = 0; m < 4; ++m)
#pragma unroll
                for (int n = 0; n < 2; ++n) acc[a][b][m][n] = (f32x4){0.f, 0.f, 0.f, 0.f};
    bf16x8 At[4][2], B0[2][2], B1[2][2];
    const char* cA = (const char*)g.A + (size_t)cur.pm * tstep; const char* cB = (const char*)g.Bt + (size_t)cur.pn * tstep;
    S.a_ready(cur);
    if constexpr (SP2) {
        PG8_STAGE(PG8_SB(0, 0), cB, voffB); PG8_STAGE(PG8_SB(0, 1), cB + hstep, voffB); PG8_STAGE(PG8_SA(0, 0), cA, voffA); PG8_STAGE(PG8_SA(0, 1), cA + hstep, voffA);
        if (wr == 1) PG8_BAR;
        PG8_WAIT_V(2); PG8_BAR;
        PG8_STAGE(PG8_SB(1, 0), cB + kstep, voffB); PG8_STAGE(PG8_SA(1, 0), cA + kstep, voffA); PG8_STAGE(PG8_SB(1, 1), cB + hstep + kstep, voffB);
        PG8_WAIT_V(6); PG8_BAR;
    } else {
        PG8_STAGE(PG8_SB(0, 0), cB, voffB); PG8_STAGE(PG8_SA(0, 0), cA, voffA); PG8_STAGE(PG8_SB(0, 1), cB + hstep, voffB); PG8_STAGE(PG8_SA(0, 1), cA + hstep, voffA);
        if (wr == 1) PG8_BAR;
        PG8_WAIT_V(4); PG8_BAR;
        PG8_STAGE(PG8_SB(1, 0), cB + kstep, voffB); PG8_STAGE(PG8_SA(1, 0), cA + kstep, voffA); PG8_STAGE(PG8_SB(1, 1), cB + hstep + kstep, voffB);
        PG8_WAIT_V(6); PG8_BAR;
    }
    for (;;) {
        const bool has_next = S.next(ui + 1, nxt);
        const char* nA = has_next ? (const char*)g.A + (size_t)nxt.pm * tstep : cA; const char* nB = has_next ? (const char*)g.Bt + (size_t)nxt.pn * tstep : cB;
        for (int t = 0; t < nt; t += 2) {
            const bool last = (t == nt - 2);
            const char* a1 = cA + (size_t)(t + 1) * kstep;
            const char* a2 = last ? nA : cA + (size_t)(t + 2) * kstep; const char* b2 = last ? nB : cB + (size_t)(t + 2) * kstep;
            const char* a3 = a2 + kstep; const char* b3 = b2 + kstep;
            if (last && has_next) S.a_ready(nxt);
            if constexpr (SP2) {
            PG8_LDB(B0, 0, 0); PG8_LDB(B1, 0, 1); PG8_SCHED; PG8_LDA(At, 0, 0); PG8_STAGE(PG8_SA(1, 1), a1 + hstep, voffA);
            PG8_WAIT_V(8); PG8_WAIT_L(0); PG8_BAR; PG8_MMA(0, 0, At, B0); PG8_MMA(0, 1, At, B1); PG8_BAR; PG8_SCHED;
            PG8_LDA(At, 0, 1); PG8_STAGE(PG8_SB(0, 0), b2, voffB); PG8_STAGE(PG8_SB(0, 1), b2 + hstep, voffB); PG8_STAGE(PG8_SA(0, 0), a2, voffA);
            PG8_WAIT_V(8); PG8_WAIT_L(0); PG8_BAR; PG8_MMA(1, 0, At, B0); PG8_MMA(1, 1, At, B1); PG8_BAR; PG8_SCHED;
            PG8_LDB(B0, 1, 0); PG8_LDB(B1, 1, 1); PG8_SCHED; PG8_LDA(At, 1, 0); PG8_STAGE(PG8_SA(0, 1), a2 + hstep, voffA);
            PG8_WAIT_V(8); PG8_WAIT_L(0); PG8_BAR; PG8_MMA(0, 0, At, B0); PG8_MMA(0, 1, At, B1); PG8_BAR; PG8_SCHED;
            PG8_LDA(At, 1, 1); PG8_STAGE(PG8_SB(1, 0), b3, voffB); PG8_STAGE(PG8_SB(1, 1), b3 + hstep, voffB); PG8_STAGE(PG8_SA(1, 0), a3, voffA);
            PG8_WAIT_V(8); PG8_WAIT_L(0); PG8_BAR; PG8_MMA(1, 0, At, B0); PG8_MMA(1, 1, At, B1); PG8_BAR; PG8_SCHED;
            } else {
            PG8_LDB(B0, 0, 0); PG8_SCHED; PG8_LDA(At, 0, 0); PG8_STAGE(PG8_SA(1, 1), a1 + hstep, voffA);
            PG8_WAIT_L(8); PG8_BAR; PG8_WAIT_L(0); PG8_MMA(0, 0, At, B0); PG8_BAR; PG8_SCHED;
            PG8_LDB(B1, 0, 1); PG8_STAGE(PG8_SB(0, 0), b2, voffB);
            PG8_BAR; PG8_WAIT_L(0); PG8_MMA(0, 1, At, B1); PG8_BAR;
            PG8_LDA(At, 0, 1); PG8_STAGE(PG8_SA(0, 0), a2, voffA);
            PG8_BAR; PG8_WAIT_L(0); PG8_MMA(1, 0, At, B0); PG8_BAR; PG8_SCHED;
            PG8_STAGE(PG8_SB(0, 1), b2 + hstep, voffB);
            PG8_WAIT_V(6); PG8_BAR; PG8_MMA(1, 1, At, B1); PG8_BAR;
            PG8_LDB(B0, 1, 0); PG8_SCHED; PG8_LDA(At, 1, 0); PG8_STAGE(PG8_SA(0, 1), a2 + hstep, voffA);
            PG8_WAIT_L(8); PG8_BAR; PG8_WAIT_L(0); PG8_MMA(0, 0, At, B0); PG8_BAR; PG8_SCHED;
            PG8_LDB(B1, 1, 1); PG8_STAGE(PG8_SB(1, 0), b3, voffB);
            PG8_BAR; PG8_WAIT_L(0); PG8_MMA(0, 1, At, B1); PG8_BAR;
            PG8_LDA(At, 1, 1); PG8_STAGE(PG8_SA(1, 0), a3, voffA);
            PG8_BAR; PG8_WAIT_L(0); PG8_MMA(1, 0, At, B0); PG8_BAR; PG8_SCHED;
            PG8_STAGE(PG8_SB(1, 1), b3 + hstep, voffB);
            PG8_WAIT_V(6); PG8_BAR; PG8_MMA(1, 1, At, B1); PG8_BAR;
            }
        }
        if constexpr (ALIGN_EPI) { if (wr == 0) PG8_BAR; }
        if constexpr (!Epi::AFTER_DRAIN) { E(acc, cur, wr, wc, fr, fq); S.done(cur); }
        if (!has_next) break;
#pragma unroll
        for (int a = 0; a < 2; ++a)
#pragma unroll
            for (int b = 0; b < 2; ++b)
#pragma unroll
                for (int m = 0; m < 4; ++m)
#pragma unroll
                    for (int n = 0; n < 2; ++n) acc[a][b][m][n] = (f32x4){0.f, 0.f, 0.f, 0.f};
        cur = nxt; cA = nA; cB = nB; ++ui;
        if constexpr (ALIGN_EPI) { if (wr == 1) PG8_BAR; }
    }
    PG8_WAIT_V(0);
    if constexpr (!ALIGN_EPI) { if (wr == 0) PG8_BAR; }
    PG8_BAR;
    if constexpr (Epi::AFTER_DRAIN) { E.fused(acc, cur, wr, wc, fr, fq, lds, wid, lane); S.done(cur); }
#undef PG8_SA
#undef PG8_SB
#undef PG8_STAGE
#undef PG8_LDA
#undef PG8_LDB
#undef PG8_MMA
#undef PG8_WAIT_V
#undef PG8_WAIT_L
#undef PG8_BAR
#undef PG8_SCHED
}
}

#define GAS __attribute__((address_space(1)))
#define LAS __attribute__((address_space(3)))
typedef unsigned short bf16;
typedef short bf16x8 __attribute__((ext_vector_type(8)));
typedef float f32x4 __attribute__((ext_vector_type(4)));
typedef float f32x16 __attribute__((ext_vector_type(16)));
typedef unsigned u32x4 __attribute__((ext_vector_type(4)));
typedef unsigned u32x2 __attribute__((ext_vector_type(2)));
typedef float f32x2_t __attribute__((ext_vector_type(2)));
typedef __bf16 bf16x2_t __attribute__((ext_vector_type(2)));
using pg8::Unit;

constexpr int NB = 16, SEQ = 2048, MTOK = NB * SEQ, DM = 1024, NPROJ = 2560, DEPTH = 2;
constexpr int NTT = MTOK / 256;
constexpr int ZROWS = MTOK + DEPTH * NPROJ;
constexpr float RMS_EPS = 1e-6f;
constexpr float LOG2E = 1.4426950408889634f;
constexpr float QSCALE = 0.125f * LOG2E;
constexpr int LDS_BYTES = 147456;
constexpr int LDS_MISC = 131072;
constexpr int LDS_CTL = LDS_BYTES - 512;

constexpr size_t MiB = 1u << 20;
constexpr size_t WS_CTL = 0, CTL_BYTES = 64 * 1024;
constexpr size_t WS_Z = 2 * MiB, WS_WOUT = 78 * MiB, WS_GLU = 82 * MiB, WS_TE = 83 * MiB, WS_G = 89 * MiB, WS_AT = 91 * MiB;
constexpr size_t WS_U = 92 * MiB, WS_SG = 108 * MiB, WS_AQ = 124 * MiB, WS_AK = 148 * MiB, WS_AG = 156 * MiB, WS_MQ = 180 * MiB, WS_MK = 204 * MiB, WS_MG = 212 * MiB;
constexpr size_t WS_VT = 236 * MiB, WS_KPART = 252 * MiB, WS_ROWSS = 253 * MiB, WS_YPRE = 254 * MiB, WS_Y = 270 * MiB, WS_END = 334 * MiB;
static_assert(WS_Z + (size_t)ZROWS * DM * 2 <= WS_WOUT, "Z fits");
constexpr size_t WS_NW = 1 * MiB;
constexpr int TE_ELEMS = 256 * 384, G_ELEMS = 128 * 256;
constexpr int CW_QUEUE = 1024;
constexpr int CW_SSMDONE = 8192;

__device__ __forceinline__ unsigned pk2(float lo, float hi) { f32x2_t v = {lo, hi}; bf16x2_t b = __builtin_convertvector(v, bf16x2_t); return __builtin_bit_cast(unsigned, b); }
__device__ __forceinline__ float bf2f(unsigned short x) { return __uint_as_float((unsigned)x << 16); }
__device__ __forceinline__ float bflo(unsigned w) { return __uint_as_float(w << 16); }
__device__ __forceinline__ float bfhi(unsigned w) { return __uint_as_float(w & 0xffff0000u); }
__device__ __forceinline__ float wave_sum(float v) {
#pragma unroll
    for (int o = 1; o < 64; o <<= 1) v += __shfl_xor(v, o);
    return v;
}
__device__ __forceinline__ float fast_rcp(float x) { return __builtin_amdgcn_rcpf(x); }
__device__ __forceinline__ float silu_f(float x) { return x * fast_rcp(1.f + __builtin_amdgcn_exp2f(-x * LOG2E)); }
__device__ __forceinline__ float sigmoid_f(float x) { return fast_rcp(1.f + __builtin_amdgcn_exp2f(-x * LOG2E)); }
__device__ __forceinline__ float gelu_tanh_f(float x) { const float z = 0.7978845608028654f * (x + 0.044715f * x * x * x); return x * fast_rcp(1.f + __builtin_amdgcn_exp2f(-2.f * LOG2E * z)); }
__device__ __forceinline__ float swap32_max(float m) { auto rr = __builtin_amdgcn_permlane32_swap(__float_as_uint(m), __float_as_uint(m), false, false); return fmaxf(__uint_as_float(rr[0]), __uint_as_float(rr[1])); }
__device__ __forceinline__ float swap32_sum(float m) { auto rr = __builtin_amdgcn_permlane32_swap(__float_as_uint(m), __float_as_uint(m), false, false); return __uint_as_float(rr[0]) + __uint_as_float(rr[1]); }
__device__ __forceinline__ void glds16(const void* gsrc, LAS unsigned char* ldst) {
    const unsigned dst = __builtin_amdgcn_readfirstlane((unsigned)(uintptr_t)ldst); unsigned keep;
    asm volatile("s_mov_b32 %0, m0\n\ts_mov_b32 m0, %2\n\ts_nop 0\n\tglobal_load_lds_dwordx4 %1, off\n\ts_mov_b32 m0, %0" : "=&s"(keep) : "v"(gsrc), "s"(dst) : "memory");
}
#define GLDS_WAIT() asm volatile("s_waitcnt vmcnt(0)" ::: "memory")

struct Params {
    const float* in[19]; float* out; unsigned char* ws;
};
typedef const float* const __attribute__((address_space(4))) * kargs_t;
__device__ __forceinline__ const float* kin(int i) { kargs_t ka = (kargs_t)__builtin_amdgcn_kernarg_segment_ptr(); asm volatile("" : "+s"(ka)); return ka[i]; }
struct Frame {
    LAS unsigned char* lds; int tid, lane, wave, G, bid; float* out; unsigned char* ws; unsigned* ctl;
};

__device__ __forceinline__ int proj_dest_row(int n0) {
    int slot, off;
    if (n0 < 512)       { slot = n0 >> 6; off = n0 & 63; }
    else if (n0 < 1024) { slot = 8 + ((n0 - 512) >> 6); off = n0 & 63; }
    else if (n0 < 1152) { return 2304 + (n0 - 1024); }
    else if (n0 < 1536) { slot = 16 + ((n0 - 1152) >> 6); off = (n0 - 1152) & 63; }
    else if (n0 < 1920) { slot = 22 + ((n0 - 1536) >> 6); off = (n0 - 1536) & 63; }
    else if (n0 < 2048) { slot = 28 + ((n0 - 1920) >> 6); off = (n0 - 1920) & 63; }
    else if (n0 < 2176) { return 2304 + 128 + (n0 - 2048); }
    else                { slot = 30 + ((n0 - 2176) >> 6); off = (n0 - 2176) & 63; }
    const int t = slot >> 2, wc = slot & 3;
    return 256 * t + 128 * (off >> 5) + 32 * wc;
}
__device__ __forceinline__ void p0_transpose_item(const float* W, int K, int N, const float* gk, bf16* WT, int ldk, int drow0, LAS float* scr, int k0, int n0, int lane) {
    float tv[32];
#pragma unroll
    for (int i = 0; i < 32; ++i) { const int kk = 2 * i + (lane >> 5); tv[i] = __builtin_nontemporal_load(W + (size_t)(k0 + kk) * N + n0 + (lane & 31)); }
#pragma unroll
    for (int i = 0; i < 32; ++i) { const int kk = 2 * i + (lane >> 5); float v = tv[i]; if (gk) v *= gk[k0 + kk]; scr[kk * 33 + (lane & 31)] = v; }
    asm volatile("s_waitcnt lgkmcnt(0)" ::: "memory");
    const int c = lane & 7;
#pragma unroll
    for (int j = 0; j < 4; ++j) { const int n = (lane >> 3) + 8 * j; const LAS float* s = scr + (8 * c) * 33 + n;
        u32x4 o; o.x = pk2(s[0 * 33], s[1 * 33]); o.y = pk2(s[2 * 33], s[3 * 33]); o.z = pk2(s[4 * 33], s[5 * 33]); o.w = pk2(s[6 * 33], s[7 * 33]);
        *(u32x4*)(WT + (size_t)(drow0 + n) * ldk + k0 + 8 * c) = o; }
    asm volatile("s_waitcnt lgkmcnt(0)" ::: "memory");
}
__device__ __forceinline__ void p0_ssm_consts(const Params& P, Frame& F, int pair) {
    const int l = pair >> 4, g = pair & 15, tid = F.tid;
    LAS float* pwr = (LAS float*)(F.lds);
    LAS float* pwi = pwr + 17 * 64;
    LAS float* bbr = pwi + 17 * 64;
    LAS float* bbi = bbr + 1024;
    LAS float* ccr = bbi + 1024;
    LAS float* cci = ccr + 1024;
    LAS float* Kt = cci + 1024;
    const float dt = expf(kin(5)[l * 16 + g]);
    const float* lre = kin(3) + (l * 16 + g) * 64; const float* lim = kin(4) + (l * 16 + g) * 64;
    for (int t = tid; t < 17 * 64; t += 512) { const int p = t & 63, lag = t >> 6; const float lr = lre[p], li = lim[p];
        const float mag = expf(lr * dt * (float)lag); float sn, cs; sincosf(li * dt * (float)lag, &sn, &cs); pwr[t] = mag * cs; pwi[t] = mag * sn; }
    for (int t = tid; t < 1024; t += 512) { const int p = t >> 4, h = t & 15; const float lr = lre[p], li = lim[p];
        const float mag = expf(lr * dt); float sn, cs; sincosf(li * dt, &sn, &cs); const float ar = mag * cs, ai = mag * sn;
        const float den = lr * lr + li * li, nr = ar - 1.f, ni = ai; const float cr = (nr * lr + ni * li) / den, ci = (ni * lr - nr * li) / den;
        const float br = kin(6)[((size_t)(l * 16 + g) * 64 + p) * 16 + h], bi = kin(7)[((size_t)(l * 16 + g) * 64 + p) * 16 + h];
        bbr[t] = cr * br - ci * bi; bbi[t] = cr * bi + ci * br; }
    for (int t = tid; t < 1024; t += 512) { ccr[t] = kin(8)[(size_t)(l * 16 + g) * 1024 + t]; cci[t] = kin(9)[(size_t)(l * 16 + g) * 1024 + t]; }
    __syncthreads();
    for (int t = tid; t < 4096; t += 512) { const int lag = t >> 8, hp = (t >> 4) & 15, h = t & 15; float s = 0.f;
        for (int p = 0; p < 64; ++p) { const float cr = ccr[hp * 64 + p], ci = cci[hp * 64 + p], pr = pwr[lag * 64 + p], pi = pwi[lag * 64 + p];
            const float xr = cr * pr - ci * pi, xi = cr * pi + ci * pr; s += xr * bbr[p * 16 + h] - xi * bbi[p * 16 + h]; }
        if (lag == 0 && hp == h) s += kin(10)[l * 256 + g * 16 + h];
        Kt[t] = s; }
    __syncthreads();
    bf16* TE = ((bf16*)(F.ws + WS_TE)) + (size_t)pair * TE_ELEMS; bf16* GM = ((bf16*)(F.ws + WS_G)) + (size_t)pair * G_ELEMS;
    for (int t = tid; t < 256 * 192; t += 512) { const int n = t / 192, kp = t % 192, k = 2 * kp; const int i = n >> 4, hp = n & 15; float v0, v1;
        if (k < 256) { const int j = k >> 4, h = k & 15; if (j <= i) { v0 = Kt[((i - j) * 16 + hp) * 16 + h]; v1 = Kt[((i - j) * 16 + hp) * 16 + h + 1]; } else { v0 = 0.f; v1 = 0.f; } }
        else { const int p = (k - 256) >> 1; const float cr = ccr[hp * 64 + p], ci = cci[hp * 64 + p], pr = pwr[(i + 1) * 64 + p], pi = pwi[(i + 1) * 64 + p];
            v0 = cr * pr - ci * pi; v1 = -(cr * pi + ci * pr); }
        *(unsigned*)(TE + (size_t)n * 384 + k) = pk2(v0, v1); }
    for (int t = tid; t < 128 * 128; t += 512) { const int n = t >> 7, kp = t & 127, k = 2 * kp; const int p = n >> 1, ri = n & 1, j = k >> 4, h = k & 15;
        const float pr = pwr[(15 - j) * 64 + p], pi = pwi[(15 - j) * 64 + p];
        float v0, v1;
        { const float br = bbr[p * 16 + h], bi = bbi[p * 16 + h]; v0 = ri ? (pr * bi + pi * br) : (pr * br - pi * bi); }
        { const float br = bbr[p * 16 + h + 1], bi = bbi[p * 16 + h + 1]; v1 = ri ? (pr * bi + pi * br) : (pr * br - pi * bi); }
        *(unsigned*)(GM + (size_t)n * 256 + k) = pk2(v0, v1); }
    if (tid < 64) { ((float*)(F.ws + WS_AT))[(size_t)pair * 128 + 2 * tid] = pwr[16 * 64 + tid]; ((float*)(F.ws + WS_AT))[(size_t)pair * 128 + 2 * tid + 1] = pwi[16 * 64 + tid]; }
    __syncthreads();
}
__device__ __forceinline__ void p0_prologue(const Params& P, Frame& F) {
    const bool split = F.G > 64;
    if (!split || F.bid < 32) { for (int pair = F.bid; pair < 32; pair += (split ? 32 : F.G)) p0_ssm_consts(P, F, pair); if (split) return; }
    const int vb = split ? F.bid - 32 : F.bid, nvb = split ? F.G - 32 : F.G;
    if (vb == 0) { float* nwp = (float*)(F.ws + WS_NW);
        for (int t = F.tid; t < DEPTH * 256; t += 512) { const int l = t >> 8, k = (t >> 6) & 3, d = t & 63;
            nwp[t] = (k == 0) ? kin(13)[l * 64 + d] * QSCALE : (k == 1) ? kin(14)[l * 64 + d] : (k == 2) ? kin(16)[l * 64 + d] * QSCALE : kin(17)[l * 64 + d]; } }
    const int gw = vb * 8 + F.wave, NGW = nvb * 8;
    LAS float* scr = (LAS float*)(F.lds + F.wave * 16384);
    constexpr int I_IN = 16 * 80, I_OUT = 16 * 32, I_GLU = 4 * 8, I_L = I_IN + I_OUT + I_GLU;
    for (int it = gw; it < DEPTH * I_L; it += NGW) {
        const int l = it / I_L; int r = it % I_L;
        if (r < I_IN) { const int kb = r / 80, nb = r % 80; p0_transpose_item(kin(2) + (size_t)l * DM * NPROJ, DM, NPROJ, kin(1) + l * DM, ((bf16*)(F.ws + WS_Z)) + (size_t)(MTOK + l * NPROJ) * DM, DM, proj_dest_row(32 * nb), scr, 64 * kb, 32 * nb, F.lane); continue; }
        r -= I_IN;
        if (r < I_OUT) { const int kb = r / 32, nb = r % 32; p0_transpose_item(kin(18) + (size_t)l * DM * DM, DM, DM, nullptr, ((bf16*)(F.ws + WS_WOUT)) + (size_t)l * DM * DM, DM, 32 * nb, scr, 64 * kb, 32 * nb, F.lane); continue; }
        r -= I_OUT;
        { const int kb = r / 8, nb = r % 8; p0_transpose_item(kin(11) + (size_t)l * 65536, 256, 256, nullptr, ((bf16*)(F.ws + WS_GLU)) + (size_t)l * 65536, 256, 32 * nb, scr, 64 * kb, 32 * nb, F.lane); }
    }
    for (int m0 = gw; m0 < MTOK; m0 += 4 * NGW) {
        f32x4 v[4][4];
#pragma unroll
        for (int q = 0; q < 4; ++q) { const int m = m0 + q * NGW; if (m < MTOK) { const f32x4* xr = (const f32x4*)(kin(0) + (size_t)m * DM) + F.lane;
#pragma unroll
            for (int j = 0; j < 4; ++j) v[q][j] = __builtin_nontemporal_load(xr + 64 * j); } }
#pragma unroll
        for (int q = 0; q < 4; ++q) { const int m = m0 + q * NGW; if (m < MTOK) { float s = 0.f;
#pragma unroll
            for (int j = 0; j < 4; ++j) s += (v[q][j].x * v[q][j].x + v[q][j].y * v[q][j].y) + (v[q][j].z * v[q][j].z + v[q][j].w * v[q][j].w);
            s = wave_sum(s);
            u32x2* o8 = (u32x2*)(((bf16*)(F.ws + WS_Z)) + (size_t)m * DM) + F.lane;
#pragma unroll
            for (int j = 0; j < 4; ++j) { u32x2 w; w.x = pk2(v[q][j].x, v[q][j].y); w.y = pk2(v[q][j].z, v[q][j].w); o8[64 * j] = w; }
            if (F.lane < 4) ((float*)(F.ws + WS_ROWSS))[(size_t)m * 4 + F.lane] = (F.lane == 0) ? s : 0.f; } }
    }
}

__device__ __forceinline__ Frame phase_frame(const Frame& F0) {
    Frame F = F0; asm volatile("" : "+v"(F.tid)); F.lane = F.tid & 63; F.wave = __builtin_amdgcn_readfirstlane(F.tid >> 6);
    asm volatile("" : "+s"(F.ws)); F.ctl = (unsigned*)(F.ws + WS_CTL); return F;
}
struct SchedTab { const volatile LAS int* tab; int n;
    __device__ __forceinline__ bool next(int i, Unit& u) const { if (i >= n) return false; u.pm = __builtin_amdgcn_readfirstlane(tab[2 * i]); u.pn = __builtin_amdgcn_readfirstlane(tab[2 * i + 1]); return true; }
    __device__ __forceinline__ void a_ready(const Unit&) const {}
    __device__ __forceinline__ void done(const Unit&) const {}
};
__device__ __forceinline__ bool unit_p1(int G, int c, int wbase, int i, int& pm, int& pn) {
    int tok, j;
    if (G == 256) { if (i >= 5) return false; const int x = c & 7, l = c >> 3, n = i * 32 + l, tq = n / 40, rem = n % 40; j = rem >> 2; tok = 16 * x + 4 * tq + (rem & 3); }
    else { const long L = (long)i * G + c; if (L >= NTT * 10) return false; tok = (int)(L / 10); j = (int)(L % 10); }
    if (j < 9) { pm = tok; pn = wbase + j; } else { pm = wbase + 9; pn = tok; }
    return true;
}
__device__ __forceinline__ bool unit_p3(int G, int c, int i, int& pm, int& pn) {
    if (G == 256) { if (i >= 2) return false; const int x = c & 7, l = c >> 3, n = i * 32 + l, tq = n >> 4, rem = n & 15; pn = rem >> 2; pm = 16 * x + 4 * tq + (rem & 3); }
    else { const long L = (long)i * G + c; if (L >= NTT * 4) return false; pm = (int)(L / 4); pn = (int)(L % 4); }
    return true;
}
__device__ __forceinline__ bool unit_glu(int G, int c, int i, int& pm, int& pn) {
    if (G == 256) { if (i >= 1 || (c >> 3) >= 16) return false; pm = 16 * (c & 7) + (c >> 3); pn = 0; }
    else { const long L = (long)i * G + c; if (L >= NTT) return false; pm = (int)L; pn = 0; }
    return true;
}
template <int KIND>
__device__ __forceinline__ SchedTab make_sched(const Frame& F, int wbase) {
    volatile LAS int* tab = (volatile LAS int*)(F.lds + LDS_CTL + 64);
    volatile LAS int* cnt = (volatile LAS int*)(F.lds + LDS_CTL + 32);
    if (F.tid == 0) { int n = 0;
#pragma unroll 1
        for (int i = 0; i < 24; ++i) { int pm, pn; const bool ok = (KIND == 0) ? unit_p1(F.G, F.bid, wbase, i, pm, pn) : (KIND == 1) ? unit_p3(F.G, F.bid, i, pm, pn) : unit_glu(F.G, F.bid, i, pm, pn);
            if (!ok) break; tab[2 * i] = pm; tab[2 * i + 1] = pn; n = i + 1; }
        cnt[0] = n; }
    __syncthreads();
    SchedTab S; S.tab = tab; S.n = __builtin_amdgcn_readfirstlane(cnt[0]); return S;
}

struct EpiProj {
    static constexpr bool PERM = true, AFTER_DRAIN = false;
    int wbase, layer; unsigned char* ws;
    __device__ __forceinline__ void operator()(const f32x4 (&acc)[2][2][4][2], const Unit& u, int wr, int wc, int fr, int fq) const {
        asm volatile("" : "+v"(fr), "+v"(fq));
        const float* rowss = (const float*)(ws + WS_ROWSS);
        if (u.pm >= NTT) {
            bf16* VT = (bf16*)(ws + WS_VT);
            const int tc = u.pn * 256 + wc * 32 + 8 * fq;
#pragma unroll
            for (int bj = 0; bj < 2; ++bj) {
                float rs[8];
                { f32x4 p[8];
#pragma unroll
                  for (int e = 0; e < 8; ++e) p[e] = *(const f32x4*)(rowss + (size_t)(tc + bj * 128 + e) * 4);
#pragma unroll
                  for (int e = 0; e < 8; ++e) rs[e] = rsqrtf(((p[e].x + p[e].y) + (p[e].z + p[e].w)) * (1.f / DM) + RMS_EPS); }
#pragma unroll
                for (int ai = 0; ai < 2; ++ai)
#pragma unroll
                    for (int m = 0; m < 4; ++m) { const int f = ai * 128 + wr * 64 + m * 16 + fr; const f32x4 a = acc[ai][bj][m][0], b = acc[ai][bj][m][1]; u32x4 w;
                        w.x = pk2(a[0] * rs[0], a[1] * rs[1]); w.y = pk2(a[2] * rs[2], a[3] * rs[3]); w.z = pk2(b[0] * rs[4], b[1] * rs[5]); w.w = pk2(b[2] * rs[6], b[3] * rs[7]);
                        *(u32x4*)(VT + ((size_t)u.pn * 256 + f) * 256 + (wc * 32 + 8 * fq + bj * 128)) = w; }
            }
            return;
        }
        const int t = u.pn - wbase;
        int kind, pitch, col, nwi = 0; size_t dsto;
        switch (t) {
            case 0: kind = 0; dsto = WS_U; pitch = 256; col = 64 * wc; break;
            case 1: kind = 1; dsto = WS_SG; pitch = 256; col = 64 * wc; break;
            case 2: kind = 2; dsto = WS_AQ; pitch = 384; col = 64 * wc; nwi = 0; break;
            case 3: if (wc < 2) { kind = 2; dsto = WS_AQ; pitch = 384; col = 64 * (4 + wc); nwi = 0; } else { kind = 2; dsto = WS_AK; pitch = 128; col = 64 * (wc - 2); nwi = 1; } break;
            case 4: kind = 1; dsto = WS_AG; pitch = 384; col = 64 * wc; break;
            case 5: if (wc < 2) { kind = 1; dsto = WS_AG; pitch = 384; col = 64 * (4 + wc); } else { kind = 2; dsto = WS_MQ; pitch = 384; col = 64 * (wc - 2); nwi = 2; } break;
            case 6: kind = 2; dsto = WS_MQ; pitch = 384; col = 64 * (2 + wc); nwi = 2; break;
            case 7: if (wc < 2) { kind = 5; dsto = WS_MK; pitch = 128; col = 64 * wc; nwi = 3; } else { kind = 1; dsto = WS_MG; pitch = 384; col = 64 * (wc - 2); } break;
            default: kind = 1; dsto = WS_MG; pitch = 384; col = 64 * (2 + wc); break;
        }
        bf16* dst = (bf16*)(ws + dsto) + col + 8 * fq; const float* nw = (const float*)(ws + WS_NW) + (layer * 4 + nwi) * 64 + 8 * fq;
        int row0 = u.pm * 256 + wr * 64 + fr; asm volatile("" : "+v"(row0));
        if (kind == 0) rows<0>(acc, row0, (bf16*)(ws + WS_U) + ((size_t)(4 * wc + (fq >> 1)) * SEQ) * 16 + 8 * (fq & 1), 0, nw, rowss, nullptr);
        else if (kind == 1) rows<1>(acc, row0, dst, pitch, nw, rowss, nullptr);
        else if (kind == 2) rows<2>(acc, row0, dst, pitch, nw, rowss, nullptr);
        else rows<5>(acc, row0, dst, pitch, nw, rowss, (fr == 0) ? (float*)(ws + WS_KPART) + ((size_t)(u.pm * 2 + wr) * 2 + wc) * 64 + 8 * fq : nullptr);
    }
    template <int KIND>
    __device__ __forceinline__ void rows(const f32x4 (&acc)[2][2][4][2], int row0, bf16* dst, int pitch, const float* nw, const float* rowss, float* kp) const {
        f32x4 wv[2][2], ks[2][2];
        if (KIND >= 2) {
#pragma unroll
            for (int bj = 0; bj < 2; ++bj)
#pragma unroll
                for (int n = 0; n < 2; ++n) { wv[bj][n] = *(const f32x4*)(nw + 32 * bj + 4 * n); ks[bj][n] = (f32x4){0.f, 0.f, 0.f, 0.f}; }
        }
#pragma unroll
        for (int ai = 0; ai < 2; ++ai) {
            float rsv[4];
            { f32x4 pr[4];
#pragma unroll
              for (int m = 0; m < 4; ++m) pr[m] = *(const f32x4*)(rowss + (size_t)(row0 + ai * 128 + m * 16) * 4);
#pragma unroll
              for (int m = 0; m < 4; ++m) { const f32x4 p = pr[m]; rsv[m] = rsqrtf(((p.x + p.y) + (p.z + p.w)) * (1.f / DM) + RMS_EPS); } }
#pragma unroll
            for (int m = 0; m < 4; ++m) {
                const int row = row0 + ai * 128 + m * 16;
                const float rs = rsv[m];
                f32x4 v[2][2];
#pragma unroll
                for (int bj = 0; bj < 2; ++bj)
#pragma unroll
                    for (int n = 0; n < 2; ++n) v[bj][n] = acc[ai][bj][m][n] * rs;
                if (KIND >= 2) {
                    float ss = 0.f;
#pragma unroll
                    for (int bj = 0; bj < 2; ++bj)
#pragma unroll
                        for (int n = 0; n < 2; ++n) { const f32x4 q = v[bj][n]; ss += (q[0] * q[0] + q[1] * q[1]) + (q[2] * q[2] + q[3] * q[3]); }
                    ss += __shfl_xor(ss, 16); ss += __shfl_xor(ss, 32);
                    const float hn = rsqrtf(ss * (1.f / 64.f) + RMS_EPS);
#pragma unroll
                    for (int bj = 0; bj < 2; ++bj)
#pragma unroll
                        for (int n = 0; n < 2; ++n) { v[bj][n] = v[bj][n] * wv[bj][n] * hn; if (KIND == 5) ks[bj][n] += v[bj][n]; }
                } else if (KIND == 1) {
#pragma unroll
                    for (int bj = 0; bj < 2; ++bj)
#pragma unroll
                        for (int n = 0; n < 2; ++n)
#pragma unroll
                            for (int e = 0; e < 4; ++e) v[bj][n][e] = silu_f(v[bj][n][e]);
                }
                bf16* rp = (KIND == 0) ? dst + ((size_t)(row >> 11) * 16 * SEQ + (row & (SEQ - 1))) * 16 : dst + (size_t)row * pitch;
#pragma unroll
                for (int bj = 0; bj < 2; ++bj) { u32x4 w; w.x = pk2(v[bj][0][0], v[bj][0][1]); w.y = pk2(v[bj][0][2], v[bj][0][3]); w.z = pk2(v[bj][1][0], v[bj][1][1]); w.w = pk2(v[bj][1][2], v[bj][1][3]);
                    *(u32x4*)(rp + (KIND == 0 ? 2 * SEQ * 16 * bj : 32 * bj)) = w; }
                if (m & 1) asm volatile("" ::: "memory");
            }
        }
        if (KIND == 5) {
#pragma unroll
            for (int bj = 0; bj < 2; ++bj)
#pragma unroll
                for (int n = 0; n < 2; ++n)
#pragma unroll
                    for (int e = 0; e < 4; ++e) { float s = ks[bj][n][e]; s += __shfl_xor(s, 1); s += __shfl_xor(s, 2); s += __shfl_xor(s, 4); s += __shfl_xor(s, 8); ks[bj][n][e] = s; }
            if (kp) {
#pragma unroll
                for (int bj = 0; bj < 2; ++bj)
#pragma unroll
                    for (int n = 0; n < 2; ++n) *(f32x4*)(kp + 32 * bj + 4 * n) = ks[bj][n];
            }
        }
    }
};
struct EpiGlu {
    static constexpr bool PERM = true, AFTER_DRAIN = false;
    const bf16* YPRE; const bf16* SG; const float* gb; bf16* Y;
    __device__ __forceinline__ void operator()(const f32x4 (&acc)[2][2][4][2], const Unit& u, int wr, int wc, int fr, int fq) const {
#pragma unroll
        for (int bj = 0; bj < 2; ++bj) { const int c = wc * 32 + 8 * fq + 128 * bj;
            const f32x4 b0 = *(const f32x4*)(gb + c), b1 = *(const f32x4*)(gb + c + 4);
#pragma unroll
            for (int ai = 0; ai < 2; ++ai)
#pragma unroll
                for (int m = 0; m < 4; ++m) { const int row = u.pm * 256 + ai * 128 + wr * 64 + m * 16 + fr;
                    const u32x4 yp = *(const u32x4*)(YPRE + (size_t)row * 256 + c), sg = *(const u32x4*)(SG + (size_t)row * 256 + c);
                    const f32x4 z0 = acc[ai][bj][m][0] + b0, z1 = acc[ai][bj][m][1] + b1;
                    u32x4 w;
                    w.x = pk2(bflo(yp.x) * sigmoid_f(z0[0]) * bflo(sg.x), bfhi(yp.x) * sigmoid_f(z0[1]) * bfhi(sg.x));
                    w.y = pk2(bflo(yp.y) * sigmoid_f(z0[2]) * bflo(sg.y), bfhi(yp.y) * sigmoid_f(z0[3]) * bfhi(sg.y));
                    w.z = pk2(bflo(yp.z) * sigmoid_f(z1[0]) * bflo(sg.z), bfhi(yp.z) * sigmoid_f(z1[1]) * bfhi(sg.z));
                    w.w = pk2(bflo(yp.w) * sigmoid_f(z1[2]) * bflo(sg.w), bfhi(yp.w) * sigmoid_f(z1[3]) * bfhi(sg.w));
                    *(u32x4*)(Y + (size_t)row * DM + c) = w;
                    if (m & 1) asm volatile("" ::: "memory"); } }
    }
};
struct EpiOut {
    static constexpr bool PERM = false, AFTER_DRAIN = false;
    const float* resid_f; float* out; bf16* xb; float* rowss; int write_next; LAS float* xch; int probe_skip;
    __device__ __forceinline__ void operator()(const f32x4 (&acc)[2][2][4][2], const Unit& u, int wr, int wc, int fr, int fq) const {
        const int c0 = u.pn * 256 + wc * 32 + 4 * fq;
        if (probe_skip) { asm volatile("" :: "v"(acc[0][0][0][0]), "v"(acc[1][1][3][1])); asm volatile("s_waitcnt lgkmcnt(0)" ::: "memory"); __builtin_amdgcn_s_barrier(); return; }
        if (write_next) {
#pragma unroll
            for (int ai = 0; ai < 2; ++ai) {
                u32x2 pre[4][2][2];
#pragma unroll
                for (int m = 0; m < 4; ++m) { const size_t off = (size_t)(u.pm * 256 + ai * 128 + wr * 64 + m * 16 + fr) * DM + c0;
#pragma unroll
                    for (int bj = 0; bj < 2; ++bj)
#pragma unroll
                        for (int n = 0; n < 2; ++n) pre[m][bj][n] = *(const u32x2*)(xb + off + bj * 128 + n * 16); }
#pragma unroll
                for (int m = 0; m < 4; ++m) { const int rt = ai * 128 + wr * 64 + m * 16 + fr; const size_t off = (size_t)(u.pm * 256 + rt) * DM + c0; float ss = 0.f;
#pragma unroll
                    for (int bj = 0; bj < 2; ++bj)
#pragma unroll
                        for (int n = 0; n < 2; ++n) { const u32x2 rb = pre[m][bj][n]; const f32x4 a4 = acc[ai][bj][m][n]; f32x4 o;
                            o[0] = bflo(rb.x) + a4[0]; o[1] = bfhi(rb.x) + a4[1]; o[2] = bflo(rb.y) + a4[2]; o[3] = bfhi(rb.y) + a4[3];
                            u32x2 w; w.x = pk2(o[0], o[1]); w.y = pk2(o[2], o[3]); *(u32x2*)(xb + off + bj * 128 + n * 16) = w; ss += (o[0] * o[0] + o[1] * o[1]) + (o[2] * o[2] + o[3] * o[3]); }
                    ss += __shfl_xor(ss, 16); ss += __shfl_xor(ss, 32); if (fq == 0) xch[rt * 4 + wc] = ss; }
            }
        } else {
#pragma unroll
            for (int ai = 0; ai < 2; ++ai) {
                u32x2 pre[4][2][2];
#pragma unroll
                for (int m = 0; m < 4; ++m) { const size_t off = (size_t)(u.pm * 256 + ai * 128 + wr * 64 + m * 16 + fr) * DM + c0;
#pragma unroll
                    for (int bj = 0; bj < 2; ++bj)
#pragma unroll
                        for (int n = 0; n < 2; ++n) pre[m][bj][n] = *(const u32x2*)(xb + off + bj * 128 + n * 16); }
#pragma unroll
                for (int m = 0; m < 4; ++m) { const size_t off = (size_t)(u.pm * 256 + ai * 128 + wr * 64 + m * 16 + fr) * DM + c0;
#pragma unroll
                    for (int bj = 0; bj < 2; ++bj)
#pragma unroll
                        for (int n = 0; n < 2; ++n) { const u32x2 rb = pre[m][bj][n]; const f32x4 a4 = acc[ai][bj][m][n]; f32x4 o;
                            o[0] = bflo(rb.x) + a4[0]; o[1] = bfhi(rb.x) + a4[1]; o[2] = bflo(rb.y) + a4[2]; o[3] = bfhi(rb.y) + a4[3];
                            __builtin_nontemporal_store(o, (f32x4*)(out + off + bj * 128 + n * 16)); } }
            }
        }
        asm volatile("s_waitcnt lgkmcnt(0)" ::: "memory"); __builtin_amdgcn_s_barrier(); asm volatile("" ::: "memory");
        if (write_next && threadIdx.x < 256) { const f32x4 p = *(const LAS f32x4*)(xch + threadIdx.x * 4); rowss[(size_t)(u.pm * 256 + threadIdx.x) * 4 + u.pn] = (p.x + p.y) + (p.z + p.w); }
    }
};

__device__ __forceinline__ int pi32(int r) { return (r & ~12) | ((r & 8) >> 1) | ((r & 4) << 1); }
template <int MODE>
__device__ __forceinline__ void attn_tile(const bf16x8 (&kf)[4], const bf16x8 (&vf)[2][2], const bf16x8 (&qf)[4], const f32x16& cv, float& l, f32x16 (&O)[2], int a, int h) {
    f32x16 S = __builtin_amdgcn_mfma_f32_32x32x16_bf16(kf[0], qf[0], cv, 0, 0, 0);
#pragma unroll
    for (int ks = 1; ks < 4; ++ks) S = __builtin_amdgcn_mfma_f32_32x32x16_bf16(kf[ks], qf[ks], S, 0, 0, 0);
    if (MODE != 0) {
#pragma unroll
        for (int i = 0; i < 16; ++i) { const int c = pi32((i & 3) + 8 * (i >> 2) + 4 * h); const bool dead = (MODE == 1) ? (c > a) : (c <= a); if (dead) S[i] = -1e30f; }
    }
    float s0 = 0.f, s1 = 0.f;
#pragma unroll
    for (int i = 0; i < 16; i += 2) { S[i] = __builtin_amdgcn_exp2f(S[i]); S[i + 1] = __builtin_amdgcn_exp2f(S[i + 1]); s0 += S[i]; s1 += S[i + 1]; }
    l += s0 + s1;
    bf16x8 pb[2];
#pragma unroll
    for (int s = 0; s < 2; ++s) { u32x4 w; w.x = pk2(S[8 * s], S[8 * s + 1]); w.y = pk2(S[8 * s + 2], S[8 * s + 3]); w.z = pk2(S[8 * s + 4], S[8 * s + 5]); w.w = pk2(S[8 * s + 6], S[8 * s + 7]); pb[s] = __builtin_bit_cast(bf16x8, w); }
#pragma unroll
    for (int dt = 0; dt < 2; ++dt)
#pragma unroll
        for (int s = 0; s < 2; ++s) O[dt] = __builtin_amdgcn_mfma_f32_32x32x16_bf16(vf[dt][s], pb[s], O[dt], 0, 0, 0);
}
template <int NK>
__device__ __forceinline__ void stage_kv(LAS unsigned char* Kimg, LAS unsigned char* Vimg, const bf16* Ksrc  , const bf16* VTf  ,
                                         long tokbase  , long key_lo  , long key_min  , int wave, int lane) {
    constexpr int KP = NK * 128 / 1024, VCH = NK / 8, VP = 64 * VCH * 16 / 1024;
    for (int p = wave; p < KP; p += 8) { const int L = p * 64 + lane, r = L >> 3, s = L & 7, c = s ^ ((r >> 1) & 7); long kr = key_lo + r; if (kr < key_min) kr = key_min;
        glds16(Ksrc + (kr - key_lo) * 128 + c * 8, Kimg + p * 1024); }
    for (int p = wave; p < VP; p += 8) { const int L = p * 64 + lane, d = L / VCH, s = L % VCH, c = s ^ (d & 15); long kc = key_lo + 8 * c; if (kc < key_min) kc = key_min; const long tok = tokbase + kc;
        glds16(VTf + ((tok >> 8) * 256 + d) * 256 + (tok & 255), Vimg + p * 1024); }
}
template <int NK>
__device__ __forceinline__ void load_kv_frags(bf16x8 (&kf)[4], bf16x8 (&vf)[2][2], const LAS unsigned char* Kimg, const LAS unsigned char* Vimg, int row0  , int lane) {
    const int r = row0 + pi32(lane & 31), h = lane >> 5;
#pragma unroll
    for (int ks = 0; ks < 4; ++ks) kf[ks] = *(const LAS bf16x8*)(Kimg + r * 128 + (((2 * ks + h) ^ ((r >> 1) & 7)) << 4));
#pragma unroll
    for (int dt = 0; dt < 2; ++dt) { const int d = 32 * dt + (lane & 31);
#pragma unroll
        for (int s = 0; s < 2; ++s) { const int c = (row0 >> 3) + 2 * s + h; vf[dt][s] = *(const LAS bf16x8*)(Vimg + d * (NK * 2) + ((c ^ (d & 15)) << 4)); } }
}
template <int NK>
__device__ __forceinline__ void load_k_frags(bf16x8 (&kf)[4], const LAS unsigned char* Kimg, int row0, int lane) {
    const int r = row0 + pi32(lane & 31), h = lane >> 5;
#pragma unroll
    for (int ks = 0; ks < 4; ++ks) kf[ks] = *(const LAS bf16x8*)(Kimg + r * 128 + (((2 * ks + h) ^ ((r >> 1) & 7)) << 4));
}
template <int NK>
__device__ __forceinline__ void load_v_frags(bf16x8 (&vf)[2][2], const LAS unsigned char* Vimg, int row0, int lane) {
    const int h = lane >> 5;
#pragma unroll
    for (int dt = 0; dt < 2; ++dt) { const int d = 32 * dt + (lane & 31);
#pragma unroll
        for (int s = 0; s < 2; ++s) { const int c = (row0 >> 3) + 2 * s + h; vf[dt][s] = *(const LAS bf16x8*)(Vimg + d * (NK * 2) + ((c ^ (d & 15)) << 4)); } }
}
__device__ __forceinline__ f32x16 qk_tile(const bf16x8 (&kf)[4], const bf16x8 (&qf)[4], const f32x16& cv) {
    f32x16 S = __builtin_amdgcn_mfma_f32_32x32x16_bf16(kf[0], qf[0], cv, 0, 0, 0);
#pragma unroll
    for (int ks = 1; ks < 4; ++ks) S = __builtin_amdgcn_mfma_f32_32x32x16_bf16(kf[ks], qf[ks], S, 0, 0, 0);
    return S;
}
template <int MODE>
__device__ __forceinline__ void softmax_pv(f32x16& S, const bf16x8 (&vf)[2][2], float& l, f32x16 (&O)[2], int a, int h) {
    if (MODE != 0) {
#pragma unroll
        for (int i = 0; i < 16; ++i) { const int c = pi32((i & 3) + 8 * (i >> 2) + 4 * h); const bool dead = (MODE == 1) ? (c > a) : (c <= a); if (dead) S[i] = -1e30f; }
    }
    float s0 = 0.f, s1 = 0.f;
#pragma unroll
    for (int i = 0; i < 16; i += 2) { S[i] = __builtin_amdgcn_exp2f(S[i]); S[i + 1] = __builtin_amdgcn_exp2f(S[i + 1]); s0 += S[i]; s1 += S[i + 1]; }
    l += s0 + s1;
    bf16x8 pb[2];
#pragma unroll
    for (int s = 0; s < 2; ++s) { u32x4 w; w.x = pk2(S[8 * s], S[8 * s + 1]); w.y = pk2(S[8 * s + 2], S[8 * s + 3]); w.z = pk2(S[8 * s + 4], S[8 * s + 5]); w.w = pk2(S[8 * s + 6], S[8 * s + 7]); pb[s] = __builtin_bit_cast(bf16x8, w); }
#pragma unroll
    for (int dt = 0; dt < 2; ++dt)
#pragma unroll
        for (int s = 0; s < 2; ++s) O[dt] = __builtin_amdgcn_mfma_f32_32x32x16_bf16(vf[dt][s], pb[s], O[dt], 0, 0, 0);
}
template <int NK, int N, int MFIRST, int MLAST>
__device__ __forceinline__ void attn_run(const LAS unsigned char* Kimg, const LAS unsigned char* Vimg, int row0, const bf16x8 (&qf)[4], const f32x16& cv, float& l, f32x16 (&O)[2], int lane) {
    const int a = lane & 31, h = lane >> 5;
    bf16x8 kf[4], vfa[2][2], vfb[2][2];
    load_k_frags<NK>(kf, Kimg, row0, lane); load_v_frags<NK>(vfa, Vimg, row0, lane);
    f32x16 S = qk_tile(kf, qf, cv);
#pragma unroll
    for (int t = 0; t < N; ++t) {
        f32x16 Sn;
        if (t + 1 < N) { load_k_frags<NK>(kf, Kimg, row0 + 32 * (t + 1), lane); if (t & 1) load_v_frags<NK>(vfa, Vimg, row0 + 32 * (t + 1), lane); else load_v_frags<NK>(vfb, Vimg, row0 + 32 * (t + 1), lane);
            Sn = qk_tile(kf, qf, cv); }
        if (t == 0 && MFIRST != 0) { if (t & 1) softmax_pv<MFIRST>(S, vfb, l, O, a, h); else softmax_pv<MFIRST>(S, vfa, l, O, a, h); }
        else if (t == N - 1 && MLAST != 0) { if (t & 1) softmax_pv<MLAST>(S, vfb, l, O, a, h); else softmax_pv<MLAST>(S, vfa, l, O, a, h); }
        else { if (t & 1) softmax_pv<0>(S, vfb, l, O, a, h); else softmax_pv<0>(S, vfa, l, O, a, h); }
        if (t + 1 < N) S = Sn;
    }
}
template <int NK, int PVAR>
__device__ __forceinline__ void attn_run8(const LAS unsigned char* Kimg, const LAS unsigned char* Vimg, const bf16x8 (&qf)[4], const f32x16& cv, float& l, f32x16 (&O)[2], int lane) {
    const int a = lane & 31, h = lane >> 5;
    bf16x8 kf[4], vfa[2][2], vfb[2][2];
    load_k_frags<NK>(kf, Kimg, 0, lane); load_v_frags<NK>(vfa, Vimg, 0, lane);
    if (PVAR == 4) load_v_frags<NK>(vfb, Vimg, 32, lane);
#define QKT() ((PVAR == 5) ? cv : qk_tile(kf, qf, cv))
#define SMPV(S_, vf_) do { if (PVAR == 3) { bf16x8 pb[2]; _Pragma("unroll") for (int s = 0; s < 2; ++s) { u32x4 w; w.x = pk2(S_[8 * s], S_[8 * s + 1]); w.y = pk2(S_[8 * s + 2], S_[8 * s + 3]); w.z = pk2(S_[8 * s + 4], S_[8 * s + 5]); w.w = pk2(S_[8 * s + 6], S_[8 * s + 7]); pb[s] = __builtin_bit_cast(bf16x8, w); } \
        _Pragma("unroll") for (int dt = 0; dt < 2; ++dt) _Pragma("unroll") for (int s = 0; s < 2; ++s) O[dt] = __builtin_amdgcn_mfma_f32_32x32x16_bf16(vf_[dt][s], pb[s], O[dt], 0, 0, 0); } \
      else if (PVAR == 6) { _Pragma("unroll") for (int i = 0; i < 16; ++i) { l += __builtin_amdgcn_exp2f(S_[i]); } asm volatile("" :: "v"(vf_[0][0]), "v"(vf_[1][1])); } \
      else softmax_pv<0>(S_, vf_, l, O, a, h); } while (0)
    f32x16 S = QKT();
#pragma unroll 1
    for (int j = 0; j < 3; ++j) {
        { if (PVAR != 4) { load_k_frags<NK>(kf, Kimg, 64 * j + 32, lane); load_v_frags<NK>(vfb, Vimg, 64 * j + 32, lane); } f32x16 Sn = QKT(); SMPV(S, vfa); S = Sn; }
        { if (PVAR != 4) { load_k_frags<NK>(kf, Kimg, 64 * j + 64, lane); load_v_frags<NK>(vfa, Vimg, 64 * j + 64, lane); } f32x16 Sn = QKT(); SMPV(S, vfb); S = Sn; }
    }
    { if (PVAR != 4) { load_k_frags<NK>(kf, Kimg, 224, lane); load_v_frags<NK>(vfb, Vimg, 224, lane); } f32x16 Sn = QKT(); SMPV(S, vfa); S = Sn; }
    SMPV(S, vfb);
#undef QKT
#undef SMPV
}
template <int NK>
__device__ __forceinline__ void attn_run_own(const LAS unsigned char* Kimg, const LAS unsigned char* Vimg, int w, const bf16x8 (&qf)[4], const f32x16& cv, float& l, f32x16 (&O)[2], int lane) {
    const int a = lane & 31, h = lane >> 5;
    bf16x8 kf[4], vfa[2][2], vfb[2][2];
    load_k_frags<NK>(kf, Kimg, 0, lane); load_v_frags<NK>(vfa, Vimg, 0, lane);
    f32x16 S = qk_tile(kf, qf, cv);
    int t = 0;
#pragma unroll 1
    for (; t + 2 <= w; t += 2) {
        { load_k_frags<NK>(kf, Kimg, 32 * t + 32, lane); load_v_frags<NK>(vfb, Vimg, 32 * t + 32, lane); f32x16 Sn = qk_tile(kf, qf, cv); softmax_pv<0>(S, vfa, l, O, a, h); S = Sn; }
        { load_k_frags<NK>(kf, Kimg, 32 * t + 64, lane); load_v_frags<NK>(vfa, Vimg, 32 * t + 64, lane); f32x16 Sn = qk_tile(kf, qf, cv); softmax_pv<0>(S, vfb, l, O, a, h); S = Sn; }
    }
    if (t < w) { load_k_frags<NK>(kf, Kimg, 32 * t + 32, lane); load_v_frags<NK>(vfb, Vimg, 32 * t + 32, lane); f32x16 Sn = qk_tile(kf, qf, cv); softmax_pv<0>(S, vfa, l, O, a, h); softmax_pv<1>(Sn, vfb, l, O, a, h); }
    else softmax_pv<1>(S, vfa, l, O, a, h);
}
__device__ __forceinline__ void attn_store(const f32x16 (&O)[2], float l, const bf16* gate  , bf16* y  , int h) {
    u32x2 gv[2][4];
#pragma unroll
    for (int dt = 0; dt < 2; ++dt)
#pragma unroll
        for (int q = 0; q < 4; ++q) gv[dt][q] = *(const u32x2*)(gate + 32 * dt + 8 * q + 4 * h);
    const float inv = 1.f / swap32_sum(l);
#pragma unroll
    for (int dt = 0; dt < 2; ++dt)
#pragma unroll
        for (int q = 0; q < 4; ++q) { const int d = 32 * dt + 8 * q + 4 * h; const u32x2 g2 = gv[dt][q];
            u32x2 w; w.x = pk2(O[dt][4 * q] * inv * bflo(g2.x), O[dt][4 * q + 1] * inv * bfhi(g2.x)); w.y = pk2(O[dt][4 * q + 2] * inv * bflo(g2.y), O[dt][4 * q + 3] * inv * bfhi(g2.y));
            *(u32x2*)(y + d) = w; }
}

template <int VAR>
__device__ __forceinline__ void moba_unit(Frame& F, int b, int kvh, int qb, int g) {
    constexpr int IMG = 32768;
    LAS unsigned char* buf0 = F.lds; LAS unsigned char* buf1 = F.lds + 2 * IMG;
    LAS float* km = (LAS float*)(F.lds + LDS_MISC + 1024);
    const int lane = F.lane, wave = F.wave, a = lane & 31, h = lane >> 5;
    const long tok0 = (long)b * SEQ + 256 * qb;
    const bf16* Kb = ((bf16*)(F.ws + WS_MK)) + (size_t)b * SEQ * 128 + kvh * 64;
    const bf16* Vb = ((bf16*)(F.ws + WS_VT)) + (size_t)(128 + kvh * 64) * 256; const long tokb = (long)b * SEQ;
    unsigned kvoff[4], vvoff[4];
#pragma unroll
    for (int i = 0; i < 4; ++i) { const int L = (wave + 8 * i) * 64 + lane; { const int r = L >> 3, s = L & 7, c = s ^ ((r >> 1) & 7); kvoff[i] = (unsigned)(r * 128 + c * 8) * 2u; }
        { const int d = L >> 5, s = L & 31, c = s ^ (d & 15); vvoff[i] = (unsigned)(d * 256 + 8 * c) * 2u; } }
    const char* Kbytes = (const char*)Kb; const char* Vbytes = (const char*)(Vb + (size_t)(tokb >> 8) * 65536);
#define MOBA_STAGE(dstK, blk) do { _Pragma("unroll") for (int i_ = 0; i_ < 4; ++i_) { glds16(Kbytes + (size_t)(blk) * 65536 + kvoff[i_], (dstK) + (wave + 8 * i_) * 1024); \
        glds16(Vbytes + (size_t)(blk) * 131072 + vvoff[i_], (dstK) + IMG + (wave + 8 * i_) * 1024); } } while (0)
    if (VAR != 1) MOBA_STAGE(buf0, qb);
    { const int n = F.tid >> 6, d = F.tid & 63; float s = 0.f;
      if (n < qb) { const int tile = b * 8 + n; s = ((float*)(F.ws + WS_KPART))[((size_t)(tile * 2 + 0) * 2 + kvh) * 64 + d] + ((float*)(F.ws + WS_KPART))[((size_t)(tile * 2 + 1) * 2 + kvh) * 64 + d]; }
      km[n * 64 + d] = s; }
    const size_t row = (size_t)(tok0 + 32 * wave + a);
    const bf16* qp = ((bf16*)(F.ws + WS_MQ)) + row * 384 + kvh * 192 + 8 * h;
    GLDS_WAIT(); __syncthreads();
    unsigned selmask = (VAR == 8) ? 0x7fu : 0u;
    if (qb > 0 && VAR != 8) {
        float sc[8];
#pragma unroll
        for (int n = 0; n < 8; ++n) sc[n] = 0.f;
#pragma unroll
        for (int ks = 0; ks < 4; ++ks) { const bf16x8 q0 = *(const bf16x8*)(qp + 16 * ks), q1 = *(const bf16x8*)(qp + 64 + 16 * ks), q2 = *(const bf16x8*)(qp + 128 + 16 * ks);
#pragma unroll
            for (int j = 0; j < 8; ++j) { const float qs = bf2f((unsigned short)q0[j]) + bf2f((unsigned short)q1[j]) + bf2f((unsigned short)q2[j]); const int d = 16 * ks + 8 * h + j;
#pragma unroll
                for (int n = 0; n < 7; ++n) sc[n] += qs * km[n * 64 + d]; } }
#pragma unroll
        for (int n = 0; n < 7; ++n) { sc[n] = swap32_sum(sc[n]); if (n >= qb) sc[n] = -INFINITY; }
#pragma unroll
        for (int t = 0; t < 3; ++t) { float best = -INFINITY; int bi = -1;
#pragma unroll
            for (int n = 0; n < 7; ++n) if (sc[n] > best) { best = sc[n]; bi = n; }
            if (bi >= 0) { selmask |= 1u << bi;
#pragma unroll
                for (int n = 0; n < 7; ++n) if (n == bi) sc[n] = -INFINITY; } }
    }
    float l = 0.f; f32x16 O[2]; bf16x8 qf[4];
#pragma unroll
    for (int i = 0; i < 16; ++i) { O[0][i] = 0.f; O[1][i] = 0.f; }
#pragma unroll
    for (int ks = 0; ks < 4; ++ks) qf[ks] = *(const bf16x8*)(qp + g * 64 + 16 * ks);
    asm volatile("" : "+v"(qf[0]), "+v"(qf[1]), "+v"(qf[2]), "+v"(qf[3]));
#pragma unroll 1
    for (int s = 0; s <= qb; ++s) {
        LAS unsigned char* cur = (s & 1) ? buf1 : buf0; LAS unsigned char* nxt = (s & 1) ? buf0 : buf1;
        if (s < qb && VAR != 1) MOBA_STAGE(nxt, s);
        if (VAR == 2) {} else if (s == 0) { if (VAR != 7) {
            f32x16 cv;
#pragma unroll
            for (int i = 0; i < 16; ++i) cv[i] = 0.f;
            attn_run_own<256>(cur, cur + IMG, wave, qf, cv, l, O, lane);
        } } else if (VAR != 9) {
            const float cinit = ((selmask >> (s - 1)) & 1u) ? 0.f : -1e30f;
            if (__any(cinit == 0.f)) {
                f32x16 cv;
#pragma unroll
                for (int i = 0; i < 16; ++i) cv[i] = cinit;
                attn_run8<256, (VAR >= 3 ? VAR : 0)>(cur, cur + IMG, qf, cv, l, O, lane);
            }
        }
        GLDS_WAIT(); __syncthreads();
    }
    attn_store(O, l, ((bf16*)(F.ws + WS_MG)) + row * 384 + (kvh * 3 + g) * 64, ((bf16*)(F.ws + (VAR ? WS_END : WS_Y))) + row * DM + 640 + (kvh * 3 + g) * 64, h);
#undef MOBA_STAGE
}

__device__ __forceinline__ void swa_unit(const Params& P, Frame& F, int layer, int b, int kvh, int qblk) {
    constexpr int NK = 384;
    LAS unsigned char* Kimg = F.lds; LAS unsigned char* Vimg = F.lds + NK * 128;
    const int lane = F.lane, wave = F.wave, a = lane & 31, h = lane >> 5;
    const int q0 = 256 * qblk; const long tok0 = (long)b * SEQ + q0;
    const bf16* Kb = ((bf16*)(F.ws + WS_AK)) + ((long)b * SEQ + q0 - 128) * 128 + kvh * 64;
    const bf16* Vb = ((bf16*)(F.ws + WS_VT)) + (size_t)(kvh * 64) * 256;
    stage_kv<NK>(Kimg, Vimg, Kb, Vb, (long)b * SEQ, (long)q0 - 128, 0, wave, lane);
    const size_t row = (size_t)(tok0 + 32 * wave + a);
    const bf16* qp = ((bf16*)(F.ws + WS_AQ)) + row * 384 + kvh * 192 + 8 * h;
    f32x16 cv;
#pragma unroll
    for (int i = 0; i < 16; ++i) cv[i] = 0.f;
    const bool head = (q0 - 128 + 32 * wave) >= 0;
    bf16x8 qfa[3][4]; float sink[3];
#pragma unroll
    for (int g = 0; g < 3; ++g) { sink[g] = kin(15)[layer * 6 + kvh * 3 + g];
#pragma unroll
        for (int ks = 0; ks < 4; ++ks) qfa[g][ks] = *(const bf16x8*)(qp + g * 64 + 16 * ks); }
    asm volatile("" : "+v"(qfa[0][0]), "+v"(qfa[0][1]), "+v"(qfa[0][2]), "+v"(qfa[0][3]), "+v"(qfa[1][0]), "+v"(qfa[1][1]), "+v"(qfa[1][2]), "+v"(qfa[1][3]), "+v"(qfa[2][0]), "+v"(qfa[2][1]), "+v"(qfa[2][2]), "+v"(qfa[2][3]));
    GLDS_WAIT(); __syncthreads();
#pragma unroll
    for (int g = 0; g < 3; ++g) {
        bf16x8 qf[4];
#pragma unroll
        for (int ks = 0; ks < 4; ++ks) qf[ks] = qfa[g][ks];
        float l = 0.5f * __builtin_amdgcn_exp2f(sink[g] * LOG2E);
        f32x16 O[2];
#pragma unroll
        for (int i = 0; i < 16; ++i) { O[0][i] = 0.f; O[1][i] = 0.f; }
        const int r0 = 32 * wave;
        if (head) attn_run<NK, 5, 2, 1>(Kimg, Vimg, r0, qf, cv, l, O, lane);
        else {
#pragma unroll 1
            for (int kt = 4 - wave; kt < 4; ++kt) { bf16x8 kfa[4], vfa[2][2]; load_kv_frags<NK>(kfa, vfa, Kimg, Vimg, r0 + 32 * kt, lane); attn_tile<0>(kfa, vfa, qf, cv, l, O, a, h); }
            { bf16x8 kfa[4], vfa[2][2]; load_kv_frags<NK>(kfa, vfa, Kimg, Vimg, r0 + 128, lane); attn_tile<1>(kfa, vfa, qf, cv, l, O, a, h); }
        }
        attn_store(O, l, ((bf16*)(F.ws + WS_AG)) + row * 384 + (kvh * 3 + g) * 64, ((bf16*)(F.ws + WS_Y)) + row * DM + 256 + (kvh * 3 + g) * 64, h);
    }
    __syncthreads();
}

__device__ __forceinline__ void ssm_unit(Frame& F, int layer, int b, int g) {
    constexpr int APITCH = 528;
    LAS unsigned char* AU = F.lds;
    LAS unsigned char* SC = F.lds + 128 * APITCH;
    LAS float* seg = (LAS float*)(F.lds + 2 * 128 * APITCH);
    const int lane = F.lane, wave = F.wave, tid = F.tid, fr = lane & 15, fq = lane >> 4;
    const int pair = layer * 16 + g;
    const bf16* TE = ((bf16*)(F.ws + WS_TE)) + (size_t)pair * TE_ELEMS; const bf16* GM = ((bf16*)(F.ws + WS_G)) + (size_t)pair * G_ELEMS;
    u32x4 uv[8];
    { const bf16* up = ((bf16*)(F.ws + WS_U)) + (size_t)(b * 16 + g) * SEQ * 16;
#pragma unroll
      for (int i = 0; i < 8; ++i) { const int idx = tid + 512 * i; uv[i] = *(const u32x4*)(up + (size_t)idx * 8); } }
    bf16x8 gf[8];
#pragma unroll
    for (int ks = 0; ks < 8; ++ks) gf[ks] = *(const bf16x8*)(GM + (size_t)(16 * wave + fr) * 256 + 32 * ks + 8 * fq);
    const float ar = ((float*)(F.ws + WS_AT))[(size_t)pair * 128 + 2 * lane], ai = ((float*)(F.ws + WS_AT))[(size_t)pair * 128 + 2 * lane + 1];
    bf16x8 tfu[2][8], tfc[2][4];
#pragma unroll
    for (int half = 0; half < 2; ++half) { const int i = half ? 15 - wave : wave, nks = (i >> 1) + 1; const bf16* tp = TE + (size_t)(16 * i + fr) * 384 + 8 * fq;
#pragma unroll
        for (int ks = 0; ks < 8; ++ks) tfu[half][ks] = *(const bf16x8*)(tp + 32 * (ks < nks ? ks : 0));
#pragma unroll
        for (int ks = 0; ks < 4; ++ks) tfc[half][ks] = *(const bf16x8*)(tp + 256 + 32 * ks); }
#pragma unroll
    for (int i = 0; i < 8; ++i) { const int idx = tid + 512 * i, t = idx >> 1, hf = idx & 1; *(LAS u32x4*)(AU + (t >> 4) * APITCH + ((t & 15) * 16 + 8 * hf) * 2) = uv[i]; }
    __syncthreads();
    {
#pragma unroll
        for (int rt = 0; rt < 8; ++rt) { f32x4 acc = {0.f, 0.f, 0.f, 0.f};
#pragma unroll
            for (int ks = 0; ks < 8; ++ks) { const bf16x8 af = *(const LAS bf16x8*)(AU + (16 * rt + fr) * APITCH + (32 * ks + 8 * fq) * 2); acc = __builtin_amdgcn_mfma_f32_16x16x32_bf16(gf[ks], af, acc, 0, 0, 0); }
            *(LAS f32x4*)(SC + (16 * rt + fr) * APITCH + (16 * wave + 4 * fq) * 4) = acc; }
    }
    __syncthreads();
    {
        float lr = 0.f, li = 0.f, locr[16], loci[16];
#pragma unroll
        for (int k = 0; k < 16; ++k) { locr[k] = lr; loci[k] = li; const f32x2_t s = *(const LAS f32x2_t*)(SC + (16 * wave + k) * APITCH + lane * 8);
            const float nr = ar * lr - ai * li + s.x, ni = ar * li + ai * lr + s.y; lr = nr; li = ni; }
        seg[(wave * 64 + lane) * 2] = lr; seg[(wave * 64 + lane) * 2 + 1] = li;
        __syncthreads();
        float a16r = ar, a16i = ai;
#pragma unroll
        for (int q = 0; q < 4; ++q) { const float tr = a16r * a16r - a16i * a16i, ti = 2.f * a16r * a16i; a16r = tr; a16i = ti; }
        float ir = 0.f, ii = 0.f;
        for (int w2 = 0; w2 < wave; ++w2) { const float sr = seg[(w2 * 64 + lane) * 2], si = seg[(w2 * 64 + lane) * 2 + 1]; const float nr = a16r * ir - a16i * ii + sr, ni = a16r * ii + a16i * ir + si; ir = nr; ii = ni; }
        float pr = 1.f, pi = 0.f;
#pragma unroll
        for (int k = 0; k < 16; ++k) { const float cr = locr[k] + pr * ir - pi * ii, ci = loci[k] + pr * ii + pi * ir;
            *(LAS unsigned*)(SC + (16 * wave + k) * APITCH + lane * 4) = pk2(cr, ci);
            const float tr = pr * ar - pi * ai, ti = pr * ai + pi * ar; pr = tr; pi = ti; }
    }
    __syncthreads();
#pragma unroll
    for (int half = 0; half < 2; ++half) {
        const int i = half ? 15 - wave : wave;
        f32x4 acc[8];
#pragma unroll
        for (int rt = 0; rt < 8; ++rt) acc[rt] = (f32x4){0.f, 0.f, 0.f, 0.f};
        const int nks = (i >> 1) + 1;
#pragma unroll
        for (int ks = 0; ks < 8; ++ks) { if (ks < nks) {
#pragma unroll
            for (int rt = 0; rt < 8; ++rt) { const bf16x8 af = *(const LAS bf16x8*)(AU + (16 * rt + fr) * APITCH + (32 * ks + 8 * fq) * 2); acc[rt] = __builtin_amdgcn_mfma_f32_16x16x32_bf16(tfu[half][ks], af, acc[rt], 0, 0, 0); } } }
#pragma unroll
        for (int ks = 0; ks < 4; ++ks) {
#pragma unroll
            for (int rt = 0; rt < 8; ++rt) { const bf16x8 af = *(const LAS bf16x8*)(SC + (16 * rt + fr) * APITCH + (32 * ks + 8 * fq) * 2); acc[rt] = __builtin_amdgcn_mfma_f32_16x16x32_bf16(tfc[half][ks], af, acc[rt], 0, 0, 0); } }
#pragma unroll
        for (int rt = 0; rt < 8; ++rt) { const int chunk = 16 * rt + fr; u32x2 w; w.x = pk2(gelu_tanh_f(acc[rt][0]), gelu_tanh_f(acc[rt][1])); w.y = pk2(gelu_tanh_f(acc[rt][2]), gelu_tanh_f(acc[rt][3]));
            __hip_atomic_store((unsigned long long*)(((bf16*)(F.ws + WS_YPRE)) + ((size_t)(b * 16 + g) * SEQ + 16 * chunk + i) * 16 + 4 * fq), ((unsigned long long)w.y << 32) | w.x, __ATOMIC_RELAXED, __HIP_MEMORY_SCOPE_AGENT); }
    }
    asm volatile("s_waitcnt vmcnt(0)" ::: "memory");
    __syncthreads();
    if (tid == 0) __hip_atomic_fetch_add(F.ctl + CW_SSMDONE + 64 * (layer * NB + b), 1u, __ATOMIC_RELAXED, __HIP_MEMORY_SCOPE_AGENT);
}

__device__ __forceinline__ void glu_unit(const Params& P, Frame& F, int layer, int b, int j) {
    constexpr int APITCH = 528;
    LAS unsigned char* AT_ = F.lds;
    const int lane = F.lane, wave = F.wave, tid = F.tid, fr = lane & 15, fq = lane >> 4;
    const size_t tok0 = (size_t)b * SEQ + 128 * j;
    const bf16* wp = ((bf16*)(F.ws + WS_GLU)) + (size_t)layer * 65536 + (size_t)(32 * wave + fr) * 256 + 8 * fq;
    bf16x8 wf[8][2];
#pragma unroll
    for (int ks = 0; ks < 8; ++ks) { wf[ks][0] = *(const bf16x8*)(wp + 32 * ks); wf[ks][1] = *(const bf16x8*)(wp + 16 * 256 + 32 * ks); }
    if (tid == 0) { unsigned* c = F.ctl + CW_SSMDONE + 64 * (layer * NB + b); unsigned sp = 0;
        while (__hip_atomic_load(c, __ATOMIC_RELAXED, __HIP_MEMORY_SCOPE_AGENT) < 16u) { __builtin_amdgcn_s_sleep(2); if (++sp > (1u << 22)) break; }
        __builtin_amdgcn_fence(__ATOMIC_ACQUIRE, "agent"); asm volatile("s_waitcnt vmcnt(0)" ::: "memory"); }
    __syncthreads();
    { const bf16* yp = ((bf16*)(F.ws + WS_YPRE)) + ((size_t)b * 16 * SEQ + 128 * j) * 16;
#pragma unroll
      for (int i = 0; i < 8; ++i) { const int idx = tid + 512 * i, c = idx >> 7, t = idx & 127; const u32x4 v = *(const u32x4*)(yp + ((size_t)(c >> 1) * SEQ + t) * 16 + 8 * (c & 1)); *(LAS u32x4*)(AT_ + t * APITCH + c * 16) = v; } }
    f32x4 acc[8][2];
#pragma unroll
    for (int rt = 0; rt < 8; ++rt) { acc[rt][0] = (f32x4){0.f, 0.f, 0.f, 0.f}; acc[rt][1] = (f32x4){0.f, 0.f, 0.f, 0.f}; }
    __syncthreads();
    u32x2 sgv[2][8];
#pragma unroll
    for (int nt = 0; nt < 2; ++nt)
#pragma unroll
        for (int rt = 0; rt < 8; ++rt) sgv[nt][rt] = *(const u32x2*)(((bf16*)(F.ws + WS_SG)) + (tok0 + 16 * rt + fr) * 256 + 32 * wave + 16 * nt + 4 * fq);
#pragma unroll
    for (int ks = 0; ks < 8; ++ks)
#pragma unroll
        for (int rt = 0; rt < 8; ++rt) { const bf16x8 af = *(const LAS bf16x8*)(AT_ + (16 * rt + fr) * APITCH + (32 * ks + 8 * fq) * 2);
            acc[rt][0] = __builtin_amdgcn_mfma_f32_16x16x32_bf16(wf[ks][0], af, acc[rt][0], 0, 0, 0); acc[rt][1] = __builtin_amdgcn_mfma_f32_16x16x32_bf16(wf[ks][1], af, acc[rt][1], 0, 0, 0); }
    const float* gb = kin(12) + layer * 256;
#pragma unroll
    for (int nt = 0; nt < 2; ++nt) { const int n0 = 32 * wave + 16 * nt + 4 * fq; const f32x4 bv = *(const f32x4*)(gb + n0);
#pragma unroll
        for (int rt = 0; rt < 8; ++rt) { const int t = 16 * rt + fr; const u32x2 yp = *(const LAS u32x2*)(AT_ + t * APITCH + n0 * 2); const u32x2 sg = sgv[nt][rt];
            const f32x4 z = acc[rt][nt] + bv; u32x2 w;
            w.x = pk2(bflo(yp.x) * sigmoid_f(z[0]) * bflo(sg.x), bfhi(yp.x) * sigmoid_f(z[1]) * bfhi(sg.x));
            w.y = pk2(bflo(yp.y) * sigmoid_f(z[2]) * bflo(sg.y), bfhi(yp.y) * sigmoid_f(z[3]) * bfhi(sg.y));
            *(u32x2*)(((bf16*)(F.ws + WS_Y)) + (tok0 + t) * DM + n0) = w; } }
    __syncthreads();
}

__device__ __forceinline__ void mixer_phase(const Params& P, Frame& F, int qslot, int layer, int mask) {
    volatile LAS int* qw = (volatile LAS int*)(F.lds + LDS_CTL);
    unsigned* head = F.ctl + CW_QUEUE + 64 * qslot;
    for (;;) {
        if (F.tid == 0) qw[0] = (int)atomicAdd(head, 1u);
        __syncthreads();
        const int it = qw[0];
        __syncthreads();
        if (it >= 1536) break;
        Frame Fu = phase_frame(F);
#ifndef NO_MOBA
        if (it < 768 && (mask & 1)) { const int qb = 7 - it / 96, r = it % 96, b = r / 6, kvh = (r % 6) / 3, g = r % 3;
            if (mask & 8) moba_unit<1>(Fu, b, kvh, qb, g); else if (mask & 16) moba_unit<2>(Fu, b, kvh, qb, g);
#ifdef MOBA_PVAR
            else if (mask & 64) moba_unit<MOBA_PVAR>(Fu, b, kvh, qb, g);
#endif
            else moba_unit<0>(Fu, b, kvh, qb, g); }
#endif
#ifndef NO_SSM
        if (it >= 768 && it < 1024 && (mask & 2)) { const int r = it - 768; ssm_unit(Fu, layer, r >> 4, r & 15); }
#endif
#ifndef NO_SWA
        if (it >= 1024 && it < 1280 && (mask & 4)) { const int r = it - 1024; swa_unit(P, Fu, layer, r >> 4, (r >> 3) & 1, r & 7); }
#endif
        if (it >= 1280 && (mask & 32)) { const int r = it - 1280; glu_unit(P, Fu, layer, r >> 4, r & 15); }
    }
}

#define XB_TMO      128
#define XB_XCNT(j)  (256  + 64 * (j))
#define XB_XSUB(j)  (1280 + 64 * (j))
#define XB_XGEN(j)  (2304 + 64 * (j))
#define XB_TOP      3328
#define XB_TOPGEN   3392
#define XCD_BAR_WORDS 3456
#define XB_SPIN_CAP (1u << 18)

__device__ __forceinline__ unsigned xb_ld(unsigned* p)              { return __hip_atomic_load(p, __ATOMIC_RELAXED, __HIP_MEMORY_SCOPE_AGENT); }
__device__ __forceinline__ unsigned xb_add(unsigned* p, unsigned v) { return __hip_atomic_fetch_add(p, v, __ATOMIC_RELAXED, __HIP_MEMORY_SCOPE_AGENT); }
__device__ __forceinline__ unsigned xb_xcc_id() { return (unsigned)__builtin_amdgcn_s_getreg((3 << 11) | 20) & 0xFu; }
#define XB_SPIN(cond, bar) do { unsigned _sp = 0; while (cond) { __builtin_amdgcn_s_sleep(1); \
    if ((++_sp & 255u) == 0u) { if (xb_ld(&(bar)[XB_TMO])) break; if (_sp > XB_SPIN_CAP) { atomicAdd(&(bar)[XB_TMO], 1u); break; } } } } while (0)

struct XcdBarrier {
    unsigned* bar; unsigned x;
    volatile LAS unsigned* st;
};

__device__ __forceinline__ XcdBarrier xcd_barrier_post(unsigned* bar, volatile LAS unsigned* st) {
    XcdBarrier b; b.bar = bar; b.x = xb_xcc_id(); b.st = st;
    if (threadIdx.x == 0) (void)xb_add(&bar[XB_XCNT(b.x)], 1u);
    return b;
}
__device__ __forceinline__ void xcd_barrier_complete(unsigned* bar, unsigned x, unsigned& nloc, unsigned& nx) {
    const unsigned G = gridDim.x * gridDim.y * gridDim.z;
    unsigned sum, cnt, mine, sp = 0u;
    for (;;) {
        sum = 0u; cnt = 0u; mine = 0u;
#pragma unroll 1
        for (unsigned j = 0; j < 16; ++j) { const unsigned c = xb_ld(&bar[XB_XCNT(j)]); sum += c; cnt += (c > 0u) ? 1u : 0u; mine = (j == x) ? c : mine; }
        if (sum == G) break;
        __builtin_amdgcn_s_sleep(1);
        if ((++sp & 255u) == 0u) { if (xb_ld(&bar[XB_TMO])) break; if (sp > XB_SPIN_CAP) { atomicAdd(&bar[XB_TMO], 1u); break; } }
    }
    nloc = mine > 0u ? mine : 1u; nx = cnt > 0u ? cnt : 1u;
}

__device__ __forceinline__ void xcd_barrier(const XcdBarrier& b) {
    asm volatile("s_waitcnt vmcnt(0)" ::: "memory");
    __syncthreads();
    if (threadIdx.x == 0) {
        unsigned* bar = b.bar;
        __builtin_amdgcn_s_waitcnt(0);
        unsigned nloc = b.st[0], nx = b.st[1];
        if (nloc == 0u) { xcd_barrier_complete(bar, b.x, nloc, nx); b.st[0] = nloc; b.st[1] = nx; }
        const unsigned old = xb_add(&bar[XB_XSUB(b.x)], 1u);
        const unsigned gen = old / nloc;
        if (old + 1u == (gen + 1u) * nloc) {
            __builtin_amdgcn_fence(__ATOMIC_RELEASE, "agent");
            asm volatile("s_waitcnt vmcnt(0)" ::: "memory");
            const unsigned og = xb_add(&bar[XB_TOP], 1u);
            const unsigned tg = og / nx;
            if (og + 1u == (tg + 1u) * nx) xb_add(&bar[XB_TOPGEN], 1u);
            else XB_SPIN(xb_ld(&bar[XB_TOPGEN]) == tg, bar);
            __builtin_amdgcn_fence(__ATOMIC_ACQUIRE, "agent");
            xb_add(&bar[XB_XGEN(b.x)], 1u);
            asm volatile("s_waitcnt vmcnt(0)" ::: "memory");
        } else {
            XB_SPIN(xb_ld(&bar[XB_XGEN(b.x)]) == gen, bar);
            __builtin_amdgcn_fence(__ATOMIC_ACQUIRE, "agent");
            asm volatile("s_waitcnt vmcnt(0)" ::: "memory");
        }
    }
    __syncthreads();
}

constexpr int CW_BAR = 4096;
#ifndef USE_COOP_LAUNCH
#define USE_COOP_LAUNCH 0
#endif
#ifndef REP_P0
#define REP_P0 1
#endif
#ifndef REP_P1
#define REP_P1 1
#endif
#ifndef REP_MIX
#define REP_MIX 1
#endif
#ifndef REP_GLU
#define REP_GLU 1
#endif
#ifndef REP_P3L0
#define REP_P3L0 1
#endif
#ifndef REP_SYNC
#define REP_SYNC 1
#endif
#ifndef P3_PROBE_SKIP
#define P3_PROBE_SKIP 0
#endif
#ifndef MIX_EXTRA_MASK
#define MIX_EXTRA_MASK 39
#endif
#ifndef USE_CG_SYNC
#define USE_CG_SYNC 0
#endif
#define GRID_SYNC() do { for (int r_ = 0; r_ < REP_SYNC; ++r_) { if (USE_CG_SYNC) cg::this_grid().sync(); else xcd_barrier(xbar); } STAMP(); } while (0)
#ifdef PROBE_TS_A
#define STAMP() do { if (n_stamp == PROBE_TS_A) ts_a = __builtin_amdgcn_s_memrealtime(); if (n_stamp == PROBE_TS_B) ts_b = __builtin_amdgcn_s_memrealtime(); ++n_stamp; } while (0)
#else
#define STAMP() do {} while (0)
#endif
__global__ void __launch_bounds__(512, 2) mk_fwd(Params P) {
    extern __shared__ __attribute__((aligned(16))) unsigned char lds_raw[];
    Frame F;
    F.lds = (LAS unsigned char*)lds_raw; F.tid = threadIdx.x; F.lane = F.tid & 63; F.wave = __builtin_amdgcn_readfirstlane(F.tid >> 6); F.G = gridDim.x; F.bid = blockIdx.x;
    F.out = (float*)kin(19); F.ws = (unsigned char*)kin(20); F.ctl = (unsigned*)(F.ws + WS_CTL);
    if (F.tid < 128) ((LAS unsigned*)(F.lds + LDS_CTL))[F.tid] = 0u;
    __syncthreads();
    const XcdBarrier xbar = xcd_barrier_post(F.ctl + CW_BAR, (volatile LAS unsigned*)(F.lds + LDS_CTL + 16));

    int n_stamp = 0; unsigned long long ts_a = 0, ts_b = 0; (void)n_stamp; (void)ts_a; (void)ts_b;
    STAMP();
#ifndef NO_P0
    for (int rep = 0; rep < REP_P0; ++rep) { Frame Fp = phase_frame(F); p0_prologue(P, Fp); }
#endif
    GRID_SYNC();
#pragma unroll 1
    for (int layer = 0; layer < DEPTH; ++layer) {
#ifndef NO_P1
        for (int rep = 0; rep < REP_P1; ++rep) {
            Frame Fp = phase_frame(F);
            pg8::Gemm g{((bf16*)(Fp.ws + WS_Z)), ((bf16*)(Fp.ws + WS_Z)), ZROWS, ZROWS, DM}; const SchedTab S = make_sched<0>(Fp, NTT + 10 * layer);
            EpiProj E{NTT + 10 * layer, layer, Fp.ws};
            pg8::gemm_phase<EpiProj, SchedTab, true, true>(F.lds, g, S, E);
        }
#endif
        GRID_SYNC();
#ifndef NO_MIX
        for (int rep = 0; rep < REP_MIX; ++rep) { Frame Fp = phase_frame(F); mixer_phase(P, Fp, layer + 2 * rep, layer, rep ? MIX_EXTRA_MASK : 39); }
#endif
        GRID_SYNC();
#ifndef NO_P3
        {
            Frame Fp = phase_frame(F);
            pg8::Gemm g{((bf16*)(Fp.ws + WS_Y)), ((bf16*)(Fp.ws + WS_WOUT)) + (size_t)layer * DM * DM, MTOK, DM, DM}; const SchedTab S = make_sched<1>(Fp, 0);
            EpiOut E{kin(0), F.out, ((bf16*)(Fp.ws + WS_Z)), ((float*)(Fp.ws + WS_ROWSS)), layer + 1 < DEPTH ? 1 : 0, (LAS float*)(F.lds + LDS_MISC + 4096), 0};
            pg8::gemm_phase<EpiOut, SchedTab, true, true>(F.lds, g, S, E);
        }
#endif
        if (layer + 1 < DEPTH) GRID_SYNC();
    }
#ifdef PROBE_TS_A
    GRID_SYNC();
    if (blockIdx.x == 0) { const unsigned long long n = (ts_b - ts_a) * PROBE_TS_MULT / PROBE_TS_DIV; for (unsigned long long i = threadIdx.x; i < n; i += 512) F.out[i] += 0.08f; }
#endif
}

extern "C" void kernel_launch(void* const* d_in, const int* in_sizes, int n_in, void* d_out, int out_size, void* d_ws, size_t ws_size, hipStream_t stream) {
    static int grid = 0;
    if (grid == 0) {
        if (n_in != 19 || out_size != MTOK * DM || ws_size < WS_END) { fprintf(stderr, "kernel_launch: unexpected problem (n_in %d out %d ws %zu)\n", n_in, out_size, ws_size); grid = -1; return; }
        int dev = 0, cus = 0, per_cu = 0;
        (void)hipGetDevice(&dev);
        (void)hipDeviceGetAttribute(&cus, hipDeviceAttributeMultiprocessorCount, dev);
        (void)hipFuncSetAttribute((const void*)mk_fwd, hipFuncAttributeMaxDynamicSharedMemorySize, LDS_BYTES);
        (void)hipOccupancyMaxActiveBlocksPerMultiprocessor(&per_cu, (const void*)mk_fwd, 512, LDS_BYTES);
        if (per_cu < 1) { fprintf(stderr, "kernel_launch: occupancy query says %d blocks per CU\n", per_cu); per_cu = 1; }
        grid = cus;
    }
    if (grid < 0) return;
    (void)hipMemsetAsync((char*)d_ws + WS_CTL, 0, CTL_BYTES, stream);
    Params p{};
    for (int i = 0; i < 19; ++i) p.in[i] = (const float*)d_in[i];
    p.out = (float*)d_out; p.ws = (unsigned char*)d_ws;
#if USE_COOP_LAUNCH
    void* args[] = {&p};
    hipError_t e = hipLaunchCooperativeKernel((const void*)mk_fwd, dim3(grid), dim3(512), args, LDS_BYTES, stream);
    if (e != hipSuccess) fprintf(stderr, "cooperative launch failed: %s (grid %d)\n", hipGetErrorString(e), grid);
#else
    hipLaunchKernelGGL(mk_fwd, dim3(grid), dim3(512), LDS_BYTES, stream, p);
    const hipError_t e = hipPeekAtLastError();
    if (e != hipSuccess) fprintf(stderr, "launch failed: %s (grid %d)\n", hipGetErrorString(e), grid);
#endif
}
```
